# Optimizing an MI355X kernel written in HIP

```python
import jax, jax.numpy as jnp
from jax import lax
import numpy as np

D_MODEL = 1024
BATCH = 8
SEQ = 4096
DEPTH = 2

QBLOCK = 128
WINDOW = 128
EPS = 1e-6
ROPE_THETA = 10000.0
MLA_HEADS = D_MODEL // 128
MLA_Q_RANK = D_MODEL // 4
MLA_KV_RANK = D_MODEL // 8
MLA_NOPE = 64
MLA_ROPE = 32
MLA_V = 64
SWA_HEADS = D_MODEL // 128
SWA_KV_HEADS = SWA_HEADS // 4
SWA_HEAD_DIM = 64
FOX_HEADS = D_MODEL // 64
FOX_HEAD_DIM = 64
FOX_WIDTH = FOX_HEADS * FOX_HEAD_DIM
FORGET_BIAS_INIT = 2.0

EVEN_WIDTH = MLA_HEADS * MLA_V + SWA_HEADS * SWA_HEAD_DIM
EVEN_SPLITS = (MLA_Q_RANK, MLA_KV_RANK, MLA_ROPE, SWA_HEADS * SWA_HEAD_DIM,
               SWA_KV_HEADS * SWA_HEAD_DIM, SWA_KV_HEADS * SWA_HEAD_DIM, EVEN_WIDTH)
ODD_SPLITS = (FOX_WIDTH, FOX_WIDTH, FOX_WIDTH, FOX_HEADS, FOX_WIDTH)
N_EVEN = (DEPTH + 1) // 2
N_ODD = DEPTH // 2

kernel_name = "hybrid_mla_swa_fox_gated"


def rms_norm(x, g):
    xf = x.astype(jnp.float32)
    y = xf * lax.rsqrt(jnp.mean(xf * xf, axis=-1, keepdims=True) + EPS)
    return (y * g.astype(jnp.float32)).astype(x.dtype)


def split_cols(z, sizes):
    idx = [int(v) for v in np.cumsum(sizes)[:-1]]
    return jnp.split(z, idx, axis=-1)


def rope_angles(positions, dim):
    inv_freq = 1.0 / (ROPE_THETA ** (jnp.arange(0, dim, 2, dtype=jnp.float32) / dim))
    return positions.astype(jnp.float32)[..., None] * inv_freq


def apply_rope(x, ang):
    cos, sin = jnp.cos(ang), jnp.sin(ang)
    xf = x.astype(jnp.float32)
    x1, x2 = jnp.split(xf, 2, axis=-1)
    return jnp.concatenate([x1 * cos - x2 * sin, x2 * cos + x1 * sin], axis=-1).astype(x.dtype)


def alibi_slopes(n):
    return 2.0 ** (-8.0 * (jnp.arange(n, dtype=jnp.float32) + 1.0) / n)


def causal_block_attention(q, k, v, log_cum=None):
    B, S, H, Dk = q.shape
    Dv = v.shape[-1]
    nb = S // QBLOCK
    scale = Dk ** -0.5
    kpos = jnp.arange(S)
    lc_t = None if log_cum is None else jnp.transpose(log_cum, (0, 2, 1))

    def one_block(i):
        start = i * QBLOCK
        qi = lax.dynamic_slice_in_dim(q, start, QBLOCK, axis=1)
        s = jnp.einsum('bqhd,bkhd->bhqk', qi, k, preferred_element_type=jnp.float32) * scale
        if lc_t is not None:
            ci = lax.dynamic_slice_in_dim(lc_t, start, QBLOCK, axis=2)
            s = s + ci[..., :, None] - lc_t[..., None, :]
        qpos = start + jnp.arange(QBLOCK)
        mask = kpos[None, :] <= qpos[:, None]
        s = jnp.where(mask, s, -jnp.inf)
        p = jax.nn.softmax(s, axis=-1)
        return jnp.einsum('bhqk,bkhd->bqhd', p.astype(v.dtype), v)

    out = lax.map(one_block, jnp.arange(nb))
    return jnp.transpose(out, (1, 0, 2, 3, 4)).reshape(B, S, H, Dv)


def sliding_window_sink_attention(q, k, v, sinks, slopes):
    B, S, H, D = q.shape
    KV = k.shape[2]
    G = H // KV
    W = WINDOW
    nb = S // W
    qb = q.reshape(B, nb, W, KV, G, D)
    pad = ((0, 0), (W, 0), (0, 0), (0, 0))
    kp = jnp.pad(k, pad).reshape(B, nb + 1, W, KV, D)
    vp = jnp.pad(v, pad).reshape(B, nb + 1, W, KV, D)
    kb = jnp.concatenate([kp[:, :-1], kp[:, 1:]], axis=2)
    vb = jnp.concatenate([vp[:, :-1], vp[:, 1:]], axis=2)
    s = jnp.einsum('bnqkgd,bnckd->bnkgqc', qb, kb, preferred_element_type=jnp.float32) * (D ** -0.5)
    a = jnp.arange(W)[:, None]
    c = jnp.arange(2 * W)[None, :]
    dist = (W + a - c).astype(jnp.float32)
    blk = jnp.arange(nb)[:, None, None]
    valid = (dist >= 0) & (dist < W) & (blk * W + c[None] - W >= 0)
    s = s - slopes.reshape(KV, G)[:, :, None, None] * dist
    s = jnp.where(valid[None, :, None, None], s, -jnp.inf)
    sink = sinks.astype(jnp.float32).reshape(KV, G)[:, :, None, None]
    m = jnp.maximum(jnp.max(s, axis=-1, keepdims=True), sink)
    p = jnp.exp(s - m)
    p = p / (jnp.sum(p, axis=-1, keepdims=True) + jnp.exp(sink - m))
    o = jnp.einsum('bnkgqc,bnckd->bnqkgd', p.astype(v.dtype), vb)
    return o.reshape(B, S, H, D)


def mla_swa_layer(x, positions, g_in, w_in, g_q_a, w_q_up, g_kv_a, w_kv_up, sinks, w_out):
    B, S, _ = x.shape
    h = rms_norm(x, g_in)
    z = h @ w_in
    cq, ckv, kpe, q_s, k_s, v_s, gate = split_cols(z, EVEN_SPLITS)
    q = (rms_norm(cq, g_q_a) @ w_q_up).reshape(B, S, MLA_HEADS, MLA_NOPE + MLA_ROPE)
    q_nope, q_pe = q[..., :MLA_NOPE], q[..., MLA_NOPE:]
    kv = (rms_norm(ckv, g_kv_a) @ w_kv_up).reshape(B, S, MLA_HEADS, MLA_NOPE + MLA_V)
    k_nope, v_m = kv[..., :MLA_NOPE], kv[..., MLA_NOPE:]
    ang = rope_angles(positions, MLA_ROPE)
    q_pe = apply_rope(q_pe, ang[:, :, None, :])
    k_pe = apply_rope(kpe, ang)[:, :, None, :]
    qm = jnp.concatenate([q_nope, q_pe], axis=-1)
    km = jnp.concatenate([k_nope, jnp.broadcast_to(k_pe, (B, S, MLA_HEADS, MLA_ROPE))], axis=-1)
    o_mla = causal_block_attention(qm, km, v_m)
    o_swa = sliding_window_sink_attention(
        q_s.reshape(B, S, SWA_HEADS, SWA_HEAD_DIM),
        k_s.reshape(B, S, SWA_KV_HEADS, SWA_HEAD_DIM),
        v_s.reshape(B, S, SWA_KV_HEADS, SWA_HEAD_DIM),
        sinks, alibi_slopes(SWA_HEADS))
    o = jnp.concatenate([o_mla.reshape(B, S, -1), o_swa.reshape(B, S, -1)], axis=-1)
    return x + (o * jax.nn.silu(gate)) @ w_out


def fox_layer(x, g_in, w_in, b_f, w_out):
    B, S, _ = x.shape
    h = rms_norm(x, g_in)
    z = h @ w_in
    q, k, v, f_logit, gate = split_cols(z, ODD_SPLITS)
    log_f = jax.nn.log_sigmoid(f_logit.astype(jnp.float32) + b_f.astype(jnp.float32))
    log_cum = jnp.cumsum(log_f, axis=1)
    o = causal_block_attention(q.reshape(B, S, FOX_HEADS, FOX_HEAD_DIM),
                               k.reshape(B, S, FOX_HEADS, FOX_HEAD_DIM),
                               v.reshape(B, S, FOX_HEADS, FOX_HEAD_DIM), log_cum=log_cum)
    return x + (o.reshape(B, S, FOX_WIDTH) * jax.nn.silu(gate)) @ w_out


def setup_inputs(seed: int = 0) -> dict:
    key = jax.random.key(seed)
    ks = jax.random.split(key, 16)
    f32 = jnp.float32

    def w(k, shape, fan_in):
        return jax.random.normal(k, shape, f32) * (fan_in ** -0.5)

    def gain(k, shape):
        return 1.0 + 0.05 * jax.random.normal(k, shape, f32)

    x = jax.random.normal(ks[0], (BATCH, SEQ, D_MODEL), f32)
    positions = jnp.broadcast_to(jnp.arange(SEQ, dtype=jnp.int32), (BATCH, SEQ))
    return {
        "x": x,
        "positions": positions,
        "e_g_in": gain(ks[1], (N_EVEN, D_MODEL)),
        "e_w_in": w(ks[2], (N_EVEN, D_MODEL, sum(EVEN_SPLITS)), D_MODEL),
        "e_g_q_a": gain(ks[3], (N_EVEN, MLA_Q_RANK)),
        "e_w_q_up": w(ks[4], (N_EVEN, MLA_Q_RANK, MLA_HEADS * (MLA_NOPE + MLA_ROPE)), MLA_Q_RANK),
        "e_g_kv_a": gain(ks[5], (N_EVEN, MLA_KV_RANK)),
        "e_w_kv_up": w(ks[6], (N_EVEN, MLA_KV_RANK, MLA_HEADS * (MLA_NOPE + MLA_V)), MLA_KV_RANK),
        "e_sinks": jax.random.normal(ks[7], (N_EVEN, SWA_HEADS), f32),
        "e_w_out": w(ks[8], (N_EVEN, EVEN_WIDTH, D_MODEL), EVEN_WIDTH),
        "o_g_in": gain(ks[9], (N_ODD, D_MODEL)),
        "o_w_in": w(ks[10], (N_ODD, D_MODEL, sum(ODD_SPLITS)), D_MODEL),
        "o_b_f": FORGET_BIAS_INIT + 0.5 * jax.random.normal(ks[11], (N_ODD, FOX_HEADS), f32),
        "o_w_out": w(ks[12], (N_ODD, FOX_WIDTH, D_MODEL), FOX_WIDTH),
        "g_final": gain(ks[13], (D_MODEL,)),
    }


def reference(x, positions, e_g_in, e_w_in, e_g_q_a, e_w_q_up, e_g_kv_a, e_w_kv_up, e_sinks,
              e_w_out, o_g_in, o_w_in, o_b_f, o_w_out, g_final):
    for layer in range(DEPTH):
        j = layer // 2
        if layer % 2 == 0:
            x = mla_swa_layer(x, positions, e_g_in[j], e_w_in[j], e_g_q_a[j], e_w_q_up[j],
                              e_g_kv_a[j], e_w_kv_up[j], e_sinks[j], e_w_out[j])
        else:
            x = fox_layer(x, o_g_in[j], o_w_in[j], o_b_f[j], o_w_out[j])
    return rms_norm(x, g_final)
```

```cpp
#include <hip/hip_runtime.h>
#include <hip/hip_cooperative_groups.h>
#include <cstdio>
#include <cstdint>
#include <cmath>
namespace cg = cooperative_groups;
#ifndef MK_COOP
#define MK_COOP 1
#endif
namespace pg8 {
#define PG8_LAS __attribute__((address_space(3)))
typedef unsigned short bf16_t;
typedef short bf16x8 __attribute__((ext_vector_type(8)));
typedef float f32x4 __attribute__((ext_vector_type(4)));
typedef unsigned u32x4 __attribute__((ext_vector_type(4)));
constexpr int BM = 256, BK = 64, HALF = 128, HTB = HALF * BK * 2  , STAGE_BYTES = 8 * HTB, NXCD = 8, WGM = 8;

__host__ __device__ __forceinline__ int lds_byte(int r, int c) { const int st = (r >> 4) * 2 + (c >> 5), rr = r & 15, cc = c & 31, ob = rr * 64 + cc * 2; return st * 1024 + (ob ^ (((ob >> 9) & 1) << 5)); }
__host__ __device__ __forceinline__ void stage_rc(int b, int& R, int& C) { const int st = b / 1024, sb = b % 1024, swz = sb ^ (((sb >> 9) & 1) << 5); R = (st >> 1) * 16 + swz / 64; C = (st & 1) * 32 + (swz % 64) / 2; }
__host__ __device__ __forceinline__ int perm32(int rho) { const int n = rho >> 4, i = rho & 15; return 8 * (i >> 2) + 4 * n + (i & 3); }

struct Unit { int pm, pn; };
struct Gemm { const bf16_t* A; const bf16_t* Bt; int M, N, K; };

struct StaticOrder {
    int nM, nN, nwg, G, c;
    __host__ __device__ void init(int M, int N, int G_, int c_) { nM = M / BM; nN = N / BM; nwg = nM * nN; G = G_; c = c_; }
    __host__ __device__ bool next(int i, Unit& u) const {
        const long L = (long)i * G + c; if (L >= nwg) return false;
        int wgid = (int)L; { const int q = nwg / NXCD, r = nwg % NXCD, xcd = wgid % NXCD, off = wgid / NXCD; wgid = (xcd < r ? xcd * (q + 1) : r * (q + 1) + (xcd - r) * q) + off; }
        const int nig = WGM * nN, gid = wgid / nig, fm = gid * WGM, gsz = (nM - fm) < WGM ? (nM - fm) : WGM;
        u.pm = fm + ((wgid % nig) % gsz); u.pn = (wgid % nig) / gsz; return true;
    }
    __device__ __forceinline__ void a_ready(const Unit&) const {}
    __device__ __forceinline__ void done(const Unit&) const {}
};

__device__ __forceinline__ unsigned cvt_pk_bf16(float lo, float hi) { unsigned r; asm volatile("v_cvt_pk_bf16_f32 %0, %1, %2" : "=v"(r) : "v"(lo), "v"(hi)); return r; }
typedef float f32x2 __attribute__((ext_vector_type(2)));
__device__ __forceinline__ f32x2 gelu_pk(f32x2 v) {
    const f32x2 av = __builtin_elementwise_abs(v), d = av * 0.2316418882f + 1.0f;
    f32x2 t; t.x = __builtin_amdgcn_rcpf(d.x); t.y = __builtin_amdgcn_rcpf(d.y);
    f32x2 q = t * 0.5307027145f + (-0.7265760135f); q = q * t + 0.7107068705f; q = q * t + (-0.142248368f); q = q * t + 0.127414796f; q = q * t;
    const f32x2 s = (v * v) * (-0.72134752044f);
    f32x2 e; e.x = __builtin_amdgcn_exp2f(s.x); e.y = __builtin_amdgcn_exp2f(s.y);
    const f32x2 m = v * (q * e), r = v - m;
    f32x2 o; o.x = v.x < 0.f ? m.x : r.x; o.y = v.y < 0.f ? m.y : r.y; return o;
}

template <int ACT  > struct EpiBf16 {
    static constexpr bool PERM = true, AFTER_DRAIN = false; static_assert(ACT == 0 || ACT == 1, "EpiBf16: ACT is 0 (none) or 1 (gelu_pk)");
    bf16_t* O; int ldc; const float* bias; int split_cols; size_t split_stride; float scale0;
    __device__ __forceinline__ void operator()(const f32x4 (&acc)[2][2][4][2], const Unit& u, int wr, int wc, int fr, int fq) const {
        const int row0 = u.pm * BM + wr * 64 + fr; int colt = u.pn * BM; bf16_t* base = O;
        float sc = 1.f; if (split_cols) { const int t = colt / split_cols; base += (size_t)t * split_stride; colt -= t * split_cols; if (t == 0) sc = scale0; }
        const int col0 = colt + wc * 32 + 8 * fq, bcol0 = u.pn * BM + wc * 32 + 8 * fq;
        f32x4 bv[2][2];
#pragma unroll
        for (int bj = 0; bj < 2; ++bj)
#pragma unroll
            for (int n = 0; n < 2; ++n) bv[bj][n] = bias ? *(const f32x4*)(bias + bcol0 + bj * HALF + 4 * n) : (f32x4){0.f, 0.f, 0.f, 0.f};
#pragma unroll
        for (int ai = 0; ai < 2; ++ai)
#pragma unroll
            for (int m = 0; m < 4; ++m) { bf16_t* rowp = base + (size_t)(row0 + ai * HALF + m * 16) * ldc + col0;
#pragma unroll
                for (int bj = 0; bj < 2; ++bj) { f32x4 v0 = acc[ai][bj][m][0] + bv[bj][0], v1 = acc[ai][bj][m][1] + bv[bj][1];
                    if (ACT == 1) { f32x2 a = gelu_pk((f32x2){v0[0], v0[1]}), b = gelu_pk((f32x2){v0[2], v0[3]}), c = gelu_pk((f32x2){v1[0], v1[1]}), d = gelu_pk((f32x2){v1[2], v1[3]});
                        v0 = (f32x4){a.x, a.y, b.x, b.y}; v1 = (f32x4){c.x, c.y, d.x, d.y}; }
                    v0 = v0 * sc; v1 = v1 * sc; u32x4 w; w.x = cvt_pk_bf16(v0[0], v0[1]); w.y = cvt_pk_bf16(v0[2], v0[3]); w.z = cvt_pk_bf16(v1[0], v1[1]); w.w = cvt_pk_bf16(v1[2], v1[3]);
                    *(u32x4*)(rowp + bj * HALF) = w; } }
    }
};
typedef unsigned u32x2 __attribute__((ext_vector_type(2)));
struct EpiQRope {
    static constexpr bool PERM = false, AFTER_DRAIN = false;
    bf16_t* O; int ldc; const float* cs;
    __device__ __forceinline__ void operator()(const f32x4 (&acc)[2][2][4][2], const Unit& u, int wr, int wc, int fr, int fq) const {
        const int row0 = u.pm * BM + wr * 64 + fr;
#pragma unroll
        for (int ai = 0; ai < 2; ++ai)
#pragma unroll
            for (int m = 0; m < 4; ++m) {
                const int row = row0 + ai * HALF + m * 16;
                const f32x4 cv = *(const f32x4*)(cs + (size_t)row * 32 + 4 * fq), sv = *(const f32x4*)(cs + (size_t)row * 32 + 16 + 4 * fq);
#pragma unroll
                for (int bj = 0; bj < 2; ++bj) {
                    const int colb = u.pn * BM + bj * HALF + wc * 32;
                    f32x4 v0 = acc[ai][bj][m][0], v1 = acc[ai][bj][m][1];
                    if (((colb >> 5) % 3) == 2) { const f32x4 a = v0 * cv - v1 * sv, b = v1 * cv + v0 * sv; v0 = a; v1 = b; }
                    bf16_t* rp = O + (size_t)row * ldc + colb + 4 * fq;
                    u32x2 w0, w1; w0.x = cvt_pk_bf16(v0[0], v0[1]); w0.y = cvt_pk_bf16(v0[2], v0[3]); w1.x = cvt_pk_bf16(v1[0], v1[1]); w1.y = cvt_pk_bf16(v1[2], v1[3]);
                    *(u32x2*)(rp) = w0; *(u32x2*)(rp + 16) = w1;
                }
                asm volatile("" ::: "memory");
            }
    }
};
struct EpiResF32 {
    static constexpr bool PERM = false, AFTER_DRAIN = false;
    const float* base; float* out; int ldc;
    __device__ __forceinline__ void operator()(const f32x4 (&acc)[2][2][4][2], const Unit& u, int wr, int wc, int fr, int fq) const {
        const int row0 = u.pm * BM + wr * 64 + fr, col0 = u.pn * BM + wc * 32 + 4 * fq;
#pragma unroll
        for (int ai = 0; ai < 2; ++ai)
#pragma unroll
            for (int m = 0; m < 4; ++m) {
                const size_t off = (size_t)(row0 + ai * HALF + m * 16) * ldc + col0;
#pragma unroll
                for (int bj = 0; bj < 2; ++bj)
#pragma unroll
                    for (int n = 0; n < 2; ++n) { const f32x4 b = *(const f32x4*)(base + off + bj * HALF + n * 16); *(f32x4*)(out + off + bj * HALF + n * 16) = b + acc[ai][bj][m][n]; }
                asm volatile("" ::: "memory");
            }
    }
};
template <class Epi, class Sched, bool ALIGN_EPI = false, bool SP2 = false>
__device__ __forceinline__ void gemm_phase(PG8_LAS unsigned char* lds, const Gemm g, const Sched& S, const Epi& E) {
    const int tid = threadIdx.x, wid = __builtin_amdgcn_readfirstlane(tid >> 6), lane = tid & 63, wr = wid >> 2, wc = wid & 3, fr = lane & 15, fq = lane >> 4;
    const int K = g.K, nt = K / BK;
    unsigned voffA[2], voffB[2];
#pragma unroll
    for (int i = 0; i < 2; ++i) { int R, C; stage_rc(tid * 16 + i * 8192, R, C); const int Rb = Epi::PERM ? ((R & ~31) + perm32(R & 31)) : R;
        voffA[i] = (unsigned)(R * K + C) * 2u; voffB[i] = (unsigned)(Rb * K + C) * 2u; }
    const size_t kstep = (size_t)(BK * 2);
    const size_t hstep = (size_t)HALF * K * 2;
    const size_t tstep = 2 * hstep;
    const unsigned ldsw = (unsigned)wid * 1024u;
    const int aoff = lds_byte(wr * 64 + fr, fq * 8), boff = lds_byte(wc * 32 + fr, fq * 8);
#define PG8_SA(b, h) (((b) * 2 + (h)) * HTB)
#define PG8_SB(b, h) ((4 + (b) * 2 + (h)) * HTB)
#define PG8_STAGE(bufoff, gbase, voff) do { _Pragma("unroll") for (int _i = 0; _i < 2; ++_i) \
        __builtin_amdgcn_global_load_lds((const unsigned*)((const char*)(gbase) + (voff)[_i]), (PG8_LAS unsigned*)(lds + (bufoff) + ldsw + _i * 8192), 16, 0, 0); } while (0)
#define PG8_LDA(dst, b, h) do { _Pragma("unroll") for (int m = 0; m < 4; ++m) _Pragma("unroll") for (int k = 0; k < 2; ++k) dst[m][k] = *(const PG8_LAS bf16x8*)(lds + PG8_SA(b, h) + aoff + m * 2048 + k * 1024); } while (0)
#define PG8_LDB(dst, b, h) do { _Pragma("unroll") for (int n = 0; n < 2; ++n) _Pragma("unroll") for (int k = 0; k < 2; ++k) dst[n][k] = *(const PG8_LAS bf16x8*)(lds + PG8_SB(b, h) + boff + n * 2048 + k * 1024); } while (0)
#define PG8_MMA(ai, bj, At, Bt) do { __builtin_amdgcn_s_setprio(1); _Pragma("unroll") for (int m = 0; m < 4; ++m) _Pragma("unroll") for (int n = 0; n < 2; ++n) _Pragma("unroll") for (int k = 0; k < 2; ++k) \
        acc[ai][bj][m][n] = __builtin_amdgcn_mfma_f32_16x16x32_bf16(Bt[n][k], At[m][k], acc[ai][bj][m][n], 0, 0, 0); __builtin_amdgcn_s_setprio(0); } while (0)
#define PG8_WAIT_V(n) asm volatile("s_waitcnt vmcnt(" #n ")" ::: "memory")
#define PG8_WAIT_L(n) asm volatile("s_waitcnt lgkmcnt(" #n ")" ::: "memory")
#define PG8_BAR __builtin_amdgcn_s_barrier()
#define PG8_SCHED __builtin_amdgcn_sched_barrier(0)
    Unit cur, nxt; int ui = 0;
    if (!S.next(0, cur)) return;
    f32x4 acc[2][2][4][2];
#pragma unroll
    for (int a = 0; a < 2; ++a)
#pragma unroll
        for (int b = 0; b < 2; ++b)
#pragma unroll
            for (int m = 0; m < 4; ++m)
#pragma unroll
                for (int n = 0; n < 2; ++n) acc[a][b][m][n] = (f32x4){0.f, 0.f, 0.f, 0.f};
    bf16x8 At[4][2], B0[2][2], B1[2][2];
    const char* cA = (const char*)g.A + (size_t)cur.pm * tstep; const char* cB = (const char*)g.Bt + (size_t)cur.pn * tstep;
    S.a_ready(cur);
    if constexpr (SP2) {
        PG8_STAGE(PG8_SB(0, 0), cB, voffB); PG8_STAGE(PG8_SB(0, 1), cB + hstep, voffB); PG8_STAGE(PG8_SA(0, 0), cA, voffA); PG8_STAGE(PG8_SA(0, 1), cA + hstep, voffA);
        if (wr == 1) PG8_BAR;
        PG8_WAIT_V(2); PG8_BAR;
        PG8_STAGE(PG8_SB(1, 0), cB + kstep, voffB); PG8_STAGE(PG8_SA(1, 0), cA + kstep, voffA); PG8_STAGE(PG8_SB(1, 1), cB + hstep + kstep, voffB);
        PG8_WAIT_V(6); PG8_BAR;
    } else {
        PG8_STAGE(PG8_SB(0, 0), cB, voffB); PG8_STAGE(PG8_SA(0, 0), cA, voffA); PG8_STAGE(PG8_SB(0, 1), cB + hstep, voffB); PG8_STAGE(PG8_SA(0, 1), cA + hstep, voffA);
        if (wr == 1) PG8_BAR;
        PG8_WAIT_V(4); PG8_BAR;
        PG8_STAGE(PG8_SB(1, 0), cB + kstep, voffB); PG8_STAGE(PG8_SA(1, 0), cA + kstep, voffA); PG8_STAGE(PG8_SB(1, 1), cB + hstep + kstep, voffB);
        PG8_WAIT_V(6); PG8_BAR;
    }
    for (;;) {
        const bool has_next = S.next(ui + 1, nxt);
        const char* nA = has_next ? (const char*)g.A + (size_t)nxt.pm * tstep : cA; const char* nB = has_next ? (const char*)g.Bt + (size_t)nxt.pn * tstep : cB;
        for (int t = 0; t < nt; t += 2) {
            const bool last = (t == nt - 2);
            const char* a1 = cA + (size_t)(t + 1) * kstep;
            const char* a2 = last ? nA : cA + (size_t)(t + 2) * kstep; const char* b2 = last ? nB : cB + (size_t)(t + 2) * kstep;
            const char* a3 = a2 + kstep; const char* b3 = b2 + kstep;
            if (last && has_next) S.a_ready(nxt);
            if constexpr (SP2) {
            PG8_LDB(B0, 0, 0); PG8_LDB(B1, 0, 1); PG8_SCHED; PG8_LDA(At, 0, 0); PG8_STAGE(PG8_SA(1, 1), a1 + hstep, voffA);
            PG8_WAIT_V(8); PG8_WAIT_L(0); PG8_BAR; PG8_MMA(0, 0, At, B0); PG8_MMA(0, 1, At, B1); PG8_BAR; PG8_SCHED;
            PG8_LDA(At, 0, 1); PG8_STAGE(PG8_SB(0, 0), b2, voffB); PG8_STAGE(PG8_SB(0, 1), b2 + hstep, voffB); PG8_STAGE(PG8_SA(0, 0), a2, voffA);
            PG8_WAIT_V(8); PG8_WAIT_L(0); PG8_BAR; PG8_MMA(1, 0, At, B0); PG8_MMA(1, 1, At, B1); PG8_BAR; PG8_SCHED;
            PG8_LDB(B0, 1, 0); PG8_LDB(B1, 1, 1); PG8_SCHED; PG8_LDA(At, 1, 0); PG8_STAGE(PG8_SA(0, 1), a2 + hstep, voffA);
            PG8_WAIT_V(8); PG8_WAIT_L(0); PG8_BAR; PG8_MMA(0, 0, At, B0); PG8_MMA(0, 1, At, B1); PG8_BAR; PG8_SCHED;
            PG8_LDA(At, 1, 1); PG8_STAGE(PG8_SB(1, 0), b3, voffB); PG8_STAGE(PG8_SB(1, 1), b3 + hstep, voffB); PG8_STAGE(PG8_SA(1, 0), a3, voffA);
            PG8_WAIT_V(8); PG8_WAIT_L(0); PG8_BAR; PG8_MMA(1, 0, At, B0); PG8_MMA(1, 1, At, B1); PG8_BAR; PG8_SCHED;
            } else {
            PG8_LDB(B0, 0, 0); PG8_SCHED; PG8_LDA(At, 0, 0); PG8_STAGE(PG8_SA(1, 1), a1 + hstep, voffA);
            PG8_WAIT_L(8); PG8_BAR; PG8_WAIT_L(0); PG8_MMA(0, 0, At, B0); PG8_BAR; PG8_SCHED;
            PG8_LDB(B1, 0, 1); PG8_STAGE(PG8_SB(0, 0), b2, voffB);
            PG8_BAR; PG8_WAIT_L(0); PG8_MMA(0, 1, At, B1); PG8_BAR;
            PG8_LDA(At, 0, 1); PG8_STAGE(PG8_SA(0, 0), a2, voffA);
            PG8_BAR; PG8_WAIT_L(0); PG8_MMA(1, 0, At, B0); PG8_BAR; PG8_SCHED;
            PG8_STAGE(PG8_SB(0, 1), b2 + hstep, voffB);
            PG8_WAIT_V(6); PG8_BAR; PG8_MMA(1, 1, At, B1); PG8_BAR;
            PG8_LDB(B0, 1, 0); PG8_SCHED; PG8_LDA(At, 1, 0); PG8_STAGE(PG8_SA(0, 1), a2 + hstep, voffA);
            PG8_WAIT_L(8); PG8_BAR; PG8_WAIT_L(0); PG8_MMA(0, 0, At, B0); PG8_BAR; PG8_SCHED;
            PG8_LDB(B1, 1, 1); PG8_STAGE(PG8_SB(1, 0), b3, voffB);
            PG8_BAR; PG8_WAIT_L(0); PG8_MMA(0, 1, At, B1); PG8_BAR;
            PG8_LDA(At, 1, 1); PG8_STAGE(PG8_SA(1, 0), a3, voffA);
            PG8_BAR; PG8_WAIT_L(0); PG8_MMA(1, 0, At, B0); PG8_BAR; PG8_SCHED;
            PG8_STAGE(PG8_SB(1, 1), b3 + hstep, voffB);
            PG8_WAIT_V(6); PG8_BAR; PG8_MMA(1, 1, At, B1); PG8_BAR;
            }
        }
        if constexpr (ALIGN_EPI) { if (wr == 0) PG8_BAR; }
        if constexpr (!Epi::AFTER_DRAIN) { E(acc, cur, wr, wc, fr, fq); S.done(cur); }
        if (!has_next) break;
#pragma unroll
        for (int a = 0; a < 2; ++a)
#pragma unroll
            for (int b = 0; b < 2; ++b)
#pragma unroll
                for (int m = 0; m < 4; ++m)
#pragma unroll
                    for (int n = 0; n < 2; ++n) acc[a][b][m][n] = (f32x4){0.f, 0.f, 0.f, 0.f};
        cur = nxt; cA = nA; cB = nB; ++ui;
        if constexpr (ALIGN_EPI) { if (wr == 1) PG8_BAR; }
    }
    PG8_WAIT_V(0);
    if constexpr (!ALIGN_EPI) { if (wr == 0) PG8_BAR; }
    PG8_BAR;
    if constexpr (Epi::AFTER_DRAIN) { E.fused(acc, cur, wr, wc, fr, fq, lds, wid, lane); S.done(cur); }
#undef PG8_SA
#undef PG8_SB
#undef PG8_STAGE
#undef PG8_LDA
#undef PG8_LDB
#undef PG8_MMA
#undef PG8_WAIT_V
#undef PG8_WAIT_L
#undef PG8_BAR
#undef PG8_SCHED
}
}
#define LAS __attribute__((address_space(3)))
typedef unsigned short bf16;
typedef short bf16x8 __attribute__((ext_vector_type(8)));
typedef float f32x16 __attribute__((ext_vector_type(16)));
typedef float f32x4 __attribute__((ext_vector_type(4)));
typedef float f32x2 __attribute__((ext_vector_type(2)));
typedef unsigned u32x4 __attribute__((ext_vector_type(4)));
typedef unsigned u32x2 __attribute__((ext_vector_type(2)));
typedef __bf16 bf16x2_t __attribute__((ext_vector_type(2)));

constexpr int BATCH = 8, SEQ = 4096, DM = 1024, M = BATCH * SEQ;
constexpr int N0 = 2208, N0P = 2304;
constexpr int C_CQ = 0, C_CKV = 256, C_KPE = 384, C_QS = 416, C_KS = 928, C_VS = 1056, C_G0 = 1184;
constexpr int N1W = 4112, N1 = 4096;
constexpr int C1_Q = 0, C1_K = 1024, C1_V = 2048, C1_G = 3072, W1_F = 3072, W1_G = 3088;
constexpr float EPS = 1e-6f, LOG2E = 1.4426950408889634f;
constexpr int NTHREADS = 512, NWAVES = 8;

constexpr size_t MiB = 1u << 20;
constexpr size_t WS_WT0 = 1 * MiB;
constexpr size_t WS_WQUP = 6 * MiB;
constexpr size_t WS_WKVUP = 7 * MiB;
constexpr size_t WS_WOUT0 = 8 * MiB;
constexpr size_t WS_WT1 = 10 * MiB;
constexpr size_t WS_WOUT1 = 18 * MiB;
constexpr size_t WS_XN = 32 * MiB;
constexpr size_t WS_OG = 96 * MiB;
constexpr size_t WS_LF = 160 * MiB;
constexpr size_t WS_LC = 162 * MiB;
constexpr size_t WS_TMAX = 512 * 1024;
constexpr size_t WS_CS = 164 * MiB;
constexpr size_t WS_Z1 = 168 * MiB;
constexpr size_t WS_Z0 = 168 * MiB;
constexpr size_t WS_CQN = 312 * MiB;
constexpr size_t WS_CKVN = 328 * MiB;
constexpr size_t WS_KPE = 344 * MiB;
constexpr size_t WS_Q0 = 346 * MiB;
constexpr size_t WS_KN = 394 * MiB;
constexpr size_t WS_VM = 426 * MiB;
constexpr size_t WS_END = 458 * MiB;
constexpr int LDS_BYTES = 135168, LDS_MISC = 131072 + 1024;

__device__ __forceinline__ unsigned cvtpk(float lo, float hi) { f32x2 v = {lo, hi}; bf16x2_t b = __builtin_convertvector(v, bf16x2_t); return __builtin_bit_cast(unsigned, b); }
__device__ __forceinline__ float bflo(unsigned u) { return __uint_as_float(u << 16); }
__device__ __forceinline__ float bfhi(unsigned u) { return __uint_as_float(u & 0xffff0000u); }
__device__ __forceinline__ float bf1(bf16 v) { return __uint_as_float(((unsigned)v) << 16); }
__device__ __forceinline__ float wave_sum(float v) {
#pragma unroll
    for (int o = 1; o < 64; o <<= 1) v += __shfl_xor(v, o);
    return v;
}

struct AttnP { const bf16 *Q, *K, *K2, *V, *G; bf16* O; const float* lc; const float* tmax; int ldq, ldk, ldk2, ldv, ldg, ldo; float c, sink2, slope2; };

typedef short v4i16_t __attribute__((ext_vector_type(4)));
__device__ __forceinline__ void glds16(const void* gsrc, unsigned lds_dst) { unsigned keep;
    asm volatile("s_mov_b32 %0, m0\n\ts_mov_b32 m0, %2\n\ts_nop 0\n\tglobal_load_lds_dwordx4 %1, off\n\ts_mov_b32 m0, %0" : "=&s"(keep) : "v"(gsrc), "s"(lds_dst) : "memory"); }
__device__ __forceinline__ void glds4(const void* gsrc, unsigned lds_dst) { unsigned keep;
    asm volatile("s_mov_b32 %0, m0\n\ts_mov_b32 m0, %2\n\ts_nop 0\n\tglobal_load_lds_dword %1, off\n\ts_mov_b32 m0, %0" : "=&s"(keep) : "v"(gsrc), "s"(lds_dst) : "memory"); }
#define AT_WAITV(n) asm volatile("s_waitcnt vmcnt(%0) lgkmcnt(0)" :: "n"(n) : "memory")
template <int DK, int MODE>
__device__ __forceinline__ void attn_unit(const AttnP& p, const int q0, LAS unsigned char* lds) {
    constexpr int NS = 4, KN_B = 8192, KP_B = (DK == 96) ? 4096 : 0, VHALF = 4160, V_B = 2 * VHALF, LC_B = (MODE == 2) ? 256 : 0;
    constexpr int OFF_KP = KN_B, OFF_V = KN_B + KP_B, OFF_LC = OFF_V + V_B, SLOT = OFF_LC + LC_B, OFF_FLAG = NS * SLOT;
    constexpr int NPT = 2 + ((DK == 96 || MODE == 2) ? 1 : 0);
    const int tid = threadIdx.x, lane = tid & 63, wid = __builtin_amdgcn_readfirstlane(tid >> 6), r32 = lane & 31, hi = lane >> 5;
    const int qw0 = q0 + 32 * wid, q = qw0 + r32;
    const unsigned lds0 = (unsigned)(uintptr_t)lds;
    bf16x8 qf[DK / 16];
#pragma unroll
    for (int d0 = 0; d0 < DK / 16; ++d0) qf[d0] = *(const bf16x8*)(p.Q + (size_t)q * p.ldq + 16 * d0 + 8 * hi);
#pragma unroll
    for (int d0 = 0; d0 < DK / 16; ++d0) asm volatile("" : "+v"(qf[d0]));
    const int t_hi = ((q0 + 256) >> 6) - 1;
    const int t_lo = (MODE == 1 && q0 >= 256) ? (q0 >> 6) - 2 : 0;
    const int ntile = t_hi - t_lo + 1;
    const int krow = 8 * wid + (lane >> 3), kch = (lane & 7) ^ ((krow >> 1) & 7);
    const bf16* ksrc = p.K + (size_t)krow * p.ldk + kch * 8;
    const int prow = 8 * wid + ((lane & 31) >> 2), pch = (lane & 3) ^ ((prow >> 2) & 3);
    const bf16* psrc = (DK == 96) ? (p.K2 + (size_t)prow * p.ldk2 + pch * 8) : p.K;
    const int vrow = 16 * (wid & 3) + (lane >> 2);
    const bf16* vsrc = p.V + (size_t)vrow * p.ldv + ((wid >> 2) * 4 + (lane & 3)) * 8;
    const float* lsrc = (MODE == 2) ? (p.lc + 8 * wid + (lane & 7)) : (const float*)p.K;
#define AT_DMA(t, slot) do { const size_t ro_ = (size_t)(t) * 64; const unsigned sb_ = lds0 + (unsigned)((slot) * SLOT); \
        glds16(ksrc + ro_ * p.ldk, (unsigned)__builtin_amdgcn_readfirstlane(sb_ + wid * 1024)); \
        glds16(vsrc + ro_ * p.ldv, (unsigned)__builtin_amdgcn_readfirstlane(sb_ + OFF_V + (wid >> 2) * VHALF + (wid & 3) * 1024)); \
        if (DK == 96) { if (lane < 32) glds16(psrc + ro_ * p.ldk2, (unsigned)__builtin_amdgcn_readfirstlane(sb_ + OFF_KP + wid * 512)); } \
        if (MODE == 2) { if (lane < 8) glds4(lsrc + ro_, (unsigned)__builtin_amdgcn_readfirstlane(sb_ + OFF_LC + wid * 32)); } } while (0)

    float m_run = (MODE == 1) ? p.sink2 : -INFINITY;
    float l_run = (MODE == 1 && hi == 0) ? 1.f : 0.f;
    f32x16 ot[2];
#pragma unroll
    for (int r = 0; r < 16; ++r) { ot[0][r] = 0.f; ot[1][r] = 0.f; }
    const int pim = 16 * (r32 >> 4) + 8 * ((r32 >> 2) & 1) + 4 * ((r32 >> 3) & 1) + (r32 & 3);
    const int vrd = (8 * hi + ((lane & 15) >> 2)) * 64 + ((lane >> 4) & 1) * 32 + (lane & 3) * 8;
    int koff[4], poff[2];
#pragma unroll
    for (int d0 = 0; d0 < 4; ++d0) koff[d0] = pim * 128 + (((2 * d0 + hi) ^ ((pim >> 1) & 7)) * 16);
#pragma unroll
    for (int j = 0; j < 2; ++j) poff[j] = OFF_KP + pim * 64 + (((2 * j + hi) ^ ((pim >> 2) & 3)) * 16);
    float pmv = 0.f, lcev = 0.f, qn = 0.f;
    if (MODE == 2) {
        pmv = (lane <= t_hi) ? p.tmax[lane] : 0.f;
#pragma unroll
        for (int o = 1; o < 64; o <<= 1) { const float n = __shfl_up(pmv, o); if (lane >= o) pmv = fmaxf(pmv, n); }
        lcev = (lane <= t_hi) ? p.lc[64 * lane + 63] : 0.f;
        float qs = 0.f;
#pragma unroll
        for (int d0 = 0; d0 < DK / 16; ++d0)
#pragma unroll
            for (int e = 0; e < 8; ++e) { const float f = bf1((bf16)qf[d0][e]); qs += f * f; }
        qs += __shfl_xor(qs, 32);
        qn = sqrtf(qs) * p.c * 1.002f;
    }
    AT_DMA(t_hi, 0);
    if (ntile > 1) AT_DMA(t_hi - 1, 1);
    if (ntile > 2) AT_DMA(t_hi - 2, 2);
    for (int i = 0; i < ntile; ++i) {
        const int t = t_hi - i, kv0 = t * 64, rem = ntile - 1 - i;
        if (rem >= 2) AT_WAITV(2 * NPT); else if (rem == 1) AT_WAITV(NPT); else AT_WAITV(0);
        __builtin_amdgcn_s_barrier();
        asm volatile("" ::: "memory");
        if (MODE == 2) { if (i > 0) {
            const LAS unsigned char* fp = lds + OFF_FLAG + ((i - 1) & 1) * 32;
            const u32x4 f0 = *(const LAS u32x4*)(fp), f1 = *(const LAS u32x4*)(fp + 16);
            if ((f0.x & f0.y & f0.z & f0.w & f1.x & f1.y & f1.z & f1.w) != 0u) break; } }
        if (rem >= 3) AT_DMA(t - 3, (i + 3) & 3);
        const LAS unsigned char* sb = lds + (i & 3) * SLOT;
        bool act = kv0 <= qw0 + 31;
        if (MODE == 1) act = act && (kv0 + 63 >= qw0 - 127);
        if (act) {
            f32x16 s[2];
            {
                bf16x8 kf[2][DK / 16];
#pragma unroll
                for (int ph = 0; ph < 2; ++ph) {
#pragma unroll
                    for (int d0 = 0; d0 < 4; ++d0) kf[ph][d0] = *(const LAS bf16x8*)(sb + koff[d0] + ph * 4096);
                    if (DK == 96) {
#pragma unroll
                        for (int j = 0; j < 2; ++j) kf[ph][(DK == 96) ? 4 + j : 0] = *(const LAS bf16x8*)(sb + poff[j] + ph * 2048);
                    }
                }
#pragma unroll
                for (int r = 0; r < 16; ++r) { s[0][r] = 0.f; s[1][r] = 0.f; }
                __builtin_amdgcn_sched_barrier(0);
#pragma unroll
                for (int d0 = 0; d0 < DK / 16; ++d0) {
                    s[0] = __builtin_amdgcn_mfma_f32_32x32x16_bf16(kf[0][d0], qf[d0], s[0], 0, 0, 0);
                    s[1] = __builtin_amdgcn_mfma_f32_32x32x16_bf16(kf[1][d0], qf[d0], s[1], 0, 0, 0);
                }
                __builtin_amdgcn_sched_barrier(0);
            }
            if (MODE == 2) {
                const LAS float* lcb = (const LAS float*)(sb + OFF_LC);
#pragma unroll
                for (int ph = 0; ph < 2; ++ph)
#pragma unroll
                    for (int j = 0; j < 4; ++j) { const f32x4 lk = *(const LAS f32x4*)(lcb + 32 * ph + 16 * (j >> 1) + 8 * hi + 4 * (j & 1));
#pragma unroll
                        for (int ii = 0; ii < 4; ++ii) s[ph][4 * j + ii] = s[ph][4 * j + ii] * p.c - lk[ii]; }
            } else if (MODE == 1) {
                const float dq = (float)(q - kv0 - 8 * hi);
#pragma unroll
                for (int ph = 0; ph < 2; ++ph)
#pragma unroll
                    for (int r = 0; r < 16; ++r) { const int kk = 32 * ph + 16 * (r >> 3) + 4 * ((r >> 2) & 1) + (r & 3); s[ph][r] = s[ph][r] * p.c - p.slope2 * (dq - (float)kk); }
            }
            bool needmask = (kv0 + 63 > qw0);
            if (MODE == 1) needmask = needmask || (kv0 < qw0 + 31 - 127);
            if (needmask) {
                const int dqi = q - kv0 - 8 * hi;
#pragma unroll
                for (int ph = 0; ph < 2; ++ph)
#pragma unroll
                    for (int r = 0; r < 16; ++r) { const int kk = 32 * ph + 16 * (r >> 3) + 4 * ((r >> 2) & 1) + (r & 3); const int dist = dqi - kk;
                        bool ok = dist >= 0; if (MODE == 1) ok = ok && (dist < 128); s[ph][r] = ok ? s[ph][r] : -INFINITY; }
            }
            float mx = fmaxf(fmaxf(s[0][0], s[0][1]), s[0][2]);
#pragma unroll
            for (int r = 3; r < 15; r += 2) mx = fmaxf(fmaxf(mx, s[0][r]), s[0][r + 1]);
            mx = fmaxf(mx, s[0][15]);
#pragma unroll
            for (int r = 0; r < 16; r += 2) mx = fmaxf(fmaxf(mx, s[1][r]), s[1][r + 1]);
            mx = fmaxf(mx, __shfl_xor(mx, 32));
            if (MODE == 0) mx *= p.c;
            const bool dead = (MODE == 2) && __all(mx < m_run - 30.f);
            if (!dead) {
                const float m_new = fmaxf(m_run, mx);
                const float alpha = __builtin_amdgcn_exp2f(m_run - m_new);
                m_run = m_new;
                float ls0 = 0.f, ls1 = 0.f;
#pragma unroll
                for (int ph = 0; ph < 2; ++ph)
#pragma unroll
                    for (int r = 0; r < 16; r += 2) {
                        const float e0 = __builtin_amdgcn_exp2f(MODE == 0 ? (s[ph][r] * p.c - m_new) : (s[ph][r] - m_new));
                        const float e1 = __builtin_amdgcn_exp2f(MODE == 0 ? (s[ph][r + 1] * p.c - m_new) : (s[ph][r + 1] - m_new));
                        s[ph][r] = e0; s[ph][r + 1] = e1; ls0 += e0; ls1 += e1; }
                if (__any(alpha != 1.f)) {
                    l_run *= alpha;
#pragma unroll
                    for (int r = 0; r < 16; ++r) { ot[0][r] *= alpha; ot[1][r] *= alpha; }
                }
                l_run += ls0 + ls1;
                bf16x8 pk[4];
#pragma unroll
                for (int cc = 0; cc < 4; ++cc) { const int ph = cc >> 1, o = 8 * (cc & 1); u32x4 w;
                    w.x = cvtpk(s[ph][o + 0], s[ph][o + 1]); w.y = cvtpk(s[ph][o + 2], s[ph][o + 3]); w.z = cvtpk(s[ph][o + 4], s[ph][o + 5]); w.w = cvtpk(s[ph][o + 6], s[ph][o + 7]);
                    pk[cc] = __builtin_bit_cast(bf16x8, w); }
                const LAS unsigned char* vb = sb + OFF_V + vrd;
                bf16x8 vf[2][4];
#pragma unroll
                for (int dh = 0; dh < 2; ++dh)
#pragma unroll
                    for (int cc = 0; cc < 4; ++cc) {
                        const v4i16_t v0 = __builtin_amdgcn_ds_read_tr16_b64_v4i16((LAS v4i16_t*)(vb + dh * VHALF + cc * 1024));
                        const v4i16_t v1 = __builtin_amdgcn_ds_read_tr16_b64_v4i16((LAS v4i16_t*)(vb + dh * VHALF + cc * 1024 + 256));
                        vf[dh][cc] = (bf16x8){v0[0], v0[1], v0[2], v0[3], v1[0], v1[1], v1[2], v1[3]}; }
                __builtin_amdgcn_sched_barrier(0);
#pragma unroll
                for (int cc = 0; cc < 4; ++cc) {
                    ot[0] = __builtin_amdgcn_mfma_f32_32x32x16_bf16(vf[0][cc], pk[cc], ot[0], 0, 0, 0);
                    ot[1] = __builtin_amdgcn_mfma_f32_32x32x16_bf16(vf[1][cc], pk[cc], ot[1], 0, 0, 0);
                }
                __builtin_amdgcn_sched_barrier(0);
            }
        }
        if (MODE == 2) {
            bool dn = false;
            if (rem >= 1) { const float bnd = qn * __shfl(pmv, t - 1) - __shfl(lcev, t - 1); dn = __all(bnd < m_run - 30.f); }
            if (lane == 0) *(LAS unsigned*)(lds + OFF_FLAG + (i & 1) * 32 + wid * 4) = dn ? 1u : 0u;
        }
    }
    AT_WAITV(0);
    __builtin_amdgcn_s_barrier();
    asm volatile("" ::: "memory");
    const float lt = l_run + __shfl_xor(l_run, 32);
    const float inv = 1.f / lt;
#pragma unroll
    for (int dh = 0; dh < 2; ++dh)
#pragma unroll
        for (int j = 0; j < 4; ++j) {
            const int d = 32 * dh + 8 * j + 4 * hi;
            const u32x2 g = *(const u32x2*)(p.G + (size_t)q * p.ldg + d);
            const float g0 = bflo(g.x), g1 = bfhi(g.x), g2 = bflo(g.y), g3 = bfhi(g.y);
            const float o0 = ot[dh][4 * j + 0] * inv * (g0 / (1.f + __expf(-g0)));
            const float o1 = ot[dh][4 * j + 1] * inv * (g1 / (1.f + __expf(-g1)));
            const float o2 = ot[dh][4 * j + 2] * inv * (g2 / (1.f + __expf(-g2)));
            const float o3 = ot[dh][4 * j + 3] * inv * (g3 / (1.f + __expf(-g3)));
            u32x2 w; w.x = cvtpk(o0, o1); w.y = cvtpk(o2, o3);
            *(u32x2*)(p.O + (size_t)q * p.ldo + d) = w;
        }
#undef AT_DMA
}

#define XB_TMO      128
#define XB_XCNT(j)  (256  + 64 * (j))
#define XB_XSUB(j)  (1280 + 64 * (j))
#define XB_XGEN(j)  (2304 + 64 * (j))
#define XB_TOP      3328
#define XB_TOPGEN   3392
#define XCD_BAR_WORDS 3456
#define XB_SPIN_CAP (1u << 18)

__device__ __forceinline__ unsigned xb_ld(unsigned* p)              { return __hip_atomic_load(p, __ATOMIC_RELAXED, __HIP_MEMORY_SCOPE_AGENT); }
__device__ __forceinline__ unsigned xb_add(unsigned* p, unsigned v) { return __hip_atomic_fetch_add(p, v, __ATOMIC_RELAXED, __HIP_MEMORY_SCOPE_AGENT); }
__device__ __forceinline__ unsigned xb_xcc_id() { return (unsigned)__builtin_amdgcn_s_getreg((3 << 11) | 20) & 0xFu; }
#define XB_SPIN(cond, bar) do { unsigned _sp = 0; while (cond) { __builtin_amdgcn_s_sleep(1); \
    if ((++_sp & 255u) == 0u) { if (xb_ld(&(bar)[XB_TMO])) break; if (_sp > XB_SPIN_CAP) { atomicAdd(&(bar)[XB_TMO], 1u); break; } } } } while (0)

struct XcdBarrier {
    unsigned* bar; unsigned x;
    volatile LAS unsigned* st;
};

__device__ __forceinline__ XcdBarrier xcd_barrier_post(unsigned* bar, volatile LAS unsigned* st) {
    XcdBarrier b; b.bar = bar; b.x = xb_xcc_id(); b.st = st;
    if (threadIdx.x == 0) (void)xb_add(&bar[XB_XCNT(b.x)], 1u);
    return b;
}
__device__ __forceinline__ void xcd_barrier_complete(unsigned* bar, unsigned x, unsigned& nloc, unsigned& nx) {
    const unsigned G = gridDim.x * gridDim.y * gridDim.z;
    unsigned sum, cnt, mine, sp = 0u;
    for (;;) {
        sum = 0u; cnt = 0u; mine = 0u;
#pragma unroll
        for (unsigned j = 0; j < 16; ++j) { const unsigned c = xb_ld(&bar[XB_XCNT(j)]); sum += c; cnt += (c > 0u) ? 1u : 0u; mine = (j == x) ? c : mine; }
        if (sum == G) break;
        __builtin_amdgcn_s_sleep(1);
        if ((++sp & 255u) == 0u) { if (xb_ld(&bar[XB_TMO])) break; if (sp > XB_SPIN_CAP) { atomicAdd(&bar[XB_TMO], 1u); break; } }
    }
    nloc = mine > 0u ? mine : 1u; nx = cnt > 0u ? cnt : 1u;
}

__device__ __forceinline__ void xcd_barrier(const XcdBarrier& b) {
    asm volatile("s_waitcnt vmcnt(0)" ::: "memory");
    __syncthreads();
    if (threadIdx.x == 0) {
        unsigned* bar = b.bar;
        __builtin_amdgcn_s_waitcnt(0);
        unsigned nloc = b.st[0], nx = b.st[1];
        if (nloc == 0u) { xcd_barrier_complete(bar, b.x, nloc, nx); b.st[0] = nloc; b.st[1] = nx; }
        const unsigned old = xb_add(&bar[XB_XSUB(b.x)], 1u);
        const unsigned gen = old / nloc;
        if (old + 1u == (gen + 1u) * nloc) {
            __builtin_amdgcn_fence(__ATOMIC_RELEASE, "agent");
            asm volatile("s_waitcnt vmcnt(0)" ::: "memory");
            const unsigned og = xb_add(&bar[XB_TOP], 1u);
            const unsigned tg = og / nx;
            if (og + 1u == (tg + 1u) * nx) xb_add(&bar[XB_TOPGEN], 1u);
            else XB_SPIN(xb_ld(&bar[XB_TOPGEN]) == tg, bar);
            __builtin_amdgcn_fence(__ATOMIC_ACQUIRE, "agent");
            xb_add(&bar[XB_XGEN(b.x)], 1u);
            asm volatile("s_waitcnt vmcnt(0)" ::: "memory");
        } else {
            XB_SPIN(xb_ld(&bar[XB_XGEN(b.x)]) == gen, bar);
            __builtin_amdgcn_fence(__ATOMIC_ACQUIRE, "agent");
            asm volatile("s_waitcnt vmcnt(0)" ::: "memory");
        }
    }
    __syncthreads();
}

struct Args { const float* in[15]; const int* pos; float* out; unsigned char* ws; int ph_lo, ph_hi; };

__device__ __forceinline__ void transpose_item(const float* W, int ldw, int col0, int k0, bf16* WT, int ldt, int row_off, LAS float* scr, int lane) {
#pragma unroll 8
    for (int i = 0; i < 32; ++i) { const int kk = 2 * i + (lane >> 5); scr[kk * 33 + (lane & 31)] = W[(size_t)(k0 + kk) * ldw + col0 + (lane & 31)]; }
    asm volatile("s_waitcnt lgkmcnt(0)" ::: "memory");
    const int c = lane & 7;
#pragma unroll
    for (int j = 0; j < 4; ++j) { const int n = (lane >> 3) + 8 * j; const LAS float* s = scr + (8 * c) * 33 + n;
        u32x4 o; o.x = cvtpk(s[0 * 33], s[1 * 33]); o.y = cvtpk(s[2 * 33], s[3 * 33]); o.z = cvtpk(s[4 * 33], s[5 * 33]); o.w = cvtpk(s[6 * 33], s[7 * 33]);
        *(u32x4*)(WT + (size_t)(row_off + n) * ldt + k0 + 8 * c) = o; }
    asm volatile("s_waitcnt lgkmcnt(0)" ::: "memory");
}

__device__ __forceinline__ void rms_row_to_bf16(const float* xrow, const float* g, bf16* orow, int lane) {
    const f32x4* xr = (const f32x4*)xrow + lane; const f32x4* gr = (const f32x4*)g + lane;
    f32x4 v[4]; float s = 0.f;
#pragma unroll
    for (int j = 0; j < 4; ++j) { v[j] = xr[64 * j]; s += (v[j].x * v[j].x + v[j].y * v[j].y) + (v[j].z * v[j].z + v[j].w * v[j].w); }
    const float rs = 1.f / sqrtf(wave_sum(s) * (1.f / DM) + EPS);
    u32x2* o8 = (u32x2*)orow + lane;
#pragma unroll
    for (int j = 0; j < 4; ++j) { const f32x4 gg = gr[64 * j]; u32x2 w; w.x = cvtpk(v[j].x * rs * gg.x, v[j].y * rs * gg.y); w.y = cvtpk(v[j].z * rs * gg.z, v[j].w * rs * gg.w); o8[64 * j] = w; }
}

template <bool COOP>
__global__ void __launch_bounds__(NTHREADS, 2) mk_fwd(Args args) {
    extern __shared__ __attribute__((aligned(16))) unsigned char lds_raw[];
    LAS unsigned char* lds = (LAS unsigned char*)lds_raw;
    const int tid = threadIdx.x, lane = tid & 63, wave = __builtin_amdgcn_readfirstlane(tid >> 6);
    const int G = gridDim.x, bx = blockIdx.x;
    const int vcu = (G % 8 == 0) ? (bx % 8) * (G / 8) + bx / 8 : bx;
    const int gw = vcu * NWAVES + wave, NGW = G * NWAVES;
    unsigned char* ws = args.ws;
    const float* x = args.in[0];
    bf16* Wt0 = (bf16*)(ws + WS_WT0); bf16* Wqup = (bf16*)(ws + WS_WQUP); bf16* Wkvup = (bf16*)(ws + WS_WKVUP); bf16* Wout0 = (bf16*)(ws + WS_WOUT0);
    bf16* Wt1 = (bf16*)(ws + WS_WT1); bf16* Wout1 = (bf16*)(ws + WS_WOUT1);
    bf16* XN = (bf16*)(ws + WS_XN); bf16* OG = (bf16*)(ws + WS_OG); float* LF = (float*)(ws + WS_LF); float* LC = (float*)(ws + WS_LC); float* CS = (float*)(ws + WS_CS); float* TMAXB = (float*)(ws + WS_TMAX);
    bf16* Z0 = (bf16*)(ws + WS_Z0); bf16* Z1 = (bf16*)(ws + WS_Z1); bf16* CQN = (bf16*)(ws + WS_CQN); bf16* CKVN = (bf16*)(ws + WS_CKVN); bf16* KPE = (bf16*)(ws + WS_KPE);
    bf16* Q0 = (bf16*)(ws + WS_Q0); bf16* KN = (bf16*)(ws + WS_KN); bf16* VM = (bf16*)(ws + WS_VM);
    float* out = args.out;
    const int lo = args.ph_lo, hi_ph = args.ph_hi;
#ifndef REPMASK
#define REPMASK 0
#endif
#define NREP(k) (1 + (((REPMASK) >> (k)) & 1))
#ifndef PHMASK
#define PHMASK 0xfff
#endif
#define IN(k) ((((PHMASK) >> (k)) & 1) && lo <= (k) && (k) < hi_ph)
#define SEAM(k) do { if constexpr (COOP) { if (IN(k) && IN((k) + 1)) { if ((k) == 0) { cg::this_grid().sync(); xbar = xcd_barrier_post(barw, (volatile LAS unsigned*)(lds + LDS_MISC)); } else { xcd_barrier(xbar); } } } } while (0)
    unsigned* qctr = (unsigned*)(ws + 256 * 1024);
    unsigned* barw = (unsigned*)ws;
    XcdBarrier xbar; xbar.bar = barw; xbar.x = 0; xbar.st = (volatile LAS unsigned*)(lds + LDS_MISC);
    if constexpr (COOP) {
        if (tid < 16) ((LAS unsigned*)(lds + LDS_MISC))[tid] = 0u;
        if (bx == 0) { for (int i = tid; i < XCD_BAR_WORDS; i += NTHREADS) barw[i] = 0u; for (int i = tid; i < 16 * 64; i += NTHREADS) qctr[i] = 0u; }
        __syncthreads();
    }

    if (IN(0)) {
        LAS float* scr = (LAS float*)(lds + wave * 16384);
        constexpr int I_A = 16 * 69, I_B = 4 * 24, I_C = 2 * 32, I_D = 16 * 32, I_E1 = 16 * 96, I_E2 = 16 * 32, I_F = 16 * 32;
        constexpr int NIT = I_A + I_B + I_C + I_D + I_E1 + I_E2 + I_F;
        for (int it = gw; it < NIT; it += NGW) {
            int r = it;
            if (r < I_A) { const int kb = r / 69, nb = r % 69; transpose_item(args.in[3], N0, 32 * nb, 64 * kb, Wt0, 1024, 32 * nb, scr, lane); continue; } r -= I_A;
            if (r < I_B) { const int kb = r / 24, nb = r % 24; transpose_item(args.in[5], 768, 32 * nb, 64 * kb, Wqup, 256, 32 * nb, scr, lane); continue; } r -= I_B;
            if (r < I_C) { const int kb = r / 32, nb = r % 32; const int n0 = 32 * nb, h = n0 >> 7, j0 = n0 & 127; const int dst = (j0 < 64) ? (h * 64 + j0) : (512 + h * 64 + (j0 - 64));
                           transpose_item(args.in[7], 1024, n0, 64 * kb, Wkvup, 256, dst, scr, lane); continue; } r -= I_C;
            if (r < I_D) { const int kb = r / 32, nb = r % 32; transpose_item(args.in[9], 1024, 32 * nb, 64 * kb, Wout0, 1024, 32 * nb, scr, lane); continue; } r -= I_D;
            if (r < I_E1) { const int kb = r / 96, nb = r % 96; transpose_item(args.in[11], N1W, 32 * nb, 64 * kb, Wt1, 1024, 32 * nb, scr, lane); continue; } r -= I_E1;
            if (r < I_E2) { const int kb = r / 32, nb = r % 32; transpose_item(args.in[11], N1W, W1_G + 32 * nb, 64 * kb, Wt1, 1024, C1_G + 32 * nb, scr, lane); continue; } r -= I_E2;
            { const int kb = r / 32, nb = r % 32; transpose_item(args.in[13], 1024, 32 * nb, 64 * kb, Wout1, 1024, 32 * nb, scr, lane); }
        }
        { const u32x4 z = {0u, 0u, 0u, 0u};
          u32x4* p0 = (u32x4*)(Wt0 + (size_t)N0 * 1024);
          for (int i = vcu * NTHREADS + tid; i < 96 * 1024 / 8; i += G * NTHREADS) p0[i] = z;
          for (int i = vcu * NTHREADS + tid; i < 1024 * 16; i += G * NTHREADS) { const int row = i >> 4, c = i & 15; *(u32x4*)(Wkvup + (size_t)row * 256 + 128 + c * 8) = z; } }
        for (int m = gw; m < M; m += NGW) rms_row_to_bf16(x + (size_t)m * DM, args.in[2], XN + (size_t)m * DM, lane);
    }
    SEAM(0);
    if (IN(1)) {
        __syncthreads();
        pg8::Gemm g{XN, Wt0, M, N0P, 1024}; pg8::StaticOrder S; S.init(M, N0P, G, bx);
        pg8::EpiBf16<0> E{Z0, N0P, nullptr, 0, 0, 1.f};
        for (int rep = 0; rep < NREP(1); ++rep) {
        pg8::gemm_phase<pg8::EpiBf16<0>, pg8::StaticOrder, true, true>(lds, g, S, E); __syncthreads(); }
    }
    SEAM(1);
    if (IN(2)) {
        const float* gq = args.in[4]; const float* gkv = args.in[6];
        for (int m = gw; m < M; m += NGW) {
            const bf16* z = Z0 + (size_t)m * N0P;
            const u32x2 a = *(const u32x2*)(z + C_CQ + 4 * lane);
            const unsigned bb = *(const unsigned*)(z + C_CKV + 2 * lane);
            const float a0 = bflo(a.x), a1 = bfhi(a.x), a2 = bflo(a.y), a3 = bfhi(a.y), b0 = bflo(bb), b1 = bfhi(bb);
            const float sa = wave_sum((a0 * a0 + a1 * a1) + (a2 * a2 + a3 * a3)), sb = wave_sum(b0 * b0 + b1 * b1);
            const float ra = 1.f / sqrtf(sa * (1.f / 256.f) + EPS), rb = 1.f / sqrtf(sb * (1.f / 128.f) + EPS);
            const f32x4 ga = *(const f32x4*)(gq + 4 * lane); const f32x2 gb = *(const f32x2*)(gkv + 2 * lane);
            u32x2 w; w.x = cvtpk(a0 * ra * ga.x, a1 * ra * ga.y); w.y = cvtpk(a2 * ra * ga.z, a3 * ra * ga.w);
            *(u32x2*)(CQN + (size_t)m * 256 + 4 * lane) = w;
            *(unsigned*)(CKVN + (size_t)m * 256 + 2 * lane) = cvtpk(b0 * rb * gb.x, b1 * rb * gb.y);
            *(unsigned*)(CKVN + (size_t)m * 256 + 128 + 2 * lane) = 0u;
            if (lane < 16) {
                const float invf = (float)exp2(-(double)lane * 0.8304820237218406);
                const double ang = (double)(float)args.pos[m] * (double)invf;
                const double rev = ang * 0.15915494309189535;
                const float rr = (float)(rev - rint(rev));
                const float cv = __builtin_amdgcn_cosf(rr), sv = __builtin_amdgcn_sinf(rr);
                CS[(size_t)m * 32 + lane] = cv; CS[(size_t)m * 32 + 16 + lane] = sv;
                const float x1 = bf1(z[C_KPE + lane]), x2 = bf1(z[C_KPE + 16 + lane]);
                const unsigned o1 = cvtpk(x1 * cv - x2 * sv, 0.f), o2 = cvtpk(x2 * cv + x1 * sv, 0.f);
                KPE[(size_t)m * 32 + lane] = (bf16)(o1 & 0xffffu); KPE[(size_t)m * 32 + 16 + lane] = (bf16)(o2 & 0xffffu);
            }
        }
    }
    SEAM(2);
    if (IN(3)) {
        __syncthreads();
#ifndef NO_QUP
        { int kq_ = 256; asm volatile("" : "+s"(kq_)); pg8::Gemm g{CQN, Wqup, M, 768, kq_}; pg8::StaticOrder S; S.init(M, 768, G, bx);
          pg8::EpiQRope E{Q0, 768, CS};
          pg8::gemm_phase<pg8::EpiQRope, pg8::StaticOrder, true, true>(lds, g, S, E); }
#endif
        __syncthreads();
#ifndef NO_KVUP
        { int kk_ = 256; asm volatile("" : "+s"(kk_)); pg8::Gemm g{CKVN, Wkvup, M, 1024, kk_}; pg8::StaticOrder S; S.init(M, 1024, G, bx);
          pg8::EpiBf16<0> E{KN, 512, nullptr, 512, (size_t)(WS_VM - WS_KN) / 2, 1.f};
          pg8::gemm_phase<pg8::EpiBf16<0>, pg8::StaticOrder, true, true>(lds, g, S, E); }
#endif
    }
    SEAM(3);
    if (IN(4)) {
        __syncthreads();
        for (;;) {
            if (tid == 0) *(volatile LAS int*)(lds + LDS_MISC + 64) = (int)atomicAdd(qctr + 64 * (bx & 7), 1u);
            __syncthreads();
            const int tk = *(volatile LAS int*)(lds + LDS_MISC + 64);
            __syncthreads();
            if (tk >= 128) break;
            const bool swa = tk >= 64; const int bh = 8 * (bx & 7) + ((tk & 63) >> 3), s = tk & 7, b = bh >> 3, h = bh & 7;
            const size_t rb = (size_t)b * SEQ;
            AttnP p;
            if (!swa) {
                p.Q = Q0 + rb * 768 + h * 96; p.ldq = 768; p.K = KN + rb * 512 + h * 64; p.ldk = 512; p.K2 = KPE + rb * 32; p.ldk2 = 32; p.V = VM + rb * 512 + h * 64; p.ldv = 512;
                p.G = Z0 + rb * N0P + C_G0 + h * 64; p.ldg = N0P; p.O = OG + rb * 1024 + h * 64; p.ldo = 1024; p.lc = nullptr; p.tmax = nullptr; p.c = 0.10206207261596575f * LOG2E; p.sink2 = 0.f; p.slope2 = 0.f;
                attn_unit<96, 0>(p, (15 - s) * 256, lds); attn_unit<96, 0>(p, s * 256, lds);
            } else {
                p.Q = Z0 + rb * N0P + C_QS + h * 64; p.ldq = N0P; p.K = Z0 + rb * N0P + C_KS + (h >> 2) * 64; p.ldk = N0P; p.K2 = nullptr; p.ldk2 = 0; p.V = Z0 + rb * N0P + C_VS + (h >> 2) * 64; p.ldv = N0P;
                p.G = Z0 + rb * N0P + C_G0 + 512 + h * 64; p.ldg = N0P; p.O = OG + rb * 1024 + 512 + h * 64; p.ldo = 1024; p.lc = nullptr; p.tmax = nullptr; p.c = 0.125f * LOG2E;
                p.sink2 = args.in[8][h] * LOG2E; p.slope2 = exp2f(-(float)(h + 1)) * LOG2E;
                attn_unit<64, 1>(p, (15 - s) * 256, lds); attn_unit<64, 1>(p, s * 256, lds);
            }
        }
    }
    SEAM(4);
    if (IN(5)) {
        __syncthreads();
        pg8::Gemm g{OG, Wout0, M, 1024, 1024}; pg8::StaticOrder S; S.init(M, 1024, G, bx);
        pg8::EpiResF32 E{x, out, 1024};
        pg8::gemm_phase<pg8::EpiResF32, pg8::StaticOrder, true, true>(lds, g, S, E);
    }
    SEAM(5);
    if (IN(6)) {
        __syncthreads();
        const float* g1 = args.in[10]; const float* w1 = args.in[11]; const float* bfp = args.in[12];
        LAS float* WF = (LAS float*)lds;
        for (int k = tid; k < 1024; k += NTHREADS) {
            const int l = (k & 255) >> 2, j = k >> 8, e = k & 3; const int R = l + 64 * (4 * j + e); const float gk = g1[k];
#pragma unroll
            for (int c = 0; c < 4; ++c) { const f32x4 wv = *(const f32x4*)(w1 + (size_t)k * N1W + W1_F + 4 * c); *(LAS f32x4*)(WF + R * 20 + 4 * c) = wv * gk; }
        }
        __syncthreads();
        for (int m = gw; m < M; m += NGW) {
            const f32x4* xr = (const f32x4*)(out + (size_t)m * DM) + lane; const f32x4* gr = (const f32x4*)g1 + lane;
            f32x4 v[4]; float ss = 0.f;
#pragma unroll
            for (int j = 0; j < 4; ++j) { v[j] = xr[64 * j]; ss += (v[j].x * v[j].x + v[j].y * v[j].y) + (v[j].z * v[j].z + v[j].w * v[j].w); }
            const float rs = 1.f / sqrtf(wave_sum(ss) * (1.f / DM) + EPS);
            u32x2* o8 = (u32x2*)(XN + (size_t)m * DM) + lane;
            float fa[16];
#pragma unroll
            for (int n = 0; n < 16; ++n) fa[n] = 0.f;
#pragma unroll
            for (int j = 0; j < 4; ++j) { const f32x4 gg = gr[64 * j]; u32x2 w; w.x = cvtpk(v[j].x * rs * gg.x, v[j].y * rs * gg.y); w.y = cvtpk(v[j].z * rs * gg.z, v[j].w * rs * gg.w); o8[64 * j] = w;
#pragma unroll
                for (int e = 0; e < 4; ++e) { const float xv = v[j][e]; const LAS float* wr_ = WF + (lane + 64 * (4 * j + e)) * 20;
#pragma unroll
                    for (int c = 0; c < 4; ++c) { const f32x4 wv = *(const LAS f32x4*)(wr_ + 4 * c); fa[4 * c + 0] += xv * wv.x; fa[4 * c + 1] += xv * wv.y; fa[4 * c + 2] += xv * wv.z; fa[4 * c + 3] += xv * wv.w; }
                    asm volatile("" ::: "memory"); } }
            float mine = 0.f;
#pragma unroll
            for (int n = 0; n < 16; ++n) { const float t = wave_sum(fa[n]); if (lane == n) mine = t; }
            if (lane < 16) { const float f = mine * rs + bfp[lane]; const float lsg = fminf(f, 0.f) - log1pf(expf(-fabsf(f))); LF[(size_t)m * 16 + lane] = lsg; }
        }
    }
    SEAM(6);
    if (IN(7)) {
        __syncthreads();
        LAS float* sm = (LAS float*)lds;
        for (int bh = bx; bh < 128; bh += G) {
            const int b = bh >> 4, h = bh & 15; float v[8]; float run = 0.f;
#pragma unroll
            for (int e = 0; e < 8; ++e) { run += LF[((size_t)b * SEQ + 8 * tid + e) * 16 + h]; v[e] = run; }
            float sc = run;
#pragma unroll
            for (int o = 1; o < 64; o <<= 1) { const float n = __shfl_up(sc, o); if (lane >= o) sc += n; }
            if (lane == 63) sm[wave] = sc;
            __syncthreads();
            float off = sc - run;
            for (int w = 0; w < wave; ++w) off += sm[w];
            f32x4 o0 = {(v[0] + off) * LOG2E, (v[1] + off) * LOG2E, (v[2] + off) * LOG2E, (v[3] + off) * LOG2E}, o1 = {(v[4] + off) * LOG2E, (v[5] + off) * LOG2E, (v[6] + off) * LOG2E, (v[7] + off) * LOG2E};
            *(f32x4*)(LC + (size_t)bh * SEQ + 8 * tid) = o0; *(f32x4*)(LC + (size_t)bh * SEQ + 8 * tid + 4) = o1;
            __syncthreads();
        }
        pg8::Gemm g{XN, Wt1, M, N1, 1024}; pg8::StaticOrder S; S.init(M, N1, G, bx);
        pg8::EpiBf16<0> E{Z1, N1, nullptr, 0, 0, 1.f};
        for (int rep = 0; rep < NREP(7); ++rep) {
        pg8::gemm_phase<pg8::EpiBf16<0>, pg8::StaticOrder, true, true>(lds, g, S, E); __syncthreads(); }
    }
    SEAM(7);
    if (IN(8)) {
        __syncthreads();
        LAS float* sm = (LAS float*)lds;
        for (int task = vcu; task < 512; task += G) {
            const int b = task >> 6, T = task & 63;
            const bf16* kbase = Z1 + ((size_t)b * SEQ + 64 * T + (tid >> 7)) * N1 + C1_K + (tid & 127) * 8;
            float mxn = 0.f;
#pragma unroll 4
            for (int i = 0; i < 16; ++i) {
                const u32x4 v = *(const u32x4*)(kbase + (size_t)(4 * i) * N1);
                float s = 0.f;
#pragma unroll
                for (int e = 0; e < 4; ++e) { const float a = bflo(v[e]), c = bfhi(v[e]); s += a * a + c * c; }
                s += __shfl_xor(s, 1); s += __shfl_xor(s, 2); s += __shfl_xor(s, 4);
                mxn = fmaxf(mxn, s);
            }
            if ((tid & 7) == 0) sm[(tid >> 7) * 16 + ((tid & 127) >> 3)] = mxn;
            __syncthreads();
            if (tid < 16) { const float m4 = fmaxf(fmaxf(sm[tid], sm[16 + tid]), fmaxf(sm[32 + tid], sm[48 + tid])); TMAXB[((size_t)(b * 16 + tid)) * 64 + T] = sqrtf(m4); }
            __syncthreads();
        }
    }
    SEAM(8);
    if (IN(9)) {
        __syncthreads();
        for (;;) {
            if (tid == 0) *(volatile LAS int*)(lds + LDS_MISC + 64) = (int)atomicAdd(qctr + 64 * (8 + (bx & 7)), 1u);
            __syncthreads();
            const int tk = *(volatile LAS int*)(lds + LDS_MISC + 64);
            __syncthreads();
            if (tk >= 128) break;
            const int bh = 16 * (bx & 7) + (tk >> 3), s = tk & 7, b = bh >> 4, h = bh & 15; const size_t rb = (size_t)b * SEQ;
            AttnP p;
            p.Q = Z1 + rb * N1 + C1_Q + h * 64; p.ldq = N1; p.K = Z1 + rb * N1 + C1_K + h * 64; p.ldk = N1; p.K2 = nullptr; p.ldk2 = 0; p.V = Z1 + rb * N1 + C1_V + h * 64; p.ldv = N1;
            p.G = Z1 + rb * N1 + C1_G + h * 64; p.ldg = N1; p.O = OG + rb * 1024 + h * 64; p.ldo = 1024; p.lc = LC + (size_t)bh * SEQ; p.tmax = TMAXB + (size_t)bh * 64; p.c = 0.125f * LOG2E; p.sink2 = 0.f; p.slope2 = 0.f;
            attn_unit<64, 2>(p, (15 - s) * 256, lds); attn_unit<64, 2>(p, s * 256, lds);
        }
    }
    SEAM(9);
    if (IN(10)) {
        __syncthreads();
        pg8::Gemm g{OG, Wout1, M, 1024, 1024}; pg8::StaticOrder S; S.init(M, 1024, G, bx);
        pg8::EpiResF32 E{out, out, 1024};
        pg8::gemm_phase<pg8::EpiResF32, pg8::StaticOrder, true, true>(lds, g, S, E);
    }
    SEAM(10);
    if (IN(11)) {
        const float* gf = args.in[14];
        for (int m = gw; m < M; m += NGW) {
            f32x4* xr = (f32x4*)(out + (size_t)m * DM) + lane; const f32x4* gr = (const f32x4*)gf + lane;
            f32x4 v[4]; float ss = 0.f;
#pragma unroll
            for (int j = 0; j < 4; ++j) { v[j] = xr[64 * j]; ss += (v[j].x * v[j].x + v[j].y * v[j].y) + (v[j].z * v[j].z + v[j].w * v[j].w); }
            const float rs = 1.f / sqrtf(wave_sum(ss) * (1.f / DM) + EPS);
#pragma unroll
            for (int j = 0; j < 4; ++j) xr[64 * j] = v[j] * rs * gr[64 * j];
        }
    }
#undef IN
#undef SEAM
}

constexpr int NPHASES = 12;
extern "C" void kernel_launch(void* const* d_in, const int* in_sizes, int n_in, void* d_out, int out_size, void* d_ws, size_t ws_size, hipStream_t stream) {
    static int grid = 0;
    if (grid == 0) {
        if (n_in != 15 || out_size != M * DM || ws_size < WS_END) { fprintf(stderr, "kernel_launch: unexpected shapes (n_in %d, out %d, ws %zu)\n", n_in, out_size, ws_size); grid = -1; return; }
        int dev = 0, cus = 0, per_cu = 0;
        (void)hipGetDevice(&dev); (void)hipDeviceGetAttribute(&cus, hipDeviceAttributeMultiprocessorCount, dev);
#if MK_COOP
        (void)hipFuncSetAttribute((const void*)mk_fwd<true>, hipFuncAttributeMaxDynamicSharedMemorySize, LDS_BYTES);
        (void)hipOccupancyMaxActiveBlocksPerMultiprocessor(&per_cu, (const void*)mk_fwd<true>, NTHREADS, LDS_BYTES);
#else
        (void)hipFuncSetAttribute((const void*)mk_fwd<false>, hipFuncAttributeMaxDynamicSharedMemorySize, LDS_BYTES);
        (void)hipOccupancyMaxActiveBlocksPerMultiprocessor(&per_cu, (const void*)mk_fwd<false>, NTHREADS, LDS_BYTES);
#endif
        (void)hipGetLastError();
        if (per_cu < 1) per_cu = 1;
        if (cus <= 0) cus = 256;
        grid = cus * 1;
    }
    if (grid < 0) return;
    Args a{};
    for (int i = 0; i < 15; ++i) a.in[i] = (const float*)d_in[i];
    a.pos = (const int*)d_in[1]; a.out = (float*)d_out; a.ws = (unsigned char*)d_ws;
#if MK_COOP
    a.ph_lo = 0; a.ph_hi = NPHASES;
    void* kargs[] = {&a};
    hipError_t e = hipLaunchCooperativeKernel((const void*)mk_fwd<true>, dim3(grid), dim3(NTHREADS), kargs, LDS_BYTES, stream);
    if (e != hipSuccess) fprintf(stderr, "cooperative launch failed: %s (grid %d)\n", hipGetErrorString(e), grid);
#else
    for (int ph = 0; ph < NPHASES; ++ph) { a.ph_lo = ph; a.ph_hi = ph + 1; hipLaunchKernelGGL(mk_fwd<false>, dim3(grid), dim3(NTHREADS), LDS_BYTES, stream, a); }
#endif
}
```

```cpp
#include <hip/hip_runtime.h>
#include <hip/hip_cooperative_groups.h>
#include <cstdio>
#include <cstdint>
#include <cmath>
namespace cg = cooperative_groups;
#ifndef MK_COOP
#define MK_COOP 1
#endif
namespace pg8 {
#define PG8_LAS __attribute__((address_space(3)))
typedef unsigned short bf16_t;
typedef short bf16x8 __attribute__((ext_vector_type(8)));
typedef float f32x4 __attribute__((ext_vector_type(4)));
typedef unsigned u32x4 __attribute__((ext_vector_type(4)));
constexpr int BM = 256, BK = 64, HALF = 128, HTB = HALF * BK * 2  , STAGE_BYTES = 8 * HTB, NXCD = 8, WGM = 8;

__host__ __device__ __forceinline__ int lds_byte(int r, int c) { const int st = (r >> 4) * 2 + (c >> 5), rr = r & 15, cc = c & 31, ob = rr * 64 + cc * 2; return st * 1024 + (ob ^ (((ob >> 9) & 1) << 5)); }
__host__ __device__ __forceinline__ void stage_rc(int b, int& R, int& C) { const int st = b / 1024, sb = b % 1024, swz = sb ^ (((sb >> 9) & 1) << 5); R = (st >> 1) * 16 + swz / 64; C = (st & 1) * 32 + (swz % 64) / 2; }
__host__ __device__ __forceinline__ int perm32(int rho) { const int n = rho >> 4, i = rho & 15; return 8 * (i >> 2) + 4 * n + (i & 3); }

struct Unit { int pm, pn; };
struct Gemm { const bf16_t* A; const bf16_t* Bt; int M, N, K; };

struct StaticOrder {
    int nM, nN, nwg, G, c;
    __host__ __device__ void init(int M, int N, int G_, int c_) { nM = M / BM; nN = N / BM; nwg = nM * nN; G = G_; c = c_; }
    __host__ __device__ bool next(int i, Unit& u) const {
        const long L = (long)i * G + c; if (L >= nwg) return false;
        int wgid = (int)L; { const int q = nwg / NXCD, r = nwg % NXCD, xcd = wgid % NXCD, off = wgid / NXCD; wgid = (xcd < r ? xcd * (q + 1) : r * (q + 1) + (xcd - r) * q) + off; }
        const int nig = WGM * nN, gid = wgid / nig, fm = gid * WGM, gsz = (nM - fm) < WGM ? (nM - fm) : WGM;
        u.pm = fm + ((wgid % nig) % gsz); u.pn = (wgid % nig) / gsz; return true;
    }
    __device__ __forceinline__ void a_ready(const Unit&) const {}
    __device__ __forceinline__ void done(const Unit&) const {}
};

__device__ __forceinline__ unsigned cvt_pk_bf16(float lo, float hi) { unsigned r; asm volatile("v_cvt_pk_bf16_f32 %0, %1, %2" : "=v"(r) : "v"(lo), "v"(hi)); return r; }
typedef float f32x2 __attribute__((ext_vector_type(2)));
__device__ __forceinline__ f32x2 gelu_pk(f32x2 v) {
    const f32x2 av = __builtin_elementwise_abs(v), d = av * 0.2316418882f + 1.0f;
    f32x2 t; t.x = __builtin_amdgcn_rcpf(d.x); t.y = __builtin_amdgcn_rcpf(d.y);
    f32x2 q = t * 0.5307027145f + (-0.7265760135f); q = q * t + 0.7107068705f; q = q * t + (-0.142248368f); q = q * t + 0.127414796f; q = q * t;
    const f32x2 s = (v * v) * (-0.72134752044f);
    f32x2 e; e.x = __builtin_amdgcn_exp2f(s.x); e.y = __builtin_amdgcn_exp2f(s.y);
    const f32x2 m = v * (q * e), r = v - m;
    f32x2 o; o.x = v.x < 0.f ? m.x : r.x; o.y = v.y < 0.f ? m.y : r.y; return o;
}

template <int ACT  > struct EpiBf16 {
    static constexpr bool PERM = true, AFTER_DRAIN = false; static_assert(ACT == 0 || ACT == 1, "EpiBf16: ACT is 0 (none) or 1 (gelu_pk)");
    bf16_t* O; int ldc; const float* bias; int split_cols; size_t split_stride; float scale0;
    __device__ __forceinline__ void operator()(const f32x4 (&acc)[2][2][4][2], const Unit& u, int wr, int wc, int fr, int fq) const {
        const int row0 = u.pm * BM + wr * 64 + fr; int colt = u.pn * BM; bf16_t* base = O;
        float sc = 1.f; if (split_cols) { const int t = colt / split_cols; base += (size_t)t * split_stride; colt -= t * split_cols; if (t == 0) sc = scale0; }
        const int col0 = colt + wc * 32 + 8 * fq, bcol0 = u.pn * BM + wc * 32 + 8 * fq;
        f32x4 bv[2][2];
#pragma unroll
        for (int bj = 0; bj < 2; ++bj)
#pragma unroll
            for (int n = 0; n < 2; ++n) bv[bj][n] = bias ? *(const f32x4*)(bias + bcol0 + bj * HALF + 4 * n) : (f32x4){0.f, 0.f, 0.f, 0.f};
#pragma unroll
        for (int ai = 0; ai < 2; ++ai)
#pragma unroll
            for (int m = 0; m < 4; ++m) { bf16_t* rowp = base + (size_t)(row0 + ai * HALF + m * 16) * ldc + col0;
#pragma unroll
                for (int bj = 0; bj < 2; ++bj) { f32x4 v0 = acc[ai][bj][m][0] + bv[bj][0], v1 = acc[ai][bj][m][1] + bv[bj][1];
                    if (ACT == 1) { f32x2 a = gelu_pk((f32x2){v0[0], v0[1]}), b = gelu_pk((f32x2){v0[2], v0[3]}), c = gelu_pk((f32x2){v1[0], v1[1]}), d = gelu_pk((f32x2){v1[2], v1[3]});
                        v0 = (f32x4){a.x, a.y, b.x, b.y}; v1 = (f32x4){c.x, c.y, d.x, d.y}; }
                    v0 = v0 * sc; v1 = v1 * sc; u32x4 w; w.x = cvt_pk_bf16(v0[0], v0[1]); w.y = cvt_pk_bf16(v0[2], v0[3]); w.z = cvt_pk_bf16(v1[0], v1[1]); w.w = cvt_pk_bf16(v1[2], v1[3]);
                    *(u32x4*)(rowp + bj * HALF) = w; } }
    }
};
typedef unsigned u32x2 __attribute__((ext_vector_type(2)));
struct EpiQRope {
    static constexpr bool PERM = false, AFTER_DRAIN = false;
    bf16_t* O; int ldc; const float* cs;
    __device__ __forceinline__ void operator()(const f32x4 (&acc)[2][2][4][2], const Unit& u, int wr, int wc, int fr, int fq) const {
        const int row0 = u.pm * BM + wr * 64 + fr;
#pragma unroll
        for (int ai = 0; ai < 2; ++ai)
#pragma unroll
            for (int m = 0; m < 4; ++m) {
                const int row = row0 + ai * HALF + m * 16;
                const f32x4 cv = *(const f32x4*)(cs + (size_t)row * 32 + 4 * fq), sv = *(const f32x4*)(cs + (size_t)row * 32 + 16 + 4 * fq);
#pragma unroll
                for (int bj = 0; bj < 2; ++bj) {
                    const int colb = u.pn * BM + bj * HALF + wc * 32;
                    f32x4 v0 = acc[ai][bj][m][0], v1 = acc[ai][bj][m][1];
                    if (((colb >> 5) % 3) == 2) { const f32x4 a = v0 * cv - v1 * sv, b = v1 * cv + v0 * sv; v0 = a; v1 = b; }
                    bf16_t* rp = O + (size_t)row * ldc + colb + 4 * fq;
                    u32x2 w0, w1; w0.x = cvt_pk_bf16(v0[0], v0[1]); w0.y = cvt_pk_bf16(v0[2], v0[3]); w1.x = cvt_pk_bf16(v1[0], v1[1]); w1.y = cvt_pk_bf16(v1[2], v1[3]);
                    *(u32x2*)(rp) = w0; *(u32x2*)(rp + 16) = w1;
                }
                asm volatile("" ::: "memory");
            }
    }
};
struct EpiResF32 {
    static constexpr bool PERM = false, AFTER_DRAIN = false;
    const float* base; float* out; int ldc;
    __device__ __forceinline__ void operator()(const f32x4 (&acc)[2][2][4][2], const Unit& u, int wr, int wc, int fr, int fq) const {
        const int row0 = u.pm * BM + wr * 64 + fr, col0 = u.pn * BM + wc * 32 + 4 * fq;
#pragma unroll
        for (int ai = 0; ai < 2; ++ai)
#pragma unroll
            for (int m = 0; m < 4; ++m) {
                const size_t off = (size_t)(row0 + ai * HALF + m * 16) * ldc + col0;
#pragma unroll
                for (int bj = 0; bj < 2; ++bj)
#pragma unroll
                    for (int n = 0; n < 2; ++n) { const f32x4 b = *(const f32x4*)(base + off + bj * HALF + n * 16); *(f32x4*)(out + off + bj * HALF + n * 16) = b + acc[ai][bj][m][n]; }
                asm volatile("" ::: "memory");
            }
    }
};
struct PanelRms {
    float* xbuf;
    unsigned* cnt;
    float eps;
    __device__ __forceinline__ void run(const f32x4 (&v)[2][2][4][2], const Unit& u, int wr, int wc, int fr, int fq, PG8_LAS unsigned char* lds, int wid, int lane) const {
        PG8_LAS float* P = (PG8_LAS float*)lds;
        PG8_LAS float* S = (PG8_LAS float*)(lds + 4096);
#pragma unroll
        for (int ai = 0; ai < 2; ++ai)
#pragma unroll
            for (int m = 0; m < 4; ++m) {
                float s = 0.f;
#pragma unroll
                for (int bj = 0; bj < 2; ++bj)
#pragma unroll
                    for (int n = 0; n < 2; ++n) { const f32x4 x = v[ai][bj][m][n]; s += (x[0] * x[0] + x[1] * x[1]) + (x[2] * x[2] + x[3] * x[3]); }
                s += __shfl_xor(s, 16); s += __shfl_xor(s, 32);
                if (fq == 0) P[(ai * HALF + wr * 64 + m * 16 + fr) * 4 + wc] = s;
            }
        asm volatile("s_waitcnt lgkmcnt(0)" ::: "memory"); __builtin_amdgcn_s_barrier(); asm volatile("" ::: "memory");
        const int row = wid * 32 + (lane & 31);
        if (lane < 32) {
            const float t = (P[row * 4 + 0] + P[row * 4 + 1]) + (P[row * 4 + 2] + P[row * 4 + 3]);
            __hip_atomic_store(xbuf + ((size_t)(u.pm * BM + row) * 4 + u.pn), t, __ATOMIC_RELAXED, __HIP_MEMORY_SCOPE_AGENT);
        }
        asm volatile("s_waitcnt vmcnt(0)" ::: "memory");
        if (lane == 0) __hip_atomic_fetch_add(cnt + 64 * u.pm, 1u, __ATOMIC_RELAXED, __HIP_MEMORY_SCOPE_AGENT);
        if (wid == 0) {
            unsigned spins = 0;
            while ((unsigned)__builtin_amdgcn_readfirstlane(__hip_atomic_load(cnt + 64 * u.pm, __ATOMIC_RELAXED, __HIP_MEMORY_SCOPE_AGENT)) < 32u) { __builtin_amdgcn_s_sleep(2); if (++spins > (1u << 20)) break; }
            __builtin_amdgcn_fence(__ATOMIC_ACQUIRE, "agent");
        }
        asm volatile("s_waitcnt vmcnt(0) lgkmcnt(0)" ::: "memory"); __builtin_amdgcn_s_barrier(); asm volatile("" ::: "memory");
        if (lane < 32) {
            const float* slot = xbuf + (size_t)(u.pm * BM + row) * 4; float q = 0.f;
#pragma unroll
            for (int t = 0; t < 4; ++t) q += __hip_atomic_load(slot + t, __ATOMIC_RELAXED, __HIP_MEMORY_SCOPE_AGENT);
            S[row] = 1.0f / sqrtf(q * (1.0f / 1024.0f) + eps);
        }
        asm volatile("s_waitcnt lgkmcnt(0)" ::: "memory"); __builtin_amdgcn_s_barrier(); asm volatile("" ::: "memory");
    }
};
struct EpiRmsOut {
    static constexpr bool PERM = false, AFTER_DRAIN = true;
    const float* base; float* out; const float* g; int ldc; PanelRms st;
    __device__ __forceinline__ void fused(f32x4 (&acc)[2][2][4][2], const Unit& u, int wr, int wc, int fr, int fq, PG8_LAS unsigned char* lds, int wid, int lane) const {
        const PG8_LAS float* S = (const PG8_LAS float*)(lds + 4096);
        const int col0 = u.pn * BM + wc * 32 + 4 * fq;
#pragma unroll
        for (int ai = 0; ai < 2; ++ai)
#pragma unroll
            for (int m = 0; m < 4; ++m) { const size_t off = (size_t)(u.pm * BM + ai * HALF + wr * 64 + m * 16 + fr) * ldc + col0;
#pragma unroll
                for (int bj = 0; bj < 2; ++bj)
#pragma unroll
                    for (int n = 0; n < 2; ++n) acc[ai][bj][m][n] += *(const f32x4*)(base + off + bj * HALF + n * 16);
                asm volatile("" : "+v"(acc[ai][0][m][0]), "+v"(acc[ai][0][m][1]), "+v"(acc[ai][1][m][0]), "+v"(acc[ai][1][m][1]));
                if (m & 1) asm volatile("" ::: "memory"); }
        st.run(acc, u, wr, wc, fr, fq, lds, wid, lane);
#pragma unroll
        for (int bj = 0; bj < 2; ++bj)
#pragma unroll
            for (int n = 0; n < 2; ++n) { const f32x4 gv = *(const f32x4*)(g + col0 + bj * HALF + n * 16);
#pragma unroll
                for (int ai = 0; ai < 2; ++ai)
#pragma unroll
                    for (int m = 0; m < 4; ++m) { const int r = ai * HALF + wr * 64 + m * 16 + fr; const float rs = S[r];
                        *(f32x4*)(out + (size_t)(u.pm * BM + r) * ldc + col0 + bj * HALF + n * 16) = acc[ai][bj][m][n] * rs * gv; } }
    }
};
template <class Epi, class Sched, bool ALIGN_EPI = false, bool SP2 = false>
__device__ __forceinline__ void gemm_phase(PG8_LAS unsigned char* lds, const Gemm g, const Sched& S, const Epi& E) {
    const int tid = threadIdx.x, wid = __builtin_amdgcn_readfirstlane(tid >> 6), lane = tid & 63, wr = wid >> 2, wc = wid & 3, fr = lane & 15, fq = lane >> 4;
    const int K = g.K, nt = K / BK;
    unsigned voffA[2], voffB[2];
#pragma unroll
    for (int i = 0; i < 2; ++i) { int R, C; stage_rc(tid * 16 + i * 8192, R, C); const int Rb = Epi::PERM ? ((R & ~31) + perm32(R & 31)) : R;
        voffA[i] = (unsigned)(R * K + C) * 2u; voffB[i] = (unsigned)(Rb * K + C) * 2u; }
    const size_t kstep = (size_t)(BK * 2);
    const size_t hstep = (size_t)HALF * K * 2;
    const size_t tstep = 2 * hstep;
    const unsigned ldsw = (unsigned)wid * 1024u;
    const int aoff = lds_byte(wr * 64 + fr, fq * 8), boff = lds_byte(wc * 32 + fr, fq * 8);
#define PG8_SA(b, h) (((b) * 2 + (h)) * HTB)
#define PG8_SB(b, h) ((4 + (b) * 2 + (h)) * HTB)
#define PG8_STAGE(bufoff, gbase, voff) do { _Pragma("unroll") for (int _i = 0; _i < 2; ++_i) \
        __builtin_amdgcn_global_load_lds((const unsigned*)((const char*)(gbase) + (voff)[_i]), (PG8_LAS unsigned*)(lds + (bufoff) + ldsw + _i * 8192), 16, 0, 0); } while (0)
#define PG8_LDA(dst, b, h) do { _Pragma("unroll") for (int m = 0; m < 4; ++m) _Pragma("unroll") for (int k = 0; k < 2; ++k) dst[m][k] = *(const PG8_LAS bf16x8*)(lds + PG8_SA(b, h) + aoff + m * 2048 + k * 1024); } while (0)
#define PG8_LDB(dst, b, h) do { _Pragma("unroll") for (int n = 0; n < 2; ++n) _Pragma("unroll") for (int k = 0; k < 2; ++k) dst[n][k] = *(const PG8_LAS bf16x8*)(lds + PG8_SB(b, h) + boff + n * 2048 + k * 1024); } while (0)
#define PG8_MMA(ai, bj, At, Bt) do { __builtin_amdgcn_s_setprio(1); _Pragma("unroll") for (int m = 0; m < 4; ++m) _Pragma("unroll") for (int n = 0; n < 2; ++n) _Pragma("unroll") for (int k = 0; k < 2; ++k) \
        acc[ai][bj][m][n] = __builtin_amdgcn_mfma_f32_16x16x32_bf16(Bt[n][k], At[m][k], acc[ai][bj][m][n], 0, 0, 0); __builtin_amdgcn_s_setprio(0); } while (0)
#define PG8_WAIT_V(n) asm volatile("s_waitcnt vmcnt(" #n ")" ::: "memory")
#define PG8_WAIT_L(n) asm volatile("s_waitcnt lgkmcnt(" #n ")" ::: "memory")
#define PG8_BAR __builtin_amdgcn_s_barrier()
#define PG8_SCHED __builtin_amdgcn_sched_barrier(0)
    Unit cur, nxt; int ui = 0;
    if (!S.next(0, cur)) return;
    f32x4 acc[2][2][4][2];
#pragma unroll
    for (int a = 0; a < 2; ++a)
#pragma unroll
        for (int b = 0; b < 2; ++b)
#pragma unroll
            for (int m = 0; m < 4; ++m)
#pragma unroll
                for (int n = 0; n < 2; ++n) acc[a][b][m][n] = (f32x4){0.f, 0.f, 0.f, 0.f};
    bf16x8 At[4][2], B0[2][2], B1[2][2];
    const char* cA = (const char*)g.A + (size_t)cur.pm * tstep; const char* cB = (const char*)g.Bt + (size_t)cur.pn * tstep;
    S.a_ready(cur);
    if constexpr (SP2) {
        PG8_STAGE(PG8_SB(0, 0), cB, voffB); PG8_STAGE(PG8_SB(0, 1), cB + hstep, voffB); PG8_STAGE(PG8_SA(0, 0), cA, voffA); PG8_STAGE(PG8_SA(0, 1), cA + hstep, voffA);
        if (wr == 1) PG8_BAR;
        PG8_WAIT_V(2); PG8_BAR;
        PG8_STAGE(PG8_SB(1, 0), cB + kstep, voffB); PG8_STAGE(PG8_SA(1, 0), cA + kstep, voffA); PG8_STAGE(PG8_SB(1, 1), cB + hstep + kstep, voffB);
        PG8_WAIT_V(6); PG8_BAR;
    } else {
        PG8_STAGE(PG8_SB(0, 0), cB, voffB); PG8_STAGE(PG8_SA(0, 0), cA, voffA); PG8_STAGE(PG8_SB(0, 1), cB + hstep, voffB); PG8_STAGE(PG8_SA(0, 1), cA + hstep, voffA);
        if (wr == 1) PG8_BAR;
        PG8_WAIT_V(4); PG8_BAR;
        PG8_STAGE(PG8_SB(1, 0), cB + kstep, voffB); PG8_STAGE(PG8_SA(1, 0), cA + kstep, voffA); PG8_STAGE(PG8_SB(1, 1), cB + hstep + kstep, voffB);
        PG8_WAIT_V(6); PG8_BAR;
    }
    for (;;) {
        const bool has_next = S.next(ui + 1, nxt);
        const char* nA = has_next ? (const char*)g.A + (size_t)nxt.pm * tstep : cA; const char* nB = has_next ? (const char*)g.Bt + (size_t)nxt.pn * tstep : cB;
        for (int t = 0; t < nt; t += 2) {
            const bool last = (t == nt - 2);
            const char* a1 = cA + (size_t)(t + 1) * kstep;
            const char* a2 = last ? nA : cA + (size_t)(t + 2) * kstep; const char* b2 = last ? nB : cB + (size_t)(t + 2) * kstep;
            const char* a3 = a2 + kstep; const char* b3 = b2 + kstep;
            if (last && has_next) S.a_ready(nxt);
            if constexpr (SP2) {
            PG8_LDB(B0, 0, 0); PG8_LDB(B1, 0, 1); PG8_SCHED; PG8_LDA(At, 0, 0); PG8_STAGE(PG8_SA(1, 1), a1 + hstep, voffA);
            PG8_WAIT_V(8); PG8_WAIT_L(0); PG8_BAR; PG8_MMA(0, 0, At, B0); PG8_MMA(0, 1, At, B1); PG8_BAR; PG8_SCHED;
            PG8_LDA(At, 0, 1); PG8_STAGE(PG8_SB(0, 0), b2, voffB); PG8_STAGE(PG8_SB(0, 1), b2 + hstep, voffB); PG8_STAGE(PG8_SA(0, 0), a2, voffA);
            PG8_WAIT_V(8); PG8_WAIT_L(0); PG8_BAR; PG8_MMA(1, 0, At, B0); PG8_MMA(1, 1, At, B1); PG8_BAR; PG8_SCHED;
            PG8_LDB(B0, 1, 0); PG8_LDB(B1, 1, 1); PG8_SCHED; PG8_LDA(At, 1, 0); PG8_STAGE(PG8_SA(0, 1), a2 + hstep, voffA);
            PG8_WAIT_V(8); PG8_WAIT_L(0); PG8_BAR; PG8_MMA(0, 0, At, B0); PG8_MMA(0, 1, At, B1); PG8_BAR; PG8_SCHED;
            PG8_LDA(At, 1, 1); PG8_STAGE(PG8_SB(1, 0), b3, voffB); PG8_STAGE(PG8_SB(1, 1), b3 + hstep, voffB); PG8_STAGE(PG8_SA(1, 0), a3, voffA);
            PG8_WAIT_V(8); PG8_WAIT_L(0); PG8_BAR; PG8_MMA(1, 0, At, B0); PG8_MMA(1, 1, At, B1); PG8_BAR; PG8_SCHED;
            } else {
            PG8_LDB(B0, 0, 0); PG8_SCHED; PG8_LDA(At, 0, 0); PG8_STAGE(PG8_SA(1, 1), a1 + hstep, voffA);
            PG8_WAIT_L(8); PG8_BAR; PG8_WAIT_L(0); PG8_MMA(0, 0, At, B0); PG8_BAR; PG8_SCHED;
            PG8_LDB(B1, 0, 1); PG8_STAGE(PG8_SB(0, 0), b2, voffB);
            PG8_BAR; PG8_WAIT_L(0); PG8_MMA(0, 1, At, B1); PG8_BAR;
            PG8_LDA(At, 0, 1); PG8_STAGE(PG8_SA(0, 0), a2, voffA);
            PG8_BAR; PG8_WAIT_L(0); PG8_MMA(1, 0, At, B0); PG8_BAR; PG8_SCHED;
            PG8_STAGE(PG8_SB(0, 1), b2 + hstep, voffB);
            PG8_WAIT_V(6); PG8_BAR; PG8_MMA(1, 1, At, B1); PG8_BAR;
            PG8_LDB(B0, 1, 0); PG8_SCHED; PG8_LDA(At, 1, 0); PG8_STAGE(PG8_SA(0, 1), a2 + hstep, voffA);
            PG8_WAIT_L(8); PG8_BAR; PG8_WAIT_L(0); PG8_MMA(0, 0, At, B0); PG8_BAR; PG8_SCHED;
            PG8_LDB(B1, 1, 1); PG8_STAGE(PG8_SB(1, 0), b3, voffB);
            PG8_BAR; PG8_WAIT_L(0); PG8_MMA(0, 1, At, B1); PG8_BAR;
            PG8_LDA(At, 1, 1); PG8_STAGE(PG8_SA(1, 0), a3, voffA);
            PG8_BAR; PG8_WAIT_L(0); PG8_MMA(1, 0, At, B0); PG8_BAR; PG8_SCHED;
            PG8_STAGE(PG8_SB(1, 1), b3 + hstep, voffB);
            PG8_WAIT_V(6); PG8_BAR; PG8_MMA(1, 1, At, B1); PG8_BAR;
            }
        }
        if constexpr (ALIGN_EPI) { if (wr == 0) PG8_BAR; }
        if constexpr (!Epi::AFTER_DRAIN) { E(acc, cur, wr, wc, fr, fq); S.done(cur); }
        if (!has_next) break;
#pragma unroll
        for (int a = 0; a < 2; ++a)
#pragma unroll
            for (int b = 0; b < 2; ++b)
#pragma unroll
                for (int m = 0; m < 4; ++m)
#pragma unroll
                    for (int n = 0; n < 2; ++n) acc[a][b][m][n] = (f32x4){0.f, 0.f, 0.f, 0.f};
        cur = nxt; cA = nA; cB = nB; ++ui;
        if constexpr (ALIGN_EPI) { if (wr == 1) PG8_BAR; }
    }
    PG8_WAIT_V(0);
    if constexpr (!ALIGN_EPI) { if (wr == 0) PG8_BAR; }
    PG8_BAR;
    if constexpr (Epi::AFTER_DRAIN) { E.fused(acc, cur, wr, wc, fr, fq, lds, wid, lane); S.done(cur); }
#undef PG8_SA
#undef PG8_SB
#undef PG8_STAGE
#undef PG8_LDA
#undef PG8_LDB
#undef PG8_MMA
#undef PG8_WAIT_V
#undef PG8_WAIT_L
#undef PG8_BAR
#undef PG8_SCHED
}
}
#define LAS __attribute__((address_space(3)))
typedef unsigned short bf16;
typedef short bf16x8 __attribute__((ext_vector_type(8)));
typedef float f32x16 __attribute__((ext_vector_type(16)));
typedef float f32x4 __attribute__((ext_vector_type(4)));
typedef float f32x2 __attribute__((ext_vector_type(2)));
typedef unsigned u32x4 __attribute__((ext_vector_type(4)));
typedef unsigned u32x2 __attribute__((ext_vector_type(2)));
typedef __bf16 bf16x2_t __attribute__((ext_vector_type(2)));

constexpr int BATCH = 8, SEQ = 4096, DM = 1024, M = BATCH * SEQ;
constexpr int N0 = 2208, N0P = 2304;
constexpr int C_CQ = 0, C_CKV = 256, C_KPE = 384, C_QS = 416, C_KS = 928, C_VS = 1056, C_G0 = 1184;
constexpr int N1W = 4112, N1 = 4096;
constexpr int C1_Q = 0, C1_K = 1024, C1_V = 2048, C1_G = 3072, W1_F = 3072, W1_G = 3088;
constexpr float EPS = 1e-6f, LOG2E = 1.4426950408889634f;
constexpr int NTHREADS = 512, NWAVES = 8;

constexpr size_t MiB = 1u << 20;
constexpr size_t WS_WT0 = 1 * MiB;
constexpr size_t WS_WQUP = 6 * MiB;
constexpr size_t WS_WKVUP = 7 * MiB;
constexpr size_t WS_WOUT0 = 8 * MiB;
constexpr size_t WS_WT1 = 10 * MiB;
constexpr size_t WS_WOUT1 = 18 * MiB;
constexpr size_t WS_XN = 32 * MiB;
constexpr size_t WS_OG = 96 * MiB;
constexpr size_t WS_LF = 160 * MiB;
constexpr size_t WS_LC = 162 * MiB;
constexpr size_t WS_TMAX = 512 * 1024;
constexpr size_t WS_CS = 164 * MiB;
constexpr size_t WS_Z1 = 168 * MiB;
constexpr size_t WS_Z0 = 168 * MiB;
constexpr size_t WS_CQN = 312 * MiB;
constexpr size_t WS_CKVN = 328 * MiB;
constexpr size_t WS_KPE = 344 * MiB;
constexpr size_t WS_Q0 = 346 * MiB;
constexpr size_t WS_KN = 394 * MiB;
constexpr size_t WS_VM = 426 * MiB;
constexpr size_t WS_END = 458 * MiB;
constexpr int LDS_BYTES = 135168, LDS_MISC = 131072 + 1024;

__device__ __forceinline__ unsigned cvtpk(float lo, float hi) { f32x2 v = {lo, hi}; bf16x2_t b = __builtin_convertvector(v, bf16x2_t); return __builtin_bit_cast(unsigned, b); }
__device__ __forceinline__ float bflo(unsigned u) { return __uint_as_float(u << 16); }
__device__ __forceinline__ float bfhi(unsigned u) { return __uint_as_float(u & 0xffff0000u); }
__device__ __forceinline__ float bf1(bf16 v) { return __uint_as_float(((unsigned)v) << 16); }
__device__ __forceinline__ float wave_sum(float v) {
#pragma unroll
    for (int o = 1; o < 64; o <<= 1) v += __shfl_xor(v, o);
    return v;
}

struct AttnP { const bf16 *Q, *K, *K2, *V, *G; bf16* O; const float* lc; const float* tmax; int ldq, ldk, ldk2, ldv, ldg, ldo; float c, sink2, slope2; };

typedef short v4i16_t __attribute__((ext_vector_type(4)));
__device__ __forceinline__ void glds16(const void* gsrc, unsigned lds_dst) { unsigned keep;
    asm volatile("s_mov_b32 %0, m0\n\ts_mov_b32 m0, %2\n\ts_nop 0\n\tglobal_load_lds_dwordx4 %1, off\n\ts_mov_b32 m0, %0" : "=&s"(keep) : "v"(gsrc), "s"(lds_dst) : "memory"); }
__device__ __forceinline__ void glds4(const void* gsrc, unsigned lds_dst) { unsigned keep;
    asm volatile("s_mov_b32 %0, m0\n\ts_mov_b32 m0, %2\n\ts_nop 0\n\tglobal_load_lds_dword %1, off\n\ts_mov_b32 m0, %0" : "=&s"(keep) : "v"(gsrc), "s"(lds_dst) : "memory"); }
#define AT_WAITV(n) asm volatile("s_waitcnt vmcnt(%0) lgkmcnt(0)" :: "n"(n) : "memory")
template <int DK, int MODE>
__device__ __forceinline__ void attn_unit(const AttnP& p, const int q0, LAS unsigned char* lds) {
    constexpr int NS = 4, KN_B = 8192, KP_B = (DK == 96) ? 4096 : 0, VHALF = 4160, V_B = 2 * VHALF, LC_B = (MODE == 2) ? 256 : 0;
    constexpr int OFF_KP = KN_B, OFF_V = KN_B + KP_B, OFF_LC = OFF_V + V_B, SLOT = OFF_LC + LC_B, OFF_FLAG = NS * SLOT;
    constexpr int NPT = 2 + ((DK == 96 || MODE == 2) ? 1 : 0);
    const int tid = threadIdx.x, lane = tid & 63, wid = __builtin_amdgcn_readfirstlane(tid >> 6), r32 = lane & 31, hi = lane >> 5;
    const int qw0 = q0 + 32 * wid, q = qw0 + r32;
    const unsigned lds0 = (unsigned)(uintptr_t)lds;
    bf16x8 qf[DK / 16];
#pragma unroll
    for (int d0 = 0; d0 < DK / 16; ++d0) qf[d0] = *(const bf16x8*)(p.Q + (size_t)q * p.ldq + 16 * d0 + 8 * hi);
#pragma unroll
    for (int d0 = 0; d0 < DK / 16; ++d0) asm volatile("" : "+v"(qf[d0]));
    const int t_hi = ((q0 + 256) >> 6) - 1;
    const int t_lo = (MODE == 1 && q0 >= 256) ? (q0 >> 6) - 2 : 0;
    const int ntile = t_hi - t_lo + 1;
    const int krow = 8 * wid + (lane >> 3), kch = (lane & 7) ^ ((krow >> 1) & 7);
    const bf16* ksrc = p.K + (size_t)krow * p.ldk + kch * 8;
    const int prow = 8 * wid + ((lane & 31) >> 2), pch = (lane & 3) ^ ((prow >> 2) & 3);
    const bf16* psrc = (DK == 96) ? (p.K2 + (size_t)prow * p.ldk2 + pch * 8) : p.K;
    const int vrow = 16 * (wid & 3) + (lane >> 2);
    const bf16* vsrc = p.V + (size_t)vrow * p.ldv + ((wid >> 2) * 4 + (lane & 3)) * 8;
    const float* lsrc = (MODE == 2) ? (p.lc + 8 * wid + (lane & 7)) : (const float*)p.K;
#define AT_DMA(t, slot) do { const size_t ro_ = (size_t)(t) * 64; const unsigned sb_ = lds0 + (unsigned)((slot) * SLOT); \
        glds16(ksrc + ro_ * p.ldk, (unsigned)__builtin_amdgcn_readfirstlane(sb_ + wid * 1024)); \
        glds16(vsrc + ro_ * p.ldv, (unsigned)__builtin_amdgcn_readfirstlane(sb_ + OFF_V + (wid >> 2) * VHALF + (wid & 3) * 1024)); \
        if (DK == 96) { if (lane < 32) glds16(psrc + ro_ * p.ldk2, (unsigned)__builtin_amdgcn_readfirstlane(sb_ + OFF_KP + wid * 512)); } \
        if (MODE == 2) { if (lane < 8) glds4(lsrc + ro_, (unsigned)__builtin_amdgcn_readfirstlane(sb_ + OFF_LC + wid * 32)); } } while (0)

    float m_run = (MODE == 1) ? p.sink2 : -INFINITY;
    float l_run = (MODE == 1 && hi == 0) ? 1.f : 0.f;
    f32x16 ot[2];
#pragma unroll
    for (int r = 0; r < 16; ++r) { ot[0][r] = 0.f; ot[1][r] = 0.f; }
    const int pim = 16 * (r32 >> 4) + 8 * ((r32 >> 2) & 1) + 4 * ((r32 >> 3) & 1) + (r32 & 3);
    const int vrd = (8 * hi + ((lane & 15) >> 2)) * 64 + ((lane >> 4) & 1) * 32 + (lane & 3) * 8;
    int koff[4], poff[2];
#pragma unroll
    for (int d0 = 0; d0 < 4; ++d0) koff[d0] = pim * 128 + (((2 * d0 + hi) ^ ((pim >> 1) & 7)) * 16);
#pragma unroll
    for (int j = 0; j < 2; ++j) poff[j] = OFF_KP + pim * 64 + (((2 * j + hi) ^ ((pim >> 2) & 3)) * 16);
    float pmv = 0.f, lcev = 0.f, qn = 0.f;
    if (MODE == 2) {
        pmv = (lane <= t_hi) ? p.tmax[lane] : 0.f;
#pragma unroll
        for (int o = 1; o < 64; o <<= 1) { const float n = __shfl_up(pmv, o); if (lane >= o) pmv = fmaxf(pmv, n); }
        lcev = (lane <= t_hi) ? p.lc[64 * lane + 63] : 0.f;
        float qs = 0.f;
#pragma unroll
        for (int d0 = 0; d0 < DK / 16; ++d0)
#pragma unroll
            for (int e = 0; e < 8; ++e) { const float f = bf1((bf16)qf[d0][e]); qs += f * f; }
        qs += __shfl_xor(qs, 32);
        qn = sqrtf(qs) * p.c * 1.002f;
    }
    AT_DMA(t_hi, 0);
    if (ntile > 1) AT_DMA(t_hi - 1, 1);
    if (ntile > 2) AT_DMA(t_hi - 2, 2);
    for (int i = 0; i < ntile; ++i) {
        const int t = t_hi - i, kv0 = t * 64, rem = ntile - 1 - i;
        if (rem >= 2) AT_WAITV(2 * NPT); else if (rem == 1) AT_WAITV(NPT); else AT_WAITV(0);
        __builtin_amdgcn_s_barrier();
        asm volatile("" ::: "memory");
        if (MODE == 2) { if (i > 0) {
            const LAS unsigned char* fp = lds + OFF_FLAG + ((i - 1) & 1) * 32;
            const u32x4 f0 = *(const LAS u32x4*)(fp), f1 = *(const LAS u32x4*)(fp + 16);
            if ((f0.x & f0.y & f0.z & f0.w & f1.x & f1.y & f1.z & f1.w) != 0u) break; } }
        if (rem >= 3) AT_DMA(t - 3, (i + 3) & 3);
        const LAS unsigned char* sb = lds + (i & 3) * SLOT;
        bool act = kv0 <= qw0 + 31;
        if (MODE == 1) act = act && (kv0 + 63 >= qw0 - 127);
        if (act) {
            f32x16 s[2];
            {
                bf16x8 kf[2][DK / 16];
#pragma unroll
                for (int ph = 0; ph < 2; ++ph) {
#pragma unroll
                    for (int d0 = 0; d0 < 4; ++d0) kf[ph][d0] = *(const LAS bf16x8*)(sb + koff[d0] + ph * 4096);
                    if (DK == 96) {
#pragma unroll
                        for (int j = 0; j < 2; ++j) kf[ph][(DK == 96) ? 4 + j : 0] = *(const LAS bf16x8*)(sb + poff[j] + ph * 2048);
                    }
                }
#pragma unroll
                for (int r = 0; r < 16; ++r) { s[0][r] = 0.f; s[1][r] = 0.f; }
                __builtin_amdgcn_sched_barrier(0);
#pragma unroll
                for (int d0 = 0; d0 < DK / 16; ++d0) {
                    s[0] = __builtin_amdgcn_mfma_f32_32x32x16_bf16(kf[0][d0], qf[d0], s[0], 0, 0, 0);
                    s[1] = __builtin_amdgcn_mfma_f32_32x32x16_bf16(kf[1][d0], qf[d0], s[1], 0, 0, 0);
                }
                __builtin_amdgcn_sched_barrier(0);
            }
            if (MODE == 2) {
                const LAS float* lcb = (const LAS float*)(sb + OFF_LC);
#pragma unroll
                for (int ph = 0; ph < 2; ++ph)
#pragma unroll
                    for (int j = 0; j < 4; ++j) { const f32x4 lk = *(const LAS f32x4*)(lcb + 32 * ph + 16 * (j >> 1) + 8 * hi + 4 * (j & 1));
#pragma unroll
                        for (int ii = 0; ii < 4; ++ii) s[ph][4 * j + ii] = s[ph][4 * j + ii] * p.c - lk[ii]; }
            } else if (MODE == 1) {
                const float dq = (float)(q - kv0 - 8 * hi);
#pragma unroll
                for (int ph = 0; ph < 2; ++ph)
#pragma unroll
                    for (int r = 0; r < 16; ++r) { const int kk = 32 * ph + 16 * (r >> 3) + 4 * ((r >> 2) & 1) + (r & 3); s[ph][r] = s[ph][r] * p.c - p.slope2 * (dq - (float)kk); }
            }
            bool needmask = (kv0 + 63 > qw0);
            if (MODE == 1) needmask = needmask || (kv0 < qw0 + 31 - 127);
            if (needmask) {
                const int dqi = q - kv0 - 8 * hi;
#pragma unroll
                for (int ph = 0; ph < 2; ++ph)
#pragma unroll
                    for (int r = 0; r < 16; ++r) { const int kk = 32 * ph + 16 * (r >> 3) + 4 * ((r >> 2) & 1) + (r & 3); const int dist = dqi - kk;
                        bool ok = dist >= 0; if (MODE == 1) ok = ok && (dist < 128); s[ph][r] = ok ? s[ph][r] : -INFINITY; }
            }
            float mx = fmaxf(fmaxf(s[0][0], s[0][1]), s[0][2]);
#pragma unroll
            for (int r = 3; r < 15; r += 2) mx = fmaxf(fmaxf(mx, s[0][r]), s[0][r + 1]);
            mx = fmaxf(mx, s[0][15]);
#pragma unroll
            for (int r = 0; r < 16; r += 2) mx = fmaxf(fmaxf(mx, s[1][r]), s[1][r + 1]);
            mx = fmaxf(mx, __shfl_xor(mx, 32));
            if (MODE == 0) mx *= p.c;
            const bool dead = (MODE == 2) && __all(mx < m_run - 40.f);
            if (!dead) {
                const float m_new = fmaxf(m_run, mx);
                const float alpha = __builtin_amdgcn_exp2f(m_run - m_new);
                m_run = m_new;
                float ls0 = 0.f, ls1 = 0.f;
#pragma unroll
                for (int ph = 0; ph < 2; ++ph)
#pragma unroll
                    for (int r = 0; r < 16; r += 2) {
                        const float e0 = __builtin_amdgcn_exp2f(MODE == 0 ? (s[ph][r] * p.c - m_new) : (s[ph][r] - m_new));
                        const float e1 = __builtin_amdgcn_exp2f(MODE == 0 ? (s[ph][r + 1] * p.c - m_new) : (s[ph][r + 1] - m_new));
                        s[ph][r] = e0; s[ph][r + 1] = e1; ls0 += e0; ls1 += e1; }
                if (__any(alpha != 1.f)) {
                    l_run *= alpha;
#pragma unroll
                    for (int r = 0; r < 16; ++r) { ot[0][r] *= alpha; ot[1][r] *= alpha; }
                }
                l_run += ls0 + ls1;
                bf16x8 pk[4];
#pragma unroll
                for (int cc = 0; cc < 4; ++cc) { const int ph = cc >> 1, o = 8 * (cc & 1); u32x4 w;
                    w.x = cvtpk(s[ph][o + 0], s[ph][o + 1]); w.y = cvtpk(s[ph][o + 2], s[ph][o + 3]); w.z = cvtpk(s[ph][o + 4], s[ph][o + 5]); w.w = cvtpk(s[ph][o + 6], s[ph][o + 7]);
                    pk[cc] = __builtin_bit_cast(bf16x8, w); }
                const LAS unsigned char* vb = sb + OFF_V + vrd;
                bf16x8 vf[2][4];
#pragma unroll
                for (int dh = 0; dh < 2; ++dh)
#pragma unroll
                    for (int cc = 0; cc < 4; ++cc) {
                        const v4i16_t v0 = __builtin_amdgcn_ds_read_tr16_b64_v4i16((LAS v4i16_t*)(vb + dh * VHALF + cc * 1024));
                        const v4i16_t v1 = __builtin_amdgcn_ds_read_tr16_b64_v4i16((LAS v4i16_t*)(vb + dh * VHALF + cc * 1024 + 256));
                        vf[dh][cc] = (bf16x8){v0[0], v0[1], v0[2], v0[3], v1[0], v1[1], v1[2], v1[3]}; }
                __builtin_amdgcn_sched_barrier(0);
#pragma unroll
                for (int cc = 0; cc < 4; ++cc) {
                    ot[0] = __builtin_amdgcn_mfma_f32_32x32x16_bf16(vf[0][cc], pk[cc], ot[0], 0, 0, 0);
                    ot[1] = __builtin_amdgcn_mfma_f32_32x32x16_bf16(vf[1][cc], pk[cc], ot[1], 0, 0, 0);
                }
                __builtin_amdgcn_sched_barrier(0);
            }
        }
        if (MODE == 2) {
            bool dn = false;
            if (rem >= 1) { const float bnd = qn * __shfl(pmv, t - 1) - __shfl(lcev, t - 1); dn = __all(bnd < m_run - 40.f); }
            if (lane == 0) *(LAS unsigned*)(lds + OFF_FLAG + (i & 1) * 32 + wid * 4) = dn ? 1u : 0u;
        }
    }
    AT_WAITV(0);
    __builtin_amdgcn_s_barrier();
    asm volatile("" ::: "memory");
    const float lt = l_run + __shfl_xor(l_run, 32);
    const float inv = 1.f / lt;
#pragma unroll
    for (int dh = 0; dh < 2; ++dh)
#pragma unroll
        for (int j = 0; j < 4; ++j) {
            const int d = 32 * dh + 8 * j + 4 * hi;
            const u32x2 g = *(const u32x2*)(p.G + (size_t)q * p.ldg + d);
            const float g0 = bflo(g.x), g1 = bfhi(g.x), g2 = bflo(g.y), g3 = bfhi(g.y);
            const float o0 = ot[dh][4 * j + 0] * inv * (g0 / (1.f + __expf(-g0)));
            const float o1 = ot[dh][4 * j + 1] * inv * (g1 / (1.f + __expf(-g1)));
            const float o2 = ot[dh][4 * j + 2] * inv * (g2 / (1.f + __expf(-g2)));
            const float o3 = ot[dh][4 * j + 3] * inv * (g3 / (1.f + __expf(-g3)));
            u32x2 w; w.x = cvtpk(o0, o1); w.y = cvtpk(o2, o3);
            *(u32x2*)(p.O + (size_t)q * p.ldo + d) = w;
        }
#undef AT_DMA
}

#define XB_TMO      128
#define XB_XCNT(j)  (256  + 64 * (j))
#define XB_XSUB(j)  (1280 + 64 * (j))
#define XB_XGEN(j)  (2304 + 64 * (j))
#define XB_TOP      3328
#define XB_TOPGEN   3392
#define XCD_BAR_WORDS 3456
#define XB_SPIN_CAP (1u << 18)

__device__ __forceinline__ unsigned xb_ld(unsigned* p)              { return __hip_atomic_load(p, __ATOMIC_RELAXED, __HIP_MEMORY_SCOPE_AGENT); }
__device__ __forceinline__ unsigned xb_add(unsigned* p, unsigned v) { return __hip_atomic_fetch_add(p, v, __ATOMIC_RELAXED, __HIP_MEMORY_SCOPE_AGENT); }
__device__ __forceinline__ unsigned xb_xcc_id() { return (unsigned)__builtin_amdgcn_s_getreg((3 << 11) | 20) & 0xFu; }
#define XB_SPIN(cond, bar) do { unsigned _sp = 0; while (cond) { __builtin_amdgcn_s_sleep(1); \
    if ((++_sp & 255u) == 0u) { if (xb_ld(&(bar)[XB_TMO])) break; if (_sp > XB_SPIN_CAP) { atomicAdd(&(bar)[XB_TMO], 1u); break; } } } } while (0)

struct XcdBarrier {
    unsigned* bar; unsigned x;
    volatile LAS unsigned* st;
};

__device__ __forceinline__ XcdBarrier xcd_barrier_post(unsigned* bar, volatile LAS unsigned* st) {
    XcdBarrier b; b.bar = bar; b.x = xb_xcc_id(); b.st = st;
    if (threadIdx.x == 0) (void)xb_add(&bar[XB_XCNT(b.x)], 1u);
    return b;
}
__device__ __forceinline__ void xcd_barrier_complete(unsigned* bar, unsigned x, unsigned& nloc, unsigned& nx) {
    const unsigned G = gridDim.x * gridDim.y * gridDim.z;
    unsigned sum, cnt, mine, sp = 0u;
    for (;;) {
        sum = 0u; cnt = 0u; mine = 0u;
#pragma unroll
        for (unsigned j = 0; j < 16; ++j) { const unsigned c = xb_ld(&bar[XB_XCNT(j)]); sum += c; cnt += (c > 0u) ? 1u : 0u; mine = (j == x) ? c : mine; }
        if (sum == G) break;
        __builtin_amdgcn_s_sleep(1);
        if ((++sp & 255u) == 0u) { if (xb_ld(&bar[XB_TMO])) break; if (sp > XB_SPIN_CAP) { atomicAdd(&bar[XB_TMO], 1u); break; } }
    }
    nloc = mine > 0u ? mine : 1u; nx = cnt > 0u ? cnt : 1u;
}

__device__ __forceinline__ void xcd_barrier(const XcdBarrier& b) {
    asm volatile("s_waitcnt vmcnt(0)" ::: "memory");
    __syncthreads();
    if (threadIdx.x == 0) {
        unsigned* bar = b.bar;
        __builtin_amdgcn_s_waitcnt(0);
        unsigned nloc = b.st[0], nx = b.st[1];
        if (nloc == 0u) { xcd_barrier_complete(bar, b.x, nloc, nx); b.st[0] = nloc; b.st[1] = nx; }
        const unsigned old = xb_add(&bar[XB_XSUB(b.x)], 1u);
        const unsigned gen = old / nloc;
        if (old + 1u == (gen + 1u) * nloc) {
            __builtin_amdgcn_fence(__ATOMIC_RELEASE, "agent");
            asm volatile("s_waitcnt vmcnt(0)" ::: "memory");
            const unsigned og = xb_add(&bar[XB_TOP], 1u);
            const unsigned tg = og / nx;
            if (og + 1u == (tg + 1u) * nx) xb_add(&bar[XB_TOPGEN], 1u);
            else XB_SPIN(xb_ld(&bar[XB_TOPGEN]) == tg, bar);
            __builtin_amdgcn_fence(__ATOMIC_ACQUIRE, "agent");
            xb_add(&bar[XB_XGEN(b.x)], 1u);
            asm volatile("s_waitcnt vmcnt(0)" ::: "memory");
        } else {
            XB_SPIN(xb_ld(&bar[XB_XGEN(b.x)]) == gen, bar);
            __builtin_amdgcn_fence(__ATOMIC_ACQUIRE, "agent");
            asm volatile("s_waitcnt vmcnt(0)" ::: "memory");
        }
    }
    __syncthreads();
}

struct Args { const float* in[15]; const int* pos; float* out; unsigned char* ws; int ph_lo, ph_hi; };

__device__ __forceinline__ void transpose_item(const float* W, int ldw, int col0, int k0, bf16* WT, int ldt, int row_off, LAS float* scr, int lane) {
#pragma unroll 8
    for (int i = 0; i < 32; ++i) { const int kk = 2 * i + (lane >> 5); scr[kk * 33 + (lane & 31)] = W[(size_t)(k0 + kk) * ldw + col0 + (lane & 31)]; }
    asm volatile("s_waitcnt lgkmcnt(0)" ::: "memory");
    const int c = lane & 7;
#pragma unroll
    for (int j = 0; j < 4; ++j) { const int n = (lane >> 3) + 8 * j; const LAS float* s = scr + (8 * c) * 33 + n;
        u32x4 o; o.x = cvtpk(s[0 * 33], s[1 * 33]); o.y = cvtpk(s[2 * 33], s[3 * 33]); o.z = cvtpk(s[4 * 33], s[5 * 33]); o.w = cvtpk(s[6 * 33], s[7 * 33]);
        *(u32x4*)(WT + (size_t)(row_off + n) * ldt + k0 + 8 * c) = o; }
    asm volatile("s_waitcnt lgkmcnt(0)" ::: "memory");
}

__device__ __forceinline__ void rms_row_to_bf16(const float* xrow, const float* g, bf16* orow, int lane) {
    const f32x4* xr = (const f32x4*)xrow + lane; const f32x4* gr = (const f32x4*)g + lane;
    f32x4 v[4]; float s = 0.f;
#pragma unroll
    for (int j = 0; j < 4; ++j) { v[j] = xr[64 * j]; s += (v[j].x * v[j].x + v[j].y * v[j].y) + (v[j].z * v[j].z + v[j].w * v[j].w); }
    const float rs = 1.f / sqrtf(wave_sum(s) * (1.f / DM) + EPS);
    u32x2* o8 = (u32x2*)orow + lane;
#pragma unroll
    for (int j = 0; j < 4; ++j) { const f32x4 gg = gr[64 * j]; u32x2 w; w.x = cvtpk(v[j].x * rs * gg.x, v[j].y * rs * gg.y); w.y = cvtpk(v[j].z * rs * gg.z, v[j].w * rs * gg.w); o8[64 * j] = w; }
}

template <bool COOP>
__global__ void __launch_bounds__(NTHREADS, 2) mk_fwd(Args args) {
    extern __shared__ __attribute__((aligned(16))) unsigned char lds_raw[];
    LAS unsigned char* lds = (LAS unsigned char*)lds_raw;
    const int tid = threadIdx.x, lane = tid & 63, wave = __builtin_amdgcn_readfirstlane(tid >> 6);
    const int G = gridDim.x, bx = blockIdx.x;
    const int vcu = (G % 8 == 0) ? (bx % 8) * (G / 8) + bx / 8 : bx;
    const int gw = vcu * NWAVES + wave, NGW = G * NWAVES;
    unsigned char* ws = args.ws;
    const float* x = args.in[0];
    bf16* Wt0 = (bf16*)(ws + WS_WT0); bf16* Wqup = (bf16*)(ws + WS_WQUP); bf16* Wkvup = (bf16*)(ws + WS_WKVUP); bf16* Wout0 = (bf16*)(ws + WS_WOUT0);
    bf16* Wt1 = (bf16*)(ws + WS_WT1); bf16* Wout1 = (bf16*)(ws + WS_WOUT1);
    bf16* XN = (bf16*)(ws + WS_XN); bf16* OG = (bf16*)(ws + WS_OG); float* LF = (float*)(ws + WS_LF); float* LC = (float*)(ws + WS_LC); float* CS = (float*)(ws + WS_CS); float* TMAXB = (float*)(ws + WS_TMAX);
    bf16* Z0 = (bf16*)(ws + WS_Z0); bf16* Z1 = (bf16*)(ws + WS_Z1); bf16* CQN = (bf16*)(ws + WS_CQN); bf16* CKVN = (bf16*)(ws + WS_CKVN); bf16* KPE = (bf16*)(ws + WS_KPE);
    bf16* Q0 = (bf16*)(ws + WS_Q0); bf16* KN = (bf16*)(ws + WS_KN); bf16* VM = (bf16*)(ws + WS_VM);
    float* out = args.out;
    const int lo = args.ph_lo, hi_ph = args.ph_hi;
#ifndef REPMASK
#define REPMASK 0
#endif
#define NREP(k) (1 + (((REPMASK) >> (k)) & 1))
#ifndef PHMASK
#define PHMASK 0xfff
#endif
#define IN(k) ((((PHMASK) >> (k)) & 1) && lo <= (k) && (k) < hi_ph)
#define SEAM(k) do { if constexpr (COOP) { if (IN(k) && IN((k) + 1)) { if ((k) == 0) { cg::this_grid().sync(); xbar = xcd_barrier_post(barw, (volatile LAS unsigned*)(lds + LDS_MISC)); } else { xcd_barrier(xbar); } } } } while (0)
    unsigned* qctr = (unsigned*)(ws + 256 * 1024);
    unsigned* barw = (unsigned*)ws;
    XcdBarrier xbar; xbar.bar = barw; xbar.x = 0; xbar.st = (volatile LAS unsigned*)(lds + LDS_MISC);
    if constexpr (COOP) {
        if (tid < 16) ((LAS unsigned*)(lds + LDS_MISC))[tid] = 0u;
        if (bx == 0) { for (int i = tid; i < XCD_BAR_WORDS; i += NTHREADS) barw[i] = 0u; for (int i = tid; i < 16 * 64; i += NTHREADS) qctr[i] = 0u; for (int i = tid; i < 2 * 64 * 64; i += NTHREADS) ((unsigned*)(ws + 64 * 1024))[i] = 0u; }
        __syncthreads();
    }

    if (IN(0)) {
        LAS float* scr = (LAS float*)(lds + wave * 16384);
        constexpr int I_A = 16 * 69, I_B = 4 * 24, I_C = 2 * 32, I_D = 16 * 32, I_E1 = 16 * 96, I_E2 = 16 * 32, I_F = 16 * 32;
        constexpr int NIT = I_A + I_B + I_C + I_D + I_E1 + I_E2 + I_F;
        for (int it = gw; it < NIT; it += NGW) {
            int r = it;
            if (r < I_A) { const int kb = r / 69, nb = r % 69; transpose_item(args.in[3], N0, 32 * nb, 64 * kb, Wt0, 1024, 32 * nb, scr, lane); continue; } r -= I_A;
            if (r < I_B) { const int kb = r / 24, nb = r % 24; transpose_item(args.in[5], 768, 32 * nb, 64 * kb, Wqup, 256, 32 * nb, scr, lane); continue; } r -= I_B;
            if (r < I_C) { const int kb = r / 32, nb = r % 32; const int n0 = 32 * nb, h = n0 >> 7, j0 = n0 & 127; const int dst = (j0 < 64) ? (h * 64 + j0) : (512 + h * 64 + (j0 - 64));
                           transpose_item(args.in[7], 1024, n0, 64 * kb, Wkvup, 256, dst, scr, lane); continue; } r -= I_C;
            if (r < I_D) { const int kb = r / 32, nb = r % 32; transpose_item(args.in[9], 1024, 32 * nb, 64 * kb, Wout0, 1024, 32 * nb, scr, lane); continue; } r -= I_D;
            if (r < I_E1) { const int kb = r / 96, nb = r % 96; transpose_item(args.in[11], N1W, 32 * nb, 64 * kb, Wt1, 1024, 32 * nb, scr, lane); continue; } r -= I_E1;
            if (r < I_E2) { const int kb = r / 32, nb = r % 32; transpose_item(args.in[11], N1W, W1_G + 32 * nb, 64 * kb, Wt1, 1024, C1_G + 32 * nb, scr, lane); continue; } r -= I_E2;
            { const int kb = r / 32, nb = r % 32; transpose_item(args.in[13], 1024, 32 * nb, 64 * kb, Wout1, 1024, 32 * nb, scr, lane); }
        }
        { const u32x4 z = {0u, 0u, 0u, 0u};
          u32x4* p0 = (u32x4*)(Wt0 + (size_t)N0 * 1024);
          for (int i = vcu * NTHREADS + tid; i < 96 * 1024 / 8; i += G * NTHREADS) p0[i] = z;
          for (int i = vcu * NTHREADS + tid; i < 1024 * 16; i += G * NTHREADS) { const int row = i >> 4, c = i & 15; *(u32x4*)(Wkvup + (size_t)row * 256 + 128 + c * 8) = z; } }
        for (int m = gw; m < M; m += NGW) rms_row_to_bf16(x + (size_t)m * DM, args.in[2], XN + (size_t)m * DM, lane);
    }
    SEAM(0);
    if (IN(1)) {
        __syncthreads();
        pg8::Gemm g{XN, Wt0, M, N0P, 1024}; pg8::StaticOrder S; S.init(M, N0P, G, bx);
        pg8::EpiBf16<0> E{Z0, N0P, nullptr, 0, 0, 1.f};
        for (int rep = 0; rep < NREP(1); ++rep) {
        pg8::gemm_phase<pg8::EpiBf16<0>, pg8::StaticOrder, true, true>(lds, g, S, E); __syncthreads(); }
    }
    SEAM(1);
    if (IN(2)) {
        const float* gq = args.in[4]; const float* gkv = args.in[6];
        for (int m = gw; m < M; m += NGW) {
            const bf16* z = Z0 + (size_t)m * N0P;
            const u32x2 a = *(const u32x2*)(z + C_CQ + 4 * lane);
            const unsigned bb = *(const unsigned*)(z + C_CKV + 2 * lane);
            const float a0 = bflo(a.x), a1 = bfhi(a.x), a2 = bflo(a.y), a3 = bfhi(a.y), b0 = bflo(bb), b1 = bfhi(bb);
            const float sa = wave_sum((a0 * a0 + a1 * a1) + (a2 * a2 + a3 * a3)), sb = wave_sum(b0 * b0 + b1 * b1);
            const float ra = 1.f / sqrtf(sa * (1.f / 256.f) + EPS), rb = 1.f / sqrtf(sb * (1.f / 128.f) + EPS);
            const f32x4 ga = *(const f32x4*)(gq + 4 * lane); const f32x2 gb = *(const f32x2*)(gkv + 2 * lane);
            u32x2 w; w.x = cvtpk(a0 * ra * ga.x, a1 * ra * ga.y); w.y = cvtpk(a2 * ra * ga.z, a3 * ra * ga.w);
            *(u32x2*)(CQN + (size_t)m * 256 + 4 * lane) = w;
            *(unsigned*)(CKVN + (size_t)m * 256 + 2 * lane) = cvtpk(b0 * rb * gb.x, b1 * rb * gb.y);
            *(unsigned*)(CKVN + (size_t)m * 256 + 128 + 2 * lane) = 0u;
            if (lane < 16) {
                const float invf = (float)exp2(-(double)lane * 0.8304820237218406);
                const double ang = (double)(float)args.pos[m] * (double)invf;
                const double rev = ang * 0.15915494309189535;
                const float rr = (float)(rev - rint(rev));
                const float cv = __builtin_amdgcn_cosf(rr), sv = __builtin_amdgcn_sinf(rr);
                CS[(size_t)m * 32 + lane] = cv; CS[(size_t)m * 32 + 16 + lane] = sv;
                const float x1 = bf1(z[C_KPE + lane]), x2 = bf1(z[C_KPE + 16 + lane]);
                const unsigned o1 = cvtpk(x1 * cv - x2 * sv, 0.f), o2 = cvtpk(x2 * cv + x1 * sv, 0.f);
                KPE[(size_t)m * 32 + lane] = (bf16)(o1 & 0xffffu); KPE[(size_t)m * 32 + 16 + lane] = (bf16)(o2 & 0xffffu);
            }
        }
    }
    SEAM(2);
    if (IN(3)) {
        __syncthreads();
#ifndef NO_QUP
        { int kq_ = 256; asm volatile("" : "+s"(kq_)); pg8::Gemm g{CQN, Wqup, M, 768, kq_}; pg8::StaticOrder S; S.init(M, 768, G, bx);
          pg8::EpiQRope E{Q0, 768, CS};
          pg8::gemm_phase<pg8::EpiQRope, pg8::StaticOrder, true, true>(lds, g, S, E); }
#endif
        __syncthreads();
#ifndef NO_KVUP
        { int kk_ = 256; asm volatile("" : "+s"(kk_)); pg8::Gemm g{CKVN, Wkvup, M, 1024, kk_}; pg8::StaticOrder S; S.init(M, 1024, G, bx);
          pg8::EpiBf16<0> E{KN, 512, nullptr, 512, (size_t)(WS_VM - WS_KN) / 2, 1.f};
          pg8::gemm_phase<pg8::EpiBf16<0>, pg8::StaticOrder, true, true>(lds, g, S, E); }
#endif
    }
    SEAM(3);
    if (IN(4)) {
        __syncthreads();
        for (;;) {
            if (tid == 0) *(volatile LAS int*)(lds + LDS_MISC + 64) = (int)atomicAdd(qctr + 64 * (bx & 7), 1u);
            __syncthreads();
            const int tk = *(volatile LAS int*)(lds + LDS_MISC + 64);
            __syncthreads();
            if (tk >= 128) break;
            const bool swa = tk >= 64; const int bh = 8 * (bx & 7) + ((tk & 63) >> 3), s = tk & 7, b = bh >> 3, h = bh & 7;
            const size_t rb = (size_t)b * SEQ;
            AttnP p;
            if (!swa) {
                p.Q = Q0 + rb * 768 + h * 96; p.ldq = 768; p.K = KN + rb * 512 + h * 64; p.ldk = 512; p.K2 = KPE + rb * 32; p.ldk2 = 32; p.V = VM + rb * 512 + h * 64; p.ldv = 512;
                p.G = Z0 + rb * N0P + C_G0 + h * 64; p.ldg = N0P; p.O = OG + rb * 1024 + h * 64; p.ldo = 1024; p.lc = nullptr; p.tmax = nullptr; p.c = 0.10206207261596575f * LOG2E; p.sink2 = 0.f; p.slope2 = 0.f;
                attn_unit<96, 0>(p, (15 - s) * 256, lds); attn_unit<96, 0>(p, s * 256, lds);
            } else {
                p.Q = Z0 + rb * N0P + C_QS + h * 64; p.ldq = N0P; p.K = Z0 + rb * N0P + C_KS + (h >> 2) * 64; p.ldk = N0P; p.K2 = nullptr; p.ldk2 = 0; p.V = Z0 + rb * N0P + C_VS + (h >> 2) * 64; p.ldv = N0P;
                p.G = Z0 + rb * N0P + C_G0 + 512 + h * 64; p.ldg = N0P; p.O = OG + rb * 1024 + 512 + h * 64; p.ldo = 1024; p.lc = nullptr; p.tmax = nullptr; p.c = 0.125f * LOG2E;
                p.sink2 = args.in[8][h] * LOG2E; p.slope2 = exp2f(-(float)(h + 1)) * LOG2E;
                attn_unit<64, 1>(p, (15 - s) * 256, lds); attn_unit<64, 1>(p, s * 256, lds);
            }
        }
    }
    SEAM(4);
    if (IN(5)) {
        __syncthreads();
        pg8::Gemm g{OG, Wout0, M, 1024, 1024}; pg8::StaticOrder S; S.init(M, 1024, G, bx);
        pg8::EpiResF32 E{x, out, 1024};
        pg8::gemm_phase<pg8::EpiResF32, pg8::StaticOrder, true, true>(lds, g, S, E);
    }
    SEAM(5);
    if (IN(6)) {
        __syncthreads();
        const float* g1 = args.in[10]; const float* w1 = args.in[11]; const float* bfp = args.in[12];
        LAS float* WF = (LAS float*)lds;
        for (int k = tid; k < 1024; k += NTHREADS) {
            const int l = (k & 255) >> 2, j = k >> 8, e = k & 3; const int R = l + 64 * (4 * j + e); const float gk = g1[k];
#pragma unroll
            for (int c = 0; c < 4; ++c) { const f32x4 wv = *(const f32x4*)(w1 + (size_t)k * N1W + W1_F + 4 * c); *(LAS f32x4*)(WF + R * 20 + 4 * c) = wv * gk; }
        }
        __syncthreads();
        for (int m = gw; m < M; m += NGW) {
            const f32x4* xr = (const f32x4*)(out + (size_t)m * DM) + lane; const f32x4* gr = (const f32x4*)g1 + lane;
            f32x4 v[4]; float ss = 0.f;
#pragma unroll
            for (int j = 0; j < 4; ++j) { v[j] = xr[64 * j]; ss += (v[j].x * v[j].x + v[j].y * v[j].y) + (v[j].z * v[j].z + v[j].w * v[j].w); }
            const float rs = 1.f / sqrtf(wave_sum(ss) * (1.f / DM) + EPS);
            u32x2* o8 = (u32x2*)(XN + (size_t)m * DM) + lane;
            float fa[16];
#pragma unroll
            for (int n = 0; n < 16; ++n) fa[n] = 0.f;
#pragma unroll
            for (int j = 0; j < 4; ++j) { const f32x4 gg = gr[64 * j]; u32x2 w; w.x = cvtpk(v[j].x * rs * gg.x, v[j].y * rs * gg.y); w.y = cvtpk(v[j].z * rs * gg.z, v[j].w * rs * gg.w); o8[64 * j] = w;
#pragma unroll
                for (int e = 0; e < 4; ++e) { const float xv = v[j][e]; const LAS float* wr_ = WF + (lane + 64 * (4 * j + e)) * 20;
#pragma unroll
                    for (int c = 0; c < 4; ++c) { const f32x4 wv = *(const LAS f32x4*)(wr_ + 4 * c); fa[4 * c + 0] += xv * wv.x; fa[4 * c + 1] += xv * wv.y; fa[4 * c + 2] += xv * wv.z; fa[4 * c + 3] += xv * wv.w; }
                    asm volatile("" ::: "memory"); } }
            float mine = 0.f;
#pragma unroll
            for (int n = 0; n < 16; ++n) { const float t = wave_sum(fa[n]); if (lane == n) mine = t; }
            if (lane < 16) { const float f = mine * rs + bfp[lane]; const float lsg = fminf(f, 0.f) - log1pf(expf(-fabsf(f))); LF[(size_t)m * 16 + lane] = lsg; }
        }
    }
    SEAM(6);
    if (IN(7)) {
        __syncthreads();
        LAS float* sm = (LAS float*)lds;
        for (int bh = bx; bh < 128; bh += G) {
            const int b = bh >> 4, h = bh & 15; float v[8]; float run = 0.f;
#pragma unroll
            for (int e = 0; e < 8; ++e) { run += LF[((size_t)b * SEQ + 8 * tid + e) * 16 + h]; v[e] = run; }
            float sc = run;
#pragma unroll
            for (int o = 1; o < 64; o <<= 1) { const float n = __shfl_up(sc, o); if (lane >= o) sc += n; }
            if (lane == 63) sm[wave] = sc;
            __syncthreads();
            float off = sc - run;
            for (int w = 0; w < wave; ++w) off += sm[w];
            f32x4 o0 = {(v[0] + off) * LOG2E, (v[1] + off) * LOG2E, (v[2] + off) * LOG2E, (v[3] + off) * LOG2E}, o1 = {(v[4] + off) * LOG2E, (v[5] + off) * LOG2E, (v[6] + off) * LOG2E, (v[7] + off) * LOG2E};
            *(f32x4*)(LC + (size_t)bh * SEQ + 8 * tid) = o0; *(f32x4*)(LC + (size_t)bh * SEQ + 8 * tid + 4) = o1;
            __syncthreads();
        }
        pg8::Gemm g{XN, Wt1, M, N1, 1024}; pg8::StaticOrder S; S.init(M, N1, G, bx);
        pg8::EpiBf16<0> E{Z1, N1, nullptr, 0, 0, 1.f};
        for (int rep = 0; rep < NREP(7); ++rep) {
        pg8::gemm_phase<pg8::EpiBf16<0>, pg8::StaticOrder, true, true>(lds, g, S, E); __syncthreads(); }
    }
    SEAM(7);
    if (IN(8)) {
        __syncthreads();
        LAS float* sm = (LAS float*)lds;
        for (int task = vcu; task < 512; task += G) {
            const int b = task >> 6, T = task & 63;
            const bf16* kbase = Z1 + ((size_t)b * SEQ + 64 * T + (tid >> 7)) * N1 + C1_K + (tid & 127) * 8;
            float mxn = 0.f;
#pragma unroll 4
            for (int i = 0; i < 16; ++i) {
                const u32x4 v = *(const u32x4*)(kbase + (size_t)(4 * i) * N1);
                float s = 0.f;
#pragma unroll
                for (int e = 0; e < 4; ++e) { const float a = bflo(v[e]), c = bfhi(v[e]); s += a * a + c * c; }
                s += __shfl_xor(s, 1); s += __shfl_xor(s, 2); s += __shfl_xor(s, 4);
                mxn = fmaxf(mxn, s);
            }
            if ((tid & 7) == 0) sm[(tid >> 7) * 16 + ((tid & 127) >> 3)] = mxn;
            __syncthreads();
            if (tid < 16) { const float m4 = fmaxf(fmaxf(sm[tid], sm[16 + tid]), fmaxf(sm[32 + tid], sm[48 + tid])); TMAXB[((size_t)(b * 16 + tid)) * 64 + T] = sqrtf(m4); }
            __syncthreads();
        }
    }
    SEAM(8);
    if (IN(9)) {
        __syncthreads();
        for (;;) {
            if (tid == 0) *(volatile LAS int*)(lds + LDS_MISC + 64) = (int)atomicAdd(qctr + 64 * (8 + (bx & 7)), 1u);
            __syncthreads();
            const int tk = *(volatile LAS int*)(lds + LDS_MISC + 64);
            __syncthreads();
            if (tk >= 128) break;
            const int bh = 16 * (bx & 7) + (tk >> 3), s = tk & 7, b = bh >> 4, h = bh & 15; const size_t rb = (size_t)b * SEQ;
            AttnP p;
            p.Q = Z1 + rb * N1 + C1_Q + h * 64; p.ldq = N1; p.K = Z1 + rb * N1 + C1_K + h * 64; p.ldk = N1; p.K2 = nullptr; p.ldk2 = 0; p.V = Z1 + rb * N1 + C1_V + h * 64; p.ldv = N1;
            p.G = Z1 + rb * N1 + C1_G + h * 64; p.ldg = N1; p.O = OG + rb * 1024 + h * 64; p.ldo = 1024; p.lc = LC + (size_t)bh * SEQ; p.tmax = TMAXB + (size_t)bh * 64; p.c = 0.125f * LOG2E; p.sink2 = 0.f; p.slope2 = 0.f;
            attn_unit<64, 2>(p, (15 - s) * 256, lds); attn_unit<64, 2>(p, s * 256, lds);
        }
    }
    SEAM(9);
    if (IN(10)) {
        __syncthreads();
        for (int sub = 0; sub < 2; ++sub) {
            const size_t r0 = (size_t)sub * 16384;
            pg8::Gemm g{OG + r0 * 1024, Wout1, 16384, 1024, 1024}; pg8::StaticOrder S; S.init(16384, 1024, G, bx);
            pg8::PanelRms st{(float*)(ws + WS_LF) + (size_t)sub * 16384 * 4, (unsigned*)(ws + 64 * 1024) + sub * 64 * 64, EPS};
            pg8::EpiRmsOut E{out + r0 * 1024, out + r0 * 1024, args.in[14], 1024, st};
            pg8::gemm_phase<pg8::EpiRmsOut, pg8::StaticOrder, false, true>(lds, g, S, E);
            __syncthreads();
        }
    }
#undef IN
#undef SEAM
}

constexpr int NPHASES = 11;
extern "C" void kernel_launch(void* const* d_in, const int* in_sizes, int n_in, void* d_out, int out_size, void* d_ws, size_t ws_size, hipStream_t stream) {
    static int grid = 0;
    if (grid == 0) {
        if (n_in != 15 || out_size != M * DM || ws_size < WS_END) { fprintf(stderr, "kernel_launch: unexpected shapes (n_in %d, out %d, ws %zu)\n", n_in, out_size, ws_size); grid = -1; return; }
        int dev = 0, cus = 0, per_cu = 0;
        (void)hipGetDevice(&dev); (void)hipDeviceGetAttribute(&cus, hipDeviceAttributeMultiprocessorCount, dev);
#if MK_COOP
        (void)hipFuncSetAttribute((const void*)mk_fwd<true>, hipFuncAttributeMaxDynamicSharedMemorySize, LDS_BYTES);
        (void)hipOccupancyMaxActiveBlocksPerMultiprocessor(&per_cu, (const void*)mk_fwd<true>, NTHREADS, LDS_BYTES);
#else
        (void)hipFuncSetAttribute((const void*)mk_fwd<false>, hipFuncAttributeMaxDynamicSharedMemorySize, LDS_BYTES);
        (void)hipOccupancyMaxActiveBlocksPerMultiprocessor(&per_cu, (const void*)mk_fwd<false>, NTHREADS, LDS_BYTES);
#endif
        (void)hipGetLastError();
        if (per_cu < 1) per_cu = 1;
        if (cus <= 0) cus = 256;
        grid = cus * 1;
    }
    if (grid < 0) return;
    Args a{};
    for (int i = 0; i < 15; ++i) a.in[i] = (const float*)d_in[i];
    a.pos = (const int*)d_in[1]; a.out = (float*)d_out; a.ws = (unsigned char*)d_ws;
#if MK_COOP
    a.ph_lo = 0; a.ph_hi = NPHASES;
    void* kargs[] = {&a};
    hipError_t e = hipLaunchCooperativeKernel((const void*)mk_fwd<true>, dim3(grid), dim3(NTHREADS), kargs, LDS_BYTES, stream);
    if (e != hipSuccess) fprintf(stderr, "cooperative launch failed: %s (grid %d)\n", hipGetErrorString(e), grid);
#else
    for (int ph = 0; ph < NPHASES; ++ph) { a.ph_lo = ph; a.ph_hi = ph + 1; hipLaunchKernelGGL(mk_fwd<false>, dim3(grid), dim3(NTHREADS), LDS_BYTES, stream, a); }
#endif
}
```

```cpp
#include <hip/hip_runtime.h>
#include <hip/hip_cooperative_groups.h>
#include <cstdio>
#include <cstdint>
#include <cmath>
namespace cg = cooperative_groups;
#ifndef MK_COOP
#define MK_COOP 1
#endif
namespace pg8 {
#define PG8_LAS __attribute__((address_space(3)))
typedef unsigned short bf16_t;
typedef short bf16x8 __attribute__((ext_vector_type(8)));
typedef float f32x4 __attribute__((ext_vector_type(4)));
typedef unsigned u32x4 __attribute__((ext_vector_type(4)));
constexpr int BM = 256, BK = 64, HALF = 128, HTB = HALF * BK * 2  , STAGE_BYTES = 8 * HTB, NXCD = 8, WGM = 8;

__host__ __device__ __forceinline__ int lds_byte(int r, int c) { const int st = (r >> 4) * 2 + (c >> 5), rr = r & 15, cc = c & 31, ob = rr * 64 + cc * 2; return st * 1024 + (ob ^ (((ob >> 9) & 1) << 5)); }
__host__ __device__ __forceinline__ void stage_rc(int b, int& R, int& C) { const int st = b / 1024, sb = b % 1024, swz = sb ^ (((sb >> 9) & 1) << 5); R = (st >> 1) * 16 + swz / 64; C = (st & 1) * 32 + (swz % 64) / 2; }
__host__ __device__ __forceinline__ int perm32(int rho) { const int n = rho >> 4, i = rho & 15; return 8 * (i >> 2) + 4 * n + (i & 3); }

struct Unit { int pm, pn; };
struct Gemm { const bf16_t* A; const bf16_t* Bt; int M, N, K; };

struct StaticOrder {
    int nM, nN, nwg, G, c;
    __host__ __device__ void init(int M, int N, int G_, int c_) { nM = M / BM; nN = N / BM; nwg = nM * nN; G = G_; c = c_; }
    __host__ __device__ bool next(int i, Unit& u) const {
        const long L = (long)i * G + c; if (L >= nwg) return false;
        int wgid = (int)L; { const int q = nwg / NXCD, r = nwg % NXCD, xcd = wgid % NXCD, off = wgid / NXCD; wgid = (xcd < r ? xcd * (q + 1) : r * (q + 1) + (xcd - r) * q) + off; }
        const int nig = WGM * nN, gid = wgid / nig, fm = gid * WGM, gsz = (nM - fm) < WGM ? (nM - fm) : WGM;
        u.pm = fm + ((wgid % nig) % gsz); u.pn = (wgid % nig) / gsz; return true;
    }
    __device__ __forceinline__ void a_ready(const Unit&) const {}
    __device__ __forceinline__ void done(const Unit&) const {}
};

__device__ __forceinline__ unsigned cvt_pk_bf16(float lo, float hi) { unsigned r; asm volatile("v_cvt_pk_bf16_f32 %0, %1, %2" : "=v"(r) : "v"(lo), "v"(hi)); return r; }
typedef float f32x2 __attribute__((ext_vector_type(2)));
__device__ __forceinline__ f32x2 gelu_pk(f32x2 v) {
    const f32x2 av = __builtin_elementwise_abs(v), d = av * 0.2316418882f + 1.0f;
    f32x2 t; t.x = __builtin_amdgcn_rcpf(d.x); t.y = __builtin_amdgcn_rcpf(d.y);
    f32x2 q = t * 0.5307027145f + (-0.7265760135f); q = q * t + 0.7107068705f; q = q * t + (-0.142248368f); q = q * t + 0.127414796f; q = q * t;
    const f32x2 s = (v * v) * (-0.72134752044f);
    f32x2 e; e.x = __builtin_amdgcn_exp2f(s.x); e.y = __builtin_amdgcn_exp2f(s.y);
    const f32x2 m = v * (q * e), r = v - m;
    f32x2 o; o.x = v.x < 0.f ? m.x : r.x; o.y = v.y < 0.f ? m.y : r.y; return o;
}

template <int ACT  > struct EpiBf16 {
    static constexpr bool PERM = true, AFTER_DRAIN = false; static_assert(ACT == 0 || ACT == 1, "EpiBf16: ACT is 0 (none) or 1 (gelu_pk)");
    bf16_t* O; int ldc; const float* bias; int split_cols; size_t split_stride; float scale0;
    __device__ __forceinline__ void operator()(const f32x4 (&acc)[2][2][4][2], const Unit& u, int wr, int wc, int fr, int fq) const {
        const int row0 = u.pm * BM + wr * 64 + fr; int colt = u.pn * BM; bf16_t* base = O;
        float sc = 1.f; if (split_cols) { const int t = colt / split_cols; base += (size_t)t * split_stride; colt -= t * split_cols; if (t == 0) sc = scale0; }
        const int col0 = colt + wc * 32 + 8 * fq, bcol0 = u.pn * BM + wc * 32 + 8 * fq;
        f32x4 bv[2][2];
#pragma unroll
        for (int bj = 0; bj < 2; ++bj)
#pragma unroll
            for (int n = 0; n < 2; ++n) bv[bj][n] = bias ? *(const f32x4*)(bias + bcol0 + bj * HALF + 4 * n) : (f32x4){0.f, 0.f, 0.f, 0.f};
#pragma unroll
        for (int ai = 0; ai < 2; ++ai)
#pragma unroll
            for (int m = 0; m < 4; ++m) { bf16_t* rowp = base + (size_t)(row0 + ai * HALF + m * 16) * ldc + col0;
#pragma unroll
                for (int bj = 0; bj < 2; ++bj) { f32x4 v0 = acc[ai][bj][m][0] + bv[bj][0], v1 = acc[ai][bj][m][1] + bv[bj][1];
                    if (ACT == 1) { f32x2 a = gelu_pk((f32x2){v0[0], v0[1]}), b = gelu_pk((f32x2){v0[2], v0[3]}), c = gelu_pk((f32x2){v1[0], v1[1]}), d = gelu_pk((f32x2){v1[2], v1[3]});
                        v0 = (f32x4){a.x, a.y, b.x, b.y}; v1 = (f32x4){c.x, c.y, d.x, d.y}; }
                    v0 = v0 * sc; v1 = v1 * sc; u32x4 w; w.x = cvt_pk_bf16(v0[0], v0[1]); w.y = cvt_pk_bf16(v0[2], v0[3]); w.z = cvt_pk_bf16(v1[0], v1[1]); w.w = cvt_pk_bf16(v1[2], v1[3]);
                    *(u32x4*)(rowp + bj * HALF) = w; } }
    }
};
typedef unsigned u32x2 __attribute__((ext_vector_type(2)));
struct EpiQRope {
    static constexpr bool PERM = false, AFTER_DRAIN = false;
    bf16_t* O; int ldc; const float* cs;
    __device__ __forceinline__ void operator()(const f32x4 (&acc)[2][2][4][2], const Unit& u, int wr, int wc, int fr, int fq) const {
        const int row0 = u.pm * BM + wr * 64 + fr;
#pragma unroll
        for (int ai = 0; ai < 2; ++ai)
#pragma unroll
            for (int m = 0; m < 4; ++m) {
                const int row = row0 + ai * HALF + m * 16;
                const f32x4 cv = *(const f32x4*)(cs + (size_t)row * 32 + 4 * fq), sv = *(const f32x4*)(cs + (size_t)row * 32 + 16 + 4 * fq);
#pragma unroll
                for (int bj = 0; bj < 2; ++bj) {
                    const int colb = u.pn * BM + bj * HALF + wc * 32;
                    f32x4 v0 = acc[ai][bj][m][0], v1 = acc[ai][bj][m][1];
                    if (((colb >> 5) % 3) == 2) { const f32x4 a = v0 * cv - v1 * sv, b = v1 * cv + v0 * sv; v0 = a; v1 = b; }
                    bf16_t* rp = O + (size_t)row * ldc + colb + 4 * fq;
                    u32x2 w0, w1; w0.x = cvt_pk_bf16(v0[0], v0[1]); w0.y = cvt_pk_bf16(v0[2], v0[3]); w1.x = cvt_pk_bf16(v1[0], v1[1]); w1.y = cvt_pk_bf16(v1[2], v1[3]);
                    *(u32x2*)(rp) = w0; *(u32x2*)(rp + 16) = w1;
                }
                asm volatile("" ::: "memory");
            }
    }
};
struct EpiResF32 {
    static constexpr bool PERM = false, AFTER_DRAIN = false;
    const float* base; float* out; int ldc;
    __device__ __forceinline__ void operator()(const f32x4 (&acc)[2][2][4][2], const Unit& u, int wr, int wc, int fr, int fq) const {
        const int row0 = u.pm * BM + wr * 64 + fr, col0 = u.pn * BM + wc * 32 + 4 * fq;
#pragma unroll
        for (int ai = 0; ai < 2; ++ai)
#pragma unroll
            for (int m = 0; m < 4; ++m) {
                const size_t off = (size_t)(row0 + ai * HALF + m * 16) * ldc + col0;
#pragma unroll
                for (int bj = 0; bj < 2; ++bj)
#pragma unroll
                    for (int n = 0; n < 2; ++n) { const f32x4 b = *(const f32x4*)(base + off + bj * HALF + n * 16); *(f32x4*)(out + off + bj * HALF + n * 16) = b + acc[ai][bj][m][n]; }
                asm volatile("" ::: "memory");
            }
    }
};
struct PanelRms {
    float* xbuf;
    unsigned* cnt;
    float eps;
    __device__ __forceinline__ void run(const f32x4 (&v)[2][2][4][2], const Unit& u, int wr, int wc, int fr, int fq, PG8_LAS unsigned char* lds, int wid, int lane) const {
        PG8_LAS float* P = (PG8_LAS float*)lds;
        PG8_LAS float* S = (PG8_LAS float*)(lds + 4096);
#pragma unroll
        for (int ai = 0; ai < 2; ++ai)
#pragma unroll
            for (int m = 0; m < 4; ++m) {
                float s = 0.f;
#pragma unroll
                for (int bj = 0; bj < 2; ++bj)
#pragma unroll
                    for (int n = 0; n < 2; ++n) { const f32x4 x = v[ai][bj][m][n]; s += (x[0] * x[0] + x[1] * x[1]) + (x[2] * x[2] + x[3] * x[3]); }
                s += __shfl_xor(s, 16); s += __shfl_xor(s, 32);
                if (fq == 0) P[(ai * HALF + wr * 64 + m * 16 + fr) * 4 + wc] = s;
            }
        asm volatile("s_waitcnt lgkmcnt(0)" ::: "memory"); __builtin_amdgcn_s_barrier(); asm volatile("" ::: "memory");
        const int row = wid * 32 + (lane & 31);
        if (lane < 32) {
            const float t = (P[row * 4 + 0] + P[row * 4 + 1]) + (P[row * 4 + 2] + P[row * 4 + 3]);
            __hip_atomic_store(xbuf + ((size_t)(u.pm * BM + row) * 4 + u.pn), t, __ATOMIC_RELAXED, __HIP_MEMORY_SCOPE_AGENT);
        }
        asm volatile("s_waitcnt vmcnt(0)" ::: "memory");
        if (lane == 0) __hip_atomic_fetch_add(cnt + 64 * u.pm, 1u, __ATOMIC_RELAXED, __HIP_MEMORY_SCOPE_AGENT);
        if (wid == 0) {
            unsigned spins = 0;
            while ((unsigned)__builtin_amdgcn_readfirstlane(__hip_atomic_load(cnt + 64 * u.pm, __ATOMIC_RELAXED, __HIP_MEMORY_SCOPE_AGENT)) < 32u) { __builtin_amdgcn_s_sleep(2); if (++spins > (1u << 20)) break; }
            __builtin_amdgcn_fence(__ATOMIC_ACQUIRE, "agent");
        }
        asm volatile("s_waitcnt vmcnt(0) lgkmcnt(0)" ::: "memory"); __builtin_amdgcn_s_barrier(); asm volatile("" ::: "memory");
        if (lane < 32) {
            const float* slot = xbuf + (size_t)(u.pm * BM + row) * 4; float q = 0.f;
#pragma unroll
            for (int t = 0; t < 4; ++t) q += __hip_atomic_load(slot + t, __ATOMIC_RELAXED, __HIP_MEMORY_SCOPE_AGENT);
            S[row] = 1.0f / sqrtf(q * (1.0f / 1024.0f) + eps);
        }
        asm volatile("s_waitcnt lgkmcnt(0)" ::: "memory"); __builtin_amdgcn_s_barrier(); asm volatile("" ::: "memory");
    }
};
struct EpiRmsOut {
    static constexpr bool PERM = false, AFTER_DRAIN = true;
    const float* base; float* out; const float* g; int ldc; PanelRms st;
    __device__ __forceinline__ void fused(f32x4 (&acc)[2][2][4][2], const Unit& u, int wr, int wc, int fr, int fq, PG8_LAS unsigned char* lds, int wid, int lane) const {
        const PG8_LAS float* S = (const PG8_LAS float*)(lds + 4096);
        const int col0 = u.pn * BM + wc * 32 + 4 * fq;
#pragma unroll
        for (int ai = 0; ai < 2; ++ai)
#pragma unroll
            for (int m = 0; m < 4; ++m) { const size_t off = (size_t)(u.pm * BM + ai * HALF + wr * 64 + m * 16 + fr) * ldc + col0;
#pragma unroll
                for (int bj = 0; bj < 2; ++bj)
#pragma unroll
                    for (int n = 0; n < 2; ++n) acc[ai][bj][m][n] += *(const f32x4*)(base + off + bj * HALF + n * 16);
                asm volatile("" : "+v"(acc[ai][0][m][0]), "+v"(acc[ai][0][m][1]), "+v"(acc[ai][1][m][0]), "+v"(acc[ai][1][m][1]));
                if (m & 1) asm volatile("" ::: "memory"); }
        st.run(acc, u, wr, wc, fr, fq, lds, wid, lane);
#pragma unroll
        for (int bj = 0; bj < 2; ++bj)
#pragma unroll
            for (int n = 0; n < 2; ++n) { const f32x4 gv = *(const f32x4*)(g + col0 + bj * HALF + n * 16);
#pragma unroll
                for (int ai = 0; ai < 2; ++ai)
#pragma unroll
                    for (int m = 0; m < 4; ++m) { const int r = ai * HALF + wr * 64 + m * 16 + fr; const float rs = S[r];
                        *(f32x4*)(out + (size_t)(u.pm * BM + r) * ldc + col0 + bj * HALF + n * 16) = acc[ai][bj][m][n] * rs * gv; } }
    }
};
template <class Epi, class Sched, bool ALIGN_EPI = false, bool SP2 = false>
__device__ __forceinline__ void gemm_phase(PG8_LAS unsigned char* lds, const Gemm g, const Sched& S, const Epi& E) {
    const int tid = threadIdx.x, wid = __builtin_amdgcn_readfirstlane(tid >> 6), lane = tid & 63, wr = wid >> 2, wc = wid & 3, fr = lane & 15, fq = lane >> 4;
    const int K = g.K, nt = K / BK;
    unsigned voffA[2], voffB[2];
#pragma unroll
    for (int i = 0; i < 2; ++i) { int R, C; stage_rc(tid * 16 + i * 8192, R, C); const int Rb = Epi::PERM ? ((R & ~31) + perm32(R & 31)) : R;
        voffA[i] = (unsigned)(R * K + C) * 2u; voffB[i] = (unsigned)(Rb * K + C) * 2u; }
    const size_t kstep = (size_t)(BK * 2);
    const size_t hstep = (size_t)HALF * K * 2;
    const size_t tstep = 2 * hstep;
    const unsigned ldsw = (unsigned)wid * 1024u;
    const int aoff = lds_byte(wr * 64 + fr, fq * 8), boff = lds_byte(wc * 32 + fr, fq * 8);
#define PG8_SA(b, h) (((b) * 2 + (h)) * HTB)
#define PG8_SB(b, h) ((4 + (b) * 2 + (h)) * HTB)
#define PG8_STAGE(bufoff, gbase, voff) do { _Pragma("unroll") for (int _i = 0; _i < 2; ++_i) \
        __builtin_amdgcn_global_load_lds((const unsigned*)((const char*)(gbase) + (voff)[_i]), (PG8_LAS unsigned*)(lds + (bufoff) + ldsw + _i * 8192), 16, 0, 0); } while (0)
#define PG8_LDA(dst, b, h) do { _Pragma("unroll") for (int m = 0; m < 4; ++m) _Pragma("unroll") for (int k = 0; k < 2; ++k) dst[m][k] = *(const PG8_LAS bf16x8*)(lds + PG8_SA(b, h) + aoff + m * 2048 + k * 1024); } while (0)
#define PG8_LDB(dst, b, h) do { _Pragma("unroll") for (int n = 0; n < 2; ++n) _Pragma("unroll") for (int k = 0; k < 2; ++k) dst[n][k] = *(const PG8_LAS bf16x8*)(lds + PG8_SB(b, h) + boff + n * 2048 + k * 1024); } while (0)
#define PG8_MMA(ai, bj, At, Bt) do { __builtin_amdgcn_s_setprio(1); _Pragma("unroll") for (int m = 0; m < 4; ++m) _Pragma("unroll") for (int n = 0; n < 2; ++n) _Pragma("unroll") for (int k = 0; k < 2; ++k) \
        acc[ai][bj][m][n] = __builtin_amdgcn_mfma_f32_16x16x32_bf16(Bt[n][k], At[m][k], acc[ai][bj][m][n], 0, 0, 0); __builtin_amdgcn_s_setprio(0); } while (0)
#define PG8_WAIT_V(n) asm volatile("s_waitcnt vmcnt(" #n ")" ::: "memory")
#define PG8_WAIT_L(n) asm volatile("s_waitcnt lgkmcnt(" #n ")" ::: "memory")
#define PG8_BAR __builtin_amdgcn_s_barrier()
#define PG8_SCHED __builtin_amdgcn_sched_barrier(0)
    Unit cur, nxt; int ui = 0;
    if (!S.next(0, cur)) return;
    f32x4 acc[2][2][4][2];
#pragma unroll
    for (int a = 0; a < 2; ++a)
#pragma unroll
        for (int b = 0; b < 2; ++b)
#pragma unroll
            for (int m = 0; m < 4; ++m)
#pragma unroll
                for (int n = 0; n < 2; ++n) acc[a][b][m][n] = (f32x4){0.f, 0.f, 0.f, 0.f};
    bf16x8 At[4][2], B0[2][2], B1[2][2];
    const char* cA = (const char*)g.A + (size_t)cur.pm * tstep; const char* cB = (const char*)g.Bt + (size_t)cur.pn * tstep;
    S.a_ready(cur);
    if constexpr (SP2) {
        PG8_STAGE(PG8_SB(0, 0), cB, voffB); PG8_STAGE(PG8_SB(0, 1), cB + hstep, voffB); PG8_STAGE(PG8_SA(0, 0), cA, voffA); PG8_STAGE(PG8_SA(0, 1), cA + hstep, voffA);
        if (wr == 1) PG8_BAR;
        PG8_WAIT_V(2); PG8_BAR;
        PG8_STAGE(PG8_SB(1, 0), cB + kstep, voffB); PG8_STAGE(PG8_SA(1, 0), cA + kstep, voffA); PG8_STAGE(PG8_SB(1, 1), cB + hstep + kstep, voffB);
        PG8_WAIT_V(6); PG8_BAR;
    } else {
        PG8_STAGE(PG8_SB(0, 0), cB, voffB); PG8_STAGE(PG8_SA(0, 0), cA, voffA); PG8_STAGE(PG8_SB(0, 1), cB + hstep, voffB); PG8_STAGE(PG8_SA(0, 1), cA + hstep, voffA);
        if (wr == 1) PG8_BAR;
        PG8_WAIT_V(4); PG8_BAR;
        PG8_STAGE(PG8_SB(1, 0), cB + kstep, voffB); PG8_STAGE(PG8_SA(1, 0), cA + kstep, voffA); PG8_STAGE(PG8_SB(1, 1), cB + hstep + kstep, voffB);
        PG8_WAIT_V(6); PG8_BAR;
    }
    for (;;) {
        const bool has_next = S.next(ui + 1, nxt);
        const char* nA = has_next ? (const char*)g.A + (size_t)nxt.pm * tstep : cA; const char* nB = has_next ? (const char*)g.Bt + (size_t)nxt.pn * tstep : cB;
        for (int t = 0; t < nt; t += 2) {
            const bool last = (t == nt - 2);
            const char* a1 = cA + (size_t)(t + 1) * kstep;
            const char* a2 = last ? nA : cA + (size_t)(t + 2) * kstep; const char* b2 = last ? nB : cB + (size_t)(t + 2) * kstep;
            const char* a3 = a2 + kstep; const char* b3 = b2 + kstep;
            if (last && has_next) S.a_ready(nxt);
            if constexpr (SP2) {
            PG8_LDB(B0, 0, 0); PG8_LDB(B1, 0, 1); PG8_SCHED; PG8_LDA(At, 0, 0); PG8_STAGE(PG8_SA(1, 1), a1 + hstep, voffA);
            PG8_WAIT_V(8); PG8_WAIT_L(0); PG8_BAR; PG8_MMA(0, 0, At, B0); PG8_MMA(0, 1, At, B1); PG8_BAR; PG8_SCHED;
            PG8_LDA(At, 0, 1); PG8_STAGE(PG8_SB(0, 0), b2, voffB); PG8_STAGE(PG8_SB(0, 1), b2 + hstep, voffB); PG8_STAGE(PG8_SA(0, 0), a2, voffA);
            PG8_WAIT_V(8); PG8_WAIT_L(0); PG8_BAR; PG8_MMA(1, 0, At, B0); PG8_MMA(1, 1, At, B1); PG8_BAR; PG8_SCHED;
            PG8_LDB(B0, 1, 0); PG8_LDB(B1, 1, 1); PG8_SCHED; PG8_LDA(At, 1, 0); PG8_STAGE(PG8_SA(0, 1), a2 + hstep, voffA);
            PG8_WAIT_V(8); PG8_WAIT_L(0); PG8_BAR; PG8_MMA(0, 0, At, B0); PG8_MMA(0, 1, At, B1); PG8_BAR; PG8_SCHED;
            PG8_LDA(At, 1, 1); PG8_STAGE(PG8_SB(1, 0), b3, voffB); PG8_STAGE(PG8_SB(1, 1), b3 + hstep, voffB); PG8_STAGE(PG8_SA(1, 0), a3, voffA);
            PG8_WAIT_V(8); PG8_WAIT_L(0); PG8_BAR; PG8_MMA(1, 0, At, B0); PG8_MMA(1, 1, At, B1); PG8_BAR; PG8_SCHED;
            } else {
            PG8_LDB(B0, 0, 0); PG8_SCHED; PG8_LDA(At, 0, 0); PG8_STAGE(PG8_SA(1, 1), a1 + hstep, voffA);
            PG8_WAIT_L(8); PG8_BAR; PG8_WAIT_L(0); PG8_MMA(0, 0, At, B0); PG8_BAR; PG8_SCHED;
            PG8_LDB(B1, 0, 1); PG8_STAGE(PG8_SB(0, 0), b2, voffB);
            PG8_BAR; PG8_WAIT_L(0); PG8_MMA(0, 1, At, B1); PG8_BAR;
            PG8_LDA(At, 0, 1); PG8_STAGE(PG8_SA(0, 0), a2, voffA);
            PG8_BAR; PG8_WAIT_L(0); PG8_MMA(1, 0, At, B0); PG8_BAR; PG8_SCHED;
            PG8_STAGE(PG8_SB(0, 1), b2 + hstep, voffB);
            PG8_WAIT_V(6); PG8_BAR; PG8_MMA(1, 1, At, B1); PG8_BAR;
            PG8_LDB(B0, 1, 0); PG8_SCHED; PG8_LDA(At, 1, 0); PG8_STAGE(PG8_SA(0, 1), a2 + hstep, voffA);
            PG8_WAIT_L(8); PG8_BAR; PG8_WAIT_L(0); PG8_MMA(0, 0, At, B0); PG8_BAR; PG8_SCHED;
            PG8_LDB(B1, 1, 1); PG8_STAGE(PG8_SB(1, 0), b3, voffB);
            PG8_BAR; PG8_WAIT_L(0); PG8_MMA(0, 1, At, B1); PG8_BAR;
            PG8_LDA(At, 1, 1); PG8_STAGE(PG8_SA(1, 0), a3, voffA);
            PG8_BAR; PG8_WAIT_L(0); PG8_MMA(1, 0, At, B0); PG8_BAR; PG8_SCHED;
            PG8_STAGE(PG8_SB(1, 1), b3 + hstep, voffB);
            PG8_WAIT_V(6); PG8_BAR; PG8_MMA(1, 1, At, B1); PG8_BAR;
            }
        }
        if constexpr (ALIGN_EPI) { if (wr == 0) PG8_BAR; }
        if constexpr (!Epi::AFTER_DRAIN) { E(acc, cur, wr, wc, fr, fq); S.done(cur); }
        if (!has_next) break;
#pragma unroll
        for (int a = 0; a < 2; ++a)
#pragma unroll
            for (int b = 0; b < 2; ++b)
#pragma unroll
                for (int m = 0; m < 4; ++m)
#pragma unroll
                    for (int n = 0; n < 2; ++n) acc[a][b][m][n] = (f32x4){0.f, 0.f, 0.f, 0.f};
        cur = nxt; cA = nA; cB = nB; ++ui;
        if constexpr (ALIGN_EPI) { if (wr == 1) PG8_BAR; }
    }
    PG8_WAIT_V(0);
    if constexpr (!ALIGN_EPI) { if (wr == 0) PG8_BAR; }
    PG8_BAR;
    if constexpr (Epi::AFTER_DRAIN) { E.fused(acc, cur, wr, wc, fr, fq, lds, wid, lane); S.done(cur); }
#undef PG8_SA
#undef PG8_SB
#undef PG8_STAGE
#undef PG8_LDA
#undef PG8_LDB
#undef PG8_MMA
#undef PG8_WAIT_V
#undef PG8_WAIT_L
#undef PG8_BAR
#undef PG8_SCHED
}
}
#define LAS __attribute__((address_space(3)))
typedef unsigned short bf16;
typedef short bf16x8 __attribute__((ext_vector_type(8)));
typedef float f32x16 __attribute__((ext_vector_type(16)));
typedef float f32x4 __attribute__((ext_vector_type(4)));
typedef float f32x2 __attribute__((ext_vector_type(2)));
typedef unsigned u32x4 __attribute__((ext_vector_type(4)));
typedef unsigned u32x2 __attribute__((ext_vector_type(2)));
typedef __bf16 bf16x2_t __attribute__((ext_vector_type(2)));

constexpr int BATCH = 8, SEQ = 4096, DM = 1024, M = BATCH * SEQ;
constexpr int N0 = 2208, N0P = 2304;
constexpr int C_CQ = 0, C_CKV = 256, C_KPE = 384, C_QS = 416, C_KS = 928, C_VS = 1056, C_G0 = 1184;
constexpr int N1W = 4112, N1 = 4096;
constexpr int C1_Q = 0, C1_K = 1024, C1_V = 2048, C1_G = 3072, W1_F = 3072, W1_G = 3088;
constexpr float EPS = 1e-6f, LOG2E = 1.4426950408889634f;
constexpr int NTHREADS = 512, NWAVES = 8;

constexpr size_t MiB = 1u << 20;
constexpr size_t WS_WT0 = 1 * MiB;
constexpr size_t WS_WQUP = 6 * MiB;
constexpr size_t WS_WKVUP = 7 * MiB;
constexpr size_t WS_WOUT0 = 8 * MiB;
constexpr size_t WS_WT1 = 10 * MiB;
constexpr size_t WS_WOUT1 = 18 * MiB;
constexpr size_t WS_XN = 32 * MiB;
constexpr size_t WS_OG = 96 * MiB;
constexpr size_t WS_LF = 160 * MiB;
constexpr size_t WS_LC = 162 * MiB;
constexpr size_t WS_TMAX = 512 * 1024;
constexpr size_t WS_CS = 164 * MiB;
constexpr size_t WS_Z1 = 168 * MiB;
constexpr size_t WS_Z0 = 168 * MiB;
constexpr size_t WS_CQN = 312 * MiB;
constexpr size_t WS_CKVN = 328 * MiB;
constexpr size_t WS_KPE = 344 * MiB;
constexpr size_t WS_Q0 = 346 * MiB;
constexpr size_t WS_KN = 394 * MiB;
constexpr size_t WS_VM = 426 * MiB;
constexpr size_t WS_END = 458 * MiB;
constexpr int LDS_BYTES = 135168, LDS_MISC = 131072 + 1024;

__device__ __forceinline__ unsigned cvtpk(float lo, float hi) { f32x2 v = {lo, hi}; bf16x2_t b = __builtin_convertvector(v, bf16x2_t); return __builtin_bit_cast(unsigned, b); }
__device__ __forceinline__ float bflo(unsigned u) { return __uint_as_float(u << 16); }
__device__ __forceinline__ float bfhi(unsigned u) { return __uint_as_float(u & 0xffff0000u); }
__device__ __forceinline__ float bf1(bf16 v) { return __uint_as_float(((unsigned)v) << 16); }
__device__ __forceinline__ float wave_sum(float v) {
#pragma unroll
    for (int o = 1; o < 64; o <<= 1) v += __shfl_xor(v, o);
    return v;
}

struct AttnP { const bf16 *Q, *K, *K2, *V, *G; bf16* O; const float* lc; const float* tmax; const float* sinkp; int h0; int ldq, ldk, ldk2, ldv, ldg, ldo; float c, sink2, slope2; };

typedef short v4i16_t __attribute__((ext_vector_type(4)));
__device__ __forceinline__ void glds16(const void* gsrc, unsigned lds_dst) { unsigned keep;
    asm volatile("s_mov_b32 %0, m0\n\ts_mov_b32 m0, %2\n\ts_nop 0\n\tglobal_load_lds_dwordx4 %1, off\n\ts_mov_b32 m0, %0" : "=&s"(keep) : "v"(gsrc), "s"(lds_dst) : "memory"); }
__device__ __forceinline__ void glds4(const void* gsrc, unsigned lds_dst) { unsigned keep;
    asm volatile("s_mov_b32 %0, m0\n\ts_mov_b32 m0, %2\n\ts_nop 0\n\tglobal_load_lds_dword %1, off\n\ts_mov_b32 m0, %0" : "=&s"(keep) : "v"(gsrc), "s"(lds_dst) : "memory"); }
#define AT_WAITV(n) asm volatile("s_waitcnt vmcnt(%0) lgkmcnt(0)" :: "n"(n) : "memory")
template <int DK, int MODE>
__device__ __forceinline__ void attn_unit(const AttnP& p, const int q0, LAS unsigned char* lds) {
    constexpr int NS = 4, KN_B = 8192, KP_B = (DK == 96) ? 4096 : 0, VHALF = 4160, V_B = 2 * VHALF, LC_B = (MODE == 2) ? 256 : 0;
    constexpr int OFF_KP = KN_B, OFF_V = KN_B + KP_B, OFF_LC = OFF_V + V_B, SLOT = OFF_LC + LC_B, OFF_FLAG = NS * SLOT;
    constexpr int NPT = 2 + ((DK == 96 || MODE == 2) ? 1 : 0);
    const int tid = threadIdx.x, lane = tid & 63, wid = __builtin_amdgcn_readfirstlane(tid >> 6), r32 = lane & 31, hi = lane >> 5;
    const int hsel = (MODE == 1) ? (wid >> 1) : 0;
    const int qw0 = q0 + 32 * ((MODE == 1) ? (wid & 1) : wid), q = qw0 + r32;
    const bf16* Qp = p.Q + hsel * 64; const bf16* Gp = p.G + hsel * 64; bf16* Op = p.O + hsel * 64;
    float sink2 = 0.f, slope2 = 0.f;
    if (MODE == 1) { const int hh = p.h0 + hsel; sink2 = p.sinkp[hh] * LOG2E; slope2 = exp2f(-(float)(hh + 1)) * LOG2E; }
    const unsigned lds0 = (unsigned)(uintptr_t)lds;
    bf16x8 qf[DK / 16];
#pragma unroll
    for (int d0 = 0; d0 < DK / 16; ++d0) qf[d0] = *(const bf16x8*)(Qp + (size_t)q * p.ldq + 16 * d0 + 8 * hi);
#pragma unroll
    for (int d0 = 0; d0 < DK / 16; ++d0) asm volatile("" : "+v"(qf[d0]));
    const int t_hi = (MODE == 1) ? (q0 >> 6) : (((q0 + 256) >> 6) - 1);
    const int t_lo = (MODE == 1) ? (((q0 >> 6) >= 2) ? (q0 >> 6) - 2 : 0) : 0;
    const int ntile = t_hi - t_lo + 1;
    const int krow = 8 * wid + (lane >> 3), kch = (lane & 7) ^ ((krow >> 1) & 7);
    const bf16* ksrc = p.K + (size_t)krow * p.ldk + kch * 8;
    const int prow = 8 * wid + ((lane & 31) >> 2), pch = (lane & 3) ^ ((prow >> 2) & 3);
    const bf16* psrc = (DK == 96) ? (p.K2 + (size_t)prow * p.ldk2 + pch * 8) : p.K;
    const int vrow = 16 * (wid & 3) + (lane >> 2);
    const bf16* vsrc = p.V + (size_t)vrow * p.ldv + ((wid >> 2) * 4 + (lane & 3)) * 8;
    const float* lsrc = (MODE == 2) ? (p.lc + 8 * wid + (lane & 7)) : (const float*)p.K;
#define AT_DMA(t, slot) do { const size_t ro_ = (size_t)(t) * 64; const unsigned sb_ = lds0 + (unsigned)((slot) * SLOT); \
        glds16(ksrc + ro_ * p.ldk, (unsigned)__builtin_amdgcn_readfirstlane(sb_ + wid * 1024)); \
        glds16(vsrc + ro_ * p.ldv, (unsigned)__builtin_amdgcn_readfirstlane(sb_ + OFF_V + (wid >> 2) * VHALF + (wid & 3) * 1024)); \
        if (DK == 96) { if (lane < 32) glds16(psrc + ro_ * p.ldk2, (unsigned)__builtin_amdgcn_readfirstlane(sb_ + OFF_KP + wid * 512)); } \
        if (MODE == 2) { if (lane < 8) glds4(lsrc + ro_, (unsigned)__builtin_amdgcn_readfirstlane(sb_ + OFF_LC + wid * 32)); } } while (0)

    float m_run = (MODE == 1) ? sink2 : -INFINITY;
    float l_run = (MODE == 1 && hi == 0) ? 1.f : 0.f;
    f32x16 ot[2];
#pragma unroll
    for (int r = 0; r < 16; ++r) { ot[0][r] = 0.f; ot[1][r] = 0.f; }
    const int pim = 16 * (r32 >> 4) + 8 * ((r32 >> 2) & 1) + 4 * ((r32 >> 3) & 1) + (r32 & 3);
    const int vrd = (8 * hi + ((lane & 15) >> 2)) * 64 + ((lane >> 4) & 1) * 32 + (lane & 3) * 8;
    int koff[4], poff[2];
#pragma unroll
    for (int d0 = 0; d0 < 4; ++d0) koff[d0] = pim * 128 + (((2 * d0 + hi) ^ ((pim >> 1) & 7)) * 16);
#pragma unroll
    for (int j = 0; j < 2; ++j) poff[j] = OFF_KP + pim * 64 + (((2 * j + hi) ^ ((pim >> 2) & 3)) * 16);
    float pmv = 0.f, lcev = 0.f, qn = 0.f;
    if (MODE == 2) {
        pmv = (lane <= t_hi) ? p.tmax[lane] : 0.f;
#pragma unroll
        for (int o = 1; o < 64; o <<= 1) { const float n = __shfl_up(pmv, o); if (lane >= o) pmv = fmaxf(pmv, n); }
        lcev = (lane <= t_hi) ? p.lc[64 * lane + 63] : 0.f;
        float qs = 0.f;
#pragma unroll
        for (int d0 = 0; d0 < DK / 16; ++d0)
#pragma unroll
            for (int e = 0; e < 8; ++e) { const float f = bf1((bf16)qf[d0][e]); qs += f * f; }
        qs += __shfl_xor(qs, 32);
        qn = sqrtf(qs) * p.c * 1.002f;
    }
    AT_DMA(t_hi, 0);
    if (ntile > 1) AT_DMA(t_hi - 1, 1);
    if (ntile > 2) AT_DMA(t_hi - 2, 2);
    for (int i = 0; i < ntile; ++i) {
        const int t = t_hi - i, kv0 = t * 64, rem = ntile - 1 - i;
        if (rem >= 2) AT_WAITV(2 * NPT); else if (rem == 1) AT_WAITV(NPT); else AT_WAITV(0);
        __builtin_amdgcn_s_barrier();
        asm volatile("" ::: "memory");
        if (MODE == 2) { if (i > 0) {
            const LAS unsigned char* fp = lds + OFF_FLAG + ((i - 1) & 1) * 32;
            const u32x4 f0 = *(const LAS u32x4*)(fp), f1 = *(const LAS u32x4*)(fp + 16);
            if ((f0.x & f0.y & f0.z & f0.w & f1.x & f1.y & f1.z & f1.w) != 0u) break; } }
        if (rem >= 3) AT_DMA(t - 3, (i + 3) & 3);
        const LAS unsigned char* sb = lds + (i & 3) * SLOT;
        bool act = kv0 <= qw0 + 31;
        if (MODE == 1) act = act && (kv0 + 63 >= qw0 - 127);
        if (act) {
            f32x16 s[2];
            {
                bf16x8 kf[2][DK / 16];
#pragma unroll
                for (int ph = 0; ph < 2; ++ph) {
#pragma unroll
                    for (int d0 = 0; d0 < 4; ++d0) kf[ph][d0] = *(const LAS bf16x8*)(sb + koff[d0] + ph * 4096);
                    if (DK == 96) {
#pragma unroll
                        for (int j = 0; j < 2; ++j) kf[ph][(DK == 96) ? 4 + j : 0] = *(const LAS bf16x8*)(sb + poff[j] + ph * 2048);
                    }
                }
#pragma unroll
                for (int r = 0; r < 16; ++r) { s[0][r] = 0.f; s[1][r] = 0.f; }
                __builtin_amdgcn_sched_barrier(0);
#pragma unroll
                for (int d0 = 0; d0 < DK / 16; ++d0) {
                    s[0] = __builtin_amdgcn_mfma_f32_32x32x16_bf16(kf[0][d0], qf[d0], s[0], 0, 0, 0);
                    s[1] = __builtin_amdgcn_mfma_f32_32x32x16_bf16(kf[1][d0], qf[d0], s[1], 0, 0, 0);
                }
                __builtin_amdgcn_sched_barrier(0);
            }
            if (MODE == 2) {
                const LAS float* lcb = (const LAS float*)(sb + OFF_LC);
#pragma unroll
                for (int ph = 0; ph < 2; ++ph)
#pragma unroll
                    for (int j = 0; j < 4; ++j) { const f32x4 lk = *(const LAS f32x4*)(lcb + 32 * ph + 16 * (j >> 1) + 8 * hi + 4 * (j & 1));
#pragma unroll
                        for (int ii = 0; ii < 4; ++ii) s[ph][4 * j + ii] = s[ph][4 * j + ii] * p.c - lk[ii]; }
            } else if (MODE == 1) {
                const float dq = (float)(q - kv0 - 8 * hi);
#pragma unroll
                for (int ph = 0; ph < 2; ++ph)
#pragma unroll
                    for (int r = 0; r < 16; ++r) { const int kk = 32 * ph + 16 * (r >> 3) + 4 * ((r >> 2) & 1) + (r & 3); s[ph][r] = s[ph][r] * p.c - slope2 * (dq - (float)kk); }
            }
            bool needmask = (kv0 + 63 > qw0);
            if (MODE == 1) needmask = needmask || (kv0 < qw0 + 31 - 127);
            if (needmask) {
                const int dqi = q - kv0 - 8 * hi;
#pragma unroll
                for (int ph = 0; ph < 2; ++ph)
#pragma unroll
                    for (int r = 0; r < 16; ++r) { const int kk = 32 * ph + 16 * (r >> 3) + 4 * ((r >> 2) & 1) + (r & 3); const int dist = dqi - kk;
                        bool ok = dist >= 0; if (MODE == 1) ok = ok && (dist < 128); s[ph][r] = ok ? s[ph][r] : -INFINITY; }
            }
            float mx = fmaxf(fmaxf(s[0][0], s[0][1]), s[0][2]);
#pragma unroll
            for (int r = 3; r < 15; r += 2) mx = fmaxf(fmaxf(mx, s[0][r]), s[0][r + 1]);
            mx = fmaxf(mx, s[0][15]);
#pragma unroll
            for (int r = 0; r < 16; r += 2) mx = fmaxf(fmaxf(mx, s[1][r]), s[1][r + 1]);
            mx = fmaxf(mx, __shfl_xor(mx, 32));
            if (MODE == 0) mx *= p.c;
            const bool dead = (MODE == 2) && __all(mx < m_run - 40.f);
            if (!dead) {
                const float m_new = fmaxf(m_run, mx);
                const float alpha = __builtin_amdgcn_exp2f(m_run - m_new);
                m_run = m_new;
                float ls0 = 0.f, ls1 = 0.f;
#pragma unroll
                for (int ph = 0; ph < 2; ++ph)
#pragma unroll
                    for (int r = 0; r < 16; r += 2) {
                        const float e0 = __builtin_amdgcn_exp2f(MODE == 0 ? (s[ph][r] * p.c - m_new) : (s[ph][r] - m_new));
                        const float e1 = __builtin_amdgcn_exp2f(MODE == 0 ? (s[ph][r + 1] * p.c - m_new) : (s[ph][r + 1] - m_new));
                        s[ph][r] = e0; s[ph][r + 1] = e1; ls0 += e0; ls1 += e1; }
                if (__any(alpha != 1.f)) {
                    l_run *= alpha;
#pragma unroll
                    for (int r = 0; r < 16; ++r) { ot[0][r] *= alpha; ot[1][r] *= alpha; }
                }
                l_run += ls0 + ls1;
                bf16x8 pk[4];
#pragma unroll
                for (int cc = 0; cc < 4; ++cc) { const int ph = cc >> 1, o = 8 * (cc & 1); u32x4 w;
                    w.x = cvtpk(s[ph][o + 0], s[ph][o + 1]); w.y = cvtpk(s[ph][o + 2], s[ph][o + 3]); w.z = cvtpk(s[ph][o + 4], s[ph][o + 5]); w.w = cvtpk(s[ph][o + 6], s[ph][o + 7]);
                    pk[cc] = __builtin_bit_cast(bf16x8, w); }
                const LAS unsigned char* vb = sb + OFF_V + vrd;
                bf16x8 vf[2][4];
#pragma unroll
                for (int dh = 0; dh < 2; ++dh)
#pragma unroll
                    for (int cc = 0; cc < 4; ++cc) {
                        const v4i16_t v0 = __builtin_amdgcn_ds_read_tr16_b64_v4i16((LAS v4i16_t*)(vb + dh * VHALF + cc * 1024));
                        const v4i16_t v1 = __builtin_amdgcn_ds_read_tr16_b64_v4i16((LAS v4i16_t*)(vb + dh * VHALF + cc * 1024 + 256));
                        vf[dh][cc] = (bf16x8){v0[0], v0[1], v0[2], v0[3], v1[0], v1[1], v1[2], v1[3]}; }
                __builtin_amdgcn_sched_barrier(0);
#pragma unroll
                for (int cc = 0; cc < 4; ++cc) {
                    ot[0] = __builtin_amdgcn_mfma_f32_32x32x16_bf16(vf[0][cc], pk[cc], ot[0], 0, 0, 0);
                    ot[1] = __builtin_amdgcn_mfma_f32_32x32x16_bf16(vf[1][cc], pk[cc], ot[1], 0, 0, 0);
                }
                __builtin_amdgcn_sched_barrier(0);
            }
        }
        if (MODE == 2) {
            bool dn = false;
            if (rem >= 1) { const float bnd = qn * __shfl(pmv, t - 1) - __shfl(lcev, t - 1); dn = __all(bnd < m_run - 40.f); }
            if (lane == 0) *(LAS unsigned*)(lds + OFF_FLAG + (i & 1) * 32 + wid * 4) = dn ? 1u : 0u;
        }
    }
    AT_WAITV(0);
    __builtin_amdgcn_s_barrier();
    asm volatile("" ::: "memory");
    const float lt = l_run + __shfl_xor(l_run, 32);
    const float inv = 1.f / lt;
#pragma unroll
    for (int dh = 0; dh < 2; ++dh)
#pragma unroll
        for (int j = 0; j < 4; ++j) {
            const int d = 32 * dh + 8 * j + 4 * hi;
            const u32x2 g = *(const u32x2*)(Gp + (size_t)q * p.ldg + d);
            const float g0 = bflo(g.x), g1 = bfhi(g.x), g2 = bflo(g.y), g3 = bfhi(g.y);
            const float o0 = ot[dh][4 * j + 0] * inv * (g0 / (1.f + __expf(-g0)));
            const float o1 = ot[dh][4 * j + 1] * inv * (g1 / (1.f + __expf(-g1)));
            const float o2 = ot[dh][4 * j + 2] * inv * (g2 / (1.f + __expf(-g2)));
            const float o3 = ot[dh][4 * j + 3] * inv * (g3 / (1.f + __expf(-g3)));
            u32x2 w; w.x = cvtpk(o0, o1); w.y = cvtpk(o2, o3);
            *(u32x2*)(Op + (size_t)q * p.ldo + d) = w;
        }
#undef AT_DMA
}

#define XB_TMO      128
#define XB_XCNT(j)  (256  + 64 * (j))
#define XB_XSUB(j)  (1280 + 64 * (j))
#define XB_XGEN(j)  (2304 + 64 * (j))
#define XB_TOP      3328
#define XB_TOPGEN   3392
#define XCD_BAR_WORDS 3456
#define XB_SPIN_CAP (1u << 18)

__device__ __forceinline__ unsigned xb_ld(unsigned* p)              { return __hip_atomic_load(p, __ATOMIC_RELAXED, __HIP_MEMORY_SCOPE_AGENT); }
__device__ __forceinline__ unsigned xb_add(unsigned* p, unsigned v) { return __hip_atomic_fetch_add(p, v, __ATOMIC_RELAXED, __HIP_MEMORY_SCOPE_AGENT); }
__device__ __forceinline__ unsigned xb_xcc_id() { return (unsigned)__builtin_amdgcn_s_getreg((3 << 11) | 20) & 0xFu; }
#define XB_SPIN(cond, bar) do { unsigned _sp = 0; while (cond) { __builtin_amdgcn_s_sleep(1); \
    if ((++_sp & 255u) == 0u) { if (xb_ld(&(bar)[XB_TMO])) break; if (_sp > XB_SPIN_CAP) { atomicAdd(&(bar)[XB_TMO], 1u); break; } } } } while (0)

struct XcdBarrier {
    unsigned* bar; unsigned x;
    volatile LAS unsigned* st;
};

__device__ __forceinline__ XcdBarrier xcd_barrier_post(unsigned* bar, volatile LAS unsigned* st) {
    XcdBarrier b; b.bar = bar; b.x = xb_xcc_id(); b.st = st;
    if (threadIdx.x == 0) (void)xb_add(&bar[XB_XCNT(b.x)], 1u);
    return b;
}
__device__ __forceinline__ void xcd_barrier_complete(unsigned* bar, unsigned x, unsigned& nloc, unsigned& nx) {
    const unsigned G = gridDim.x * gridDim.y * gridDim.z;
    unsigned sum, cnt, mine, sp = 0u;
    for (;;) {
        sum = 0u; cnt = 0u; mine = 0u;
#pragma unroll
        for (unsigned j = 0; j < 16; ++j) { const unsigned c = xb_ld(&bar[XB_XCNT(j)]); sum += c; cnt += (c > 0u) ? 1u : 0u; mine = (j == x) ? c : mine; }
        if (sum == G) break;
        __builtin_amdgcn_s_sleep(1);
        if ((++sp & 255u) == 0u) { if (xb_ld(&bar[XB_TMO])) break; if (sp > XB_SPIN_CAP) { atomicAdd(&bar[XB_TMO], 1u); break; } }
    }
    nloc = mine > 0u ? mine : 1u; nx = cnt > 0u ? cnt : 1u;
}

__device__ __forceinline__ void xcd_barrier(const XcdBarrier& b) {
    asm volatile("s_waitcnt vmcnt(0)" ::: "memory");
    __syncthreads();
    if (threadIdx.x == 0) {
        unsigned* bar = b.bar;
        __builtin_amdgcn_s_waitcnt(0);
        unsigned nloc = b.st[0], nx = b.st[1];
        if (nloc == 0u) { xcd_barrier_complete(bar, b.x, nloc, nx); b.st[0] = nloc; b.st[1] = nx; }
        const unsigned old = xb_add(&bar[XB_XSUB(b.x)], 1u);
        const unsigned gen = old / nloc;
        if (old + 1u == (gen + 1u) * nloc) {
            __builtin_amdgcn_fence(__ATOMIC_RELEASE, "agent");
            asm volatile("s_waitcnt vmcnt(0)" ::: "memory");
            const unsigned og = xb_add(&bar[XB_TOP], 1u);
            const unsigned tg = og / nx;
            if (og + 1u == (tg + 1u) * nx) xb_add(&bar[XB_TOPGEN], 1u);
            else XB_SPIN(xb_ld(&bar[XB_TOPGEN]) == tg, bar);
            __builtin_amdgcn_fence(__ATOMIC_ACQUIRE, "agent");
            xb_add(&bar[XB_XGEN(b.x)], 1u);
            asm volatile("s_waitcnt vmcnt(0)" ::: "memory");
        } else {
            XB_SPIN(xb_ld(&bar[XB_XGEN(b.x)]) == gen, bar);
            __builtin_amdgcn_fence(__ATOMIC_ACQUIRE, "agent");
            asm volatile("s_waitcnt vmcnt(0)" ::: "memory");
        }
    }
    __syncthreads();
}

struct Args { const float* in[15]; const int* pos; float* out; unsigned char* ws; int ph_lo, ph_hi; };

__device__ __forceinline__ void transpose_item(const float* W, int ldw, int col0, int k0, bf16* WT, int ldt, int row_off, LAS float* scr, int lane) {
#pragma unroll 8
    for (int i = 0; i < 32; ++i) { const int kk = 2 * i + (lane >> 5); scr[kk * 33 + (lane & 31)] = W[(size_t)(k0 + kk) * ldw + col0 + (lane & 31)]; }
    asm volatile("s_waitcnt lgkmcnt(0)" ::: "memory");
    const int c = lane & 7;
#pragma unroll
    for (int j = 0; j < 4; ++j) { const int n = (lane >> 3) + 8 * j; const LAS float* s = scr + (8 * c) * 33 + n;
        u32x4 o; o.x = cvtpk(s[0 * 33], s[1 * 33]); o.y = cvtpk(s[2 * 33], s[3 * 33]); o.z = cvtpk(s[4 * 33], s[5 * 33]); o.w = cvtpk(s[6 * 33], s[7 * 33]);
        *(u32x4*)(WT + (size_t)(row_off + n) * ldt + k0 + 8 * c) = o; }
    asm volatile("s_waitcnt lgkmcnt(0)" ::: "memory");
}

__device__ __forceinline__ void rms_row_to_bf16(const float* xrow, const float* g, bf16* orow, int lane) {
    const f32x4* xr = (const f32x4*)xrow + lane; const f32x4* gr = (const f32x4*)g + lane;
    f32x4 v[4]; float s = 0.f;
#pragma unroll
    for (int j = 0; j < 4; ++j) { v[j] = xr[64 * j]; s += (v[j].x * v[j].x + v[j].y * v[j].y) + (v[j].z * v[j].z + v[j].w * v[j].w); }
    const float rs = 1.f / sqrtf(wave_sum(s) * (1.f / DM) + EPS);
    u32x2* o8 = (u32x2*)orow + lane;
#pragma unroll
    for (int j = 0; j < 4; ++j) { const f32x4 gg = gr[64 * j]; u32x2 w; w.x = cvtpk(v[j].x * rs * gg.x, v[j].y * rs * gg.y); w.y = cvtpk(v[j].z * rs * gg.z, v[j].w * rs * gg.w); o8[64 * j] = w; }
}

template <bool COOP>
__global__ void __launch_bounds__(NTHREADS, 2) mk_fwd(Args args) {
    extern __shared__ __attribute__((aligned(16))) unsigned char lds_raw[];
    LAS unsigned char* lds = (LAS unsigned char*)lds_raw;
    const int tid = threadIdx.x, lane = tid & 63, wave = __builtin_amdgcn_readfirstlane(tid >> 6);
    const int G = gridDim.x, bx = blockIdx.x;
    const int vcu = (G % 8 == 0) ? (bx % 8) * (G / 8) + bx / 8 : bx;
    const int gw = vcu * NWAVES + wave, NGW = G * NWAVES;
    unsigned char* ws = args.ws;
    const float* x = args.in[0];
    bf16* Wt0 = (bf16*)(ws + WS_WT0); bf16* Wqup = (bf16*)(ws + WS_WQUP); bf16* Wkvup = (bf16*)(ws + WS_WKVUP); bf16* Wout0 = (bf16*)(ws + WS_WOUT0);
    bf16* Wt1 = (bf16*)(ws + WS_WT1); bf16* Wout1 = (bf16*)(ws + WS_WOUT1);
    bf16* XN = (bf16*)(ws + WS_XN); bf16* OG = (bf16*)(ws + WS_OG); float* LF = (float*)(ws + WS_LF); float* LC = (float*)(ws + WS_LC); float* CS = (float*)(ws + WS_CS); float* TMAXB = (float*)(ws + WS_TMAX);
    bf16* Z0 = (bf16*)(ws + WS_Z0); bf16* Z1 = (bf16*)(ws + WS_Z1); bf16* CQN = (bf16*)(ws + WS_CQN); bf16* CKVN = (bf16*)(ws + WS_CKVN); bf16* KPE = (bf16*)(ws + WS_KPE);
    bf16* Q0 = (bf16*)(ws + WS_Q0); bf16* KN = (bf16*)(ws + WS_KN); bf16* VM = (bf16*)(ws + WS_VM);
    float* out = args.out;
    const int lo = args.ph_lo, hi_ph = args.ph_hi;
#ifndef REPMASK
#define REPMASK 0
#endif
#define NREP(k) (1 + (((REPMASK) >> (k)) & 1))
#ifndef PHMASK
#define PHMASK 0xfff
#endif
#define IN(k) ((((PHMASK) >> (k)) & 1) && lo <= (k) && (k) < hi_ph)
#define SEAM(k) do { if constexpr (COOP) { if (IN(k) && IN((k) + 1)) { if ((k) == 0) { cg::this_grid().sync(); xbar = xcd_barrier_post(barw, (volatile LAS unsigned*)(lds + LDS_MISC)); } else { xcd_barrier(xbar); } } } } while (0)
    unsigned* qctr = (unsigned*)(ws + 256 * 1024);
    unsigned* barw = (unsigned*)ws;
    XcdBarrier xbar; xbar.bar = barw; xbar.x = 0; xbar.st = (volatile LAS unsigned*)(lds + LDS_MISC);
    if constexpr (COOP) {
        if (tid < 16) ((LAS unsigned*)(lds + LDS_MISC))[tid] = 0u;
        if (bx == 0) { for (int i = tid; i < XCD_BAR_WORDS; i += NTHREADS) barw[i] = 0u; for (int i = tid; i < 16 * 64; i += NTHREADS) qctr[i] = 0u; for (int i = tid; i < 2 * 64 * 64; i += NTHREADS) ((unsigned*)(ws + 64 * 1024))[i] = 0u; }
        __syncthreads();
    }

    if (IN(0)) {
        LAS float* scr = (LAS float*)(lds + wave * 16384);
        constexpr int I_A = 16 * 69, I_B = 4 * 24, I_C = 2 * 32, I_D = 16 * 32, I_E1 = 16 * 96, I_E2 = 16 * 32, I_F = 16 * 32;
        constexpr int NIT = I_A + I_B + I_C + I_D + I_E1 + I_E2 + I_F;
        for (int it = gw; it < NIT; it += NGW) {
            int r = it;
            if (r < I_A) { const int kb = r / 69, nb = r % 69; transpose_item(args.in[3], N0, 32 * nb, 64 * kb, Wt0, 1024, 32 * nb, scr, lane); continue; } r -= I_A;
            if (r < I_B) { const int kb = r / 24, nb = r % 24; transpose_item(args.in[5], 768, 32 * nb, 64 * kb, Wqup, 256, 32 * nb, scr, lane); continue; } r -= I_B;
            if (r < I_C) { const int kb = r / 32, nb = r % 32; const int n0 = 32 * nb, h = n0 >> 7, j0 = n0 & 127; const int dst = (j0 < 64) ? (h * 64 + j0) : (512 + h * 64 + (j0 - 64));
                           transpose_item(args.in[7], 1024, n0, 64 * kb, Wkvup, 256, dst, scr, lane); continue; } r -= I_C;
            if (r < I_D) { const int kb = r / 32, nb = r % 32; transpose_item(args.in[9], 1024, 32 * nb, 64 * kb, Wout0, 1024, 32 * nb, scr, lane); continue; } r -= I_D;
            if (r < I_E1) { const int kb = r / 96, nb = r % 96; transpose_item(args.in[11], N1W, 32 * nb, 64 * kb, Wt1, 1024, 32 * nb, scr, lane); continue; } r -= I_E1;
            if (r < I_E2) { const int kb = r / 32, nb = r % 32; transpose_item(args.in[11], N1W, W1_G + 32 * nb, 64 * kb, Wt1, 1024, C1_G + 32 * nb, scr, lane); continue; } r -= I_E2;
            { const int kb = r / 32, nb = r % 32; transpose_item(args.in[13], 1024, 32 * nb, 64 * kb, Wout1, 1024, 32 * nb, scr, lane); }
        }
        { const u32x4 z = {0u, 0u, 0u, 0u};
          u32x4* p0 = (u32x4*)(Wt0 + (size_t)N0 * 1024);
          for (int i = vcu * NTHREADS + tid; i < 96 * 1024 / 8; i += G * NTHREADS) p0[i] = z;
          for (int i = vcu * NTHREADS + tid; i < 1024 * 16; i += G * NTHREADS) { const int row = i >> 4, c = i & 15; *(u32x4*)(Wkvup + (size_t)row * 256 + 128 + c * 8) = z; } }
        for (int m = gw; m < M; m += NGW) rms_row_to_bf16(x + (size_t)m * DM, args.in[2], XN + (size_t)m * DM, lane);
    }
    SEAM(0);
    if (IN(1)) {
        __syncthreads();
        pg8::Gemm g{XN, Wt0, M, N0P, 1024}; pg8::StaticOrder S; S.init(M, N0P, G, bx);
        pg8::EpiBf16<0> E{Z0, N0P, nullptr, 0, 0, 1.f};
        for (int rep = 0; rep < NREP(1); ++rep) {
        pg8::gemm_phase<pg8::EpiBf16<0>, pg8::StaticOrder, true, true>(lds, g, S, E); __syncthreads(); }
    }
    SEAM(1);
    if (IN(2)) {
        const float* gq = args.in[4]; const float* gkv = args.in[6];
        for (int m = gw; m < M; m += NGW) {
            const bf16* z = Z0 + (size_t)m * N0P;
            const u32x2 a = *(const u32x2*)(z + C_CQ + 4 * lane);
            const unsigned bb = *(const unsigned*)(z + C_CKV + 2 * lane);
            const float a0 = bflo(a.x), a1 = bfhi(a.x), a2 = bflo(a.y), a3 = bfhi(a.y), b0 = bflo(bb), b1 = bfhi(bb);
            const float sa = wave_sum((a0 * a0 + a1 * a1) + (a2 * a2 + a3 * a3)), sb = wave_sum(b0 * b0 + b1 * b1);
            const float ra = 1.f / sqrtf(sa * (1.f / 256.f) + EPS), rb = 1.f / sqrtf(sb * (1.f / 128.f) + EPS);
            const f32x4 ga = *(const f32x4*)(gq + 4 * lane); const f32x2 gb = *(const f32x2*)(gkv + 2 * lane);
            u32x2 w; w.x = cvtpk(a0 * ra * ga.x, a1 * ra * ga.y); w.y = cvtpk(a2 * ra * ga.z, a3 * ra * ga.w);
            *(u32x2*)(CQN + (size_t)m * 256 + 4 * lane) = w;
            *(unsigned*)(CKVN + (size_t)m * 256 + 2 * lane) = cvtpk(b0 * rb * gb.x, b1 * rb * gb.y);
            *(unsigned*)(CKVN + (size_t)m * 256 + 128 + 2 * lane) = 0u;
            if (lane < 16) {
                const float invf = (float)exp2(-(double)lane * 0.8304820237218406);
                const double ang = (double)(float)args.pos[m] * (double)invf;
                const double rev = ang * 0.15915494309189535;
                const float rr = (float)(rev - rint(rev));
                const float cv = __builtin_amdgcn_cosf(rr), sv = __builtin_amdgcn_sinf(rr);
                CS[(size_t)m * 32 + lane] = cv; CS[(size_t)m * 32 + 16 + lane] = sv;
                const float x1 = bf1(z[C_KPE + lane]), x2 = bf1(z[C_KPE + 16 + lane]);
                const unsigned o1 = cvtpk(x1 * cv - x2 * sv, 0.f), o2 = cvtpk(x2 * cv + x1 * sv, 0.f);
                KPE[(size_t)m * 32 + lane] = (bf16)(o1 & 0xffffu); KPE[(size_t)m * 32 + 16 + lane] = (bf16)(o2 & 0xffffu);
            }
        }
    }
    SEAM(2);
    if (IN(3)) {
        __syncthreads();
#ifndef NO_QUP
        { int kq_ = 256; asm volatile("" : "+s"(kq_)); pg8::Gemm g{CQN, Wqup, M, 768, kq_}; pg8::StaticOrder S; S.init(M, 768, G, bx);
          pg8::EpiQRope E{Q0, 768, CS};
          pg8::gemm_phase<pg8::EpiQRope, pg8::StaticOrder, true, true>(lds, g, S, E); }
#endif
        __syncthreads();
#ifndef NO_KVUP
        { int kk_ = 256; asm volatile("" : "+s"(kk_)); pg8::Gemm g{CKVN, Wkvup, M, 1024, kk_}; pg8::StaticOrder S; S.init(M, 1024, G, bx);
          pg8::EpiBf16<0> E{KN, 512, nullptr, 512, (size_t)(WS_VM - WS_KN) / 2, 1.f};
          pg8::gemm_phase<pg8::EpiBf16<0>, pg8::StaticOrder, true, true>(lds, g, S, E); }
#endif
    }
    SEAM(3);
    if (IN(4)) {
        __syncthreads();
        for (;;) {
            if (tid == 0) *(volatile LAS int*)(lds + LDS_MISC + 64) = (int)atomicAdd(qctr + 64 * (bx & 7), 1u);
            __syncthreads();
            const int tk = *(volatile LAS int*)(lds + LDS_MISC + 64);
            __syncthreads();
            if (tk >= 128) break;
            const bool swa = tk >= 64;
            AttnP p; p.sinkp = args.in[8]; p.h0 = 0;
            if (!swa) {
                const int bh = 8 * (bx & 7) + (tk >> 3), s = tk & 7, b = bh >> 3, h = bh & 7; const size_t rb = (size_t)b * SEQ;
                p.Q = Q0 + rb * 768 + h * 96; p.ldq = 768; p.K = KN + rb * 512 + h * 64; p.ldk = 512; p.K2 = KPE + rb * 32; p.ldk2 = 32; p.V = VM + rb * 512 + h * 64; p.ldv = 512;
                p.G = Z0 + rb * N0P + C_G0 + h * 64; p.ldg = N0P; p.O = OG + rb * 1024 + h * 64; p.ldo = 1024; p.lc = nullptr; p.tmax = nullptr; p.c = 0.10206207261596575f * LOG2E; p.sink2 = 0.f; p.slope2 = 0.f;
                attn_unit<96, 0>(p, (15 - s) * 256, lds); attn_unit<96, 0>(p, s * 256, lds);
            } else {
                const int j = tk - 64, pkv = 2 * (bx & 7) + (j >> 5), b = pkv >> 1, kvh = pkv & 1, qb = 2 * (j & 31); const size_t rb = (size_t)b * SEQ;
                p.Q = Z0 + rb * N0P + C_QS + kvh * 256; p.ldq = N0P; p.K = Z0 + rb * N0P + C_KS + kvh * 64; p.ldk = N0P; p.K2 = nullptr; p.ldk2 = 0; p.V = Z0 + rb * N0P + C_VS + kvh * 64; p.ldv = N0P;
                p.G = Z0 + rb * N0P + C_G0 + 512 + kvh * 256; p.ldg = N0P; p.O = OG + rb * 1024 + 512 + kvh * 256; p.ldo = 1024; p.lc = nullptr; p.tmax = nullptr; p.c = 0.125f * LOG2E;
                p.sink2 = 0.f; p.slope2 = 0.f; p.h0 = 4 * kvh;
                attn_unit<64, 1>(p, qb * 64, lds); attn_unit<64, 1>(p, (qb + 1) * 64, lds);
            }
        }
    }
    SEAM(4);
    if (IN(5)) {
        __syncthreads();
        pg8::Gemm g{OG, Wout0, M, 1024, 1024}; pg8::StaticOrder S; S.init(M, 1024, G, bx);
        pg8::EpiResF32 E{x, out, 1024};
        pg8::gemm_phase<pg8::EpiResF32, pg8::StaticOrder, true, true>(lds, g, S, E);
    }
    SEAM(5);
    if (IN(6)) {
        __syncthreads();
        const float* g1 = args.in[10]; const float* w1 = args.in[11]; const float* bfp = args.in[12];
        LAS float* WF = (LAS float*)lds;
        for (int k = tid; k < 1024; k += NTHREADS) {
            const int l = (k & 255) >> 2, j = k >> 8, e = k & 3; const int R = l + 64 * (4 * j + e); const float gk = g1[k];
#pragma unroll
            for (int c = 0; c < 4; ++c) { const f32x4 wv = *(const f32x4*)(w1 + (size_t)k * N1W + W1_F + 4 * c); *(LAS f32x4*)(WF + R * 20 + 4 * c) = wv * gk; }
        }
        __syncthreads();
        for (int m = gw; m < M; m += NGW) {
            const f32x4* xr = (const f32x4*)(out + (size_t)m * DM) + lane; const f32x4* gr = (const f32x4*)g1 + lane;
            f32x4 v[4]; float ss = 0.f;
#pragma unroll
            for (int j = 0; j < 4; ++j) { v[j] = xr[64 * j]; ss += (v[j].x * v[j].x + v[j].y * v[j].y) + (v[j].z * v[j].z + v[j].w * v[j].w); }
            const float rs = 1.f / sqrtf(wave_sum(ss) * (1.f / DM) + EPS);
            u32x2* o8 = (u32x2*)(XN + (size_t)m * DM) + lane;
            float fa[16];
#pragma unroll
            for (int n = 0; n < 16; ++n) fa[n] = 0.f;
#pragma unroll
            for (int j = 0; j < 4; ++j) { const f32x4 gg = gr[64 * j]; u32x2 w; w.x = cvtpk(v[j].x * rs * gg.x, v[j].y * rs * gg.y); w.y = cvtpk(v[j].z * rs * gg.z, v[j].w * rs * gg.w); o8[64 * j] = w;
#pragma unroll
                for (int e = 0; e < 4; ++e) { const float xv = v[j][e]; const LAS float* wr_ = WF + (lane + 64 * (4 * j + e)) * 20;
#pragma unroll
                    for (int c = 0; c < 4; ++c) { const f32x4 wv = *(const LAS f32x4*)(wr_ + 4 * c); fa[4 * c + 0] += xv * wv.x; fa[4 * c + 1] += xv * wv.y; fa[4 * c + 2] += xv * wv.z; fa[4 * c + 3] += xv * wv.w; }
                    asm volatile("" ::: "memory"); } }
            float mine = 0.f;
#pragma unroll
            for (int n = 0; n < 16; ++n) { const float t = wave_sum(fa[n]); if (lane == n) mine = t; }
            if (lane < 16) { const float f = mine * rs + bfp[lane]; const float lsg = fminf(f, 0.f) - log1pf(expf(-fabsf(f))); LF[(size_t)m * 16 + lane] = lsg; }
        }
    }
    SEAM(6);
    if (IN(7)) {
        __syncthreads();
        LAS float* sm = (LAS float*)lds;
        for (int bh = bx; bh < 128; bh += G) {
            const int b = bh >> 4, h = bh & 15; float v[8]; float run = 0.f;
#pragma unroll
            for (int e = 0; e < 8; ++e) { run += LF[((size_t)b * SEQ + 8 * tid + e) * 16 + h]; v[e] = run; }
            float sc = run;
#pragma unroll
            for (int o = 1; o < 64; o <<= 1) { const float n = __shfl_up(sc, o); if (lane >= o) sc += n; }
            if (lane == 63) sm[wave] = sc;
            __syncthreads();
            float off = sc - run;
            for (int w = 0; w < wave; ++w) off += sm[w];
            f32x4 o0 = {(v[0] + off) * LOG2E, (v[1] + off) * LOG2E, (v[2] + off) * LOG2E, (v[3] + off) * LOG2E}, o1 = {(v[4] + off) * LOG2E, (v[5] + off) * LOG2E, (v[6] + off) * LOG2E, (v[7] + off) * LOG2E};
            *(f32x4*)(LC + (size_t)bh * SEQ + 8 * tid) = o0; *(f32x4*)(LC + (size_t)bh * SEQ + 8 * tid + 4) = o1;
            __syncthreads();
        }
        pg8::Gemm g{XN, Wt1, M, N1, 1024}; pg8::StaticOrder S; S.init(M, N1, G, bx);
        pg8::EpiBf16<0> E{Z1, N1, nullptr, 0, 0, 1.f};
        for (int rep = 0; rep < NREP(7); ++rep) {
        pg8::gemm_phase<pg8::EpiBf16<0>, pg8::StaticOrder, true, true>(lds, g, S, E); __syncthreads(); }
    }
    SEAM(7);
    if (IN(8)) {
        __syncthreads();
        LAS float* sm = (LAS float*)lds;
        for (int task = vcu; task < 512; task += G) {
            const int b = task >> 6, T = task & 63;
            const bf16* kbase = Z1 + ((size_t)b * SEQ + 64 * T + (tid >> 7)) * N1 + C1_K + (tid & 127) * 8;
            float mxn = 0.f;
#pragma unroll 4
            for (int i = 0; i < 16; ++i) {
                const u32x4 v = *(const u32x4*)(kbase + (size_t)(4 * i) * N1);
                float s = 0.f;
#pragma unroll
                for (int e = 0; e < 4; ++e) { const float a = bflo(v[e]), c = bfhi(v[e]); s += a * a + c * c; }
                s += __shfl_xor(s, 1); s += __shfl_xor(s, 2); s += __shfl_xor(s, 4);
                mxn = fmaxf(mxn, s);
            }
            if ((tid & 7) == 0) sm[(tid >> 7) * 16 + ((tid & 127) >> 3)] = mxn;
            __syncthreads();
            if (tid < 16) { const float m4 = fmaxf(fmaxf(sm[tid], sm[16 + tid]), fmaxf(sm[32 + tid], sm[48 + tid])); TMAXB[((size_t)(b * 16 + tid)) * 64 + T] = sqrtf(m4); }
            __syncthreads();
        }
    }
    SEAM(8);
    if (IN(9)) {
        __syncthreads();
        for (;;) {
            if (tid == 0) *(volatile LAS int*)(lds + LDS_MISC + 64) = (int)atomicAdd(qctr + 64 * (8 + (bx & 7)), 1u);
            __syncthreads();
            const int tk = *(volatile LAS int*)(lds + LDS_MISC + 64);
            __syncthreads();
            if (tk >= 128) break;
            const int bh = 16 * (bx & 7) + (tk >> 3), s = tk & 7, b = bh >> 4, h = bh & 15; const size_t rb = (size_t)b * SEQ;
            AttnP p;
            p.Q = Z1 + rb * N1 + C1_Q + h * 64; p.ldq = N1; p.K = Z1 + rb * N1 + C1_K + h * 64; p.ldk = N1; p.K2 = nullptr; p.ldk2 = 0; p.V = Z1 + rb * N1 + C1_V + h * 64; p.ldv = N1;
            p.G = Z1 + rb * N1 + C1_G + h * 64; p.ldg = N1; p.O = OG + rb * 1024 + h * 64; p.ldo = 1024; p.lc = LC + (size_t)bh * SEQ; p.tmax = TMAXB + (size_t)bh * 64; p.sinkp = args.in[8]; p.h0 = 0; p.c = 0.125f * LOG2E; p.sink2 = 0.f; p.slope2 = 0.f;
            attn_unit<64, 2>(p, (15 - s) * 256, lds); attn_unit<64, 2>(p, s * 256, lds);
        }
    }
    SEAM(9);
    if (IN(10)) {
        __syncthreads();
        for (int sub = 0; sub < 2; ++sub) {
            const size_t r0 = (size_t)sub * 16384;
            pg8::Gemm g{OG + r0 * 1024, Wout1, 16384, 1024, 1024}; pg8::StaticOrder S; S.init(16384, 1024, G, bx);
            pg8::PanelRms st{(float*)(ws + WS_LF) + (size_t)sub * 16384 * 4, (unsigned*)(ws + 64 * 1024) + sub * 64 * 64, EPS};
            pg8::EpiRmsOut E{out + r0 * 1024, out + r0 * 1024, args.in[14], 1024, st};
            pg8::gemm_phase<pg8::EpiRmsOut, pg8::StaticOrder, false, true>(lds, g, S, E);
            __syncthreads();
        }
    }
#undef IN
#undef SEAM
}

constexpr int NPHASES = 11;
extern "C" void kernel_launch(void* const* d_in, const int* in_sizes, int n_in, void* d_out, int out_size, void* d_ws, size_t ws_size, hipStream_t stream) {
    static int grid = 0;
    if (grid == 0) {
        if (n_in != 15 || out_size != M * DM || ws_size < WS_END) { fprintf(stderr, "kernel_launch: unexpected shapes (n_in %d, out %d, ws %zu)\n", n_in, out_size, ws_size); grid = -1; return; }
        int dev = 0, cus = 0, per_cu = 0;
        (void)hipGetDevice(&dev); (void)hipDeviceGetAttribute(&cus, hipDeviceAttributeMultiprocessorCount, dev);
#if MK_COOP
        (void)hipFuncSetAttribute((const void*)mk_fwd<true>, hipFuncAttributeMaxDynamicSharedMemorySize, LDS_BYTES);
        (void)hipOccupancyMaxActiveBlocksPerMultiprocessor(&per_cu, (const void*)mk_fwd<true>, NTHREADS, LDS_BYTES);
#else
        (void)hipFuncSetAttribute((const void*)mk_fwd<false>, hipFuncAttributeMaxDynamicSharedMemorySize, LDS_BYTES);
        (void)hipOccupancyMaxActiveBlocksPerMultiprocessor(&per_cu, (const void*)mk_fwd<false>, NTHREADS, LDS_BYTES);
#endif
        (void)hipGetLastError();
        if (per_cu < 1) per_cu = 1;
        if (cus <= 0) cus = 256;
        grid = cus * 1;
    }
    if (grid < 0) return;
    Args a{};
    for (int i = 0; i < 15; ++i) a.in[i] = (const float*)d_in[i];
    a.pos = (const int*)d_in[1]; a.out = (float*)d_out; a.ws = (unsigned char*)d_ws;
#if MK_COOP
    a.ph_lo = 0; a.ph_hi = NPHASES;
    void* kargs[] = {&a};
    hipError_t e = hipLaunchCooperativeKernel((const void*)mk_fwd<true>, dim3(grid), dim3(NTHREADS), kargs, LDS_BYTES, stream);
    if (e != hipSuccess) fprintf(stderr, "cooperative launch failed: %s (grid %d)\n", hipGetErrorString(e), grid);
#else
    for (int ph = 0; ph < NPHASES; ++ph) { a.ph_lo = ph; a.ph_hi = ph + 1; hipLaunchKernelGGL(mk_fwd<false>, dim3(grid), dim3(NTHREADS), LDS_BYTES, stream, a); }
#endif
}
```

```cpp
#include <hip/hip_runtime.h>
#include <hip/hip_cooperative_groups.h>
#include <cstdio>
#include <cstdint>
#include <cmath>
namespace cg = cooperative_groups;
#ifndef MK_COOP
#define MK_COOP 1
#endif
namespace pg8 {
#define PG8_LAS __attribute__((address_space(3)))
typedef unsigned short bf16_t;
typedef short bf16x8 __attribute__((ext_vector_type(8)));
typedef float f32x4 __attribute__((ext_vector_type(4)));
typedef unsigned u32x4 __attribute__((ext_vector_type(4)));
constexpr int BM = 256, BK = 64, HALF = 128, HTB = HALF * BK * 2  , STAGE_BYTES = 8 * HTB, NXCD = 8, WGM = 8;

__host__ __device__ __forceinline__ int lds_byte(int r, int c) { const int st = (r >> 4) * 2 + (c >> 5), rr = r & 15, cc = c & 31, ob = rr * 64 + cc * 2; return st * 1024 + (ob ^ (((ob >> 9) & 1) << 5)); }
__host__ __device__ __forceinline__ void stage_rc(int b, int& R, int& C) { const int st = b / 1024, sb = b % 1024, swz = sb ^ (((sb >> 9) & 1) << 5); R = (st >> 1) * 16 + swz / 64; C = (st & 1) * 32 + (swz % 64) / 2; }
__host__ __device__ __forceinline__ int perm32(int rho) { const int n = rho >> 4, i = rho & 15; return 8 * (i >> 2) + 4 * n + (i & 3); }

struct Unit { int pm, pn; };
struct Gemm { const bf16_t* A; const bf16_t* Bt; int M, N, K; };

struct StaticOrder {
    int nM, nN, nwg, G, c;
    __host__ __device__ void init(int M, int N, int G_, int c_) { nM = M / BM; nN = N / BM; nwg = nM * nN; G = G_; c = c_; }
    __host__ __device__ bool next(int i, Unit& u) const {
        const long L = (long)i * G + c; if (L >= nwg) return false;
        int wgid = (int)L; { const int q = nwg / NXCD, r = nwg % NXCD, xcd = wgid % NXCD, off = wgid / NXCD; wgid = (xcd < r ? xcd * (q + 1) : r * (q + 1) + (xcd - r) * q) + off; }
        const int nig = WGM * nN, gid = wgid / nig, fm = gid * WGM, gsz = (nM - fm) < WGM ? (nM - fm) : WGM;
        u.pm = fm + ((wgid % nig) % gsz); u.pn = (wgid % nig) / gsz; return true;
    }
    __device__ __forceinline__ void a_ready(const Unit&) const {}
    __device__ __forceinline__ void done(const Unit&) const {}
};

__device__ __forceinline__ unsigned cvt_pk_bf16(float lo, float hi) { unsigned r; asm volatile("v_cvt_pk_bf16_f32 %0, %1, %2" : "=v"(r) : "v"(lo), "v"(hi)); return r; }
typedef float f32x2 __attribute__((ext_vector_type(2)));
__device__ __forceinline__ f32x2 gelu_pk(f32x2 v) {
    const f32x2 av = __builtin_elementwise_abs(v), d = av * 0.2316418882f + 1.0f;
    f32x2 t; t.x = __builtin_amdgcn_rcpf(d.x); t.y = __builtin_amdgcn_rcpf(d.y);
    f32x2 q = t * 0.5307027145f + (-0.7265760135f); q = q * t + 0.7107068705f; q = q * t + (-0.142248368f); q = q * t + 0.127414796f; q = q * t;
    const f32x2 s = (v * v) * (-0.72134752044f);
    f32x2 e; e.x = __builtin_amdgcn_exp2f(s.x); e.y = __builtin_amdgcn_exp2f(s.y);
    const f32x2 m = v * (q * e), r = v - m;
    f32x2 o; o.x = v.x < 0.f ? m.x : r.x; o.y = v.y < 0.f ? m.y : r.y; return o;
}

template <int ACT  > struct EpiBf16 {
    static constexpr bool PERM = true, AFTER_DRAIN = false; static_assert(ACT == 0 || ACT == 1, "EpiBf16: ACT is 0 (none) or 1 (gelu_pk)");
    bf16_t* O; int ldc; const float* bias; int split_cols; size_t split_stride; float scale0;
    __device__ __forceinline__ void operator()(const f32x4 (&acc)[2][2][4][2], const Unit& u, int wr, int wc, int fr, int fq) const {
        const int row0 = u.pm * BM + wr * 64 + fr; int colt = u.pn * BM; bf16_t* base = O;
        float sc = 1.f; if (split_cols) { const int t = colt / split_cols; base += (size_t)t * split_stride; colt -= t * split_cols; if (t == 0) sc = scale0; }
        const int col0 = colt + wc * 32 + 8 * fq, bcol0 = u.pn * BM + wc * 32 + 8 * fq;
        f32x4 bv[2][2];
#pragma unroll
        for (int bj = 0; bj < 2; ++bj)
#pragma unroll
            for (int n = 0; n < 2; ++n) bv[bj][n] = bias ? *(const f32x4*)(bias + bcol0 + bj * HALF + 4 * n) : (f32x4){0.f, 0.f, 0.f, 0.f};
#pragma unroll
        for (int ai = 0; ai < 2; ++ai)
#pragma unroll
            for (int m = 0; m < 4; ++m) { bf16_t* rowp = base + (size_t)(row0 + ai * HALF + m * 16) * ldc + col0;
#pragma unroll
                for (int bj = 0; bj < 2; ++bj) { f32x4 v0 = acc[ai][bj][m][0] + bv[bj][0], v1 = acc[ai][bj][m][1] + bv[bj][1];
                    if (ACT == 1) { f32x2 a = gelu_pk((f32x2){v0[0], v0[1]}), b = gelu_pk((f32x2){v0[2], v0[3]}), c = gelu_pk((f32x2){v1[0], v1[1]}), d = gelu_pk((f32x2){v1[2], v1[3]});
                        v0 = (f32x4){a.x, a.y, b.x, b.y}; v1 = (f32x4){c.x, c.y, d.x, d.y}; }
                    v0 = v0 * sc; v1 = v1 * sc; u32x4 w; w.x = cvt_pk_bf16(v0[0], v0[1]); w.y = cvt_pk_bf16(v0[2], v0[3]); w.z = cvt_pk_bf16(v1[0], v1[1]); w.w = cvt_pk_bf16(v1[2], v1[3]);
                    *(u32x4*)(rowp + bj * HALF) = w; } }
    }
};
typedef unsigned u32x2 __attribute__((ext_vector_type(2)));
struct EpiQRope {
    static constexpr bool PERM = false, AFTER_DRAIN = false;
    bf16_t* O; int ldc; const float* cs;
    __device__ __forceinline__ void operator()(const f32x4 (&acc)[2][2][4][2], const Unit& u, int wr, int wc, int fr, int fq) const {
        const int row0 = u.pm * BM + wr * 64 + fr;
#pragma unroll
        for (int ai = 0; ai < 2; ++ai)
#pragma unroll
            for (int m = 0; m < 4; ++m) {
                const int row = row0 + ai * HALF + m * 16;
                const f32x4 cv = *(const f32x4*)(cs + (size_t)row * 32 + 4 * fq), sv = *(const f32x4*)(cs + (size_t)row * 32 + 16 + 4 * fq);
#pragma unroll
                for (int bj = 0; bj < 2; ++bj) {
                    const int colb = u.pn * BM + bj * HALF + wc * 32;
                    f32x4 v0 = acc[ai][bj][m][0], v1 = acc[ai][bj][m][1];
                    if (((colb >> 5) % 3) == 2) { const f32x4 a = v0 * cv - v1 * sv, b = v1 * cv + v0 * sv; v0 = a; v1 = b; }
                    bf16_t* rp = O + (size_t)row * ldc + colb + 4 * fq;
                    u32x2 w0, w1; w0.x = cvt_pk_bf16(v0[0], v0[1]); w0.y = cvt_pk_bf16(v0[2], v0[3]); w1.x = cvt_pk_bf16(v1[0], v1[1]); w1.y = cvt_pk_bf16(v1[2], v1[3]);
                    *(u32x2*)(rp) = w0; *(u32x2*)(rp + 16) = w1;
                }
                asm volatile("" ::: "memory");
            }
    }
};
struct EpiResF32 {
    static constexpr bool PERM = false, AFTER_DRAIN = false;
    const float* base; float* out; int ldc;
    __device__ __forceinline__ void operator()(const f32x4 (&acc)[2][2][4][2], const Unit& u, int wr, int wc, int fr, int fq) const {
        const int row0 = u.pm * BM + wr * 64 + fr, col0 = u.pn * BM + wc * 32 + 4 * fq;
#pragma unroll
        for (int ai = 0; ai < 2; ++ai)
#pragma unroll
            for (int m = 0; m < 4; ++m) {
                const size_t off = (size_t)(row0 + ai * HALF + m * 16) * ldc + col0;
#pragma unroll
                for (int bj = 0; bj < 2; ++bj)
#pragma unroll
                    for (int n = 0; n < 2; ++n) { const f32x4 b = *(const f32x4*)(base + off + bj * HALF + n * 16); *(f32x4*)(out + off + bj * HALF + n * 16) = b + acc[ai][bj][m][n]; }
                asm volatile("" ::: "memory");
            }
    }
};
struct PanelRms {
    float* xbuf;
    unsigned* cnt;
    float eps;
    __device__ __forceinline__ void run(const f32x4 (&v)[2][2][4][2], const Unit& u, int wr, int wc, int fr, int fq, PG8_LAS unsigned char* lds, int wid, int lane) const {
        PG8_LAS float* P = (PG8_LAS float*)lds;
        PG8_LAS float* S = (PG8_LAS float*)(lds + 4096);
#pragma unroll
        for (int ai = 0; ai < 2; ++ai)
#pragma unroll
            for (int m = 0; m < 4; ++m) {
                float s = 0.f;
#pragma unroll
                for (int bj = 0; bj < 2; ++bj)
#pragma unroll
                    for (int n = 0; n < 2; ++n) { const f32x4 x = v[ai][bj][m][n]; s += (x[0] * x[0] + x[1] * x[1]) + (x[2] * x[2] + x[3] * x[3]); }
                s += __shfl_xor(s, 16); s += __shfl_xor(s, 32);
                if (fq == 0) P[(ai * HALF + wr * 64 + m * 16 + fr) * 4 + wc] = s;
            }
        asm volatile("s_waitcnt lgkmcnt(0)" ::: "memory"); __builtin_amdgcn_s_barrier(); asm volatile("" ::: "memory");
        const int row = wid * 32 + (lane & 31);
        if (lane < 32) {
            const float t = (P[row * 4 + 0] + P[row * 4 + 1]) + (P[row * 4 + 2] + P[row * 4 + 3]);
            __hip_atomic_store(xbuf + ((size_t)(u.pm * BM + row) * 4 + u.pn), t, __ATOMIC_RELAXED, __HIP_MEMORY_SCOPE_AGENT);
        }
        asm volatile("s_waitcnt vmcnt(0)" ::: "memory");
        if (lane == 0) __hip_atomic_fetch_add(cnt + 64 * u.pm, 1u, __ATOMIC_RELAXED, __HIP_MEMORY_SCOPE_AGENT);
        if (wid == 0) {
            unsigned spins = 0;
            while ((unsigned)__builtin_amdgcn_readfirstlane(__hip_atomic_load(cnt + 64 * u.pm, __ATOMIC_RELAXED, __HIP_MEMORY_SCOPE_AGENT)) < 32u) { __builtin_amdgcn_s_sleep(2); if (++spins > (1u << 20)) break; }
            __builtin_amdgcn_fence(__ATOMIC_ACQUIRE, "agent");
        }
        asm volatile("s_waitcnt vmcnt(0) lgkmcnt(0)" ::: "memory"); __builtin_amdgcn_s_barrier(); asm volatile("" ::: "memory");
        if (lane < 32) {
            const float* slot = xbuf + (size_t)(u.pm * BM + row) * 4; float q = 0.f;
#pragma unroll
            for (int t = 0; t < 4; ++t) q += __hip_atomic_load(slot + t, __ATOMIC_RELAXED, __HIP_MEMORY_SCOPE_AGENT);
            S[row] = 1.0f / sqrtf(q * (1.0f / 1024.0f) + eps);
        }
        asm volatile("s_waitcnt lgkmcnt(0)" ::: "memory"); __builtin_amdgcn_s_barrier(); asm volatile("" ::: "memory");
    }
};
struct EpiRmsOut {
    static constexpr bool PERM = false, AFTER_DRAIN = true;
    const float* base; float* out; const float* g; int ldc; PanelRms st;
    __device__ __forceinline__ void fused(f32x4 (&acc)[2][2][4][2], const Unit& u, int wr, int wc, int fr, int fq, PG8_LAS unsigned char* lds, int wid, int lane) const {
        const PG8_LAS float* S = (const PG8_LAS float*)(lds + 4096);
        const int col0 = u.pn * BM + wc * 32 + 4 * fq;
#pragma unroll
        for (int ai = 0; ai < 2; ++ai)
#pragma unroll
            for (int m = 0; m < 4; ++m) { const size_t off = (size_t)(u.pm * BM + ai * HALF + wr * 64 + m * 16 + fr) * ldc + col0;
#pragma unroll
                for (int bj = 0; bj < 2; ++bj)
#pragma unroll
                    for (int n = 0; n < 2; ++n) acc[ai][bj][m][n] += *(const f32x4*)(base + off + bj * HALF + n * 16);
                asm volatile("" : "+v"(acc[ai][0][m][0]), "+v"(acc[ai][0][m][1]), "+v"(acc[ai][1][m][0]), "+v"(acc[ai][1][m][1]));
                if (m & 1) asm volatile("" ::: "memory"); }
        st.run(acc, u, wr, wc, fr, fq, lds, wid, lane);
#pragma unroll
        for (int bj = 0; bj < 2; ++bj)
#pragma unroll
            for (int n = 0; n < 2; ++n) { const f32x4 gv = *(const f32x4*)(g + col0 + bj * HALF + n * 16);
#pragma unroll
                for (int ai = 0; ai < 2; ++ai)
#pragma unroll
                    for (int m = 0; m < 4; ++m) { const int r = ai * HALF + wr * 64 + m * 16 + fr; const float rs = S[r];
                        *(f32x4*)(out + (size_t)(u.pm * BM + r) * ldc + col0 + bj * HALF + n * 16) = acc[ai][bj][m][n] * rs * gv; } }
    }
};
template <class Epi, class Sched, bool ALIGN_EPI = false, bool SP2 = false>
__device__ __forceinline__ void gemm_phase(PG8_LAS unsigned char* lds, const Gemm g, const Sched& S, const Epi& E) {
    const int tid = threadIdx.x, wid = __builtin_amdgcn_readfirstlane(tid >> 6), lane = tid & 63, wr = wid >> 2, wc = wid & 3, fr = lane & 15, fq = lane >> 4;
    const int K = g.K, nt = K / BK;
    unsigned voffA[2], voffB[2];
#pragma unroll
    for (int i = 0; i < 2; ++i) { int R, C; stage_rc(tid * 16 + i * 8192, R, C); const int Rb = Epi::PERM ? ((R & ~31) + perm32(R & 31)) : R;
        voffA[i] = (unsigned)(R * K + C) * 2u; voffB[i] = (unsigned)(Rb * K + C) * 2u; }
    const size_t kstep = (size_t)(BK * 2);
    const size_t hstep = (size_t)HALF * K * 2;
    const size_t tstep = 2 * hstep;
    const unsigned ldsw = (unsigned)wid * 1024u;
    const int aoff = lds_byte(wr * 64 + fr, fq * 8), boff = lds_byte(wc * 32 + fr, fq * 8);
#define PG8_SA(b, h) (((b) * 2 + (h)) * HTB)
#define PG8_SB(b, h) ((4 + (b) * 2 + (h)) * HTB)
#define PG8_STAGE(bufoff, gbase, voff) do { _Pragma("unroll") for (int _i = 0; _i < 2; ++_i) \
        __builtin_amdgcn_global_load_lds((const unsigned*)((const char*)(gbase) + (voff)[_i]), (PG8_LAS unsigned*)(lds + (bufoff) + ldsw + _i * 8192), 16, 0, 0); } while (0)
#define PG8_LDA(dst, b, h) do { _Pragma("unroll") for (int m = 0; m < 4; ++m) _Pragma("unroll") for (int k = 0; k < 2; ++k) dst[m][k] = *(const PG8_LAS bf16x8*)(lds + PG8_SA(b, h) + aoff + m * 2048 + k * 1024); } while (0)
#define PG8_LDB(dst, b, h) do { _Pragma("unroll") for (int n = 0; n < 2; ++n) _Pragma("unroll") for (int k = 0; k < 2; ++k) dst[n][k] = *(const PG8_LAS bf16x8*)(lds + PG8_SB(b, h) + boff + n * 2048 + k * 1024); } while (0)
#define PG8_MMA(ai, bj, At, Bt) do { __builtin_amdgcn_s_setprio(1); _Pragma("unroll") for (int m = 0; m < 4; ++m) _Pragma("unroll") for (int n = 0; n < 2; ++n) _Pragma("unroll") for (int k = 0; k < 2; ++k) \
        acc[ai][bj][m][n] = __builtin_amdgcn_mfma_f32_16x16x32_bf16(Bt[n][k], At[m][k], acc[ai][bj][m][n], 0, 0, 0); __builtin_amdgcn_s_setprio(0); } while (0)
#define PG8_WAIT_V(n) asm volatile("s_waitcnt vmcnt(" #n ")" ::: "memory")
#define PG8_WAIT_L(n) asm volatile("s_waitcnt lgkmcnt(" #n ")" ::: "memory")
#define PG8_BAR __builtin_amdgcn_s_barrier()
#define PG8_SCHED __builtin_amdgcn_sched_barrier(0)
    Unit cur, nxt; int ui = 0;
    if (!S.next(0, cur)) return;
    f32x4 acc[2][2][4][2];
#pragma unroll
    for (int a = 0; a < 2; ++a)
#pragma unroll
        for (int b = 0; b < 2; ++b)
#pragma unroll
            for (int m = 0; m < 4; ++m)
#pragma unroll
                for (int n = 0; n < 2; ++n) acc[a][b][m][n] = (f32x4){0.f, 0.f, 0.f, 0.f};
    bf16x8 At[4][2], B0[2][2], B1[2][2];
    const char* cA = (const char*)g.A + (size_t)cur.pm * tstep; const char* cB = (const char*)g.Bt + (size_t)cur.pn * tstep;
    S.a_ready(cur);
    if constexpr (SP2) {
        PG8_STAGE(PG8_SB(0, 0), cB, voffB); PG8_STAGE(PG8_SB(0, 1), cB + hstep, voffB); PG8_STAGE(PG8_SA(0, 0), cA, voffA); PG8_STAGE(PG8_SA(0, 1), cA + hstep, voffA);
        if (wr == 1) PG8_BAR;
        PG8_WAIT_V(2); PG8_BAR;
        PG8_STAGE(PG8_SB(1, 0), cB + kstep, voffB); PG8_STAGE(PG8_SA(1, 0), cA + kstep, voffA); PG8_STAGE(PG8_SB(1, 1), cB + hstep + kstep, voffB);
        PG8_WAIT_V(6); PG8_BAR;
    } else {
        PG8_STAGE(PG8_SB(0, 0), cB, voffB); PG8_STAGE(PG8_SA(0, 0), cA, voffA); PG8_STAGE(PG8_SB(0, 1), cB + hstep, voffB); PG8_STAGE(PG8_SA(0, 1), cA + hstep, voffA);
        if (wr == 1) PG8_BAR;
        PG8_WAIT_V(4); PG8_BAR;
        PG8_STAGE(PG8_SB(1, 0), cB + kstep, voffB); PG8_STAGE(PG8_SA(1, 0), cA + kstep, voffA); PG8_STAGE(PG8_SB(1, 1), cB + hstep + kstep, voffB);
        PG8_WAIT_V(6); PG8_BAR;
    }
    for (;;) {
        const bool has_next = S.next(ui + 1, nxt);
        const char* nA = has_next ? (const char*)g.A + (size_t)nxt.pm * tstep : cA; const char* nB = has_next ? (const char*)g.Bt + (size_t)nxt.pn * tstep : cB;
        for (int t = 0; t < nt; t += 2) {
            const bool last = (t == nt - 2);
            const char* a1 = cA + (size_t)(t + 1) * kstep;
            const char* a2 = last ? nA : cA + (size_t)(t + 2) * kstep; const char* b2 = last ? nB : cB + (size_t)(t + 2) * kstep;
            const char* a3 = a2 + kstep; const char* b3 = b2 + kstep;
            if (last && has_next) S.a_ready(nxt);
            if constexpr (SP2) {
            PG8_LDB(B0, 0, 0); PG8_LDB(B1, 0, 1); PG8_SCHED; PG8_LDA(At, 0, 0); PG8_STAGE(PG8_SA(1, 1), a1 + hstep, voffA);
            PG8_WAIT_V(8); PG8_WAIT_L(0); PG8_BAR; PG8_MMA(0, 0, At, B0); PG8_MMA(0, 1, At, B1); PG8_BAR; PG8_SCHED;
            PG8_LDA(At, 0, 1); PG8_STAGE(PG8_SB(0, 0), b2, voffB); PG8_STAGE(PG8_SB(0, 1), b2 + hstep, voffB); PG8_STAGE(PG8_SA(0, 0), a2, voffA);
            PG8_WAIT_V(8); PG8_WAIT_L(0); PG8_BAR; PG8_MMA(1, 0, At, B0); PG8_MMA(1, 1, At, B1); PG8_BAR; PG8_SCHED;
            PG8_LDB(B0, 1, 0); PG8_LDB(B1, 1, 1); PG8_SCHED; PG8_LDA(At, 1, 0); PG8_STAGE(PG8_SA(0, 1), a2 + hstep, voffA);
            PG8_WAIT_V(8); PG8_WAIT_L(0); PG8_BAR; PG8_MMA(0, 0, At, B0); PG8_MMA(0, 1, At, B1); PG8_BAR; PG8_SCHED;
            PG8_LDA(At, 1, 1); PG8_STAGE(PG8_SB(1, 0), b3, voffB); PG8_STAGE(PG8_SB(1, 1), b3 + hstep, voffB); PG8_STAGE(PG8_SA(1, 0), a3, voffA);
            PG8_WAIT_V(8); PG8_WAIT_L(0); PG8_BAR; PG8_MMA(1, 0, At, B0); PG8_MMA(1, 1, At, B1); PG8_BAR; PG8_SCHED;
            } else {
            PG8_LDB(B0, 0, 0); PG8_SCHED; PG8_LDA(At, 0, 0); PG8_STAGE(PG8_SA(1, 1), a1 + hstep, voffA);
            PG8_WAIT_L(8); PG8_BAR; PG8_WAIT_L(0); PG8_MMA(0, 0, At, B0); PG8_BAR; PG8_SCHED;
            PG8_LDB(B1, 0, 1); PG8_STAGE(PG8_SB(0, 0), b2, voffB);
            PG8_BAR; PG8_WAIT_L(0); PG8_MMA(0, 1, At, B1); PG8_BAR;
            PG8_LDA(At, 0, 1); PG8_STAGE(PG8_SA(0, 0), a2, voffA);
            PG8_BAR; PG8_WAIT_L(0); PG8_MMA(1, 0, At, B0); PG8_BAR; PG8_SCHED;
            PG8_STAGE(PG8_SB(0, 1), b2 + hstep, voffB);
            PG8_WAIT_V(6); PG8_BAR; PG8_MMA(1, 1, At, B1); PG8_BAR;
            PG8_LDB(B0, 1, 0); PG8_SCHED; PG8_LDA(At, 1, 0); PG8_STAGE(PG8_SA(0, 1), a2 + hstep, voffA);
            PG8_WAIT_L(8); PG8_BAR; PG8_WAIT_L(0); PG8_MMA(0, 0, At, B0); PG8_BAR; PG8_SCHED;
            PG8_LDB(B1, 1, 1); PG8_STAGE(PG8_SB(1, 0), b3, voffB);
            PG8_BAR; PG8_WAIT_L(0); PG8_MMA(0, 1, At, B1); PG8_BAR;
            PG8_LDA(At, 1, 1); PG8_STAGE(PG8_SA(1, 0), a3, voffA);
            PG8_BAR; PG8_WAIT_L(0); PG8_MMA(1, 0, At, B0); PG8_BAR; PG8_SCHED;
            PG8_STAGE(PG8_SB(1, 1), b3 + hstep, voffB);
            PG8_WAIT_V(6); PG8_BAR; PG8_MMA(1, 1, At, B1); PG8_BAR;
            }
        }
        if constexpr (ALIGN_EPI) { if (wr == 0) PG8_BAR; }
        if constexpr (!Epi::AFTER_DRAIN) { E(acc, cur, wr, wc, fr, fq); S.done(cur); }
        if (!has_next) break;
#pragma unroll
        for (int a = 0; a < 2; ++a)
#pragma unroll
            for (int b = 0; b < 2; ++b)
#pragma unroll
                for (int m = 0; m < 4; ++m)
#pragma unroll
                    for (int n = 0; n < 2; ++n) acc[a][b][m][n] = (f32x4){0.f, 0.f, 0.f, 0.f};
        cur = nxt; cA = nA; cB = nB; ++ui;
        if constexpr (ALIGN_EPI) { if (wr == 1) PG8_BAR; }
    }
    PG8_WAIT_V(0);
    if constexpr (!ALIGN_EPI) { if (wr == 0) PG8_BAR; }
    PG8_BAR;
    if constexpr (Epi::AFTER_DRAIN) { E.fused(acc, cur, wr, wc, fr, fq, lds, wid, lane); S.done(cur); }
#undef PG8_SA
#undef PG8_SB
#undef PG8_STAGE
#undef PG8_LDA
#undef PG8_LDB
#undef PG8_MMA
#undef PG8_WAIT_V
#undef PG8_WAIT_L
#undef PG8_BAR
#undef PG8_SCHED
}
}
#define LAS __attribute__((address_space(3)))
typedef unsigned short bf16;
typedef short bf16x8 __attribute__((ext_vector_type(8)));
typedef float f32x16 __attribute__((ext_vector_type(16)));
typedef float f32x4 __attribute__((ext_vector_type(4)));
typedef float f32x2 __attribute__((ext_vector_type(2)));
typedef unsigned u32x4 __attribute__((ext_vector_type(4)));
typedef unsigned u32x2 __attribute__((ext_vector_type(2)));
typedef __bf16 bf16x2_t __attribute__((ext_vector_type(2)));

constexpr int BATCH = 8, SEQ = 4096, DM = 1024, M = BATCH * SEQ;
constexpr int N0 = 2208, N0P = 2304;
constexpr int C_CQ = 0, C_CKV = 256, C_KPE = 384, C_QS = 416, C_KS = 928, C_VS = 1056, C_G0 = 1184;
constexpr int N1W = 4112, N1 = 4096;
constexpr int C1_Q = 0, C1_K = 1024, C1_V = 2048, C1_G = 3072, W1_F = 3072, W1_G = 3088;
constexpr float EPS = 1e-6f, LOG2E = 1.4426950408889634f;
constexpr int NTHREADS = 512, NWAVES = 8;

constexpr size_t MiB = 1u << 20;
constexpr size_t WS_WT0 = 1 * MiB;
constexpr size_t WS_WQUP = 6 * MiB;
constexpr size_t WS_WKVUP = 7 * MiB;
constexpr size_t WS_WOUT0 = 8 * MiB;
constexpr size_t WS_WT1 = 10 * MiB;
constexpr size_t WS_WOUT1 = 18 * MiB;
constexpr size_t WS_XN = 32 * MiB;
constexpr size_t WS_OG = 96 * MiB;
constexpr size_t WS_LF = 160 * MiB;
constexpr size_t WS_LC = 162 * MiB;
constexpr size_t WS_TMAX = 512 * 1024;
constexpr size_t WS_CS = 164 * MiB;
constexpr size_t WS_Z1 = 168 * MiB;
constexpr size_t WS_Z0 = 168 * MiB;
constexpr size_t WS_CQN = 312 * MiB;
constexpr size_t WS_CKVN = 328 * MiB;
constexpr size_t WS_KPE = 344 * MiB;
constexpr size_t WS_Q0 = 346 * MiB;
constexpr size_t WS_KN = 394 * MiB;
constexpr size_t WS_VM = 426 * MiB;
constexpr size_t WS_END = 458 * MiB;
constexpr int LDS_BYTES = 135168, LDS_MISC = 131072 + 1024;

__device__ __forceinline__ unsigned cvtpk(float lo, float hi) { f32x2 v = {lo, hi}; bf16x2_t b = __builtin_convertvector(v, bf16x2_t); return __builtin_bit_cast(unsigned, b); }
__device__ __forceinline__ float bflo(unsigned u) { return __uint_as_float(u << 16); }
__device__ __forceinline__ float bfhi(unsigned u) { return __uint_as_float(u & 0xffff0000u); }
__device__ __forceinline__ float bf1(bf16 v) { return __uint_as_float(((unsigned)v) << 16); }
__device__ __forceinline__ float wave_sum(float v) {
#pragma unroll
    for (int o = 1; o < 64; o <<= 1) v += __shfl_xor(v, o);
    return v;
}

struct AttnP { const bf16 *Q, *K, *K2, *V, *G; bf16* O; const float* lc; const float* tmax; const float* sinkp; int h0; int ldq, ldk, ldk2, ldv, ldg, ldo; float c, sink2, slope2; };

typedef short v4i16_t __attribute__((ext_vector_type(4)));
__device__ __forceinline__ void glds16(const void* gsrc, unsigned lds_dst) { unsigned keep;
    asm volatile("s_mov_b32 %0, m0\n\ts_mov_b32 m0, %2\n\ts_nop 0\n\tglobal_load_lds_dwordx4 %1, off\n\ts_mov_b32 m0, %0" : "=&s"(keep) : "v"(gsrc), "s"(lds_dst) : "memory"); }
__device__ __forceinline__ void glds4(const void* gsrc, unsigned lds_dst) { unsigned keep;
    asm volatile("s_mov_b32 %0, m0\n\ts_mov_b32 m0, %2\n\ts_nop 0\n\tglobal_load_lds_dword %1, off\n\ts_mov_b32 m0, %0" : "=&s"(keep) : "v"(gsrc), "s"(lds_dst) : "memory"); }
#define AT_WAITV(n) asm volatile("s_waitcnt vmcnt(%0) lgkmcnt(0)" :: "n"(n) : "memory")
template <int DK, int MODE>
__device__ __forceinline__ void attn_unit(const AttnP& p, const int q0, LAS unsigned char* lds) {
    constexpr int NS = 4, KN_B = 8192, KP_B = (DK == 96) ? 4096 : 0, VHALF = 4160, V_B = 2 * VHALF, LC_B = (MODE == 2) ? 256 : 0;
    constexpr int OFF_KP = KN_B, OFF_V = KN_B + KP_B, OFF_LC = OFF_V + V_B, SLOT = OFF_LC + LC_B, OFF_FLAG = NS * SLOT;
    constexpr int NPT = 2 + ((DK == 96 || MODE == 2) ? 1 : 0);
    const int tid = threadIdx.x, lane = tid & 63, wid = __builtin_amdgcn_readfirstlane(tid >> 6), r32 = lane & 31, hi = lane >> 5;
    const int hsel = (MODE == 1) ? (wid >> 1) : 0;
    const int qw0 = q0 + 32 * ((MODE == 1) ? (wid & 1) : wid), q = qw0 + r32;
    const bf16* Qp = p.Q + hsel * 64; const bf16* Gp = p.G + hsel * 64; bf16* Op = p.O + hsel * 64;
    float sink2 = 0.f, slope2 = 0.f;
    if (MODE == 1) { const int hh = p.h0 + hsel; sink2 = p.sinkp[hh] * LOG2E; slope2 = exp2f(-(float)(hh + 1)) * LOG2E; }
    const unsigned lds0 = (unsigned)(uintptr_t)lds;
    bf16x8 qf[DK / 16];
#pragma unroll
    for (int d0 = 0; d0 < DK / 16; ++d0) qf[d0] = *(const bf16x8*)(Qp + (size_t)q * p.ldq + 16 * d0 + 8 * hi);
#pragma unroll
    for (int d0 = 0; d0 < DK / 16; ++d0) asm volatile("" : "+v"(qf[d0]));
    const int t_hi = (MODE == 1) ? (q0 >> 6) : (((q0 + 256) >> 6) - 1);
    const int t_lo = (MODE == 1) ? (((q0 >> 6) >= 2) ? (q0 >> 6) - 2 : 0) : 0;
    const int ntile = t_hi - t_lo + 1;
    const int krow = 8 * wid + (lane >> 3), kch = (lane & 7) ^ ((krow >> 1) & 7);
    const bf16* ksrc = p.K + (size_t)krow * p.ldk + kch * 8;
    const int prow = 8 * wid + ((lane & 31) >> 2), pch = (lane & 3) ^ ((prow >> 2) & 3);
    const bf16* psrc = (DK == 96) ? (p.K2 + (size_t)prow * p.ldk2 + pch * 8) : p.K;
    const int vrow = 16 * (wid & 3) + (lane >> 2);
    const bf16* vsrc = p.V + (size_t)vrow * p.ldv + ((wid >> 2) * 4 + (lane & 3)) * 8;
    const float* lsrc = (MODE == 2) ? (p.lc + 8 * wid + (lane & 7)) : (const float*)p.K;
#define AT_DMA(t, slot) do { const size_t ro_ = (size_t)(t) * 64; const unsigned sb_ = lds0 + (unsigned)((slot) * SLOT); \
        glds16(ksrc + ro_ * p.ldk, (unsigned)__builtin_amdgcn_readfirstlane(sb_ + wid * 1024)); \
        glds16(vsrc + ro_ * p.ldv, (unsigned)__builtin_amdgcn_readfirstlane(sb_ + OFF_V + (wid >> 2) * VHALF + (wid & 3) * 1024)); \
        if (DK == 96) { if (lane < 32) glds16(psrc + ro_ * p.ldk2, (unsigned)__builtin_amdgcn_readfirstlane(sb_ + OFF_KP + wid * 512)); } \
        if (MODE == 2) { if (lane < 8) glds4(lsrc + ro_, (unsigned)__builtin_amdgcn_readfirstlane(sb_ + OFF_LC + wid * 32)); } } while (0)

    float m_run = (MODE == 1) ? sink2 : -INFINITY;
    float l_run = (MODE == 1 && hi == 0) ? 1.f : 0.f;
    f32x16 ot[2];
#pragma unroll
    for (int r = 0; r < 16; ++r) { ot[0][r] = 0.f; ot[1][r] = 0.f; }
    const int pim = 16 * (r32 >> 4) + 8 * ((r32 >> 2) & 1) + 4 * ((r32 >> 3) & 1) + (r32 & 3);
    const int vrd = (8 * hi + ((lane & 15) >> 2)) * 64 + ((lane >> 4) & 1) * 32 + (lane & 3) * 8;
    int koff[4], poff[2];
#pragma unroll
    for (int d0 = 0; d0 < 4; ++d0) koff[d0] = pim * 128 + (((2 * d0 + hi) ^ ((pim >> 1) & 7)) * 16);
#pragma unroll
    for (int j = 0; j < 2; ++j) poff[j] = OFF_KP + pim * 64 + (((2 * j + hi) ^ ((pim >> 2) & 3)) * 16);
    float pmv = 0.f, lcev = 0.f, qn = 0.f;
    if (MODE == 2) {
        pmv = (lane <= t_hi) ? p.tmax[lane] : 0.f;
#pragma unroll
        for (int o = 1; o < 64; o <<= 1) { const float n = __shfl_up(pmv, o); if (lane >= o) pmv = fmaxf(pmv, n); }
        lcev = (lane <= t_hi) ? p.lc[64 * lane + 63] : 0.f;
        float qs = 0.f;
#pragma unroll
        for (int d0 = 0; d0 < DK / 16; ++d0)
#pragma unroll
            for (int e = 0; e < 8; ++e) { const float f = bf1((bf16)qf[d0][e]); qs += f * f; }
        qs += __shfl_xor(qs, 32);
        qn = sqrtf(qs) * p.c * 1.002f;
    }
    AT_DMA(t_hi, 0);
    if (ntile > 1) AT_DMA(t_hi - 1, 1);
    if (ntile > 2) AT_DMA(t_hi - 2, 2);
    for (int i = 0; i < ntile; ++i) {
        const int t = t_hi - i, kv0 = t * 64, rem = ntile - 1 - i;
        if (rem >= 2) AT_WAITV(2 * NPT); else if (rem == 1) AT_WAITV(NPT); else AT_WAITV(0);
        __builtin_amdgcn_s_barrier();
        asm volatile("" ::: "memory");
        if (MODE == 2) { if (i > 0) {
            const LAS unsigned char* fp = lds + OFF_FLAG + ((i - 1) & 1) * 32;
            const u32x4 f0 = *(const LAS u32x4*)(fp), f1 = *(const LAS u32x4*)(fp + 16);
            if ((f0.x & f0.y & f0.z & f0.w & f1.x & f1.y & f1.z & f1.w) != 0u) break; } }
        if (rem >= 3) AT_DMA(t - 3, (i + 3) & 3);
        const LAS unsigned char* sb = lds + (i & 3) * SLOT;
        bool act = kv0 <= qw0 + 31;
        if (MODE == 1) act = act && (kv0 + 63 >= qw0 - 127);
        if (act) {
            f32x16 s[2];
            {
                bf16x8 kf[2][DK / 16];
#pragma unroll
                for (int ph = 0; ph < 2; ++ph) {
#pragma unroll
                    for (int d0 = 0; d0 < 4; ++d0) kf[ph][d0] = *(const LAS bf16x8*)(sb + koff[d0] + ph * 4096);
                    if (DK == 96) {
#pragma unroll
                        for (int j = 0; j < 2; ++j) kf[ph][(DK == 96) ? 4 + j : 0] = *(const LAS bf16x8*)(sb + poff[j] + ph * 2048);
                    }
                }
#pragma unroll
                for (int r = 0; r < 16; ++r) { s[0][r] = 0.f; s[1][r] = 0.f; }
                __builtin_amdgcn_sched_barrier(0);
#pragma unroll
                for (int d0 = 0; d0 < DK / 16; ++d0) {
                    s[0] = __builtin_amdgcn_mfma_f32_32x32x16_bf16(kf[0][d0], qf[d0], s[0], 0, 0, 0);
                    s[1] = __builtin_amdgcn_mfma_f32_32x32x16_bf16(kf[1][d0], qf[d0], s[1], 0, 0, 0);
                }
                __builtin_amdgcn_sched_barrier(0);
            }
            if (MODE == 2) {
                const LAS float* lcb = (const LAS float*)(sb + OFF_LC);
#pragma unroll
                for (int ph = 0; ph < 2; ++ph)
#pragma unroll
                    for (int j = 0; j < 4; ++j) { const f32x4 lk = *(const LAS f32x4*)(lcb + 32 * ph + 16 * (j >> 1) + 8 * hi + 4 * (j & 1));
#pragma unroll
                        for (int ii = 0; ii < 4; ++ii) s[ph][4 * j + ii] = s[ph][4 * j + ii] * p.c - lk[ii]; }
            } else if (MODE == 1) {
                const float dq = (float)(q - kv0 - 8 * hi);
#pragma unroll
                for (int ph = 0; ph < 2; ++ph)
#pragma unroll
                    for (int r = 0; r < 16; ++r) { const int kk = 32 * ph + 16 * (r >> 3) + 4 * ((r >> 2) & 1) + (r & 3); s[ph][r] = s[ph][r] * p.c - slope2 * (dq - (float)kk); }
            }
            bool needmask = (kv0 + 63 > qw0);
            if (MODE == 1) needmask = needmask || (kv0 < qw0 + 31 - 127);
            if (needmask) {
                const int dqi = q - kv0 - 8 * hi;
#pragma unroll
                for (int ph = 0; ph < 2; ++ph)
#pragma unroll
                    for (int r = 0; r < 16; ++r) { const int kk = 32 * ph + 16 * (r >> 3) + 4 * ((r >> 2) & 1) + (r & 3); const int dist = dqi - kk;
                        bool ok = dist >= 0; if (MODE == 1) ok = ok && (dist < 128); s[ph][r] = ok ? s[ph][r] : -INFINITY; }
            }
            float mx = fmaxf(fmaxf(s[0][0], s[0][1]), s[0][2]);
#pragma unroll
            for (int r = 3; r < 15; r += 2) mx = fmaxf(fmaxf(mx, s[0][r]), s[0][r + 1]);
            mx = fmaxf(mx, s[0][15]);
#pragma unroll
            for (int r = 0; r < 16; r += 2) mx = fmaxf(fmaxf(mx, s[1][r]), s[1][r + 1]);
            mx = fmaxf(mx, __shfl_xor(mx, 32));
            if (MODE == 0) mx *= p.c;
            const bool dead = (MODE == 2) && __all(mx < m_run - 40.f);
            if (!dead) {
                const float m_new = fmaxf(m_run, mx);
                const float alpha = __builtin_amdgcn_exp2f(m_run - m_new);
                m_run = m_new;
                float ls0 = 0.f, ls1 = 0.f;
#pragma unroll
                for (int ph = 0; ph < 2; ++ph)
#pragma unroll
                    for (int r = 0; r < 16; r += 2) {
                        const float e0 = __builtin_amdgcn_exp2f(MODE == 0 ? (s[ph][r] * p.c - m_new) : (s[ph][r] - m_new));
                        const float e1 = __builtin_amdgcn_exp2f(MODE == 0 ? (s[ph][r + 1] * p.c - m_new) : (s[ph][r + 1] - m_new));
                        s[ph][r] = e0; s[ph][r + 1] = e1; ls0 += e0; ls1 += e1; }
                if (__any(alpha != 1.f)) {
                    l_run *= alpha;
#pragma unroll
                    for (int r = 0; r < 16; ++r) { ot[0][r] *= alpha; ot[1][r] *= alpha; }
                }
                l_run += ls0 + ls1;
                bf16x8 pk[4];
#pragma unroll
                for (int cc = 0; cc < 4; ++cc) { const int ph = cc >> 1, o = 8 * (cc & 1); u32x4 w;
                    w.x = cvtpk(s[ph][o + 0], s[ph][o + 1]); w.y = cvtpk(s[ph][o + 2], s[ph][o + 3]); w.z = cvtpk(s[ph][o + 4], s[ph][o + 5]); w.w = cvtpk(s[ph][o + 6], s[ph][o + 7]);
                    pk[cc] = __builtin_bit_cast(bf16x8, w); }
                const LAS unsigned char* vb = sb + OFF_V + vrd;
                bf16x8 vf[2][4];
#pragma unroll
                for (int dh = 0; dh < 2; ++dh)
#pragma unroll
                    for (int cc = 0; cc < 4; ++cc) {
                        const v4i16_t v0 = __builtin_amdgcn_ds_read_tr16_b64_v4i16((LAS v4i16_t*)(vb + dh * VHALF + cc * 1024));
                        const v4i16_t v1 = __builtin_amdgcn_ds_read_tr16_b64_v4i16((LAS v4i16_t*)(vb + dh * VHALF + cc * 1024 + 256));
                        vf[dh][cc] = (bf16x8){v0[0], v0[1], v0[2], v0[3], v1[0], v1[1], v1[2], v1[3]}; }
                __builtin_amdgcn_sched_barrier(0);
#pragma unroll
                for (int cc = 0; cc < 4; ++cc) {
                    ot[0] = __builtin_amdgcn_mfma_f32_32x32x16_bf16(vf[0][cc], pk[cc], ot[0], 0, 0, 0);
                    ot[1] = __builtin_amdgcn_mfma_f32_32x32x16_bf16(vf[1][cc], pk[cc], ot[1], 0, 0, 0);
                }
                __builtin_amdgcn_sched_barrier(0);
            }
        }
        if (MODE == 2) {
            bool dn = false;
            if (rem >= 1) { const float bnd = qn * __shfl(pmv, t - 1) - __shfl(lcev, t - 1); dn = __all(bnd < m_run - 40.f); }
            if (lane == 0) *(LAS unsigned*)(lds + OFF_FLAG + (i & 1) * 32 + wid * 4) = dn ? 1u : 0u;
        }
    }
    AT_WAITV(0);
    __builtin_amdgcn_s_barrier();
    asm volatile("" ::: "memory");
    const float lt = l_run + __shfl_xor(l_run, 32);
    const float inv = 1.f / lt;
#pragma unroll
    for (int dh = 0; dh < 2; ++dh)
#pragma unroll
        for (int j = 0; j < 4; ++j) {
            const int d = 32 * dh + 8 * j + 4 * hi;
            const u32x2 g = *(const u32x2*)(Gp + (size_t)q * p.ldg + d);
            const float g0 = bflo(g.x), g1 = bfhi(g.x), g2 = bflo(g.y), g3 = bfhi(g.y);
            const float o0 = ot[dh][4 * j + 0] * inv * (g0 / (1.f + __expf(-g0)));
            const float o1 = ot[dh][4 * j + 1] * inv * (g1 / (1.f + __expf(-g1)));
            const float o2 = ot[dh][4 * j + 2] * inv * (g2 / (1.f + __expf(-g2)));
            const float o3 = ot[dh][4 * j + 3] * inv * (g3 / (1.f + __expf(-g3)));
            u32x2 w; w.x = cvtpk(o0, o1); w.y = cvtpk(o2, o3);
            *(u32x2*)(Op + (size_t)q * p.ldo + d) = w;
        }
#undef AT_DMA
}

#define XB_TMO      128
#define XB_XCNT(j)  (256  + 64 * (j))
#define XB_XSUB(j)  (1280 + 64 * (j))
#define XB_XGEN(j)  (2304 + 64 * (j))
#define XB_TOP      3328
#define XB_TOPGEN   3392
#define XCD_BAR_WORDS 3456
#define XB_SPIN_CAP (1u << 18)

__device__ __forceinline__ unsigned xb_ld(unsigned* p)              { return __hip_atomic_load(p, __ATOMIC_RELAXED, __HIP_MEMORY_SCOPE_AGENT); }
__device__ __forceinline__ unsigned xb_add(unsigned* p, unsigned v) { return __hip_atomic_fetch_add(p, v, __ATOMIC_RELAXED, __HIP_MEMORY_SCOPE_AGENT); }
__device__ __forceinline__ unsigned xb_xcc_id() { return (unsigned)__builtin_amdgcn_s_getreg((3 << 11) | 20) & 0xFu; }
#define XB_SPIN(cond, bar) do { unsigned _sp = 0; while (cond) { __builtin_amdgcn_s_sleep(1); \
    if ((++_sp & 255u) == 0u) { if (xb_ld(&(bar)[XB_TMO])) break; if (_sp > XB_SPIN_CAP) { atomicAdd(&(bar)[XB_TMO], 1u); break; } } } } while (0)

struct XcdBarrier {
    unsigned* bar; unsigned x;
    volatile LAS unsigned* st;
};

__device__ __forceinline__ XcdBarrier xcd_barrier_post(unsigned* bar, volatile LAS unsigned* st) {
    XcdBarrier b; b.bar = bar; b.x = xb_xcc_id(); b.st = st;
    if (threadIdx.x == 0) (void)xb_add(&bar[XB_XCNT(b.x)], 1u);
    return b;
}
__device__ __forceinline__ void xcd_barrier_complete(unsigned* bar, unsigned x, unsigned& nloc, unsigned& nx) {
    const unsigned G = gridDim.x * gridDim.y * gridDim.z;
    unsigned sum, cnt, mine, sp = 0u;
    for (;;) {
        sum = 0u; cnt = 0u; mine = 0u;
#pragma unroll
        for (unsigned j = 0; j < 16; ++j) { const unsigned c = xb_ld(&bar[XB_XCNT(j)]); sum += c; cnt += (c > 0u) ? 1u : 0u; mine = (j == x) ? c : mine; }
        if (sum == G) break;
        __builtin_amdgcn_s_sleep(1);
        if ((++sp & 255u) == 0u) { if (xb_ld(&bar[XB_TMO])) break; if (sp > XB_SPIN_CAP) { atomicAdd(&bar[XB_TMO], 1u); break; } }
    }
    nloc = mine > 0u ? mine : 1u; nx = cnt > 0u ? cnt : 1u;
}

__device__ __forceinline__ void xcd_barrier(const XcdBarrier& b) {
    asm volatile("s_waitcnt vmcnt(0)" ::: "memory");
    __syncthreads();
    if (threadIdx.x == 0) {
        unsigned* bar = b.bar;
        __builtin_amdgcn_s_waitcnt(0);
        unsigned nloc = b.st[0], nx = b.st[1];
        if (nloc == 0u) { xcd_barrier_complete(bar, b.x, nloc, nx); b.st[0] = nloc; b.st[1] = nx; }
        const unsigned old = xb_add(&bar[XB_XSUB(b.x)], 1u);
        const unsigned gen = old / nloc;
        if (old + 1u == (gen + 1u) * nloc) {
            __builtin_amdgcn_fence(__ATOMIC_RELEASE, "agent");
            asm volatile("s_waitcnt vmcnt(0)" ::: "memory");
            const unsigned og = xb_add(&bar[XB_TOP], 1u);
            const unsigned tg = og / nx;
            if (og + 1u == (tg + 1u) * nx) xb_add(&bar[XB_TOPGEN], 1u);
            else XB_SPIN(xb_ld(&bar[XB_TOPGEN]) == tg, bar);
            __builtin_amdgcn_fence(__ATOMIC_ACQUIRE, "agent");
            xb_add(&bar[XB_XGEN(b.x)], 1u);
            asm volatile("s_waitcnt vmcnt(0)" ::: "memory");
        } else {
            XB_SPIN(xb_ld(&bar[XB_XGEN(b.x)]) == gen, bar);
            __builtin_amdgcn_fence(__ATOMIC_ACQUIRE, "agent");
            asm volatile("s_waitcnt vmcnt(0)" ::: "memory");
        }
    }
    __syncthreads();
}

struct Args { const float* in[15]; const int* pos; float* out; unsigned char* ws; int ph_lo, ph_hi; };

__device__ __forceinline__ void transpose_item(const float* W, int ldw, int col0, int k0, bf16* WT, int ldt, int row_off, LAS float* scr, int lane) {
#pragma unroll 8
    for (int i = 0; i < 32; ++i) { const int kk = 2 * i + (lane >> 5); scr[kk * 33 + (lane & 31)] = W[(size_t)(k0 + kk) * ldw + col0 + (lane & 31)]; }
    asm volatile("s_waitcnt lgkmcnt(0)" ::: "memory");
    const int c = lane & 7;
#pragma unroll
    for (int j = 0; j < 4; ++j) { const int n = (lane >> 3) + 8 * j; const LAS float* s = scr + (8 * c) * 33 + n;
        u32x4 o; o.x = cvtpk(s[0 * 33], s[1 * 33]); o.y = cvtpk(s[2 * 33], s[3 * 33]); o.z = cvtpk(s[4 * 33], s[5 * 33]); o.w = cvtpk(s[6 * 33], s[7 * 33]);
        *(u32x4*)(WT + (size_t)(row_off + n) * ldt + k0 + 8 * c) = o; }
    asm volatile("s_waitcnt lgkmcnt(0)" ::: "memory");
}

__device__ __forceinline__ void rms_row_to_bf16(const float* xrow, const float* g, bf16* orow, int lane) {
    const f32x4* xr = (const f32x4*)xrow + lane; const f32x4* gr = (const f32x4*)g + lane;
    f32x4 v[4]; float s = 0.f;
#pragma unroll
    for (int j = 0; j < 4; ++j) { v[j] = xr[64 * j]; s += (v[j].x * v[j].x + v[j].y * v[j].y) + (v[j].z * v[j].z + v[j].w * v[j].w); }
    const float rs = 1.f / sqrtf(wave_sum(s) * (1.f / DM) + EPS);
    u32x2* o8 = (u32x2*)orow + lane;
#pragma unroll
    for (int j = 0; j < 4; ++j) { const f32x4 gg = gr[64 * j]; u32x2 w; w.x = cvtpk(v[j].x * rs * gg.x, v[j].y * rs * gg.y); w.y = cvtpk(v[j].z * rs * gg.z, v[j].w * rs * gg.w); o8[64 * j] = w; }
}

template <bool COOP>
__global__ void __launch_bounds__(NTHREADS, 2) mk_fwd(Args args) {
    extern __shared__ __attribute__((aligned(16))) unsigned char lds_raw[];
    LAS unsigned char* lds = (LAS unsigned char*)lds_raw;
    const int tid = threadIdx.x, lane = tid & 63, wave = __builtin_amdgcn_readfirstlane(tid >> 6);
    const int G = gridDim.x, bx = blockIdx.x;
    const int vcu = (G % 8 == 0) ? (bx % 8) * (G / 8) + bx / 8 : bx;
    const int gw = vcu * NWAVES + wave, NGW = G * NWAVES;
    unsigned char* ws = args.ws;
    const float* x = args.in[0];
    bf16* Wt0 = (bf16*)(ws + WS_WT0); bf16* Wqup = (bf16*)(ws + WS_WQUP); bf16* Wkvup = (bf16*)(ws + WS_WKVUP); bf16* Wout0 = (bf16*)(ws + WS_WOUT0);
    bf16* Wt1 = (bf16*)(ws + WS_WT1); bf16* Wout1 = (bf16*)(ws + WS_WOUT1);
    bf16* XN = (bf16*)(ws + WS_XN); bf16* OG = (bf16*)(ws + WS_OG); float* LF = (float*)(ws + WS_LF); float* LC = (float*)(ws + WS_LC); float* CS = (float*)(ws + WS_CS); float* TMAXB = (float*)(ws + WS_TMAX);
    bf16* Z0 = (bf16*)(ws + WS_Z0); bf16* Z1 = (bf16*)(ws + WS_Z1); bf16* CQN = (bf16*)(ws + WS_CQN); bf16* CKVN = (bf16*)(ws + WS_CKVN); bf16* KPE = (bf16*)(ws + WS_KPE);
    bf16* Q0 = (bf16*)(ws + WS_Q0); bf16* KN = (bf16*)(ws + WS_KN); bf16* VM = (bf16*)(ws + WS_VM);
    float* out = args.out;
    const int lo = args.ph_lo, hi_ph = args.ph_hi;
#ifndef REPMASK
#define REPMASK 0
#endif
#define NREP(k) (1 + (((REPMASK) >> (k)) & 1))
#ifndef PHMASK
#define PHMASK 0xfff
#endif
#define IN(k) ((((PHMASK) >> (k)) & 1) && lo <= (k) && (k) < hi_ph)
#define SEAM(k) do { if constexpr (COOP) { if (IN(k) && IN((k) + 1)) { if ((k) == 0) { cg::this_grid().sync(); xbar = xcd_barrier_post(barw, (volatile LAS unsigned*)(lds + LDS_MISC)); } else { xcd_barrier(xbar); } } } } while (0)
    unsigned* qctr = (unsigned*)(ws + 256 * 1024);
    unsigned* barw = (unsigned*)ws;
    XcdBarrier xbar; xbar.bar = barw; xbar.x = 0; xbar.st = (volatile LAS unsigned*)(lds + LDS_MISC);
    if constexpr (COOP) {
        if (tid < 16) ((LAS unsigned*)(lds + LDS_MISC))[tid] = 0u;
        if (bx == 0) { for (int i = tid; i < XCD_BAR_WORDS; i += NTHREADS) barw[i] = 0u; for (int i = tid; i < 16 * 64; i += NTHREADS) qctr[i] = 0u; for (int i = tid; i < 2 * 64 * 64; i += NTHREADS) ((unsigned*)(ws + 64 * 1024))[i] = 0u; }
        __syncthreads();
    }

    if (IN(0)) {
        LAS float* scr = (LAS float*)(lds + wave * 16384);
        constexpr int I_A = 16 * 69, I_B = 4 * 24, I_C = 2 * 32, I_D = 16 * 32, I_E1 = 16 * 96, I_E2 = 16 * 32, I_F = 16 * 32;
        constexpr int NIT = I_A + I_B + I_C + I_D + I_E1 + I_E2 + I_F;
        for (int it = gw; it < NIT; it += NGW) {
            int r = it;
            if (r < I_A) { const int kb = r / 69, nb = r % 69; transpose_item(args.in[3], N0, 32 * nb, 64 * kb, Wt0, 1024, 32 * nb, scr, lane); continue; } r -= I_A;
            if (r < I_B) { const int kb = r / 24, nb = r % 24; transpose_item(args.in[5], 768, 32 * nb, 64 * kb, Wqup, 256, 32 * nb, scr, lane); continue; } r -= I_B;
            if (r < I_C) { const int kb = r / 32, nb = r % 32; const int n0 = 32 * nb, h = n0 >> 7, j0 = n0 & 127; const int dst = (j0 < 64) ? (h * 64 + j0) : (512 + h * 64 + (j0 - 64));
                           transpose_item(args.in[7], 1024, n0, 64 * kb, Wkvup, 256, dst, scr, lane); continue; } r -= I_C;
            if (r < I_D) { const int kb = r / 32, nb = r % 32; transpose_item(args.in[9], 1024, 32 * nb, 64 * kb, Wout0, 1024, 32 * nb, scr, lane); continue; } r -= I_D;
            if (r < I_E1) { const int kb = r / 96, nb = r % 96; transpose_item(args.in[11], N1W, 32 * nb, 64 * kb, Wt1, 1024, 32 * nb, scr, lane); continue; } r -= I_E1;
            if (r < I_E2) { const int kb = r / 32, nb = r % 32; transpose_item(args.in[11], N1W, W1_G + 32 * nb, 64 * kb, Wt1, 1024, C1_G + 32 * nb, scr, lane); continue; } r -= I_E2;
            { const int kb = r / 32, nb = r % 32; transpose_item(args.in[13], 1024, 32 * nb, 64 * kb, Wout1, 1024, 32 * nb, scr, lane); }
        }
        { const u32x4 z = {0u, 0u, 0u, 0u};
          u32x4* p0 = (u32x4*)(Wt0 + (size_t)N0 * 1024);
          for (int i = vcu * NTHREADS + tid; i < 96 * 1024 / 8; i += G * NTHREADS) p0[i] = z;
          for (int i = vcu * NTHREADS + tid; i < 1024 * 16; i += G * NTHREADS) { const int row = i >> 4, c = i & 15; *(u32x4*)(Wkvup + (size_t)row * 256 + 128 + c * 8) = z; } }
        for (int m = gw; m < M; m += NGW) rms_row_to_bf16(x + (size_t)m * DM, args.in[2], XN + (size_t)m * DM, lane);
    }
    SEAM(0);
    if (IN(1)) {
        __syncthreads();
        pg8::Gemm g{XN, Wt0, M, N0P, 1024}; pg8::StaticOrder S; S.init(M, N0P, G, bx);
        pg8::EpiBf16<0> E{Z0, N0P, nullptr, 0, 0, 1.f};
        for (int rep = 0; rep < NREP(1); ++rep) {
        pg8::gemm_phase<pg8::EpiBf16<0>, pg8::StaticOrder, true, true>(lds, g, S, E); __syncthreads(); }
    }
    SEAM(1);
    if (IN(2)) {
        const float* gq = args.in[4]; const float* gkv = args.in[6];
        for (int m = gw; m < M; m += NGW) {
            const bf16* z = Z0 + (size_t)m * N0P;
            const u32x2 a = *(const u32x2*)(z + C_CQ + 4 * lane);
            const unsigned bb = *(const unsigned*)(z + C_CKV + 2 * lane);
            const float a0 = bflo(a.x), a1 = bfhi(a.x), a2 = bflo(a.y), a3 = bfhi(a.y), b0 = bflo(bb), b1 = bfhi(bb);
            const float sa = wave_sum((a0 * a0 + a1 * a1) + (a2 * a2 + a3 * a3)), sb = wave_sum(b0 * b0 + b1 * b1);
            const float ra = 1.f / sqrtf(sa * (1.f / 256.f) + EPS), rb = 1.f / sqrtf(sb * (1.f / 128.f) + EPS);
            const f32x4 ga = *(const f32x4*)(gq + 4 * lane); const f32x2 gb = *(const f32x2*)(gkv + 2 * lane);
            u32x2 w; w.x = cvtpk(a0 * ra * ga.x, a1 * ra * ga.y); w.y = cvtpk(a2 * ra * ga.z, a3 * ra * ga.w);
            *(u32x2*)(CQN + (size_t)m * 256 + 4 * lane) = w;
            *(unsigned*)(CKVN + (size_t)m * 256 + 2 * lane) = cvtpk(b0 * rb * gb.x, b1 * rb * gb.y);
            *(unsigned*)(CKVN + (size_t)m * 256 + 128 + 2 * lane) = 0u;
            if (lane < 16) {
                const float invf = (float)exp2(-(double)lane * 0.8304820237218406);
                const double ang = (double)(float)args.pos[m] * (double)invf;
                const double rev = ang * 0.15915494309189535;
                const float rr = (float)(rev - rint(rev));
                const float cv = __builtin_amdgcn_cosf(rr), sv = __builtin_amdgcn_sinf(rr);
                CS[(size_t)m * 32 + lane] = cv; CS[(size_t)m * 32 + 16 + lane] = sv;
                const float x1 = bf1(z[C_KPE + lane]), x2 = bf1(z[C_KPE + 16 + lane]);
                const unsigned o1 = cvtpk(x1 * cv - x2 * sv, 0.f), o2 = cvtpk(x2 * cv + x1 * sv, 0.f);
                KPE[(size_t)m * 32 + lane] = (bf16)(o1 & 0xffffu); KPE[(size_t)m * 32 + 16 + lane] = (bf16)(o2 & 0xffffu);
            }
        }
    }
    SEAM(2);
    if (IN(3)) {
        __syncthreads();
#ifndef NO_QUP
        { int kq_ = 256; asm volatile("" : "+s"(kq_)); pg8::Gemm g{CQN, Wqup, M, 768, kq_}; pg8::StaticOrder S; S.init(M, 768, G, bx);
          pg8::EpiQRope E{Q0, 768, CS};
          pg8::gemm_phase<pg8::EpiQRope, pg8::StaticOrder, true, true>(lds, g, S, E); }
#endif
        __syncthreads();
#ifndef NO_KVUP
        { int kk_ = 256; asm volatile("" : "+s"(kk_)); pg8::Gemm g{CKVN, Wkvup, M, 1024, kk_}; pg8::StaticOrder S; S.init(M, 1024, G, bx);
          pg8::EpiBf16<0> E{KN, 512, nullptr, 512, (size_t)(WS_VM - WS_KN) / 2, 1.f};
          pg8::gemm_phase<pg8::EpiBf16<0>, pg8::StaticOrder, true, true>(lds, g, S, E); }
#endif
    }
    SEAM(3);
    if (IN(4)) {
        __syncthreads();
        for (;;) {
            if (tid == 0) *(volatile LAS int*)(lds + LDS_MISC + 64) = (int)atomicAdd(qctr + 64 * (bx & 7), 1u);
            __syncthreads();
            const int tk = *(volatile LAS int*)(lds + LDS_MISC + 64);
            __syncthreads();
            if (tk >= 128) break;
            const bool swa = tk >= 64;
            AttnP p; p.sinkp = args.in[8]; p.h0 = 0;
            if (!swa) {
                const int bh = 8 * (bx & 7) + (tk >> 3), s = tk & 7, b = bh >> 3, h = bh & 7; const size_t rb = (size_t)b * SEQ;
                p.Q = Q0 + rb * 768 + h * 96; p.ldq = 768; p.K = KN + rb * 512 + h * 64; p.ldk = 512; p.K2 = KPE + rb * 32; p.ldk2 = 32; p.V = VM + rb * 512 + h * 64; p.ldv = 512;
                p.G = Z0 + rb * N0P + C_G0 + h * 64; p.ldg = N0P; p.O = OG + rb * 1024 + h * 64; p.ldo = 1024; p.lc = nullptr; p.tmax = nullptr; p.c = 0.10206207261596575f * LOG2E; p.sink2 = 0.f; p.slope2 = 0.f;
                attn_unit<96, 0>(p, (15 - s) * 256, lds); attn_unit<96, 0>(p, s * 256, lds);
            } else {
                const int j = tk - 64, pkv = 2 * (bx & 7) + (j >> 5), b = pkv >> 1, kvh = pkv & 1, qb = 2 * (j & 31); const size_t rb = (size_t)b * SEQ;
                p.Q = Z0 + rb * N0P + C_QS + kvh * 256; p.ldq = N0P; p.K = Z0 + rb * N0P + C_KS + kvh * 64; p.ldk = N0P; p.K2 = nullptr; p.ldk2 = 0; p.V = Z0 + rb * N0P + C_VS + kvh * 64; p.ldv = N0P;
                p.G = Z0 + rb * N0P + C_G0 + 512 + kvh * 256; p.ldg = N0P; p.O = OG + rb * 1024 + 512 + kvh * 256; p.ldo = 1024; p.lc = nullptr; p.tmax = nullptr; p.c = 0.125f * LOG2E;
                p.sink2 = 0.f; p.slope2 = 0.f; p.h0 = 4 * kvh;
                attn_unit<64, 1>(p, qb * 64, lds); attn_unit<64, 1>(p, (qb + 1) * 64, lds);
            }
        }
    }
    SEAM(4);
    if (IN(5)) {
        __syncthreads();
        pg8::Gemm g{OG, Wout0, M, 1024, 1024}; pg8::StaticOrder S; S.init(M, 1024, G, bx);
        pg8::EpiResF32 E{x, out, 1024};
        pg8::gemm_phase<pg8::EpiResF32, pg8::StaticOrder, true, true>(lds, g, S, E);
    }
    SEAM(5);
    if (IN(6)) {
        __syncthreads();
        const float* g1 = args.in[10]; const float* w1 = args.in[11]; const float* bfp = args.in[12];
        LAS float* WF = (LAS float*)lds;
        for (int k = tid; k < 1024; k += NTHREADS) {
            const int l = (k & 255) >> 2, j = k >> 8, e = k & 3; const int R = l + 64 * (4 * j + e); const float gk = g1[k];
#pragma unroll
            for (int c = 0; c < 4; ++c) { const f32x4 wv = *(const f32x4*)(w1 + (size_t)k * N1W + W1_F + 4 * c); *(LAS f32x4*)(WF + R * 20 + 4 * c) = wv * gk; }
        }
        __syncthreads();
        for (int m = gw; m < M; m += NGW) {
            const f32x4* xr = (const f32x4*)(out + (size_t)m * DM) + lane; const f32x4* gr = (const f32x4*)g1 + lane;
            f32x4 v[4]; float ss = 0.f;
#pragma unroll
            for (int j = 0; j < 4; ++j) { v[j] = xr[64 * j]; ss += (v[j].x * v[j].x + v[j].y * v[j].y) + (v[j].z * v[j].z + v[j].w * v[j].w); }
            const float rs = 1.f / sqrtf(wave_sum(ss) * (1.f / DM) + EPS);
            u32x2* o8 = (u32x2*)(XN + (size_t)m * DM) + lane;
            float fa[16];
#pragma unroll
            for (int n = 0; n < 16; ++n) fa[n] = 0.f;
#pragma unroll
            for (int j = 0; j < 4; ++j) { const f32x4 gg = gr[64 * j]; u32x2 w; w.x = cvtpk(v[j].x * rs * gg.x, v[j].y * rs * gg.y); w.y = cvtpk(v[j].z * rs * gg.z, v[j].w * rs * gg.w); o8[64 * j] = w;
#pragma unroll
                for (int e = 0; e < 4; ++e) { const float xv = v[j][e]; const LAS float* wr_ = WF + (lane + 64 * (4 * j + e)) * 20;
#pragma unroll
                    for (int c = 0; c < 4; ++c) { const f32x4 wv = *(const LAS f32x4*)(wr_ + 4 * c); fa[4 * c + 0] += xv * wv.x; fa[4 * c + 1] += xv * wv.y; fa[4 * c + 2] += xv * wv.z; fa[4 * c + 3] += xv * wv.w; }
                    asm volatile("" ::: "memory"); } }
            const bool b5 = (lane & 32) != 0, b4 = (lane & 16) != 0, b3 = (lane & 8) != 0, b2 = (lane & 4) != 0;
            float r8[8], r4[4], r2[2];
#pragma unroll
            for (int i = 0; i < 8; ++i) { const float snd = b5 ? fa[i] : fa[8 + i]; r8[i] = (b5 ? fa[8 + i] : fa[i]) + __shfl_xor(snd, 32); }
#pragma unroll
            for (int i = 0; i < 4; ++i) { const float snd = b4 ? r8[i] : r8[4 + i]; r4[i] = (b4 ? r8[4 + i] : r8[i]) + __shfl_xor(snd, 16); }
#pragma unroll
            for (int i = 0; i < 2; ++i) { const float snd = b3 ? r4[i] : r4[2 + i]; r2[i] = (b3 ? r4[2 + i] : r4[i]) + __shfl_xor(snd, 8); }
            float mine = (b2 ? r2[1] : r2[0]) + __shfl_xor(b2 ? r2[0] : r2[1], 4);
            mine += __shfl_xor(mine, 1); mine += __shfl_xor(mine, 2);
            if ((lane & 3) == 0) { const int n = (lane >> 2) & 15; const float f = mine * rs + bfp[n]; const float lsg = fminf(f, 0.f) - log1pf(expf(-fabsf(f))); LF[(size_t)m * 16 + n] = lsg; }
        }
    }
    SEAM(6);
    if (IN(7)) {
        __syncthreads();
        LAS float* sm = (LAS float*)lds;
        for (int bh = bx; bh < 128; bh += G) {
            const int b = bh >> 4, h = bh & 15; float v[8]; float run = 0.f;
#pragma unroll
            for (int e = 0; e < 8; ++e) { run += LF[((size_t)b * SEQ + 8 * tid + e) * 16 + h]; v[e] = run; }
            float sc = run;
#pragma unroll
            for (int o = 1; o < 64; o <<= 1) { const float n = __shfl_up(sc, o); if (lane >= o) sc += n; }
            if (lane == 63) sm[wave] = sc;
            __syncthreads();
            float off = sc - run;
            for (int w = 0; w < wave; ++w) off += sm[w];
            f32x4 o0 = {(v[0] + off) * LOG2E, (v[1] + off) * LOG2E, (v[2] + off) * LOG2E, (v[3] + off) * LOG2E}, o1 = {(v[4] + off) * LOG2E, (v[5] + off) * LOG2E, (v[6] + off) * LOG2E, (v[7] + off) * LOG2E};
            *(f32x4*)(LC + (size_t)bh * SEQ + 8 * tid) = o0; *(f32x4*)(LC + (size_t)bh * SEQ + 8 * tid + 4) = o1;
            __syncthreads();
        }
        pg8::Gemm g{XN, Wt1, M, N1, 1024}; pg8::StaticOrder S; S.init(M, N1, G, bx);
        pg8::EpiBf16<0> E{Z1, N1, nullptr, 0, 0, 1.f};
        for (int rep = 0; rep < NREP(7); ++rep) {
        pg8::gemm_phase<pg8::EpiBf16<0>, pg8::StaticOrder, true, true>(lds, g, S, E); __syncthreads(); }
    }
    SEAM(7);
    if (IN(8)) {
        __syncthreads();
        LAS float* sm = (LAS float*)lds;
        for (int task = vcu; task < 512; task += G) {
            const int b = task >> 6, T = task & 63;
            const bf16* kbase = Z1 + ((size_t)b * SEQ + 64 * T + (tid >> 7)) * N1 + C1_K + (tid & 127) * 8;
            float mxn = 0.f;
#pragma unroll 4
            for (int i = 0; i < 16; ++i) {
                const u32x4 v = *(const u32x4*)(kbase + (size_t)(4 * i) * N1);
                float s = 0.f;
#pragma unroll
                for (int e = 0; e < 4; ++e) { const float a = bflo(v[e]), c = bfhi(v[e]); s += a * a + c * c; }
                s += __shfl_xor(s, 1); s += __shfl_xor(s, 2); s += __shfl_xor(s, 4);
                mxn = fmaxf(mxn, s);
            }
            if ((tid & 7) == 0) sm[(tid >> 7) * 16 + ((tid & 127) >> 3)] = mxn;
            __syncthreads();
            if (tid < 16) { const float m4 = fmaxf(fmaxf(sm[tid], sm[16 + tid]), fmaxf(sm[32 + tid], sm[48 + tid])); TMAXB[((size_t)(b * 16 + tid)) * 64 + T] = sqrtf(m4); }
            __syncthreads();
        }
    }
    SEAM(8);
    if (IN(9)) {
        __syncthreads();
        for (;;) {
            if (tid == 0) *(volatile LAS int*)(lds + LDS_MISC + 64) = (int)atomicAdd(qctr + 64 * (8 + (bx & 7)), 1u);
            __syncthreads();
            const int tk = *(volatile LAS int*)(lds + LDS_MISC + 64);
            __syncthreads();
            if (tk >= 128) break;
            const int bh = 16 * (bx & 7) + (tk >> 3), s = tk & 7, b = bh >> 4, h = bh & 15; const size_t rb = (size_t)b * SEQ;
            AttnP p;
            p.Q = Z1 + rb * N1 + C1_Q + h * 64; p.ldq = N1; p.K = Z1 + rb * N1 + C1_K + h * 64; p.ldk = N1; p.K2 = nullptr; p.ldk2 = 0; p.V = Z1 + rb * N1 + C1_V + h * 64; p.ldv = N1;
            p.G = Z1 + rb * N1 + C1_G + h * 64; p.ldg = N1; p.O = OG + rb * 1024 + h * 64; p.ldo = 1024; p.lc = LC + (size_t)bh * SEQ; p.tmax = TMAXB + (size_t)bh * 64; p.sinkp = args.in[8]; p.h0 = 0; p.c = 0.125f * LOG2E; p.sink2 = 0.f; p.slope2 = 0.f;
            attn_unit<64, 2>(p, (15 - s) * 256, lds); attn_unit<64, 2>(p, s * 256, lds);
        }
    }
    SEAM(9);
    if (IN(10)) {
        __syncthreads();
        for (int sub = 0; sub < 2; ++sub) {
            const size_t r0 = (size_t)sub * 16384;
            pg8::Gemm g{OG + r0 * 1024, Wout1, 16384, 1024, 1024}; pg8::StaticOrder S; S.init(16384, 1024, G, bx);
            pg8::PanelRms st{(float*)(ws + WS_LF) + (size_t)sub * 16384 * 4, (unsigned*)(ws + 64 * 1024) + sub * 64 * 64, EPS};
            pg8::EpiRmsOut E{out + r0 * 1024, out + r0 * 1024, args.in[14], 1024, st};
            pg8::gemm_phase<pg8::EpiRmsOut, pg8::StaticOrder, false, true>(lds, g, S, E);
            __syncthreads();
        }
    }
#undef IN
#undef SEAM
}

constexpr int NPHASES = 11;
extern "C" void kernel_launch(void* const* d_in, const int* in_sizes, int n_in, void* d_out, int out_size, void* d_ws, size_t ws_size, hipStream_t stream) {
    static int grid = 0;
    if (grid == 0) {
        if (n_in != 15 || out_size != M * DM || ws_size < WS_END) { fprintf(stderr, "kernel_launch: unexpected shapes (n_in %d, out %d, ws %zu)\n", n_in, out_size, ws_size); grid = -1; return; }
        int dev = 0, cus = 0, per_cu = 0;
        (void)hipGetDevice(&dev); (void)hipDeviceGetAttribute(&cus, hipDeviceAttributeMultiprocessorCount, dev);
#if MK_COOP
        (void)hipFuncSetAttribute((const void*)mk_fwd<true>, hipFuncAttributeMaxDynamicSharedMemorySize, LDS_BYTES);
        (void)hipOccupancyMaxActiveBlocksPerMultiprocessor(&per_cu, (const void*)mk_fwd<true>, NTHREADS, LDS_BYTES);
#else
        (void)hipFuncSetAttribute((const void*)mk_fwd<false>, hipFuncAttributeMaxDynamicSharedMemorySize, LDS_BYTES);
        (void)hipOccupancyMaxActiveBlocksPerMultiprocessor(&per_cu, (const void*)mk_fwd<false>, NTHREADS, LDS_BYTES);
#endif
        (void)hipGetLastError();
        if (per_cu < 1) per_cu = 1;
        if (cus <= 0) cus = 256;
        grid = cus * 1;
    }
    if (grid < 0) return;
    Args a{};
    for (int i = 0; i < 15; ++i) a.in[i] = (const float*)d_in[i];
    a.pos = (const int*)d_in[1]; a.out = (float*)d_out; a.ws = (unsigned char*)d_ws;
#if MK_COOP
    a.ph_lo = 0; a.ph_hi = NPHASES;
    void* kargs[] = {&a};
    hipError_t e = hipLaunchCooperativeKernel((const void*)mk_fwd<true>, dim3(grid), dim3(NTHREADS), kargs, LDS_BYTES, stream);
    if (e != hipSuccess) fprintf(stderr, "cooperative launch failed: %s (grid %d)\n", hipGetErrorString(e), grid);
#else
    for (int ph = 0; ph < NPHASES; ++ph) { a.ph_lo = ph; a.ph_hi = ph + 1; hipLaunchKernelGGL(mk_fwd<false>, dim3(grid), dim3(NTHREADS), LDS_BYTES, stream, a); }
#endif
}
```

```cpp
#include <hip/hip_runtime.h>
#include <hip/hip_cooperative_groups.h>
#include <cstdio>
#include <cstdint>
#include <cmath>
namespace cg = cooperative_groups;
#ifndef MK_COOP
#define MK_COOP 1
#endif
namespace pg8 {
#define PG8_LAS __attribute__((address_space(3)))
typedef unsigned short bf16_t;
typedef short bf16x8 __attribute__((ext_vector_type(8)));
typedef float f32x4 __attribute__((ext_vector_type(4)));
typedef unsigned u32x4 __attribute__((ext_vector_type(4)));
constexpr int BM = 256, BK = 64, HALF = 128, HTB = HALF * BK * 2  , STAGE_BYTES = 8 * HTB, NXCD = 8, WGM = 8;

__host__ __device__ __forceinline__ int lds_byte(int r, int c) { const int st = (r >> 4) * 2 + (c >> 5), rr = r & 15, cc = c & 31, ob = rr * 64 + cc * 2; return st * 1024 + (ob ^ (((ob >> 9) & 1) << 5)); }
__host__ __device__ __forceinline__ void stage_rc(int b, int& R, int& C) { const int st = b / 1024, sb = b % 1024, swz = sb ^ (((sb >> 9) & 1) << 5); R = (st >> 1) * 16 + swz / 64; C = (st & 1) * 32 + (swz % 64) / 2; }
__host__ __device__ __forceinline__ int perm32(int rho) { const int n = rho >> 4, i = rho & 15; return 8 * (i >> 2) + 4 * n + (i & 3); }

struct Unit { int pm, pn; };
struct Gemm { const bf16_t* A; const bf16_t* Bt; int M, N, K; };

struct StaticOrder {
    int nM, nN, nwg, G, c;
    __host__ __device__ void init(int M, int N, int G_, int c_) { nM = M / BM; nN = N / BM; nwg = nM * nN; G = G_; c = c_; }
    __host__ __device__ bool next(int i, Unit& u) const {
        const long L = (long)i * G + c; if (L >= nwg) return false;
        int wgid = (int)L; { const int q = nwg / NXCD, r = nwg % NXCD, xcd = wgid % NXCD, off = wgid / NXCD; wgid = (xcd < r ? xcd * (q + 1) : r * (q + 1) + (xcd - r) * q) + off; }
        const int nig = WGM * nN, gid = wgid / nig, fm = gid * WGM, gsz = (nM - fm) < WGM ? (nM - fm) : WGM;
        u.pm = fm + ((wgid % nig) % gsz); u.pn = (wgid % nig) / gsz; return true;
    }
    __device__ __forceinline__ void a_ready(const Unit&) const {}
    __device__ __forceinline__ void done(const Unit&) const {}
};

__device__ __forceinline__ unsigned cvt_pk_bf16(float lo, float hi) { unsigned r; asm volatile("v_cvt_pk_bf16_f32 %0, %1, %2" : "=v"(r) : "v"(lo), "v"(hi)); return r; }
typedef float f32x2 __attribute__((ext_vector_type(2)));
__device__ __forceinline__ f32x2 gelu_pk(f32x2 v) {
    const f32x2 av = __builtin_elementwise_abs(v), d = av * 0.2316418882f + 1.0f;
    f32x2 t; t.x = __builtin_amdgcn_rcpf(d.x); t.y = __builtin_amdgcn_rcpf(d.y);
    f32x2 q = t * 0.5307027145f + (-0.7265760135f); q = q * t + 0.7107068705f; q = q * t + (-0.142248368f); q = q * t + 0.127414796f; q = q * t;
    const f32x2 s = (v * v) * (-0.72134752044f);
    f32x2 e; e.x = __builtin_amdgcn_exp2f(s.x); e.y = __builtin_amdgcn_exp2f(s.y);
    const f32x2 m = v * (q * e), r = v - m;
    f32x2 o; o.x = v.x < 0.f ? m.x : r.x; o.y = v.y < 0.f ? m.y : r.y; return o;
}

template <int ACT  > struct EpiBf16 {
    static constexpr bool PERM = true, AFTER_DRAIN = false; static_assert(ACT == 0 || ACT == 1, "EpiBf16: ACT is 0 (none) or 1 (gelu_pk)");
    bf16_t* O; int ldc; const float* bias; int split_cols; size_t split_stride; float scale0;
    __device__ __forceinline__ void operator()(const f32x4 (&acc)[2][2][4][2], const Unit& u, int wr, int wc, int fr, int fq) const {
        const int row0 = u.pm * BM + wr * 64 + fr; int colt = u.pn * BM; bf16_t* base = O;
        float sc = 1.f; if (split_cols) { const int t = colt / split_cols; base += (size_t)t * split_stride; colt -= t * split_cols; if (t == 0) sc = scale0; }
        const int col0 = colt + wc * 32 + 8 * fq, bcol0 = u.pn * BM + wc * 32 + 8 * fq;
        f32x4 bv[2][2];
#pragma unroll
        for (int bj = 0; bj < 2; ++bj)
#pragma unroll
            for (int n = 0; n < 2; ++n) bv[bj][n] = bias ? *(const f32x4*)(bias + bcol0 + bj * HALF + 4 * n) : (f32x4){0.f, 0.f, 0.f, 0.f};
#pragma unroll
        for (int ai = 0; ai < 2; ++ai)
#pragma unroll
            for (int m = 0; m < 4; ++m) { bf16_t* rowp = base + (size_t)(row0 + ai * HALF + m * 16) * ldc + col0;
#pragma unroll
                for (int bj = 0; bj < 2; ++bj) { f32x4 v0 = acc[ai][bj][m][0] + bv[bj][0], v1 = acc[ai][bj][m][1] + bv[bj][1];
                    if (ACT == 1) { f32x2 a = gelu_pk((f32x2){v0[0], v0[1]}), b = gelu_pk((f32x2){v0[2], v0[3]}), c = gelu_pk((f32x2){v1[0], v1[1]}), d = gelu_pk((f32x2){v1[2], v1[3]});
                        v0 = (f32x4){a.x, a.y, b.x, b.y}; v1 = (f32x4){c.x, c.y, d.x, d.y}; }
                    v0 = v0 * sc; v1 = v1 * sc; u32x4 w; w.x = cvt_pk_bf16(v0[0], v0[1]); w.y = cvt_pk_bf16(v0[2], v0[3]); w.z = cvt_pk_bf16(v1[0], v1[1]); w.w = cvt_pk_bf16(v1[2], v1[3]);
                    *(u32x4*)(rowp + bj * HALF) = w; } }
    }
};
typedef unsigned u32x2 __attribute__((ext_vector_type(2)));
struct EpiQRope {
    static constexpr bool PERM = false, AFTER_DRAIN = false;
    bf16_t* O; int ldc; const float* cs;
    __device__ __forceinline__ void operator()(const f32x4 (&acc)[2][2][4][2], const Unit& u, int wr, int wc, int fr, int fq) const {
        const int row0 = u.pm * BM + wr * 64 + fr;
#pragma unroll
        for (int ai = 0; ai < 2; ++ai)
#pragma unroll
            for (int m = 0; m < 4; ++m) {
                const int row = row0 + ai * HALF + m * 16;
                const f32x4 cv = *(const f32x4*)(cs + (size_t)row * 32 + 4 * fq), sv = *(const f32x4*)(cs + (size_t)row * 32 + 16 + 4 * fq);
#pragma unroll
                for (int bj = 0; bj < 2; ++bj) {
                    const int colb = u.pn * BM + bj * HALF + wc * 32;
                    f32x4 v0 = acc[ai][bj][m][0], v1 = acc[ai][bj][m][1];
                    if (((colb >> 5) % 3) == 2) { const f32x4 a = v0 * cv - v1 * sv, b = v1 * cv + v0 * sv; v0 = a; v1 = b; }
                    bf16_t* rp = O + (size_t)row * ldc + colb + 4 * fq;
                    u32x2 w0, w1; w0.x = cvt_pk_bf16(v0[0], v0[1]); w0.y = cvt_pk_bf16(v0[2], v0[3]); w1.x = cvt_pk_bf16(v1[0], v1[1]); w1.y = cvt_pk_bf16(v1[2], v1[3]);
                    *(u32x2*)(rp) = w0; *(u32x2*)(rp + 16) = w1;
                }
                asm volatile("" ::: "memory");
            }
    }
};
struct EpiResF32 {
    static constexpr bool PERM = false, AFTER_DRAIN = false;
    const float* base; float* out; int ldc;
    __device__ __forceinline__ void operator()(const f32x4 (&acc)[2][2][4][2], const Unit& u, int wr, int wc, int fr, int fq) const {
        const int row0 = u.pm * BM + wr * 64 + fr, col0 = u.pn * BM + wc * 32 + 4 * fq;
#pragma unroll
        for (int ai = 0; ai < 2; ++ai)
#pragma unroll
            for (int m = 0; m < 4; ++m) {
                const size_t off = (size_t)(row0 + ai * HALF + m * 16) * ldc + col0;
#pragma unroll
                for (int bj = 0; bj < 2; ++bj)
#pragma unroll
                    for (int n = 0; n < 2; ++n) { const f32x4 b = *(const f32x4*)(base + off + bj * HALF + n * 16); *(f32x4*)(out + off + bj * HALF + n * 16) = b + acc[ai][bj][m][n]; }
                asm volatile("" ::: "memory");
            }
    }
};
struct PanelRms {
    float* xbuf;
    unsigned* cnt;
    float eps;
    __device__ __forceinline__ void run(const f32x4 (&v)[2][2][4][2], const Unit& u, int wr, int wc, int fr, int fq, PG8_LAS unsigned char* lds, int wid, int lane) const {
        PG8_LAS float* P = (PG8_LAS float*)lds;
        PG8_LAS float* S = (PG8_LAS float*)(lds + 4096);
#pragma unroll
        for (int ai = 0; ai < 2; ++ai)
#pragma unroll
            for (int m = 0; m < 4; ++m) {
                float s = 0.f;
#pragma unroll
                for (int bj = 0; bj < 2; ++bj)
#pragma unroll
                    for (int n = 0; n < 2; ++n) { const f32x4 x = v[ai][bj][m][n]; s += (x[0] * x[0] + x[1] * x[1]) + (x[2] * x[2] + x[3] * x[3]); }
                s += __shfl_xor(s, 16); s += __shfl_xor(s, 32);
                if (fq == 0) P[(ai * HALF + wr * 64 + m * 16 + fr) * 4 + wc] = s;
            }
        asm volatile("s_waitcnt lgkmcnt(0)" ::: "memory"); __builtin_amdgcn_s_barrier(); asm volatile("" ::: "memory");
        const int row = wid * 32 + (lane & 31);
        if (lane < 32) {
            const float t = (P[row * 4 + 0] + P[row * 4 + 1]) + (P[row * 4 + 2] + P[row * 4 + 3]);
            __hip_atomic_store(xbuf + ((size_t)(u.pm * BM + row) * 4 + u.pn), t, __ATOMIC_RELAXED, __HIP_MEMORY_SCOPE_AGENT);
        }
        asm volatile("s_waitcnt vmcnt(0)" ::: "memory");
        if (lane == 0) __hip_atomic_fetch_add(cnt + 64 * u.pm, 1u, __ATOMIC_RELAXED, __HIP_MEMORY_SCOPE_AGENT);
        if (wid == 0) {
            unsigned spins = 0;
            while ((unsigned)__builtin_amdgcn_readfirstlane(__hip_atomic_load(cnt + 64 * u.pm, __ATOMIC_RELAXED, __HIP_MEMORY_SCOPE_AGENT)) < 32u) { __builtin_amdgcn_s_sleep(2); if (++spins > (1u << 20)) break; }
            __builtin_amdgcn_fence(__ATOMIC_ACQUIRE, "agent");
        }
        asm volatile("s_waitcnt vmcnt(0) lgkmcnt(0)" ::: "memory"); __builtin_amdgcn_s_barrier(); asm volatile("" ::: "memory");
        if (lane < 32) {
            const float* slot = xbuf + (size_t)(u.pm * BM + row) * 4; float q = 0.f;
#pragma unroll
            for (int t = 0; t < 4; ++t) q += __hip_atomic_load(slot + t, __ATOMIC_RELAXED, __HIP_MEMORY_SCOPE_AGENT);
            S[row] = 1.0f / sqrtf(q * (1.0f / 1024.0f) + eps);
        }
        asm volatile("s_waitcnt lgkmcnt(0)" ::: "memory"); __builtin_amdgcn_s_barrier(); asm volatile("" ::: "memory");
    }
};
struct EpiRmsOut {
    static constexpr bool PERM = false, AFTER_DRAIN = true;
    const float* base; float* out; const float* g; int ldc; PanelRms st;
    __device__ __forceinline__ void fused(f32x4 (&acc)[2][2][4][2], const Unit& u, int wr, int wc, int fr, int fq, PG8_LAS unsigned char* lds, int wid, int lane) const {
        const PG8_LAS float* S = (const PG8_LAS float*)(lds + 4096);
        const int col0 = u.pn * BM + wc * 32 + 4 * fq;
#pragma unroll
        for (int ai = 0; ai < 2; ++ai)
#pragma unroll
            for (int m = 0; m < 4; ++m) { const size_t off = (size_t)(u.pm * BM + ai * HALF + wr * 64 + m * 16 + fr) * ldc + col0;
#pragma unroll
                for (int bj = 0; bj < 2; ++bj)
#pragma unroll
                    for (int n = 0; n < 2; ++n) acc[ai][bj][m][n] += *(const f32x4*)(base + off + bj * HALF + n * 16);
                asm volatile("" : "+v"(acc[ai][0][m][0]), "+v"(acc[ai][0][m][1]), "+v"(acc[ai][1][m][0]), "+v"(acc[ai][1][m][1]));
                if (m & 1) asm volatile("" ::: "memory"); }
        st.run(acc, u, wr, wc, fr, fq, lds, wid, lane);
#pragma unroll
        for (int bj = 0; bj < 2; ++bj)
#pragma unroll
            for (int n = 0; n < 2; ++n) { const f32x4 gv = *(const f32x4*)(g + col0 + bj * HALF + n * 16);
#pragma unroll
                for (int ai = 0; ai < 2; ++ai)
#pragma unroll
                    for (int m = 0; m < 4; ++m) { const int r = ai * HALF + wr * 64 + m * 16 + fr; const float rs = S[r];
                        *(f32x4*)(out + (size_t)(u.pm * BM + r) * ldc + col0 + bj * HALF + n * 16) = acc[ai][bj][m][n] * rs * gv; } }
    }
};
template <class Epi, class Sched, bool ALIGN_EPI = false, bool SP2 = false>
__device__ __forceinline__ void gemm_phase(PG8_LAS unsigned char* lds, const Gemm g, const Sched& S, const Epi& E) {
    const int tid = threadIdx.x, wid = __builtin_amdgcn_readfirstlane(tid >> 6), lane = tid & 63, wr = wid >> 2, wc = wid & 3, fr = lane & 15, fq = lane >> 4;
    const int K = g.K, nt = K / BK;
    unsigned voffA[2], voffB[2];
#pragma unroll
    for (int i = 0; i < 2; ++i) { int R, C; stage_rc(tid * 16 + i * 8192, R, C); const int Rb = Epi::PERM ? ((R & ~31) + perm32(R & 31)) : R;
        voffA[i] = (unsigned)(R * K + C) * 2u; voffB[i] = (unsigned)(Rb * K + C) * 2u; }
    const size_t kstep = (size_t)(BK * 2);
    const size_t hstep = (size_t)HALF * K * 2;
    const size_t tstep = 2 * hstep;
    const unsigned ldsw = (unsigned)wid * 1024u;
    const int aoff = lds_byte(wr * 64 + fr, fq * 8), boff = lds_byte(wc * 32 + fr, fq * 8);
#define PG8_SA(b, h) (((b) * 2 + (h)) * HTB)
#define PG8_SB(b, h) ((4 + (b) * 2 + (h)) * HTB)
#define PG8_STAGE(bufoff, gbase, voff) do { _Pragma("unroll") for (int _i = 0; _i < 2; ++_i) \
        __builtin_amdgcn_global_load_lds((const unsigned*)((const char*)(gbase) + (voff)[_i]), (PG8_LAS unsigned*)(lds + (bufoff) + ldsw + _i * 8192), 16, 0, 0); } while (0)
#define PG8_LDA(dst, b, h) do { _Pragma("unroll") for (int m = 0; m < 4; ++m) _Pragma("unroll") for (int k = 0; k < 2; ++k) dst[m][k] = *(const PG8_LAS bf16x8*)(lds + PG8_SA(b, h) + aoff + m * 2048 + k * 1024); } while (0)
#define PG8_LDB(dst, b, h) do { _Pragma("unroll") for (int n = 0; n < 2; ++n) _Pragma("unroll") for (int k = 0; k < 2; ++k) dst[n][k] = *(const PG8_LAS bf16x8*)(lds + PG8_SB(b, h) + boff + n * 2048 + k * 1024); } while (0)
#define PG8_MMA(ai, bj, At, Bt) do { __builtin_amdgcn_s_setprio(1); _Pragma("unroll") for (int m = 0; m < 4; ++m) _Pragma("unroll") for (int n = 0; n < 2; ++n) _Pragma("unroll") for (int k = 0; k < 2; ++k) \
        acc[ai][bj][m][n] = __builtin_amdgcn_mfma_f32_16x16x32_bf16(Bt[n][k], At[m][k], acc[ai][bj][m][n], 0, 0, 0); __builtin_amdgcn_s_setprio(0); } while (0)
#define PG8_WAIT_V(n) asm volatile("s_waitcnt vmcnt(" #n ")" ::: "memory")
#define PG8_WAIT_L(n) asm volatile("s_waitcnt lgkmcnt(" #n ")" ::: "memory")
#define PG8_BAR __builtin_amdgcn_s_barrier()
#define PG8_SCHED __builtin_amdgcn_sched_barrier(0)
    Unit cur, nxt; int ui = 0;
    if (!S.next(0, cur)) return;
    f32x4 acc[2][2][4][2];
#pragma unroll
    for (int a = 0; a < 2; ++a)
#pragma unroll
        for (int b = 0; b < 2; ++b)
#pragma unroll
            for (int m = 0; m < 4; ++m)
#pragma unroll
                for (int n = 0; n < 2; ++n) acc[a][b][m][n] = (f32x4){0.f, 0.f, 0.f, 0.f};
    bf16x8 At[4][2], B0[2][2], B1[2][2];
    const char* cA = (const char*)g.A + (size_t)cur.pm * tstep; const char* cB = (const char*)g.Bt + (size_t)cur.pn * tstep;
    S.a_ready(cur);
    if constexpr (SP2) {
        PG8_STAGE(PG8_SB(0, 0), cB, voffB); PG8_STAGE(PG8_SB(0, 1), cB + hstep, voffB); PG8_STAGE(PG8_SA(0, 0), cA, voffA); PG8_STAGE(PG8_SA(0, 1), cA + hstep, voffA);
        if (wr == 1) PG8_BAR;
        PG8_WAIT_V(2); PG8_BAR;
        PG8_STAGE(PG8_SB(1, 0), cB + kstep, voffB); PG8_STAGE(PG8_SA(1, 0), cA + kstep, voffA); PG8_STAGE(PG8_SB(1, 1), cB + hstep + kstep, voffB);
        PG8_WAIT_V(6); PG8_BAR;
    } else {
        PG8_STAGE(PG8_SB(0, 0), cB, voffB); PG8_STAGE(PG8_SA(0, 0), cA, voffA); PG8_STAGE(PG8_SB(0, 1), cB + hstep, voffB); PG8_STAGE(PG8_SA(0, 1), cA + hstep, voffA);
        if (wr == 1) PG8_BAR;
        PG8_WAIT_V(4); PG8_BAR;
        PG8_STAGE(PG8_SB(1, 0), cB + kstep, voffB); PG8_STAGE(PG8_SA(1, 0), cA + kstep, voffA); PG8_STAGE(PG8_SB(1, 1), cB + hstep + kstep, voffB);
        PG8_WAIT_V(6); PG8_BAR;
    }
    for (;;) {
        const bool has_next = S.next(ui + 1, nxt);
        const char* nA = has_next ? (const char*)g.A + (size_t)nxt.pm * tstep : cA; const char* nB = has_next ? (const char*)g.Bt + (size_t)nxt.pn * tstep : cB;
        for (int t = 0; t < nt; t += 2) {
            const bool last = (t == nt - 2);
            const char* a1 = cA + (size_t)(t + 1) * kstep;
            const char* a2 = last ? nA : cA + (size_t)(t + 2) * kstep; const char* b2 = last ? nB : cB + (size_t)(t + 2) * kstep;
            const char* a3 = a2 + kstep; const char* b3 = b2 + kstep;
            if (last && has_next) S.a_ready(nxt);
            if constexpr (SP2) {
            PG8_LDB(B0, 0, 0); PG8_LDB(B1, 0, 1); PG8_SCHED; PG8_LDA(At, 0, 0); PG8_STAGE(PG8_SA(1, 1), a1 + hstep, voffA);
            PG8_WAIT_V(8); PG8_WAIT_L(0); PG8_BAR; PG8_MMA(0, 0, At, B0); PG8_MMA(0, 1, At, B1); PG8_BAR; PG8_SCHED;
            PG8_LDA(At, 0, 1); PG8_STAGE(PG8_SB(0, 0), b2, voffB); PG8_STAGE(PG8_SB(0, 1), b2 + hstep, voffB); PG8_STAGE(PG8_SA(0, 0), a2, voffA);
            PG8_WAIT_V(8); PG8_WAIT_L(0); PG8_BAR; PG8_MMA(1, 0, At, B0); PG8_MMA(1, 1, At, B1); PG8_BAR; PG8_SCHED;
            PG8_LDB(B0, 1, 0); PG8_LDB(B1, 1, 1); PG8_SCHED; PG8_LDA(At, 1, 0); PG8_STAGE(PG8_SA(0, 1), a2 + hstep, voffA);
            PG8_WAIT_V(8); PG8_WAIT_L(0); PG8_BAR; PG8_MMA(0, 0, At, B0); PG8_MMA(0, 1, At, B1); PG8_BAR; PG8_SCHED;
            PG8_LDA(At, 1, 1); PG8_STAGE(PG8_SB(1, 0), b3, voffB); PG8_STAGE(PG8_SB(1, 1), b3 + hstep, voffB); PG8_STAGE(PG8_SA(1, 0), a3, voffA);
            PG8_WAIT_V(8); PG8_WAIT_L(0); PG8_BAR; PG8_MMA(1, 0, At, B0); PG8_MMA(1, 1, At, B1); PG8_BAR; PG8_SCHED;
            } else {
            PG8_LDB(B0, 0, 0); PG8_SCHED; PG8_LDA(At, 0, 0); PG8_STAGE(PG8_SA(1, 1), a1 + hstep, voffA);
            PG8_WAIT_L(8); PG8_BAR; PG8_WAIT_L(0); PG8_MMA(0, 0, At, B0); PG8_BAR; PG8_SCHED;
            PG8_LDB(B1, 0, 1); PG8_STAGE(PG8_SB(0, 0), b2, voffB);
            PG8_BAR; PG8_WAIT_L(0); PG8_MMA(0, 1, At, B1); PG8_BAR;
            PG8_LDA(At, 0, 1); PG8_STAGE(PG8_SA(0, 0), a2, voffA);
            PG8_BAR; PG8_WAIT_L(0); PG8_MMA(1, 0, At, B0); PG8_BAR; PG8_SCHED;
            PG8_STAGE(PG8_SB(0, 1), b2 + hstep, voffB);
            PG8_WAIT_V(6); PG8_BAR; PG8_MMA(1, 1, At, B1); PG8_BAR;
            PG8_LDB(B0, 1, 0); PG8_SCHED; PG8_LDA(At, 1, 0); PG8_STAGE(PG8_SA(0, 1), a2 + hstep, voffA);
            PG8_WAIT_L(8); PG8_BAR; PG8_WAIT_L(0); PG8_MMA(0, 0, At, B0); PG8_BAR; PG8_SCHED;
            PG8_LDB(B1, 1, 1); PG8_STAGE(PG8_SB(1, 0), b3, voffB);
            PG8_BAR; PG8_WAIT_L(0); PG8_MMA(0, 1, At, B1); PG8_BAR;
            PG8_LDA(At, 1, 1); PG8_STAGE(PG8_SA(1, 0), a3, voffA);
            PG8_BAR; PG8_WAIT_L(0); PG8_MMA(1, 0, At, B0); PG8_BAR; PG8_SCHED;
            PG8_STAGE(PG8_SB(1, 1), b3 + hstep, voffB);
            PG8_WAIT_V(6); PG8_BAR; PG8_MMA(1, 1, At, B1); PG8_BAR;
            }
        }
        if constexpr (ALIGN_EPI) { if (wr == 0) PG8_BAR; }
        if constexpr (!Epi::AFTER_DRAIN) { E(acc, cur, wr, wc, fr, fq); S.done(cur); }
        if (!has_next) break;
#pragma unroll
        for (int a = 0; a < 2; ++a)
#pragma unroll
            for (int b = 0; b < 2; ++b)
#pragma unroll
                for (int m = 0; m < 4; ++m)
#pragma unroll
                    for (int n = 0; n < 2; ++n) acc[a][b][m][n] = (f32x4){0.f, 0.f, 0.f, 0.f};
        cur = nxt; cA = nA; cB = nB; ++ui;
        if constexpr (ALIGN_EPI) { if (wr == 1) PG8_BAR; }
    }
    PG8_WAIT_V(0);
    if constexpr (!ALIGN_EPI) { if (wr == 0) PG8_BAR; }
    PG8_BAR;
    if constexpr (Epi::AFTER_DRAIN) { E.fused(acc, cur, wr, wc, fr, fq, lds, wid, lane); S.done(cur); }
#undef PG8_SA
#undef PG8_SB
#undef PG8_STAGE
#undef PG8_LDA
#undef PG8_LDB
#undef PG8_MMA
#undef PG8_WAIT_V
#undef PG8_WAIT_L
#undef PG8_BAR
#undef PG8_SCHED
}
}
#define LAS __attribute__((address_space(3)))
typedef unsigned short bf16;
typedef short bf16x8 __attribute__((ext_vector_type(8)));
typedef float f32x16 __attribute__((ext_vector_type(16)));
typedef float f32x4 __attribute__((ext_vector_type(4)));
typedef float f32x2 __attribute__((ext_vector_type(2)));
typedef unsigned u32x4 __attribute__((ext_vector_type(4)));
typedef unsigned u32x2 __attribute__((ext_vector_type(2)));
typedef __bf16 bf16x2_t __attribute__((ext_vector_type(2)));

constexpr int BATCH = 8, SEQ = 4096, DM = 1024, M = BATCH * SEQ;
constexpr int N0 = 2208, N0P = 2304;
constexpr int C_CQ = 0, C_CKV = 256, C_KPE = 384, C_QS = 416, C_KS = 928, C_VS = 1056, C_G0 = 1184;
constexpr int N1W = 4112, N1 = 4096;
constexpr int C1_Q = 0, C1_K = 1024, C1_V = 2048, C1_G = 3072, W1_F = 3072, W1_G = 3088;
constexpr float EPS = 1e-6f, LOG2E = 1.4426950408889634f;
constexpr int NTHREADS = 512, NWAVES = 8;

constexpr size_t MiB = 1u << 20;
constexpr size_t WS_WT0 = 1 * MiB;
constexpr size_t WS_WQUP = 6 * MiB;
constexpr size_t WS_WKVUP = 7 * MiB;
constexpr size_t WS_WOUT0 = 8 * MiB;
constexpr size_t WS_WT1 = 10 * MiB;
constexpr size_t WS_WOUT1 = 18 * MiB;
constexpr size_t WS_XN = 32 * MiB;
constexpr size_t WS_OG = 96 * MiB;
constexpr size_t WS_LF = 160 * MiB;
constexpr size_t WS_LC = 162 * MiB;
constexpr size_t WS_TMAX = 512 * 1024;
constexpr size_t WS_CS = 164 * MiB;
constexpr size_t WS_Z1 = 168 * MiB;
constexpr size_t WS_Z0 = 168 * MiB;
constexpr size_t WS_CQN = 312 * MiB;
constexpr size_t WS_CKVN = 328 * MiB;
constexpr size_t WS_KPE = 344 * MiB;
constexpr size_t WS_Q0 = 346 * MiB;
constexpr size_t WS_KN = 394 * MiB;
constexpr size_t WS_VM = 426 * MiB;
constexpr size_t WS_END = 458 * MiB;
constexpr int LDS_BYTES = 135168, LDS_MISC = 131072 + 1024;

__device__ __forceinline__ unsigned cvtpk(float lo, float hi) { f32x2 v = {lo, hi}; bf16x2_t b = __builtin_convertvector(v, bf16x2_t); return __builtin_bit_cast(unsigned, b); }
__device__ __forceinline__ float bflo(unsigned u) { return __uint_as_float(u << 16); }
__device__ __forceinline__ float bfhi(unsigned u) { return __uint_as_float(u & 0xffff0000u); }
__device__ __forceinline__ float bf1(bf16 v) { return __uint_as_float(((unsigned)v) << 16); }
__device__ __forceinline__ float wave_sum(float v) {
#pragma unroll
    for (int o = 1; o < 64; o <<= 1) v += __shfl_xor(v, o);
    return v;
}

struct AttnP { const bf16 *Q, *K, *K2, *V, *G; bf16* O; const float* lc; const float* tmax; const float* sinkp; int h0; int ldq, ldk, ldk2, ldv, ldg, ldo; float c, sink2, slope2; };

typedef short v4i16_t __attribute__((ext_vector_type(4)));
__device__ __forceinline__ void glds16(const void* gsrc, unsigned lds_dst) { unsigned keep;
    asm volatile("s_mov_b32 %0, m0\n\ts_mov_b32 m0, %2\n\ts_nop 0\n\tglobal_load_lds_dwordx4 %1, off\n\ts_mov_b32 m0, %0" : "=&s"(keep) : "v"(gsrc), "s"(lds_dst) : "memory"); }
__device__ __forceinline__ void glds4(const void* gsrc, unsigned lds_dst) { unsigned keep;
    asm volatile("s_mov_b32 %0, m0\n\ts_mov_b32 m0, %2\n\ts_nop 0\n\tglobal_load_lds_dword %1, off\n\ts_mov_b32 m0, %0" : "=&s"(keep) : "v"(gsrc), "s"(lds_dst) : "memory"); }
#define AT_WAITV(n) asm volatile("s_waitcnt vmcnt(%0) lgkmcnt(0)" :: "n"(n) : "memory")
template <int DK, int MODE>
__device__ __forceinline__ void attn_unit(const AttnP& p, const int q0, LAS unsigned char* lds) {
    constexpr int NS = 4, KN_B = 8192, KP_B = (DK == 96) ? 4096 : 0, VHALF = 4160, V_B = 2 * VHALF, LC_B = (MODE == 2) ? 256 : 0;
    constexpr int OFF_KP = KN_B, OFF_V = KN_B + KP_B, OFF_LC = OFF_V + V_B, SLOT = OFF_LC + LC_B, OFF_FLAG = NS * SLOT;
    constexpr int NPT = 2 + ((DK == 96 || MODE == 2) ? 1 : 0);
    const int tid = threadIdx.x, lane = tid & 63, wid = __builtin_amdgcn_readfirstlane(tid >> 6), r32 = lane & 31, hi = lane >> 5;
    const int hsel = (MODE == 1) ? (wid >> 1) : 0;
    const int qw0 = q0 + 32 * ((MODE == 1) ? (wid & 1) : wid), q = qw0 + r32;
    const bf16* Qp = p.Q + hsel * 64; const bf16* Gp = p.G + hsel * 64; bf16* Op = p.O + hsel * 64;
    float sink2 = 0.f, slope2 = 0.f;
    if (MODE == 1) { const int hh = p.h0 + hsel; sink2 = p.sinkp[hh] * LOG2E; slope2 = exp2f(-(float)(hh + 1)) * LOG2E; }
    const unsigned lds0 = (unsigned)(uintptr_t)lds;
    bf16x8 qf[DK / 16];
#pragma unroll
    for (int d0 = 0; d0 < DK / 16; ++d0) qf[d0] = *(const bf16x8*)(Qp + (size_t)q * p.ldq + 16 * d0 + 8 * hi);
#pragma unroll
    for (int d0 = 0; d0 < DK / 16; ++d0) asm volatile("" : "+v"(qf[d0]));
    const int t_hi = (MODE == 1) ? (q0 >> 6) : (((q0 + 256) >> 6) - 1);
    const int t_lo = (MODE == 1) ? (((q0 >> 6) >= 2) ? (q0 >> 6) - 2 : 0) : 0;
    const int ntile = t_hi - t_lo + 1;
    const int krow = 8 * wid + (lane >> 3), kch = (lane & 7) ^ ((krow >> 1) & 7);
    const bf16* ksrc = p.K + (size_t)krow * p.ldk + kch * 8;
    const int prow = 8 * wid + ((lane & 31) >> 2), pch = (lane & 3) ^ ((prow >> 2) & 3);
    const bf16* psrc = (DK == 96) ? (p.K2 + (size_t)prow * p.ldk2 + pch * 8) : p.K;
    const int vrow = 16 * (wid & 3) + (lane >> 2);
    const bf16* vsrc = p.V + (size_t)vrow * p.ldv + ((wid >> 2) * 4 + (lane & 3)) * 8;
    const float* lsrc = (MODE == 2) ? (p.lc + 8 * wid + (lane & 7)) : (const float*)p.K;
#define AT_DMA(t, slot) do { const size_t ro_ = (size_t)(t) * 64; const unsigned sb_ = lds0 + (unsigned)((slot) * SLOT); \
        glds16(ksrc + ro_ * p.ldk, (unsigned)__builtin_amdgcn_readfirstlane(sb_ + wid * 1024)); \
        glds16(vsrc + ro_ * p.ldv, (unsigned)__builtin_amdgcn_readfirstlane(sb_ + OFF_V + (wid >> 2) * VHALF + (wid & 3) * 1024)); \
        if (DK == 96) { if (lane < 32) glds16(psrc + ro_ * p.ldk2, (unsigned)__builtin_amdgcn_readfirstlane(sb_ + OFF_KP + wid * 512)); } \
        if (MODE == 2) { if (lane < 8) glds4(lsrc + ro_, (unsigned)__builtin_amdgcn_readfirstlane(sb_ + OFF_LC + wid * 32)); } } while (0)

    float m_run = (MODE == 1) ? sink2 : -INFINITY;
    float l_run = (MODE == 1 && hi == 0) ? 1.f : 0.f;
    f32x16 ot[2];
#pragma unroll
    for (int r = 0; r < 16; ++r) { ot[0][r] = 0.f; ot[1][r] = 0.f; }
    const int pim = 16 * (r32 >> 4) + 8 * ((r32 >> 2) & 1) + 4 * ((r32 >> 3) & 1) + (r32 & 3);
    const int vrd = (8 * hi + ((lane & 15) >> 2)) * 64 + ((lane >> 4) & 1) * 32 + (lane & 3) * 8;
    int koff[4], poff[2];
#pragma unroll
    for (int d0 = 0; d0 < 4; ++d0) koff[d0] = pim * 128 + (((2 * d0 + hi) ^ ((pim >> 1) & 7)) * 16);
#pragma unroll
    for (int j = 0; j < 2; ++j) poff[j] = OFF_KP + pim * 64 + (((2 * j + hi) ^ ((pim >> 2) & 3)) * 16);
    float pmv = 0.f, lcev = 0.f, qn = 0.f;
    if (MODE == 2) {
        pmv = (lane <= t_hi) ? p.tmax[lane] : 0.f;
#pragma unroll
        for (int o = 1; o < 64; o <<= 1) { const float n = __shfl_up(pmv, o); if (lane >= o) pmv = fmaxf(pmv, n); }
        lcev = (lane <= t_hi) ? p.lc[64 * lane + 63] : 0.f;
        float qs = 0.f;
#pragma unroll
        for (int d0 = 0; d0 < DK / 16; ++d0)
#pragma unroll
            for (int e = 0; e < 8; ++e) { const float f = bf1((bf16)qf[d0][e]); qs += f * f; }
        qs += __shfl_xor(qs, 32);
        qn = sqrtf(qs) * p.c * 1.002f;
    }
    AT_DMA(t_hi, 0);
    if (ntile > 1) AT_DMA(t_hi - 1, 1);
    if (ntile > 2) AT_DMA(t_hi - 2, 2);
    for (int i = 0; i < ntile; ++i) {
        const int t = t_hi - i, kv0 = t * 64, rem = ntile - 1 - i;
        if (rem >= 2) AT_WAITV(2 * NPT); else if (rem == 1) AT_WAITV(NPT); else AT_WAITV(0);
        __builtin_amdgcn_s_barrier();
        asm volatile("" ::: "memory");
        if (MODE == 2) { if (i > 0) {
            const LAS unsigned char* fp = lds + OFF_FLAG + ((i - 1) & 1) * 32;
            const u32x4 f0 = *(const LAS u32x4*)(fp), f1 = *(const LAS u32x4*)(fp + 16);
            if ((f0.x & f0.y & f0.z & f0.w & f1.x & f1.y & f1.z & f1.w) != 0u) break; } }
        if (rem >= 3) AT_DMA(t - 3, (i + 3) & 3);
        const LAS unsigned char* sb = lds + (i & 3) * SLOT;
        bool act = kv0 <= qw0 + 31;
        if (MODE == 1) act = act && (kv0 + 63 >= qw0 - 127);
        if (act) {
            f32x16 s[2];
            {
                bf16x8 kf[2][DK / 16];
#pragma unroll
                for (int ph = 0; ph < 2; ++ph) {
#pragma unroll
                    for (int d0 = 0; d0 < 4; ++d0) kf[ph][d0] = *(const LAS bf16x8*)(sb + koff[d0] + ph * 4096);
                    if (DK == 96) {
#pragma unroll
                        for (int j = 0; j < 2; ++j) kf[ph][(DK == 96) ? 4 + j : 0] = *(const LAS bf16x8*)(sb + poff[j] + ph * 2048);
                    }
                }
#pragma unroll
                for (int r = 0; r < 16; ++r) { s[0][r] = 0.f; s[1][r] = 0.f; }
                __builtin_amdgcn_sched_barrier(0);
#pragma unroll
                for (int d0 = 0; d0 < DK / 16; ++d0) {
                    s[0] = __builtin_amdgcn_mfma_f32_32x32x16_bf16(kf[0][d0], qf[d0], s[0], 0, 0, 0);
                    s[1] = __builtin_amdgcn_mfma_f32_32x32x16_bf16(kf[1][d0], qf[d0], s[1], 0, 0, 0);
                }
                __builtin_amdgcn_sched_barrier(0);
            }
            if (MODE == 2) {
                const LAS float* lcb = (const LAS float*)(sb + OFF_LC);
#pragma unroll
                for (int ph = 0; ph < 2; ++ph)
#pragma unroll
                    for (int j = 0; j < 4; ++j) { const f32x4 lk = *(const LAS f32x4*)(lcb + 32 * ph + 16 * (j >> 1) + 8 * hi + 4 * (j & 1));
#pragma unroll
                        for (int ii = 0; ii < 4; ++ii) s[ph][4 * j + ii] = s[ph][4 * j + ii] * p.c - lk[ii]; }
            } else if (MODE == 1) {
                const float dq = (float)(q - kv0 - 8 * hi);
#pragma unroll
                for (int ph = 0; ph < 2; ++ph)
#pragma unroll
                    for (int r = 0; r < 16; ++r) { const int kk = 32 * ph + 16 * (r >> 3) + 4 * ((r >> 2) & 1) + (r & 3); s[ph][r] = s[ph][r] * p.c - slope2 * (dq - (float)kk); }
            }
            bool needmask = (kv0 + 63 > qw0);
            if (MODE == 1) needmask = needmask || (kv0 < qw0 + 31 - 127);
            if (needmask) {
                const int dqi = q - kv0 - 8 * hi;
#pragma unroll
                for (int ph = 0; ph < 2; ++ph)
#pragma unroll
                    for (int r = 0; r < 16; ++r) { const int kk = 32 * ph + 16 * (r >> 3) + 4 * ((r >> 2) & 1) + (r & 3); const int dist = dqi - kk;
                        bool ok = dist >= 0; if (MODE == 1) ok = ok && (dist < 128); s[ph][r] = ok ? s[ph][r] : -INFINITY; }
            }
            float mx = fmaxf(fmaxf(s[0][0], s[0][1]), s[0][2]);
#pragma unroll
            for (int r = 3; r < 15; r += 2) mx = fmaxf(fmaxf(mx, s[0][r]), s[0][r + 1]);
            mx = fmaxf(mx, s[0][15]);
#pragma unroll
            for (int r = 0; r < 16; r += 2) mx = fmaxf(fmaxf(mx, s[1][r]), s[1][r + 1]);
            mx = fmaxf(mx, __shfl_xor(mx, 32));
            if (MODE == 0) mx *= p.c;
            const bool dead = (MODE == 2) && __all(mx < m_run - 40.f);
            if (!dead) {
                const float m_new = fmaxf(m_run, mx);
                const float alpha = __builtin_amdgcn_exp2f(m_run - m_new);
                m_run = m_new;
                float ls0 = 0.f, ls1 = 0.f;
#pragma unroll
                for (int ph = 0; ph < 2; ++ph)
#pragma unroll
                    for (int r = 0; r < 16; r += 2) {
                        const float e0 = __builtin_amdgcn_exp2f(MODE == 0 ? (s[ph][r] * p.c - m_new) : (s[ph][r] - m_new));
                        const float e1 = __builtin_amdgcn_exp2f(MODE == 0 ? (s[ph][r + 1] * p.c - m_new) : (s[ph][r + 1] - m_new));
                        s[ph][r] = e0; s[ph][r + 1] = e1; ls0 += e0; ls1 += e1; }
                if (__any(alpha != 1.f)) {
                    l_run *= alpha;
#pragma unroll
                    for (int r = 0; r < 16; ++r) { ot[0][r] *= alpha; ot[1][r] *= alpha; }
                }
                l_run += ls0 + ls1;
                bf16x8 pk[4];
#pragma unroll
                for (int cc = 0; cc < 4; ++cc) { const int ph = cc >> 1, o = 8 * (cc & 1); u32x4 w;
                    w.x = cvtpk(s[ph][o + 0], s[ph][o + 1]); w.y = cvtpk(s[ph][o + 2], s[ph][o + 3]); w.z = cvtpk(s[ph][o + 4], s[ph][o + 5]); w.w = cvtpk(s[ph][o + 6], s[ph][o + 7]);
                    pk[cc] = __builtin_bit_cast(bf16x8, w); }
                const LAS unsigned char* vb = sb + OFF_V + vrd;
                bf16x8 vf[2][4];
#pragma unroll
                for (int dh = 0; dh < 2; ++dh)
#pragma unroll
                    for (int cc = 0; cc < 4; ++cc) {
                        const v4i16_t v0 = __builtin_amdgcn_ds_read_tr16_b64_v4i16((LAS v4i16_t*)(vb + dh * VHALF + cc * 1024));
                        const v4i16_t v1 = __builtin_amdgcn_ds_read_tr16_b64_v4i16((LAS v4i16_t*)(vb + dh * VHALF + cc * 1024 + 256));
                        vf[dh][cc] = (bf16x8){v0[0], v0[1], v0[2], v0[3], v1[0], v1[1], v1[2], v1[3]}; }
                __builtin_amdgcn_sched_barrier(0);
#pragma unroll
                for (int cc = 0; cc < 4; ++cc) {
                    ot[0] = __builtin_amdgcn_mfma_f32_32x32x16_bf16(vf[0][cc], pk[cc], ot[0], 0, 0, 0);
                    ot[1] = __builtin_amdgcn_mfma_f32_32x32x16_bf16(vf[1][cc], pk[cc], ot[1], 0, 0, 0);
                }
                __builtin_amdgcn_sched_barrier(0);
            }
        }
        if (MODE == 2) {
            bool dn = false;
            if (rem >= 1) { const float bnd = qn * __shfl(pmv, t - 1) - __shfl(lcev, t - 1); dn = __all(bnd < m_run - 40.f); }
            if (lane == 0) *(LAS unsigned*)(lds + OFF_FLAG + (i & 1) * 32 + wid * 4) = dn ? 1u : 0u;
        }
    }
    AT_WAITV(0);
    __builtin_amdgcn_s_barrier();
    asm volatile("" ::: "memory");
    const float lt = l_run + __shfl_xor(l_run, 32);
    const float inv = 1.f / lt;
#pragma unroll
    for (int dh = 0; dh < 2; ++dh)
#pragma unroll
        for (int j = 0; j < 4; ++j) {
            const int d = 32 * dh + 8 * j + 4 * hi;
            const u32x2 g = *(const u32x2*)(Gp + (size_t)q * p.ldg + d);
            const float g0 = bflo(g.x), g1 = bfhi(g.x), g2 = bflo(g.y), g3 = bfhi(g.y);
            const float o0 = ot[dh][4 * j + 0] * inv * (g0 / (1.f + __expf(-g0)));
            const float o1 = ot[dh][4 * j + 1] * inv * (g1 / (1.f + __expf(-g1)));
            const float o2 = ot[dh][4 * j + 2] * inv * (g2 / (1.f + __expf(-g2)));
            const float o3 = ot[dh][4 * j + 3] * inv * (g3 / (1.f + __expf(-g3)));
            u32x2 w; w.x = cvtpk(o0, o1); w.y = cvtpk(o2, o3);
            *(u32x2*)(Op + (size_t)q * p.ldo + d) = w;
        }
#undef AT_DMA
}

#define XB_TMO      128
#define XB_XCNT(j)  (256  + 64 * (j))
#define XB_XSUB(j)  (1280 + 64 * (j))
#define XB_XGEN(j)  (2304 + 64 * (j))
#define XB_TOP      3328
#define XB_TOPGEN   3392
#define XCD_BAR_WORDS 3456
#define XB_SPIN_CAP (1u << 18)

__device__ __forceinline__ unsigned xb_ld(unsigned* p)              { return __hip_atomic_load(p, __ATOMIC_RELAXED, __HIP_MEMORY_SCOPE_AGENT); }
__device__ __forceinline__ unsigned xb_add(unsigned* p, unsigned v) { return __hip_atomic_fetch_add(p, v, __ATOMIC_RELAXED, __HIP_MEMORY_SCOPE_AGENT); }
__device__ __forceinline__ unsigned xb_xcc_id() { return (unsigned)__builtin_amdgcn_s_getreg((3 << 11) | 20) & 0xFu; }
#define XB_SPIN(cond, bar) do { unsigned _sp = 0; while (cond) { __builtin_amdgcn_s_sleep(1); \
    if ((++_sp & 255u) == 0u) { if (xb_ld(&(bar)[XB_TMO])) break; if (_sp > XB_SPIN_CAP) { atomicAdd(&(bar)[XB_TMO], 1u); break; } } } } while (0)

struct XcdBarrier {
    unsigned* bar; unsigned x;
    volatile LAS unsigned* st;
};

__device__ __forceinline__ XcdBarrier xcd_barrier_post(unsigned* bar, volatile LAS unsigned* st) {
    XcdBarrier b; b.bar = bar; b.x = xb_xcc_id(); b.st = st;
    if (threadIdx.x == 0) (void)xb_add(&bar[XB_XCNT(b.x)], 1u);
    return b;
}
__device__ __forceinline__ void xcd_barrier_complete(unsigned* bar, unsigned x, unsigned& nloc, unsigned& nx) {
    const unsigned G = gridDim.x * gridDim.y * gridDim.z;
    unsigned sum, cnt, mine, sp = 0u;
    for (;;) {
        sum = 0u; cnt = 0u; mine = 0u;
#pragma unroll
        for (unsigned j = 0; j < 16; ++j) { const unsigned c = xb_ld(&bar[XB_XCNT(j)]); sum += c; cnt += (c > 0u) ? 1u : 0u; mine = (j == x) ? c : mine; }
        if (sum == G) break;
        __builtin_amdgcn_s_sleep(1);
        if ((++sp & 255u) == 0u) { if (xb_ld(&bar[XB_TMO])) break; if (sp > XB_SPIN_CAP) { atomicAdd(&bar[XB_TMO], 1u); break; } }
    }
    nloc = mine > 0u ? mine : 1u; nx = cnt > 0u ? cnt : 1u;
}

__device__ __forceinline__ void xcd_barrier(const XcdBarrier& b) {
    asm volatile("s_waitcnt vmcnt(0)" ::: "memory");
    __syncthreads();
    if (threadIdx.x == 0) {
        unsigned* bar = b.bar;
        __builtin_amdgcn_s_waitcnt(0);
        unsigned nloc = b.st[0], nx = b.st[1];
        if (nloc == 0u) { xcd_barrier_complete(bar, b.x, nloc, nx); b.st[0] = nloc; b.st[1] = nx; }
        const unsigned old = xb_add(&bar[XB_XSUB(b.x)], 1u);
        const unsigned gen = old / nloc;
        if (old + 1u == (gen + 1u) * nloc) {
            __builtin_amdgcn_fence(__ATOMIC_RELEASE, "agent");
            asm volatile("s_waitcnt vmcnt(0)" ::: "memory");
            const unsigned og = xb_add(&bar[XB_TOP], 1u);
            const unsigned tg = og / nx;
            if (og + 1u == (tg + 1u) * nx) xb_add(&bar[XB_TOPGEN], 1u);
            else XB_SPIN(xb_ld(&bar[XB_TOPGEN]) == tg, bar);
            __builtin_amdgcn_fence(__ATOMIC_ACQUIRE, "agent");
            xb_add(&bar[XB_XGEN(b.x)], 1u);
            asm volatile("s_waitcnt vmcnt(0)" ::: "memory");
        } else {
            XB_SPIN(xb_ld(&bar[XB_XGEN(b.x)]) == gen, bar);
            __builtin_amdgcn_fence(__ATOMIC_ACQUIRE, "agent");
            asm volatile("s_waitcnt vmcnt(0)" ::: "memory");
        }
    }
    __syncthreads();
}

struct Args { const float* in[15]; const int* pos; float* out; unsigned char* ws; int ph_lo, ph_hi; };

__device__ __forceinline__ void transpose_item(const float* W, int ldw, int col0, int k0, bf16* WT, int ldt, int row_off, LAS float* scr, int lane) {
#pragma unroll 8
    for (int i = 0; i < 32; ++i) { const int kk = 2 * i + (lane >> 5); scr[kk * 33 + (lane & 31)] = W[(size_t)(k0 + kk) * ldw + col0 + (lane & 31)]; }
    asm volatile("s_waitcnt lgkmcnt(0)" ::: "memory");
    const int c = lane & 7;
#pragma unroll
    for (int j = 0; j < 4; ++j) { const int n = (lane >> 3) + 8 * j; const LAS float* s = scr + (8 * c) * 33 + n;
        u32x4 o; o.x = cvtpk(s[0 * 33], s[1 * 33]); o.y = cvtpk(s[2 * 33], s[3 * 33]); o.z = cvtpk(s[4 * 33], s[5 * 33]); o.w = cvtpk(s[6 * 33], s[7 * 33]);
        *(u32x4*)(WT + (size_t)(row_off + n) * ldt + k0 + 8 * c) = o; }
    asm volatile("s_waitcnt lgkmcnt(0)" ::: "memory");
}

__device__ __forceinline__ void rms_row_to_bf16(const float* xrow, const float* g, bf16* orow, int lane) {
    const f32x4* xr = (const f32x4*)xrow + lane; const f32x4* gr = (const f32x4*)g + lane;
    f32x4 v[4]; float s = 0.f;
#pragma unroll
    for (int j = 0; j < 4; ++j) { v[j] = xr[64 * j]; s += (v[j].x * v[j].x + v[j].y * v[j].y) + (v[j].z * v[j].z + v[j].w * v[j].w); }
    const float rs = 1.f / sqrtf(wave_sum(s) * (1.f / DM) + EPS);
    u32x2* o8 = (u32x2*)orow + lane;
#pragma unroll
    for (int j = 0; j < 4; ++j) { const f32x4 gg = gr[64 * j]; u32x2 w; w.x = cvtpk(v[j].x * rs * gg.x, v[j].y * rs * gg.y); w.y = cvtpk(v[j].z * rs * gg.z, v[j].w * rs * gg.w); o8[64 * j] = w; }
}

template <bool COOP>
__global__ void __launch_bounds__(NTHREADS, 2) mk_fwd(Args args) {
    extern __shared__ __attribute__((aligned(16))) unsigned char lds_raw[];
    LAS unsigned char* lds = (LAS unsigned char*)lds_raw;
    const int tid = threadIdx.x, lane = tid & 63, wave = __builtin_amdgcn_readfirstlane(tid >> 6);
    const int G = gridDim.x, bx = blockIdx.x;
    const int vcu = (G % 8 == 0) ? (bx % 8) * (G / 8) + bx / 8 : bx;
    const int gw = vcu * NWAVES + wave, NGW = G * NWAVES;
    unsigned char* ws = args.ws;
    const float* x = args.in[0];
    bf16* Wt0 = (bf16*)(ws + WS_WT0); bf16* Wqup = (bf16*)(ws + WS_WQUP); bf16* Wkvup = (bf16*)(ws + WS_WKVUP); bf16* Wout0 = (bf16*)(ws + WS_WOUT0);
    bf16* Wt1 = (bf16*)(ws + WS_WT1); bf16* Wout1 = (bf16*)(ws + WS_WOUT1);
    bf16* XN = (bf16*)(ws + WS_XN); bf16* OG = (bf16*)(ws + WS_OG); float* LF = (float*)(ws + WS_LF); float* LC = (float*)(ws + WS_LC); float* CS = (float*)(ws + WS_CS); float* TMAXB = (float*)(ws + WS_TMAX);
    bf16* Z0 = (bf16*)(ws + WS_Z0); bf16* Z1 = (bf16*)(ws + WS_Z1); bf16* CQN = (bf16*)(ws + WS_CQN); bf16* CKVN = (bf16*)(ws + WS_CKVN); bf16* KPE = (bf16*)(ws + WS_KPE);
    bf16* Q0 = (bf16*)(ws + WS_Q0); bf16* KN = (bf16*)(ws + WS_KN); bf16* VM = (bf16*)(ws + WS_VM);
    float* out = args.out;
    const int lo = args.ph_lo, hi_ph = args.ph_hi;
#ifndef REPMASK
#define REPMASK 0
#endif
#define NREP(k) (1 + (((REPMASK) >> (k)) & 1))
#ifndef PHMASK
#define PHMASK 0xfff
#endif
#define IN(k) ((((PHMASK) >> (k)) & 1) && lo <= (k) && (k) < hi_ph)
#define SEAM(k) do { if constexpr (COOP) { if (IN(k) && IN((k) + 1)) { if ((k) == 0) { cg::this_grid().sync(); xbar = xcd_barrier_post(barw, (volatile LAS unsigned*)(lds + LDS_MISC)); } else { xcd_barrier(xbar); } } } } while (0)
    unsigned* qctr = (unsigned*)(ws + 256 * 1024);
    unsigned* barw = (unsigned*)ws;
    XcdBarrier xbar; xbar.bar = barw; xbar.x = 0; xbar.st = (volatile LAS unsigned*)(lds + LDS_MISC);
    if constexpr (COOP) {
        if (tid < 16) ((LAS unsigned*)(lds + LDS_MISC))[tid] = 0u;
        if (bx == 0) { for (int i = tid; i < XCD_BAR_WORDS; i += NTHREADS) barw[i] = 0u; for (int i = tid; i < 16 * 64; i += NTHREADS) qctr[i] = 0u; for (int i = tid; i < 2 * 64 * 64; i += NTHREADS) ((unsigned*)(ws + 64 * 1024))[i] = 0u; }
        __syncthreads();
    }

    if (IN(0)) {
        LAS float* scr = (LAS float*)(lds + wave * 16384);
        constexpr int I_A = 16 * 69, I_B = 4 * 24, I_C = 2 * 32, I_D = 16 * 32, I_E1 = 16 * 96, I_E2 = 16 * 32, I_F = 16 * 32;
        constexpr int NIT = I_A + I_B + I_C + I_D + I_E1 + I_E2 + I_F;
        for (int it = gw; it < NIT; it += NGW) {
            int r = it;
            if (r < I_A) { const int kb = r / 69, nb = r % 69; transpose_item(args.in[3], N0, 32 * nb, 64 * kb, Wt0, 1024, 32 * nb, scr, lane); continue; } r -= I_A;
            if (r < I_B) { const int kb = r / 24, nb = r % 24; transpose_item(args.in[5], 768, 32 * nb, 64 * kb, Wqup, 256, 32 * nb, scr, lane); continue; } r -= I_B;
            if (r < I_C) { const int kb = r / 32, nb = r % 32; const int n0 = 32 * nb, h = n0 >> 7, j0 = n0 & 127; const int dst = (j0 < 64) ? (h * 64 + j0) : (512 + h * 64 + (j0 - 64));
                           transpose_item(args.in[7], 1024, n0, 64 * kb, Wkvup, 256, dst, scr, lane); continue; } r -= I_C;
            if (r < I_D) { const int kb = r / 32, nb = r % 32; transpose_item(args.in[9], 1024, 32 * nb, 64 * kb, Wout0, 1024, 32 * nb, scr, lane); continue; } r -= I_D;
            if (r < I_E1) { const int kb = r / 96, nb = r % 96; transpose_item(args.in[11], N1W, 32 * nb, 64 * kb, Wt1, 1024, 32 * nb, scr, lane); continue; } r -= I_E1;
            if (r < I_E2) { const int kb = r / 32, nb = r % 32; transpose_item(args.in[11], N1W, W1_G + 32 * nb, 64 * kb, Wt1, 1024, C1_G + 32 * nb, scr, lane); continue; } r -= I_E2;
            { const int kb = r / 32, nb = r % 32; transpose_item(args.in[13], 1024, 32 * nb, 64 * kb, Wout1, 1024, 32 * nb, scr, lane); }
        }
        { const u32x4 z = {0u, 0u, 0u, 0u};
          u32x4* p0 = (u32x4*)(Wt0 + (size_t)N0 * 1024);
          for (int i = vcu * NTHREADS + tid; i < 96 * 1024 / 8; i += G * NTHREADS) p0[i] = z;
          for (int i = vcu * NTHREADS + tid; i < 1024 * 16; i += G * NTHREADS) { const int row = i >> 4, c = i & 15; *(u32x4*)(Wkvup + (size_t)row * 256 + 128 + c * 8) = z; } }
        for (int m = gw; m < M; m += NGW) rms_row_to_bf16(x + (size_t)m * DM, args.in[2], XN + (size_t)m * DM, lane);
    }
    SEAM(0);
    if (IN(1)) {
        __syncthreads();
        pg8::Gemm g{XN, Wt0, M, N0P, 1024}; pg8::StaticOrder S; S.init(M, N0P, G, bx);
        pg8::EpiBf16<0> E{Z0, N0P, nullptr, 0, 0, 1.f};
        for (int rep = 0; rep < NREP(1); ++rep) {
        pg8::gemm_phase<pg8::EpiBf16<0>, pg8::StaticOrder, true, true>(lds, g, S, E); __syncthreads(); }
    }
    SEAM(1);
    if (IN(2)) {
        const float* gq = args.in[4]; const float* gkv = args.in[6];
        for (int m = gw; m < M; m += NGW) {
            const bf16* z = Z0 + (size_t)m * N0P;
            const u32x2 a = *(const u32x2*)(z + C_CQ + 4 * lane);
            const unsigned bb = *(const unsigned*)(z + C_CKV + 2 * lane);
            const float a0 = bflo(a.x), a1 = bfhi(a.x), a2 = bflo(a.y), a3 = bfhi(a.y), b0 = bflo(bb), b1 = bfhi(bb);
            const float sa = wave_sum((a0 * a0 + a1 * a1) + (a2 * a2 + a3 * a3)), sb = wave_sum(b0 * b0 + b1 * b1);
            const float ra = 1.f / sqrtf(sa * (1.f / 256.f) + EPS), rb = 1.f / sqrtf(sb * (1.f / 128.f) + EPS);
            const f32x4 ga = *(const f32x4*)(gq + 4 * lane); const f32x2 gb = *(const f32x2*)(gkv + 2 * lane);
            u32x2 w; w.x = cvtpk(a0 * ra * ga.x, a1 * ra * ga.y); w.y = cvtpk(a2 * ra * ga.z, a3 * ra * ga.w);
            *(u32x2*)(CQN + (size_t)m * 256 + 4 * lane) = w;
            *(unsigned*)(CKVN + (size_t)m * 256 + 2 * lane) = cvtpk(b0 * rb * gb.x, b1 * rb * gb.y);
            *(unsigned*)(CKVN + (size_t)m * 256 + 128 + 2 * lane) = 0u;
            if (lane < 16) {
                const float invf = (float)exp2(-(double)lane * 0.8304820237218406);
                const double ang = (double)(float)args.pos[m] * (double)invf;
                const double rev = ang * 0.15915494309189535;
                const float rr = (float)(rev - rint(rev));
                const float cv = __builtin_amdgcn_cosf(rr), sv = __builtin_amdgcn_sinf(rr);
                CS[(size_t)m * 32 + lane] = cv; CS[(size_t)m * 32 + 16 + lane] = sv;
                const float x1 = bf1(z[C_KPE + lane]), x2 = bf1(z[C_KPE + 16 + lane]);
                const unsigned o1 = cvtpk(x1 * cv - x2 * sv, 0.f), o2 = cvtpk(x2 * cv + x1 * sv, 0.f);
                KPE[(size_t)m * 32 + lane] = (bf16)(o1 & 0xffffu); KPE[(size_t)m * 32 + 16 + lane] = (bf16)(o2 & 0xffffu);
            }
        }
    }
    SEAM(2);
    if (IN(3)) {
        __syncthreads();
#ifndef NO_QUP
        { int kq_ = 256; asm volatile("" : "+s"(kq_)); pg8::Gemm g{CQN, Wqup, M, 768, kq_}; pg8::StaticOrder S; S.init(M, 768, G, bx);
          pg8::EpiQRope E{Q0, 768, CS};
          pg8::gemm_phase<pg8::EpiQRope, pg8::StaticOrder, true, true>(lds, g, S, E); }
#endif
        __syncthreads();
#ifndef NO_KVUP
        { int kk_ = 256; asm volatile("" : "+s"(kk_)); pg8::Gemm g{CKVN, Wkvup, M, 1024, kk_}; pg8::StaticOrder S; S.init(M, 1024, G, bx);
          pg8::EpiBf16<0> E{KN, 512, nullptr, 512, (size_t)(WS_VM - WS_KN) / 2, 1.f};
          pg8::gemm_phase<pg8::EpiBf16<0>, pg8::StaticOrder, true, true>(lds, g, S, E); }
#endif
    }
    SEAM(3);
    if (IN(4)) {
        __syncthreads();
        for (;;) {
            if (tid == 0) *(volatile LAS int*)(lds + LDS_MISC + 64) = (int)atomicAdd(qctr + 64 * (bx & 7), 1u);
            __syncthreads();
            const int tk = *(volatile LAS int*)(lds + LDS_MISC + 64);
            __syncthreads();
            if (tk >= 128) break;
            const bool swa = tk >= 64;
            AttnP p; p.sinkp = args.in[8]; p.h0 = 0;
            if (!swa) {
                const int bh = 8 * (bx & 7) + (tk >> 3), s = tk & 7, b = bh >> 3, h = bh & 7; const size_t rb = (size_t)b * SEQ;
                p.Q = Q0 + rb * 768 + h * 96; p.ldq = 768; p.K = KN + rb * 512 + h * 64; p.ldk = 512; p.K2 = KPE + rb * 32; p.ldk2 = 32; p.V = VM + rb * 512 + h * 64; p.ldv = 512;
                p.G = Z0 + rb * N0P + C_G0 + h * 64; p.ldg = N0P; p.O = OG + rb * 1024 + h * 64; p.ldo = 1024; p.lc = nullptr; p.tmax = nullptr; p.c = 0.10206207261596575f * LOG2E; p.sink2 = 0.f; p.slope2 = 0.f;
                attn_unit<96, 0>(p, (15 - s) * 256, lds); attn_unit<96, 0>(p, s * 256, lds);
            } else {
                const int j = tk - 64, pkv = 2 * (bx & 7) + (j >> 5), b = pkv >> 1, kvh = pkv & 1, qb = 2 * (j & 31); const size_t rb = (size_t)b * SEQ;
                p.Q = Z0 + rb * N0P + C_QS + kvh * 256; p.ldq = N0P; p.K = Z0 + rb * N0P + C_KS + kvh * 64; p.ldk = N0P; p.K2 = nullptr; p.ldk2 = 0; p.V = Z0 + rb * N0P + C_VS + kvh * 64; p.ldv = N0P;
                p.G = Z0 + rb * N0P + C_G0 + 512 + kvh * 256; p.ldg = N0P; p.O = OG + rb * 1024 + 512 + kvh * 256; p.ldo = 1024; p.lc = nullptr; p.tmax = nullptr; p.c = 0.125f * LOG2E;
                p.sink2 = 0.f; p.slope2 = 0.f; p.h0 = 4 * kvh;
                attn_unit<64, 1>(p, qb * 64, lds); attn_unit<64, 1>(p, (qb + 1) * 64, lds);
            }
        }
    }
    SEAM(4);
    if (IN(5)) {
        __syncthreads();
        pg8::Gemm g{OG, Wout0, M, 1024, 1024}; pg8::StaticOrder S; S.init(M, 1024, G, bx);
        pg8::EpiResF32 E{x, out, 1024};
        pg8::gemm_phase<pg8::EpiResF32, pg8::StaticOrder, true, true>(lds, g, S, E);
    }
    SEAM(5);
    if (IN(6)) {
        __syncthreads();
        const float* g1 = args.in[10]; const float* w1 = args.in[11]; const float* bfp = args.in[12];
        LAS float* WF = (LAS float*)lds;
        for (int k = tid; k < 1024; k += NTHREADS) {
            const int l = (k & 255) >> 2, j = k >> 8, e = k & 3; const int R = l + 64 * (4 * j + e); const float gk = g1[k];
#pragma unroll
            for (int c = 0; c < 4; ++c) { const f32x4 wv = *(const f32x4*)(w1 + (size_t)k * N1W + W1_F + 4 * c); *(LAS f32x4*)(WF + R * 20 + 4 * c) = wv * gk; }
        }
        __syncthreads();
        for (int m = gw; m < M; m += NGW) {
            const f32x4* xr = (const f32x4*)(out + (size_t)m * DM) + lane; const f32x4* gr = (const f32x4*)g1 + lane;
            f32x4 v[4]; float ss = 0.f;
#pragma unroll
            for (int j = 0; j < 4; ++j) { v[j] = xr[64 * j]; ss += (v[j].x * v[j].x + v[j].y * v[j].y) + (v[j].z * v[j].z + v[j].w * v[j].w); }
            const float rs = 1.f / sqrtf(wave_sum(ss) * (1.f / DM) + EPS);
            u32x2* o8 = (u32x2*)(XN + (size_t)m * DM) + lane;
            float fa[16];
#pragma unroll
            for (int n = 0; n < 16; ++n) fa[n] = 0.f;
#pragma unroll
            for (int j = 0; j < 4; ++j) { const f32x4 gg = gr[64 * j]; u32x2 w; w.x = cvtpk(v[j].x * rs * gg.x, v[j].y * rs * gg.y); w.y = cvtpk(v[j].z * rs * gg.z, v[j].w * rs * gg.w); o8[64 * j] = w;
#pragma unroll
                for (int e = 0; e < 4; ++e) { const float xv = v[j][e]; const LAS float* wr_ = WF + (lane + 64 * (4 * j + e)) * 20;
#pragma unroll
                    for (int c = 0; c < 4; ++c) { const f32x4 wv = *(const LAS f32x4*)(wr_ + 4 * c); fa[4 * c + 0] += xv * wv.x; fa[4 * c + 1] += xv * wv.y; fa[4 * c + 2] += xv * wv.z; fa[4 * c + 3] += xv * wv.w; }
                    asm volatile("" ::: "memory"); } }
            const bool b5 = (lane & 32) != 0, b4 = (lane & 16) != 0, b3 = (lane & 8) != 0, b2 = (lane & 4) != 0;
            float r8[8], r4[4], r2[2];
#pragma unroll
            for (int i = 0; i < 8; ++i) { const float snd = b5 ? fa[i] : fa[8 + i]; r8[i] = (b5 ? fa[8 + i] : fa[i]) + __shfl_xor(snd, 32); }
#pragma unroll
            for (int i = 0; i < 4; ++i) { const float snd = b4 ? r8[i] : r8[4 + i]; r4[i] = (b4 ? r8[4 + i] : r8[i]) + __shfl_xor(snd, 16); }
#pragma unroll
            for (int i = 0; i < 2; ++i) { const float snd = b3 ? r4[i] : r4[2 + i]; r2[i] = (b3 ? r4[2 + i] : r4[i]) + __shfl_xor(snd, 8); }
            float mine = (b2 ? r2[1] : r2[0]) + __shfl_xor(b2 ? r2[0] : r2[1], 4);
            mine += __shfl_xor(mine, 1); mine += __shfl_xor(mine, 2);
            if ((lane & 3) == 0) { const int n = (lane >> 2) & 15; const float f = mine * rs + bfp[n]; const float lsg = fminf(f, 0.f) - log1pf(expf(-fabsf(f))); LF[(size_t)m * 16 + n] = lsg; }
        }
    }
    SEAM(6);
    if (IN(7)) {
        __syncthreads();
        LAS float* sm = (LAS float*)lds;
        for (int bh = bx; bh < 128; bh += G) {
            const int b = bh >> 4, h = bh & 15; float v[8]; float run = 0.f;
#pragma unroll
            for (int e = 0; e < 8; ++e) { run += LF[((size_t)b * SEQ + 8 * tid + e) * 16 + h]; v[e] = run; }
            float sc = run;
#pragma unroll
            for (int o = 1; o < 64; o <<= 1) { const float n = __shfl_up(sc, o); if (lane >= o) sc += n; }
            if (lane == 63) sm[wave] = sc;
            __syncthreads();
            float off = sc - run;
            for (int w = 0; w < wave; ++w) off += sm[w];
            f32x4 o0 = {(v[0] + off) * LOG2E, (v[1] + off) * LOG2E, (v[2] + off) * LOG2E, (v[3] + off) * LOG2E}, o1 = {(v[4] + off) * LOG2E, (v[5] + off) * LOG2E, (v[6] + off) * LOG2E, (v[7] + off) * LOG2E};
            *(f32x4*)(LC + (size_t)bh * SEQ + 8 * tid) = o0; *(f32x4*)(LC + (size_t)bh * SEQ + 8 * tid + 4) = o1;
            __syncthreads();
        }
        pg8::Gemm g{XN, Wt1, M, N1, 1024}; pg8::StaticOrder S; S.init(M, N1, G, bx);
        pg8::EpiBf16<0> E{Z1, N1, nullptr, 0, 0, 1.f};
        pg8::gemm_phase<pg8::EpiBf16<0>, pg8::StaticOrder, true, true>(lds, g, S, E);
        __syncthreads();
        { pg8::Unit u; LAS float* smx = (LAS float*)lds;
          for (int i = 0; S.next(i, u); ++i) {
            if (u.pn < 4 || u.pn >= 8) continue;
            const int b = u.pm >> 4, T0 = 4 * (u.pm & 15), h0 = 4 * (u.pn - 4);
            for (int st = 0; st < 4; ++st) {
                const bf16* kbase = Z1 + ((size_t)u.pm * 256 + 64 * st + (tid >> 5)) * N1 + u.pn * 256 + (tid & 31) * 8;
                float mxn = 0.f;
#pragma unroll
                for (int j = 0; j < 4; ++j) {
                    const u32x4 v = *(const u32x4*)(kbase + (size_t)(16 * j) * N1);
                    float s = 0.f;
#pragma unroll
                    for (int e = 0; e < 4; ++e) { const float a = bflo(v[e]), c = bfhi(v[e]); s += a * a + c * c; }
                    s += __shfl_xor(s, 1); s += __shfl_xor(s, 2); s += __shfl_xor(s, 4);
                    mxn = fmaxf(mxn, s);
                }
                if ((tid & 7) == 0) smx[(tid >> 5) * 4 + ((tid & 31) >> 3)] = mxn;
                __syncthreads();
                if (tid < 4) { float m16 = 0.f;
#pragma unroll
                    for (int r = 0; r < 16; ++r) m16 = fmaxf(m16, smx[r * 4 + tid]);
                    TMAXB[((size_t)(b * 16 + h0 + tid)) * 64 + T0 + st] = sqrtf(m16); }
                __syncthreads();
            }
          } }
    }
    SEAM(7);
    if (IN(9)) {
        __syncthreads();
        for (;;) {
            if (tid == 0) *(volatile LAS int*)(lds + LDS_MISC + 64) = (int)atomicAdd(qctr + 64 * (8 + (bx & 7)), 1u);
            __syncthreads();
            const int tk = *(volatile LAS int*)(lds + LDS_MISC + 64);
            __syncthreads();
            if (tk >= 128) break;
            const int bh = 16 * (bx & 7) + (tk >> 3), s = tk & 7, b = bh >> 4, h = bh & 15; const size_t rb = (size_t)b * SEQ;
            AttnP p;
            p.Q = Z1 + rb * N1 + C1_Q + h * 64; p.ldq = N1; p.K = Z1 + rb * N1 + C1_K + h * 64; p.ldk = N1; p.K2 = nullptr; p.ldk2 = 0; p.V = Z1 + rb * N1 + C1_V + h * 64; p.ldv = N1;
            p.G = Z1 + rb * N1 + C1_G + h * 64; p.ldg = N1; p.O = OG + rb * 1024 + h * 64; p.ldo = 1024; p.lc = LC + (size_t)bh * SEQ; p.tmax = TMAXB + (size_t)bh * 64; p.sinkp = args.in[8]; p.h0 = 0; p.c = 0.125f * LOG2E; p.sink2 = 0.f; p.slope2 = 0.f;
            attn_unit<64, 2>(p, (15 - s) * 256, lds); attn_unit<64, 2>(p, s * 256, lds);
        }
    }
    SEAM(9);
    if (IN(10)) {
        __syncthreads();
        for (int sub = 0; sub < 2; ++sub) {
            const size_t r0 = (size_t)sub * 16384;
            pg8::Gemm g{OG + r0 * 1024, Wout1, 16384, 1024, 1024}; pg8::StaticOrder S; S.init(16384, 1024, G, bx);
            pg8::PanelRms st{(float*)(ws + WS_LF) + (size_t)sub * 16384 * 4, (unsigned*)(ws + 64 * 1024) + sub * 64 * 64, EPS};
            pg8::EpiRmsOut E{out + r0 * 1024, out + r0 * 1024, args.in[14], 1024, st};
            pg8::gemm_phase<pg8::EpiRmsOut, pg8::StaticOrder, false, true>(lds, g, S, E);
            __syncthreads();
        }
    }
#undef IN
#undef SEAM
}

constexpr int NPHASES = 11;
extern "C" void kernel_launch(void* const* d_in, const int* in_sizes, int n_in, void* d_out, int out_size, void* d_ws, size_t ws_size, hipStream_t stream) {
    static int grid = 0;
    if (grid == 0) {
        if (n_in != 15 || out_size != M * DM || ws_size < WS_END) { fprintf(stderr, "kernel_launch: unexpected shapes (n_in %d, out %d, ws %zu)\n", n_in, out_size, ws_size); grid = -1; return; }
        int dev = 0, cus = 0, per_cu = 0;
        (void)hipGetDevice(&dev); (void)hipDeviceGetAttribute(&cus, hipDeviceAttributeMultiprocessorCount, dev);
#if MK_COOP
        (void)hipFuncSetAttribute((const void*)mk_fwd<true>, hipFuncAttributeMaxDynamicSharedMemorySize, LDS_BYTES);
        (void)hipOccupancyMaxActiveBlocksPerMultiprocessor(&per_cu, (const void*)mk_fwd<true>, NTHREADS, LDS_BYTES);
#else
        (void)hipFuncSetAttribute((const void*)mk_fwd<false>, hipFuncAttributeMaxDynamicSharedMemorySize, LDS_BYTES);
        (void)hipOccupancyMaxActiveBlocksPerMultiprocessor(&per_cu, (const void*)mk_fwd<false>, NTHREADS, LDS_BYTES);
#endif
        (void)hipGetLastError();
        if (per_cu < 1) per_cu = 1;
        if (cus <= 0) cus = 256;
        grid = cus * 1;
    }
    if (grid < 0) return;
    Args a{};
    for (int i = 0; i < 15; ++i) a.in[i] = (const float*)d_in[i];
    a.pos = (const int*)d_in[1]; a.out = (float*)d_out; a.ws = (unsigned char*)d_ws;
#if MK_COOP
    a.ph_lo = 0; a.ph_hi = NPHASES;
    void* kargs[] = {&a};
    hipError_t e = hipLaunchCooperativeKernel((const void*)mk_fwd<true>, dim3(grid), dim3(NTHREADS), kargs, LDS_BYTES, stream);
    if (e != hipSuccess) fprintf(stderr, "cooperative launch failed: %s (grid %d)\n", hipGetErrorString(e), grid);
#else
    for (int ph = 0; ph < NPHASES; ++ph) { a.ph_lo = ph; a.ph_hi = ph + 1; hipLaunchKernelGGL(mk_fwd<false>, dim3(grid), dim3(NTHREADS), LDS_BYTES, stream, a); }
#endif
}
```

```cpp
#include <hip/hip_runtime.h>
#include <hip/hip_cooperative_groups.h>
#include <cstdio>
#include <cstdint>
#include <cmath>
namespace cg = cooperative_groups;
#ifndef MK_COOP
#define MK_COOP 1
#endif
namespace pg8 {
#define PG8_LAS __attribute__((address_space(3)))
typedef unsigned short bf16_t;
typedef short bf16x8 __attribute__((ext_vector_type(8)));
typedef float f32x4 __attribute__((ext_vector_type(4)));
typedef unsigned u32x4 __attribute__((ext_vector_type(4)));
constexpr int BM = 256, BK = 64, HALF = 128, HTB = HALF * BK * 2  , STAGE_BYTES = 8 * HTB, NXCD = 8, WGM = 8;

__host__ __device__ __forceinline__ int lds_byte(int r, int c) { const int st = (r >> 4) * 2 + (c >> 5), rr = r & 15, cc = c & 31, ob = rr * 64 + cc * 2; return st * 1024 + (ob ^ (((ob >> 9) & 1) << 5)); }
__host__ __device__ __forceinline__ void stage_rc(int b, int& R, int& C) { const int st = b / 1024, sb = b % 1024, swz = sb ^ (((sb >> 9) & 1) << 5); R = (st >> 1) * 16 + swz / 64; C = (st & 1) * 32 + (swz % 64) / 2; }
__host__ __device__ __forceinline__ int perm32(int rho) { const int n = rho >> 4, i = rho & 15; return 8 * (i >> 2) + 4 * n + (i & 3); }

struct Unit { int pm, pn; };
struct Gemm { const bf16_t* A; const bf16_t* Bt; int M, N, K; };

struct StaticOrder {
    int nM, nN, nwg, G, c;
    __host__ __device__ void init(int M, int N, int G_, int c_) { nM = M / BM; nN = N / BM; nwg = nM * nN; G = G_; c = c_; }
    __host__ __device__ bool next(int i, Unit& u) const {
        const long L = (long)i * G + c; if (L >= nwg) return false;
        int wgid = (int)L; { const int q = nwg / NXCD, r = nwg % NXCD, xcd = wgid % NXCD, off = wgid / NXCD; wgid = (xcd < r ? xcd * (q + 1) : r * (q + 1) + (xcd - r) * q) + off; }
        const int nig = WGM * nN, gid = wgid / nig, fm = gid * WGM, gsz = (nM - fm) < WGM ? (nM - fm) : WGM;
        u.pm = fm + ((wgid % nig) % gsz); u.pn = (wgid % nig) / gsz; return true;
    }
    __device__ __forceinline__ void a_ready(const Unit&) const {}
    __device__ __forceinline__ void done(const Unit&) const {}
};

__device__ __forceinline__ unsigned cvt_pk_bf16(float lo, float hi) { unsigned r; asm volatile("v_cvt_pk_bf16_f32 %0, %1, %2" : "=v"(r) : "v"(lo), "v"(hi)); return r; }
typedef float f32x2 __attribute__((ext_vector_type(2)));
__device__ __forceinline__ f32x2 gelu_pk(f32x2 v) {
    const f32x2 av = __builtin_elementwise_abs(v), d = av * 0.2316418882f + 1.0f;
    f32x2 t; t.x = __builtin_amdgcn_rcpf(d.x); t.y = __builtin_amdgcn_rcpf(d.y);
    f32x2 q = t * 0.5307027145f + (-0.7265760135f); q = q * t + 0.7107068705f; q = q * t + (-0.142248368f); q = q * t + 0.127414796f; q = q * t;
    const f32x2 s = (v * v) * (-0.72134752044f);
    f32x2 e; e.x = __builtin_amdgcn_exp2f(s.x); e.y = __builtin_amdgcn_exp2f(s.y);
    const f32x2 m = v * (q * e), r = v - m;
    f32x2 o; o.x = v.x < 0.f ? m.x : r.x; o.y = v.y < 0.f ? m.y : r.y; return o;
}

template <int ACT  > struct EpiBf16 {
    static constexpr bool PERM = true, AFTER_DRAIN = false; static_assert(ACT == 0 || ACT == 1, "EpiBf16: ACT is 0 (none) or 1 (gelu_pk)");
    bf16_t* O; int ldc; const float* bias; int split_cols; size_t split_stride; float scale0; unsigned hm_mask; int hm_heads;
    __device__ __forceinline__ void operator()(const f32x4 (&acc)[2][2][4][2], const Unit& u, int wr, int wc, int fr, int fq) const {
        const int row0 = u.pm * BM + wr * 64 + fr; int colt = u.pn * BM; bf16_t* base = O;
        float sc = 1.f; bool hm = false; if (split_cols) { const int t = colt / split_cols; base += (size_t)t * split_stride; colt -= t * split_cols; if (t == 0) sc = scale0; hm = ((hm_mask >> t) & 1u) != 0u; }
        const int col0 = colt + wc * 32 + 8 * fq, bcol0 = u.pn * BM + wc * 32 + 8 * fq;
        f32x4 bv[2][2];
#pragma unroll
        for (int bj = 0; bj < 2; ++bj)
#pragma unroll
            for (int n = 0; n < 2; ++n) bv[bj][n] = bias ? *(const f32x4*)(bias + bcol0 + bj * HALF + 4 * n) : (f32x4){0.f, 0.f, 0.f, 0.f};
#pragma unroll
        for (int ai = 0; ai < 2; ++ai)
#pragma unroll
            for (int m = 0; m < 4; ++m) { const int rowi = row0 + ai * HALF + m * 16; bf16_t* rowp = base + (size_t)rowi * ldc + col0;
#pragma unroll
                for (int bj = 0; bj < 2; ++bj) { f32x4 v0 = acc[ai][bj][m][0] + bv[bj][0], v1 = acc[ai][bj][m][1] + bv[bj][1];
                    if (ACT == 1) { f32x2 a = gelu_pk((f32x2){v0[0], v0[1]}), b = gelu_pk((f32x2){v0[2], v0[3]}), c = gelu_pk((f32x2){v1[0], v1[1]}), d = gelu_pk((f32x2){v1[2], v1[3]});
                        v0 = (f32x4){a.x, a.y, b.x, b.y}; v1 = (f32x4){c.x, c.y, d.x, d.y}; }
                    v0 = v0 * sc; v1 = v1 * sc; u32x4 w; w.x = cvt_pk_bf16(v0[0], v0[1]); w.y = cvt_pk_bf16(v0[2], v0[3]); w.z = cvt_pk_bf16(v1[0], v1[1]); w.w = cvt_pk_bf16(v1[2], v1[3]);
                    bf16_t* dst = rowp + bj * HALF;
                    if (hm) { const int col = col0 + bj * HALF; dst = base + ((((size_t)(rowi >> 12) * hm_heads + (col >> 6)) << 18) + ((size_t)(rowi & 4095) << 6) + (col & 63)); }
                    *(u32x4*)dst = w; } }
    }
};
typedef unsigned u32x2 __attribute__((ext_vector_type(2)));
struct EpiQRope {
    static constexpr bool PERM = false, AFTER_DRAIN = false;
    bf16_t* O; int ldc; const float* cs;
    __device__ __forceinline__ void operator()(const f32x4 (&acc)[2][2][4][2], const Unit& u, int wr, int wc, int fr, int fq) const {
        const int row0 = u.pm * BM + wr * 64 + fr;
#pragma unroll
        for (int ai = 0; ai < 2; ++ai)
#pragma unroll
            for (int m = 0; m < 4; ++m) {
                const int row = row0 + ai * HALF + m * 16;
                const f32x4 cv = *(const f32x4*)(cs + (size_t)row * 32 + 4 * fq), sv = *(const f32x4*)(cs + (size_t)row * 32 + 16 + 4 * fq);
#pragma unroll
                for (int bj = 0; bj < 2; ++bj) {
                    const int colb = u.pn * BM + bj * HALF + wc * 32;
                    f32x4 v0 = acc[ai][bj][m][0], v1 = acc[ai][bj][m][1];
                    if (((colb >> 5) % 3) == 2) { const f32x4 a = v0 * cv - v1 * sv, b = v1 * cv + v0 * sv; v0 = a; v1 = b; }
                    bf16_t* rp = O + (size_t)row * ldc + colb + 4 * fq;
                    u32x2 w0, w1; w0.x = cvt_pk_bf16(v0[0], v0[1]); w0.y = cvt_pk_bf16(v0[2], v0[3]); w1.x = cvt_pk_bf16(v1[0], v1[1]); w1.y = cvt_pk_bf16(v1[2], v1[3]);
                    *(u32x2*)(rp) = w0; *(u32x2*)(rp + 16) = w1;
                }
                asm volatile("" ::: "memory");
            }
    }
};
struct EpiResF32 {
    static constexpr bool PERM = false, AFTER_DRAIN = false;
    const float* base; float* out; int ldc;
    __device__ __forceinline__ void operator()(const f32x4 (&acc)[2][2][4][2], const Unit& u, int wr, int wc, int fr, int fq) const {
        const int row0 = u.pm * BM + wr * 64 + fr, col0 = u.pn * BM + wc * 32 + 4 * fq;
#pragma unroll
        for (int ai = 0; ai < 2; ++ai)
#pragma unroll
            for (int m = 0; m < 4; ++m) {
                const size_t off = (size_t)(row0 + ai * HALF + m * 16) * ldc + col0;
#pragma unroll
                for (int bj = 0; bj < 2; ++bj)
#pragma unroll
                    for (int n = 0; n < 2; ++n) { const f32x4 b = *(const f32x4*)(base + off + bj * HALF + n * 16); *(f32x4*)(out + off + bj * HALF + n * 16) = b + acc[ai][bj][m][n]; }
                asm volatile("" ::: "memory");
            }
    }
};
struct PanelRms {
    float* xbuf;
    unsigned* cnt;
    float eps;
    __device__ __forceinline__ void run(const f32x4 (&v)[2][2][4][2], const Unit& u, int wr, int wc, int fr, int fq, PG8_LAS unsigned char* lds, int wid, int lane) const {
        PG8_LAS float* P = (PG8_LAS float*)lds;
        PG8_LAS float* S = (PG8_LAS float*)(lds + 4096);
#pragma unroll
        for (int ai = 0; ai < 2; ++ai)
#pragma unroll
            for (int m = 0; m < 4; ++m) {
                float s = 0.f;
#pragma unroll
                for (int bj = 0; bj < 2; ++bj)
#pragma unroll
                    for (int n = 0; n < 2; ++n) { const f32x4 x = v[ai][bj][m][n]; s += (x[0] * x[0] + x[1] * x[1]) + (x[2] * x[2] + x[3] * x[3]); }
                s += __shfl_xor(s, 16); s += __shfl_xor(s, 32);
                if (fq == 0) P[(ai * HALF + wr * 64 + m * 16 + fr) * 4 + wc] = s;
            }
        asm volatile("s_waitcnt lgkmcnt(0)" ::: "memory"); __builtin_amdgcn_s_barrier(); asm volatile("" ::: "memory");
        const int row = wid * 32 + (lane & 31);
        if (lane < 32) {
            const float t = (P[row * 4 + 0] + P[row * 4 + 1]) + (P[row * 4 + 2] + P[row * 4 + 3]);
            __hip_atomic_store(xbuf + ((size_t)(u.pm * BM + row) * 4 + u.pn), t, __ATOMIC_RELAXED, __HIP_MEMORY_SCOPE_AGENT);
        }
        asm volatile("s_waitcnt vmcnt(0)" ::: "memory");
        if (lane == 0) __hip_atomic_fetch_add(cnt + 64 * u.pm, 1u, __ATOMIC_RELAXED, __HIP_MEMORY_SCOPE_AGENT);
        if (wid == 0) {
            unsigned spins = 0;
            while ((unsigned)__builtin_amdgcn_readfirstlane(__hip_atomic_load(cnt + 64 * u.pm, __ATOMIC_RELAXED, __HIP_MEMORY_SCOPE_AGENT)) < 32u) { __builtin_amdgcn_s_sleep(2); if (++spins > (1u << 20)) break; }
            __builtin_amdgcn_fence(__ATOMIC_ACQUIRE, "agent");
        }
        asm volatile("s_waitcnt vmcnt(0) lgkmcnt(0)" ::: "memory"); __builtin_amdgcn_s_barrier(); asm volatile("" ::: "memory");
        if (lane < 32) {
            const float* slot = xbuf + (size_t)(u.pm * BM + row) * 4; float q = 0.f;
#pragma unroll
            for (int t = 0; t < 4; ++t) q += __hip_atomic_load(slot + t, __ATOMIC_RELAXED, __HIP_MEMORY_SCOPE_AGENT);
            S[row] = 1.0f / sqrtf(q * (1.0f / 1024.0f) + eps);
        }
        asm volatile("s_waitcnt lgkmcnt(0)" ::: "memory"); __builtin_amdgcn_s_barrier(); asm volatile("" ::: "memory");
    }
};
struct EpiRmsOut {
    static constexpr bool PERM = false, AFTER_DRAIN = true;
    const float* base; float* out; const float* g; int ldc; PanelRms st;
    __device__ __forceinline__ void fused(f32x4 (&acc)[2][2][4][2], const Unit& u, int wr, int wc, int fr, int fq, PG8_LAS unsigned char* lds, int wid, int lane) const {
        const PG8_LAS float* S = (const PG8_LAS float*)(lds + 4096);
        const int col0 = u.pn * BM + wc * 32 + 4 * fq;
#pragma unroll
        for (int ai = 0; ai < 2; ++ai)
#pragma unroll
            for (int m = 0; m < 4; ++m) { const size_t off = (size_t)(u.pm * BM + ai * HALF + wr * 64 + m * 16 + fr) * ldc + col0;
#pragma unroll
                for (int bj = 0; bj < 2; ++bj)
#pragma unroll
                    for (int n = 0; n < 2; ++n) acc[ai][bj][m][n] += *(const f32x4*)(base + off + bj * HALF + n * 16);
                asm volatile("" : "+v"(acc[ai][0][m][0]), "+v"(acc[ai][0][m][1]), "+v"(acc[ai][1][m][0]), "+v"(acc[ai][1][m][1]));
                if (m & 1) asm volatile("" ::: "memory"); }
        st.run(acc, u, wr, wc, fr, fq, lds, wid, lane);
#pragma unroll
        for (int bj = 0; bj < 2; ++bj)
#pragma unroll
            for (int n = 0; n < 2; ++n) { const f32x4 gv = *(const f32x4*)(g + col0 + bj * HALF + n * 16);
#pragma unroll
                for (int ai = 0; ai < 2; ++ai)
#pragma unroll
                    for (int m = 0; m < 4; ++m) { const int r = ai * HALF + wr * 64 + m * 16 + fr; const float rs = S[r];
                        *(f32x4*)(out + (size_t)(u.pm * BM + r) * ldc + col0 + bj * HALF + n * 16) = acc[ai][bj][m][n] * rs * gv; } }
    }
};
template <class Epi, class Sched, bool ALIGN_EPI = false, bool SP2 = false>
__device__ __forceinline__ void gemm_phase(PG8_LAS unsigned char* lds, const Gemm g, const Sched& S, const Epi& E) {
    const int tid = threadIdx.x, wid = __builtin_amdgcn_readfirstlane(tid >> 6), lane = tid & 63, wr = wid >> 2, wc = wid & 3, fr = lane & 15, fq = lane >> 4;
    const int K = g.K, nt = K / BK;
    unsigned voffA[2], voffB[2];
#pragma unroll
    for (int i = 0; i < 2; ++i) { int R, C; stage_rc(tid * 16 + i * 8192, R, C); const int Rb = Epi::PERM ? ((R & ~31) + perm32(R & 31)) : R;
        voffA[i] = (unsigned)(R * K + C) * 2u; voffB[i] = (unsigned)(Rb * K + C) * 2u; }
    const size_t kstep = (size_t)(BK * 2);
    const size_t hstep = (size_t)HALF * K * 2;
    const size_t tstep = 2 * hstep;
    const unsigned ldsw = (unsigned)wid * 1024u;
    const int aoff = lds_byte(wr * 64 + fr, fq * 8), boff = lds_byte(wc * 32 + fr, fq * 8);
#define PG8_SA(b, h) (((b) * 2 + (h)) * HTB)
#define PG8_SB(b, h) ((4 + (b) * 2 + (h)) * HTB)
#define PG8_STAGE(bufoff, gbase, voff) do { _Pragma("unroll") for (int _i = 0; _i < 2; ++_i) \
        __builtin_amdgcn_global_load_lds((const unsigned*)((const char*)(gbase) + (voff)[_i]), (PG8_LAS unsigned*)(lds + (bufoff) + ldsw + _i * 8192), 16, 0, 0); } while (0)
#define PG8_LDA(dst, b, h) do { _Pragma("unroll") for (int m = 0; m < 4; ++m) _Pragma("unroll") for (int k = 0; k < 2; ++k) dst[m][k] = *(const PG8_LAS bf16x8*)(lds + PG8_SA(b, h) + aoff + m * 2048 + k * 1024); } while (0)
#define PG8_LDB(dst, b, h) do { _Pragma("unroll") for (int n = 0; n < 2; ++n) _Pragma("unroll") for (int k = 0; k < 2; ++k) dst[n][k] = *(const PG8_LAS bf16x8*)(lds + PG8_SB(b, h) + boff + n * 2048 + k * 1024); } while (0)
#define PG8_MMA(ai, bj, At, Bt) do { __builtin_amdgcn_s_setprio(1); _Pragma("unroll") for (int m = 0; m < 4; ++m) _Pragma("unroll") for (int n = 0; n < 2; ++n) _Pragma("unroll") for (int k = 0; k < 2; ++k) \
        acc[ai][bj][m][n] = __builtin_amdgcn_mfma_f32_16x16x32_bf16(Bt[n][k], At[m][k], acc[ai][bj][m][n], 0, 0, 0); __builtin_amdgcn_s_setprio(0); } while (0)
#define PG8_WAIT_V(n) asm volatile("s_waitcnt vmcnt(" #n ")" ::: "memory")
#define PG8_WAIT_L(n) asm volatile("s_waitcnt lgkmcnt(" #n ")" ::: "memory")
#define PG8_BAR __builtin_amdgcn_s_barrier()
#define PG8_SCHED __builtin_amdgcn_sched_barrier(0)
    Unit cur, nxt; int ui = 0;
    if (!S.next(0, cur)) return;
    f32x4 acc[2][2][4][2];
#pragma unroll
    for (int a = 0; a < 2; ++a)
#pragma unroll
        for (int b = 0; b < 2; ++b)
#pragma unroll
            for (int m = 0; m < 4; ++m)
#pragma unroll
                for (int n = 0; n < 2; ++n) acc[a][b][m][n] = (f32x4){0.f, 0.f, 0.f, 0.f};
    bf16x8 At[4][2], B0[2][2], B1[2][2];
    const char* cA = (const char*)g.A + (size_t)cur.pm * tstep; const char* cB = (const char*)g.Bt + (size_t)cur.pn * tstep;
    S.a_ready(cur);
    if constexpr (SP2) {
        PG8_STAGE(PG8_SB(0, 0), cB, voffB); PG8_STAGE(PG8_SB(0, 1), cB + hstep, voffB); PG8_STAGE(PG8_SA(0, 0), cA, voffA); PG8_STAGE(PG8_SA(0, 1), cA + hstep, voffA);
        if (wr == 1) PG8_BAR;
        PG8_WAIT_V(2); PG8_BAR;
        PG8_STAGE(PG8_SB(1, 0), cB + kstep, voffB); PG8_STAGE(PG8_SA(1, 0), cA + kstep, voffA); PG8_STAGE(PG8_SB(1, 1), cB + hstep + kstep, voffB);
        PG8_WAIT_V(6); PG8_BAR;
    } else {
        PG8_STAGE(PG8_SB(0, 0), cB, voffB); PG8_STAGE(PG8_SA(0, 0), cA, voffA); PG8_STAGE(PG8_SB(0, 1), cB + hstep, voffB); PG8_STAGE(PG8_SA(0, 1), cA + hstep, voffA);
        if (wr == 1) PG8_BAR;
        PG8_WAIT_V(4); PG8_BAR;
        PG8_STAGE(PG8_SB(1, 0), cB + kstep, voffB); PG8_STAGE(PG8_SA(1, 0), cA + kstep, voffA); PG8_STAGE(PG8_SB(1, 1), cB + hstep + kstep, voffB);
        PG8_WAIT_V(6); PG8_BAR;
    }
    for (;;) {
        const bool has_next = S.next(ui + 1, nxt);
        const char* nA = has_next ? (const char*)g.A + (size_t)nxt.pm * tstep : cA; const char* nB = has_next ? (const char*)g.Bt + (size_t)nxt.pn * tstep : cB;
        for (int t = 0; t < nt; t += 2) {
            const bool last = (t == nt - 2);
            const char* a1 = cA + (size_t)(t + 1) * kstep;
            const char* a2 = last ? nA : cA + (size_t)(t + 2) * kstep; const char* b2 = last ? nB : cB + (size_t)(t + 2) * kstep;
            const char* a3 = a2 + kstep; const char* b3 = b2 + kstep;
            if (last && has_next) S.a_ready(nxt);
            if constexpr (SP2) {
            PG8_LDB(B0, 0, 0); PG8_LDB(B1, 0, 1); PG8_SCHED; PG8_LDA(At, 0, 0); PG8_STAGE(PG8_SA(1, 1), a1 + hstep, voffA);
            PG8_WAIT_V(8); PG8_WAIT_L(0); PG8_BAR; PG8_MMA(0, 0, At, B0); PG8_MMA(0, 1, At, B1); PG8_BAR; PG8_SCHED;
            PG8_LDA(At, 0, 1); PG8_STAGE(PG8_SB(0, 0), b2, voffB); PG8_STAGE(PG8_SB(0, 1), b2 + hstep, voffB); PG8_STAGE(PG8_SA(0, 0), a2, voffA);
            PG8_WAIT_V(8); PG8_WAIT_L(0); PG8_BAR; PG8_MMA(1, 0, At, B0); PG8_MMA(1, 1, At, B1); PG8_BAR; PG8_SCHED;
            PG8_LDB(B0, 1, 0); PG8_LDB(B1, 1, 1); PG8_SCHED; PG8_LDA(At, 1, 0); PG8_STAGE(PG8_SA(0, 1), a2 + hstep, voffA);
            PG8_WAIT_V(8); PG8_WAIT_L(0); PG8_BAR; PG8_MMA(0, 0, At, B0); PG8_MMA(0, 1, At, B1); PG8_BAR; PG8_SCHED;
            PG8_LDA(At, 1, 1); PG8_STAGE(PG8_SB(1, 0), b3, voffB); PG8_STAGE(PG8_SB(1, 1), b3 + hstep, voffB); PG8_STAGE(PG8_SA(1, 0), a3, voffA);
            PG8_WAIT_V(8); PG8_WAIT_L(0); PG8_BAR; PG8_MMA(1, 0, At, B0); PG8_MMA(1, 1, At, B1); PG8_BAR; PG8_SCHED;
            } else {
            PG8_LDB(B0, 0, 0); PG8_SCHED; PG8_LDA(At, 0, 0); PG8_STAGE(PG8_SA(1, 1), a1 + hstep, voffA);
            PG8_WAIT_L(8); PG8_BAR; PG8_WAIT_L(0); PG8_MMA(0, 0, At, B0); PG8_BAR; PG8_SCHED;
            PG8_LDB(B1, 0, 1); PG8_STAGE(PG8_SB(0, 0), b2, voffB);
            PG8_BAR; PG8_WAIT_L(0); PG8_MMA(0, 1, At, B1); PG8_BAR;
            PG8_LDA(At, 0, 1); PG8_STAGE(PG8_SA(0, 0), a2, voffA);
            PG8_BAR; PG8_WAIT_L(0); PG8_MMA(1, 0, At, B0); PG8_BAR; PG8_SCHED;
            PG8_STAGE(PG8_SB(0, 1), b2 + hstep, voffB);
            PG8_WAIT_V(6); PG8_BAR; PG8_MMA(1, 1, At, B1); PG8_BAR;
            PG8_LDB(B0, 1, 0); PG8_SCHED; PG8_LDA(At, 1, 0); PG8_STAGE(PG8_SA(0, 1), a2 + hstep, voffA);
            PG8_WAIT_L(8); PG8_BAR; PG8_WAIT_L(0); PG8_MMA(0, 0, At, B0); PG8_BAR; PG8_SCHED;
            PG8_LDB(B1, 1, 1); PG8_STAGE(PG8_SB(1, 0), b3, voffB);
            PG8_BAR; PG8_WAIT_L(0); PG8_MMA(0, 1, At, B1); PG8_BAR;
            PG8_LDA(At, 1, 1); PG8_STAGE(PG8_SA(1, 0), a3, voffA);
            PG8_BAR; PG8_WAIT_L(0); PG8_MMA(1, 0, At, B0); PG8_BAR; PG8_SCHED;
            PG8_STAGE(PG8_SB(1, 1), b3 + hstep, voffB);
            PG8_WAIT_V(6); PG8_BAR; PG8_MMA(1, 1, At, B1); PG8_BAR;
            }
        }
        if constexpr (ALIGN_EPI) { if (wr == 0) PG8_BAR; }
        if constexpr (!Epi::AFTER_DRAIN) { E(acc, cur, wr, wc, fr, fq); S.done(cur); }
        if (!has_next) break;
#pragma unroll
        for (int a = 0; a < 2; ++a)
#pragma unroll
            for (int b = 0; b < 2; ++b)
#pragma unroll
                for (int m = 0; m < 4; ++m)
#pragma unroll
                    for (int n = 0; n < 2; ++n) acc[a][b][m][n] = (f32x4){0.f, 0.f, 0.f, 0.f};
        cur = nxt; cA = nA; cB = nB; ++ui;
        if constexpr (ALIGN_EPI) { if (wr == 1) PG8_BAR; }
    }
    PG8_WAIT_V(0);
    if constexpr (!ALIGN_EPI) { if (wr == 0) PG8_BAR; }
    PG8_BAR;
    if constexpr (Epi::AFTER_DRAIN) { E.fused(acc, cur, wr, wc, fr, fq, lds, wid, lane); S.done(cur); }
#undef PG8_SA
#undef PG8_SB
#undef PG8_STAGE
#undef PG8_LDA
#undef PG8_LDB
#undef PG8_MMA
#undef PG8_WAIT_V
#undef PG8_WAIT_L
#undef PG8_BAR
#undef PG8_SCHED
}
}
#define LAS __attribute__((address_space(3)))
typedef unsigned short bf16;
typedef short bf16x8 __attribute__((ext_vector_type(8)));
typedef float f32x16 __attribute__((ext_vector_type(16)));
typedef float f32x4 __attribute__((ext_vector_type(4)));
typedef float f32x2 __attribute__((ext_vector_type(2)));
typedef unsigned u32x4 __attribute__((ext_vector_type(4)));
typedef unsigned u32x2 __attribute__((ext_vector_type(2)));
typedef __bf16 bf16x2_t __attribute__((ext_vector_type(2)));

constexpr int BATCH = 8, SEQ = 4096, DM = 1024, M = BATCH * SEQ;
constexpr int N0 = 2208, N0P = 2304;
constexpr int C_CQ = 0, C_CKV = 256, C_KPE = 384, C_QS = 416, C_KS = 928, C_VS = 1056, C_G0 = 1184;
constexpr int N1W = 4112, N1 = 4096;
constexpr int C1_Q = 0, C1_K = 1024, C1_V = 2048, C1_G = 3072, W1_F = 3072, W1_G = 3088;
constexpr float EPS = 1e-6f, LOG2E = 1.4426950408889634f;
constexpr int NTHREADS = 512, NWAVES = 8;

constexpr size_t MiB = 1u << 20;
constexpr size_t WS_WT0 = 1 * MiB;
constexpr size_t WS_WQUP = 6 * MiB;
constexpr size_t WS_WKVUP = 7 * MiB;
constexpr size_t WS_WOUT0 = 8 * MiB;
constexpr size_t WS_WT1 = 10 * MiB;
constexpr size_t WS_WOUT1 = 18 * MiB;
constexpr size_t WS_XN = 32 * MiB;
constexpr size_t WS_OG = 96 * MiB;
constexpr size_t WS_LF = 160 * MiB;
constexpr size_t WS_LC = 162 * MiB;
constexpr size_t WS_TMAX = 512 * 1024;
constexpr size_t WS_CS = 164 * MiB;
constexpr size_t WS_Z1 = 168 * MiB;
constexpr size_t WS_Z0 = 168 * MiB;
constexpr size_t WS_CQN = 312 * MiB;
constexpr size_t WS_CKVN = 328 * MiB;
constexpr size_t WS_KPE = 344 * MiB;
constexpr size_t WS_Q0 = 346 * MiB;
constexpr size_t WS_KN = 394 * MiB;
constexpr size_t WS_VM = 426 * MiB;
constexpr size_t WS_END = 458 * MiB;
constexpr int LDS_BYTES = 135168, LDS_MISC = 131072 + 1024;

__device__ __forceinline__ unsigned cvtpk(float lo, float hi) { f32x2 v = {lo, hi}; bf16x2_t b = __builtin_convertvector(v, bf16x2_t); return __builtin_bit_cast(unsigned, b); }
__device__ __forceinline__ float bflo(unsigned u) { return __uint_as_float(u << 16); }
__device__ __forceinline__ float bfhi(unsigned u) { return __uint_as_float(u & 0xffff0000u); }
__device__ __forceinline__ float bf1(bf16 v) { return __uint_as_float(((unsigned)v) << 16); }
__device__ __forceinline__ float wave_sum(float v) {
#pragma unroll
    for (int o = 1; o < 64; o <<= 1) v += __shfl_xor(v, o);
    return v;
}

struct AttnP { const bf16 *Q, *K, *K2, *V, *G; bf16* O; const float* lc; const float* tmax; const float* sinkp; int h0; int ldq, ldk, ldk2, ldv, ldg, ldo; float c, sink2, slope2; };

typedef short v4i16_t __attribute__((ext_vector_type(4)));
__device__ __forceinline__ void glds16(const void* gsrc, unsigned lds_dst) { unsigned keep;
    asm volatile("s_mov_b32 %0, m0\n\ts_mov_b32 m0, %2\n\ts_nop 0\n\tglobal_load_lds_dwordx4 %1, off\n\ts_mov_b32 m0, %0" : "=&s"(keep) : "v"(gsrc), "s"(lds_dst) : "memory"); }
__device__ __forceinline__ void glds4(const void* gsrc, unsigned lds_dst) { unsigned keep;
    asm volatile("s_mov_b32 %0, m0\n\ts_mov_b32 m0, %2\n\ts_nop 0\n\tglobal_load_lds_dword %1, off\n\ts_mov_b32 m0, %0" : "=&s"(keep) : "v"(gsrc), "s"(lds_dst) : "memory"); }

#define PSB() __builtin_amdgcn_sched_barrier(0)
__device__ __forceinline__ constexpr int pch_lo(int k, int nch) { return k * (32 / nch) + (k < (32 % nch) ? k : (32 % nch)); }
template <int LO, int HI> __device__ __forceinline__ void p_exp_range(f32x16 (&SC)[2], float c, float m_new, float& l0, float& l1) {
#pragma unroll
    for (int e = LO; e < HI; ++e) { const float y = __builtin_amdgcn_exp2f(SC[e >> 4][e & 15] * c - m_new); SC[e >> 4][e & 15] = y; if (e & 1) l1 += y; else l0 += y; }
}
template <int DK, int K> struct PSeg1 {
    static __device__ __forceinline__ void run(f32x16 (&SC)[2], f32x16 (&SN)[2], const bf16x8 (&kf)[2][DK / 16], const bf16x8 (&qf)[DK / 16], float c, float m_new, float& l0, float& l1) {
        constexpr int NCH = 2 * (DK / 16);
        if constexpr (K < NCH) {
            SN[K & 1] = __builtin_amdgcn_mfma_f32_32x32x16_bf16(kf[K & 1][K >> 1], qf[K >> 1], SN[K & 1], 0, 0, 0);
            PSB();
            p_exp_range<pch_lo(K, NCH), pch_lo(K + 1, NCH)>(SC, c, m_new, l0, l1);
            PSB();
            PSeg1<DK, K + 1>::run(SC, SN, kf, qf, c, m_new, l0, l1);
        }
    }
};
template <int K> struct PSeg2 {
    static __device__ __forceinline__ void run(f32x16 (&SC)[2], f32x16 (&SN)[2], const bf16x8 (&vf)[2][4], bf16x8 (&pk)[4], f32x16 (&ot)[2], float& mx, bool has_next) {
        if constexpr (K < 8) {
            ot[K & 1] = __builtin_amdgcn_mfma_f32_32x32x16_bf16(vf[K & 1][K >> 1], pk[K >> 1], ot[K & 1], 0, 0, 0);
            PSB();
            if constexpr ((K & 1) == 0 && K < 6) { constexpr int cc = (K >> 1) + 1, ph = cc >> 1, o = 8 * (cc & 1); u32x4 w;
                w.x = cvtpk(SC[ph][o + 0], SC[ph][o + 1]); w.y = cvtpk(SC[ph][o + 2], SC[ph][o + 3]); w.z = cvtpk(SC[ph][o + 4], SC[ph][o + 5]); w.w = cvtpk(SC[ph][o + 6], SC[ph][o + 7]);
                pk[cc] = __builtin_bit_cast(bf16x8, w); }
            if (has_next) { constexpr int e = 4 * K, ph = e >> 4, r = e & 15;
                mx = fmaxf(mx, fmaxf(fmaxf(SN[ph][r], SN[ph][r + 1]), fmaxf(SN[ph][r + 2], SN[ph][r + 3]))); }
            PSB();
            PSeg2<K + 1>::run(SC, SN, vf, pk, ot, mx, has_next);
        }
    }
};
#define AT_WAITV(n) asm volatile("s_waitcnt vmcnt(%0) lgkmcnt(0)" :: "n"(n) : "memory")
template <int DK, int MODE>
__device__ __forceinline__ void attn_unit(const AttnP& p, const int q0, LAS unsigned char* lds) {
    constexpr int NS = 4, KN_B = 8192, KP_B = (DK == 96) ? 4096 : 0, VHALF = 4160, V_B = 2 * VHALF, LC_B = (MODE == 2) ? 256 : 0;
    constexpr int OFF_KP = KN_B, OFF_V = KN_B + KP_B, OFF_LC = OFF_V + V_B, SLOT = OFF_LC + LC_B, OFF_FLAG = NS * SLOT;
    constexpr int NPT = 2 + ((DK == 96 || MODE == 2) ? 1 : 0);
    const int tid = threadIdx.x, lane = tid & 63, wid = __builtin_amdgcn_readfirstlane(tid >> 6), r32 = lane & 31, hi = lane >> 5;
    const int hsel = (MODE == 1) ? (wid >> 1) : 0;
    const int qw0 = q0 + 32 * ((MODE == 1) ? (wid & 1) : wid), q = qw0 + r32;
    const bf16* Qp = p.Q + hsel * 64; const bf16* Gp = p.G + hsel * 64; bf16* Op = p.O + hsel * 64;
    float sink2 = 0.f, slope2 = 0.f;
    if (MODE == 1) { const int hh = p.h0 + hsel; sink2 = p.sinkp[hh] * LOG2E; slope2 = exp2f(-(float)(hh + 1)) * LOG2E; }
    const unsigned lds0 = (unsigned)(uintptr_t)lds;
    bf16x8 qf[DK / 16];
#pragma unroll
    for (int d0 = 0; d0 < DK / 16; ++d0) qf[d0] = *(const bf16x8*)(Qp + (size_t)q * p.ldq + 16 * d0 + 8 * hi);
#pragma unroll
    for (int d0 = 0; d0 < DK / 16; ++d0) asm volatile("" : "+v"(qf[d0]));
    const int t_hi = (MODE == 1) ? (q0 >> 6) : (((q0 + 256) >> 6) - 1);
    const int t_lo = (MODE == 1) ? (((q0 >> 6) >= 2) ? (q0 >> 6) - 2 : 0) : 0;
    const int ntile = t_hi - t_lo + 1;
    const int krow = 8 * wid + (lane >> 3), kch = (lane & 7) ^ ((krow >> 1) & 7);
    const bf16* ksrc = p.K + (size_t)krow * p.ldk + kch * 8;
    const int prow = 8 * wid + ((lane & 31) >> 2), pch = (lane & 3) ^ ((prow >> 2) & 3);
    const bf16* psrc = (DK == 96) ? (p.K2 + (size_t)prow * p.ldk2 + pch * 8) : p.K;
    const int vrow = 16 * (wid & 3) + (lane >> 2);
    const bf16* vsrc = p.V + (size_t)vrow * p.ldv + ((wid >> 2) * 4 + (lane & 3)) * 8;
    const float* lsrc = (MODE == 2) ? (p.lc + 8 * wid + (lane & 7)) : (const float*)p.K;
#define AT_DMA(t, slot) do { const size_t ro_ = (size_t)(t) * 64; const unsigned sb_ = lds0 + (unsigned)((slot) * SLOT); \
        glds16(ksrc + ro_ * p.ldk, (unsigned)__builtin_amdgcn_readfirstlane(sb_ + wid * 1024)); \
        glds16(vsrc + ro_ * p.ldv, (unsigned)__builtin_amdgcn_readfirstlane(sb_ + OFF_V + (wid >> 2) * VHALF + (wid & 3) * 1024)); \
        if (DK == 96) { if (lane < 32) glds16(psrc + ro_ * p.ldk2, (unsigned)__builtin_amdgcn_readfirstlane(sb_ + OFF_KP + wid * 512)); } \
        if (MODE == 2) { if (lane < 8) glds4(lsrc + ro_, (unsigned)__builtin_amdgcn_readfirstlane(sb_ + OFF_LC + wid * 32)); } } while (0)

    float m_run = (MODE == 1) ? sink2 : -INFINITY;
    float l_run = (MODE == 1 && hi == 0) ? 1.f : 0.f;
    f32x16 ot[2];
#pragma unroll
    for (int r = 0; r < 16; ++r) { ot[0][r] = 0.f; ot[1][r] = 0.f; }
    const int pim = 16 * (r32 >> 4) + 8 * ((r32 >> 2) & 1) + 4 * ((r32 >> 3) & 1) + (r32 & 3);
    const int vrd = (8 * hi + ((lane & 15) >> 2)) * 64 + ((lane >> 4) & 1) * 32 + (lane & 3) * 8;
    int koff[4], poff[2];
#pragma unroll
    for (int d0 = 0; d0 < 4; ++d0) koff[d0] = pim * 128 + (((2 * d0 + hi) ^ ((pim >> 1) & 7)) * 16);
#pragma unroll
    for (int j = 0; j < 2; ++j) poff[j] = OFF_KP + pim * 64 + (((2 * j + hi) ^ ((pim >> 2) & 3)) * 16);
    float pmv = 0.f, lcev = 0.f, qn = 0.f;
    if (MODE == 2) {
        pmv = (lane <= t_hi) ? p.tmax[lane] : 0.f;
#pragma unroll
        for (int o = 1; o < 64; o <<= 1) { const float n = __shfl_up(pmv, o); if (lane >= o) pmv = fmaxf(pmv, n); }
        lcev = (lane <= t_hi) ? p.lc[64 * lane + 63] : 0.f;
        float qs = 0.f;
#pragma unroll
        for (int d0 = 0; d0 < DK / 16; ++d0)
#pragma unroll
            for (int e = 0; e < 8; ++e) { const float f = bf1((bf16)qf[d0][e]); qs += f * f; }
        qs += __shfl_xor(qs, 32);
        qn = sqrtf(qs) * p.c * 1.002f;
    }
    AT_DMA(t_hi, 0);
    if (ntile > 1) AT_DMA(t_hi - 1, 1);
    if (ntile > 2) AT_DMA(t_hi - 2, 2);
    const int nfirst = (MODE == 0 && ntile > 4) ? 4 : ntile;
    for (int i = 0; i < nfirst; ++i) {
        const int t = t_hi - i, kv0 = t * 64, rem = ntile - 1 - i;
        if (rem >= 2) AT_WAITV(2 * NPT); else if (rem == 1) AT_WAITV(NPT); else AT_WAITV(0);
        __builtin_amdgcn_s_barrier();
        asm volatile("" ::: "memory");
        if (MODE == 2) { if (i > 0) {
            const LAS unsigned char* fp = lds + OFF_FLAG + ((i - 1) & 1) * 32;
            const u32x4 f0 = *(const LAS u32x4*)(fp), f1 = *(const LAS u32x4*)(fp + 16);
            if ((f0.x & f0.y & f0.z & f0.w & f1.x & f1.y & f1.z & f1.w) != 0u) break; } }
        if (rem >= 3) AT_DMA(t - 3, (i + 3) & 3);
        const LAS unsigned char* sb = lds + (i & 3) * SLOT;
        bool act = kv0 <= qw0 + 31;
        if (MODE == 1) act = act && (kv0 + 63 >= qw0 - 127);
        if (act) {
            f32x16 s[2];
            {
                bf16x8 kf[2][DK / 16];
#pragma unroll
                for (int ph = 0; ph < 2; ++ph) {
#pragma unroll
                    for (int d0 = 0; d0 < 4; ++d0) kf[ph][d0] = *(const LAS bf16x8*)(sb + koff[d0] + ph * 4096);
                    if (DK == 96) {
#pragma unroll
                        for (int j = 0; j < 2; ++j) kf[ph][(DK == 96) ? 4 + j : 0] = *(const LAS bf16x8*)(sb + poff[j] + ph * 2048);
                    }
                }
#pragma unroll
                for (int r = 0; r < 16; ++r) { s[0][r] = 0.f; s[1][r] = 0.f; }
                __builtin_amdgcn_sched_barrier(0);
#pragma unroll
                for (int d0 = 0; d0 < DK / 16; ++d0) {
                    s[0] = __builtin_amdgcn_mfma_f32_32x32x16_bf16(kf[0][d0], qf[d0], s[0], 0, 0, 0);
                    s[1] = __builtin_amdgcn_mfma_f32_32x32x16_bf16(kf[1][d0], qf[d0], s[1], 0, 0, 0);
                }
                __builtin_amdgcn_sched_barrier(0);
            }
            if (MODE == 2) {
                const LAS float* lcb = (const LAS float*)(sb + OFF_LC);
#pragma unroll
                for (int ph = 0; ph < 2; ++ph)
#pragma unroll
                    for (int j = 0; j < 4; ++j) { const f32x4 lk = *(const LAS f32x4*)(lcb + 32 * ph + 16 * (j >> 1) + 8 * hi + 4 * (j & 1));
#pragma unroll
                        for (int ii = 0; ii < 4; ++ii) s[ph][4 * j + ii] = s[ph][4 * j + ii] * p.c - lk[ii]; }
            } else if (MODE == 1) {
                const float dq = (float)(q - kv0 - 8 * hi);
#pragma unroll
                for (int ph = 0; ph < 2; ++ph)
#pragma unroll
                    for (int r = 0; r < 16; ++r) { const int kk = 32 * ph + 16 * (r >> 3) + 4 * ((r >> 2) & 1) + (r & 3); s[ph][r] = s[ph][r] * p.c - slope2 * (dq - (float)kk); }
            }
            bool needmask = (kv0 + 63 > qw0);
            if (MODE == 1) needmask = needmask || (kv0 < qw0 + 31 - 127);
            if (needmask) {
                const int dqi = q - kv0 - 8 * hi;
#pragma unroll
                for (int ph = 0; ph < 2; ++ph)
#pragma unroll
                    for (int r = 0; r < 16; ++r) { const int kk = 32 * ph + 16 * (r >> 3) + 4 * ((r >> 2) & 1) + (r & 3); const int dist = dqi - kk;
                        bool ok = dist >= 0; if (MODE == 1) ok = ok && (dist < 128); s[ph][r] = ok ? s[ph][r] : -INFINITY; }
            }
            float mx = fmaxf(fmaxf(s[0][0], s[0][1]), s[0][2]);
#pragma unroll
            for (int r = 3; r < 15; r += 2) mx = fmaxf(fmaxf(mx, s[0][r]), s[0][r + 1]);
            mx = fmaxf(mx, s[0][15]);
#pragma unroll
            for (int r = 0; r < 16; r += 2) mx = fmaxf(fmaxf(mx, s[1][r]), s[1][r + 1]);
            mx = fmaxf(mx, __shfl_xor(mx, 32));
            if (MODE == 0) mx *= p.c;
            const bool dead = (MODE == 2) && __all(mx < m_run - 40.f);
            if (!dead) {
                const float m_new = fmaxf(m_run, mx);
                const float alpha = __builtin_amdgcn_exp2f(m_run - m_new);
                m_run = m_new;
                float ls0 = 0.f, ls1 = 0.f;
#pragma unroll
                for (int ph = 0; ph < 2; ++ph)
#pragma unroll
                    for (int r = 0; r < 16; r += 2) {
                        const float e0 = __builtin_amdgcn_exp2f(MODE == 0 ? (s[ph][r] * p.c - m_new) : (s[ph][r] - m_new));
                        const float e1 = __builtin_amdgcn_exp2f(MODE == 0 ? (s[ph][r + 1] * p.c - m_new) : (s[ph][r + 1] - m_new));
                        s[ph][r] = e0; s[ph][r + 1] = e1; ls0 += e0; ls1 += e1; }
                if (__any(alpha != 1.f)) {
                    l_run *= alpha;
#pragma unroll
                    for (int r = 0; r < 16; ++r) { ot[0][r] *= alpha; ot[1][r] *= alpha; }
                }
                l_run += ls0 + ls1;
                bf16x8 pk[4];
#pragma unroll
                for (int cc = 0; cc < 4; ++cc) { const int ph = cc >> 1, o = 8 * (cc & 1); u32x4 w;
                    w.x = cvtpk(s[ph][o + 0], s[ph][o + 1]); w.y = cvtpk(s[ph][o + 2], s[ph][o + 3]); w.z = cvtpk(s[ph][o + 4], s[ph][o + 5]); w.w = cvtpk(s[ph][o + 6], s[ph][o + 7]);
                    pk[cc] = __builtin_bit_cast(bf16x8, w); }
                const LAS unsigned char* vb = sb + OFF_V + vrd;
                bf16x8 vf[2][4];
#pragma unroll
                for (int dh = 0; dh < 2; ++dh)
#pragma unroll
                    for (int cc = 0; cc < 4; ++cc) {
                        const v4i16_t v0 = __builtin_amdgcn_ds_read_tr16_b64_v4i16((LAS v4i16_t*)(vb + dh * VHALF + cc * 1024));
                        const v4i16_t v1 = __builtin_amdgcn_ds_read_tr16_b64_v4i16((LAS v4i16_t*)(vb + dh * VHALF + cc * 1024 + 256));
                        vf[dh][cc] = (bf16x8){v0[0], v0[1], v0[2], v0[3], v1[0], v1[1], v1[2], v1[3]}; }
                __builtin_amdgcn_sched_barrier(0);
#pragma unroll
                for (int cc = 0; cc < 4; ++cc) {
                    ot[0] = __builtin_amdgcn_mfma_f32_32x32x16_bf16(vf[0][cc], pk[cc], ot[0], 0, 0, 0);
                    ot[1] = __builtin_amdgcn_mfma_f32_32x32x16_bf16(vf[1][cc], pk[cc], ot[1], 0, 0, 0);
                }
                __builtin_amdgcn_sched_barrier(0);
            }
        }
        if (MODE == 2) {
            bool dn = false;
            if (rem >= 1) { const float bnd = qn * __shfl(pmv, t - 1) - __shfl(lcev, t - 1); dn = __all(bnd < m_run - 40.f); }
            if (lane == 0) *(LAS unsigned*)(lds + OFF_FLAG + (i & 1) * 32 + wid * 4) = dn ? 1u : 0u;
        }
    }
    if (MODE == 0) { if (ntile > 4) {
        f32x16 SA[2], SB[2];
        float m_new, alpha;
        { const int y = ((ntile - 1 < 6) ? (ntile - 1) : 6) - 4;
          if (y >= 2) AT_WAITV(2 * NPT); else if (y == 1) AT_WAITV(NPT); else AT_WAITV(0); }
        __builtin_amdgcn_s_barrier(); asm volatile("" ::: "memory");
        { const LAS unsigned char* sb = lds + (4 & 3) * SLOT;
          bf16x8 kf[2][DK / 16];
#pragma unroll
          for (int ph = 0; ph < 2; ++ph) {
#pragma unroll
              for (int d0 = 0; d0 < 4; ++d0) kf[ph][d0] = *(const LAS bf16x8*)(sb + koff[d0] + ph * 4096);
              if (DK == 96) {
#pragma unroll
                  for (int j = 0; j < 2; ++j) kf[ph][(DK == 96) ? 4 + j : 0] = *(const LAS bf16x8*)(sb + poff[j] + ph * 2048);
              }
          }
#pragma unroll
          for (int r = 0; r < 16; ++r) { SA[0][r] = 0.f; SA[1][r] = 0.f; }
#pragma unroll
          for (int d0 = 0; d0 < DK / 16; ++d0) { SA[0] = __builtin_amdgcn_mfma_f32_32x32x16_bf16(kf[0][d0], qf[d0], SA[0], 0, 0, 0); SA[1] = __builtin_amdgcn_mfma_f32_32x32x16_bf16(kf[1][d0], qf[d0], SA[1], 0, 0, 0); }
          float mx = SA[0][0];
#pragma unroll
          for (int r = 1; r < 16; ++r) mx = fmaxf(mx, SA[0][r]);
#pragma unroll
          for (int r = 0; r < 16; ++r) mx = fmaxf(mx, SA[1][r]);
          mx = fmaxf(mx, __shfl_xor(mx, 32)) * p.c;
          m_new = fmaxf(m_run, mx); alpha = __builtin_amdgcn_exp2f(m_run - m_new); m_run = m_new; }
#define P_STEP(SC, SN, i_) do { const int i__ = (i_); const bool has_next = (i__ + 1 < ntile); \
        if (i__ + 2 < ntile) AT_WAITV(NPT); else AT_WAITV(0);                      \
        __builtin_amdgcn_s_barrier(); asm volatile("" ::: "memory"); \
        if (i__ + 3 < ntile) AT_DMA(t_hi - (i__ + 3), (i__ + 3) & 3); \
        const LAS unsigned char* sbc_ = lds + (i__ & 3) * SLOT; const LAS unsigned char* sbn_ = lds + ((i__ + 1) & 3) * SLOT; \
        float l0_ = 0.f, l1_ = 0.f; \
        if (has_next) { \
            bf16x8 kf_[2][DK / 16]; \
            _Pragma("unroll") for (int ph = 0; ph < 2; ++ph) { \
                _Pragma("unroll") for (int d0 = 0; d0 < 4; ++d0) kf_[ph][d0] = *(const LAS bf16x8*)(sbn_ + koff[d0] + ph * 4096); \
                if (DK == 96) { _Pragma("unroll") for (int j = 0; j < 2; ++j) kf_[ph][(DK == 96) ? 4 + j : 0] = *(const LAS bf16x8*)(sbn_ + poff[j] + ph * 2048); } } \
            _Pragma("unroll") for (int r = 0; r < 16; ++r) { SN[0][r] = 0.f; SN[1][r] = 0.f; } \
            PSB(); \
            PSeg1<DK, 0>::run(SC, SN, kf_, qf, p.c, m_new, l0_, l1_); \
        } else { p_exp_range<0, 32>(SC, p.c, m_new, l0_, l1_); } \
        if (__any(alpha != 1.f)) { l_run *= alpha; _Pragma("unroll") for (int r = 0; r < 16; ++r) { ot[0][r] *= alpha; ot[1][r] *= alpha; } } \
        l_run += l0_ + l1_; \
        { bf16x8 vf_[2][4], pk_[4]; const LAS unsigned char* vb_ = sbc_ + OFF_V + vrd; \
          _Pragma("unroll") for (int dh = 0; dh < 2; ++dh) _Pragma("unroll") for (int cc = 0; cc < 4; ++cc) { \
              const v4i16_t v0 = __builtin_amdgcn_ds_read_tr16_b64_v4i16((LAS v4i16_t*)(vb_ + dh * VHALF + cc * 1024)); \
              const v4i16_t v1 = __builtin_amdgcn_ds_read_tr16_b64_v4i16((LAS v4i16_t*)(vb_ + dh * VHALF + cc * 1024 + 256)); \
              vf_[dh][cc] = (bf16x8){v0[0], v0[1], v0[2], v0[3], v1[0], v1[1], v1[2], v1[3]}; } \
          { u32x4 w; w.x = cvtpk(SC[0][0], SC[0][1]); w.y = cvtpk(SC[0][2], SC[0][3]); w.z = cvtpk(SC[0][4], SC[0][5]); w.w = cvtpk(SC[0][6], SC[0][7]); pk_[0] = __builtin_bit_cast(bf16x8, w); } \
          float mx_ = -INFINITY; \
          PSB(); \
          PSeg2<0>::run(SC, SN, vf_, pk_, ot, mx_, has_next); \
          if (has_next) { mx_ = fmaxf(mx_, __shfl_xor(mx_, 32)) * p.c; m_new = fmaxf(m_run, mx_); alpha = __builtin_amdgcn_exp2f(m_run - m_new); m_run = m_new; } } \
    } while (0)
        for (int i = 4; i < ntile; i += 2) {
            P_STEP(SA, SB, i);
            if (i + 1 < ntile) P_STEP(SB, SA, i + 1);
        }
#undef P_STEP
    } }
    AT_WAITV(0);
    __builtin_amdgcn_s_barrier();
    asm volatile("" ::: "memory");
    const float lt = l_run + __shfl_xor(l_run, 32);
    const float inv = 1.f / lt;
#pragma unroll
    for (int dh = 0; dh < 2; ++dh)
#pragma unroll
        for (int j = 0; j < 4; ++j) {
            const int d = 32 * dh + 8 * j + 4 * hi;
            const u32x2 g = *(const u32x2*)(Gp + (size_t)q * p.ldg + d);
            const float g0 = bflo(g.x), g1 = bfhi(g.x), g2 = bflo(g.y), g3 = bfhi(g.y);
            const float o0 = ot[dh][4 * j + 0] * inv * (g0 / (1.f + __expf(-g0)));
            const float o1 = ot[dh][4 * j + 1] * inv * (g1 / (1.f + __expf(-g1)));
            const float o2 = ot[dh][4 * j + 2] * inv * (g2 / (1.f + __expf(-g2)));
            const float o3 = ot[dh][4 * j + 3] * inv * (g3 / (1.f + __expf(-g3)));
            u32x2 w; w.x = cvtpk(o0, o1); w.y = cvtpk(o2, o3);
            *(u32x2*)(Op + (size_t)q * p.ldo + d) = w;
        }
#undef AT_DMA
}

#define XB_TMO      128
#define XB_XCNT(j)  (256  + 64 * (j))
#define XB_XSUB(j)  (1280 + 64 * (j))
#define XB_XGEN(j)  (2304 + 64 * (j))
#define XB_TOP      3328
#define XB_TOPGEN   3392
#define XCD_BAR_WORDS 3456
#define XB_SPIN_CAP (1u << 18)

__device__ __forceinline__ unsigned xb_ld(unsigned* p)              { return __hip_atomic_load(p, __ATOMIC_RELAXED, __HIP_MEMORY_SCOPE_AGENT); }
__device__ __forceinline__ unsigned xb_add(unsigned* p, unsigned v) { return __hip_atomic_fetch_add(p, v, __ATOMIC_RELAXED, __HIP_MEMORY_SCOPE_AGENT); }
__device__ __forceinline__ unsigned xb_xcc_id() { return (unsigned)__builtin_amdgcn_s_getreg((3 << 11) | 20) & 0xFu; }
#define XB_SPIN(cond, bar) do { unsigned _sp = 0; while (cond) { __builtin_amdgcn_s_sleep(1); \
    if ((++_sp & 255u) == 0u) { if (xb_ld(&(bar)[XB_TMO])) break; if (_sp > XB_SPIN_CAP) { atomicAdd(&(bar)[XB_TMO], 1u); break; } } } } while (0)

struct XcdBarrier {
    unsigned* bar; unsigned x;
    volatile LAS unsigned* st;
};

__device__ __forceinline__ XcdBarrier xcd_barrier_post(unsigned* bar, volatile LAS unsigned* st) {
    XcdBarrier b; b.bar = bar; b.x = xb_xcc_id(); b.st = st;
    if (threadIdx.x == 0) (void)xb_add(&bar[XB_XCNT(b.x)], 1u);
    return b;
}
__device__ __forceinline__ void xcd_barrier_complete(unsigned* bar, unsigned x, unsigned& nloc, unsigned& nx) {
    const unsigned G = gridDim.x * gridDim.y * gridDim.z;
    unsigned sum, cnt, mine, sp = 0u;
    for (;;) {
        sum = 0u; cnt = 0u; mine = 0u;
#pragma unroll
        for (unsigned j = 0; j < 16; ++j) { const unsigned c = xb_ld(&bar[XB_XCNT(j)]); sum += c; cnt += (c > 0u) ? 1u : 0u; mine = (j == x) ? c : mine; }
        if (sum == G) break;
        __builtin_amdgcn_s_sleep(1);
        if ((++sp & 255u) == 0u) { if (xb_ld(&bar[XB_TMO])) break; if (sp > XB_SPIN_CAP) { atomicAdd(&bar[XB_TMO], 1u); break; } }
    }
    nloc = mine > 0u ? mine : 1u; nx = cnt > 0u ? cnt : 1u;
}

__device__ __forceinline__ void xcd_barrier(const XcdBarrier& b) {
    asm volatile("s_waitcnt vmcnt(0)" ::: "memory");
    __syncthreads();
    if (threadIdx.x == 0) {
        unsigned* bar = b.bar;
        __builtin_amdgcn_s_waitcnt(0);
        unsigned nloc = b.st[0], nx = b.st[1];
        if (nloc == 0u) { xcd_barrier_complete(bar, b.x, nloc, nx); b.st[0] = nloc; b.st[1] = nx; }
        const unsigned old = xb_add(&bar[XB_XSUB(b.x)], 1u);
        const unsigned gen = old / nloc;
        if (old + 1u == (gen + 1u) * nloc) {
            __builtin_amdgcn_fence(__ATOMIC_RELEASE, "agent");
            asm volatile("s_waitcnt vmcnt(0)" ::: "memory");
            const unsigned og = xb_add(&bar[XB_TOP], 1u);
            const unsigned tg = og / nx;
            if (og + 1u == (tg + 1u) * nx) xb_add(&bar[XB_TOPGEN], 1u);
            else XB_SPIN(xb_ld(&bar[XB_TOPGEN]) == tg, bar);
            __builtin_amdgcn_fence(__ATOMIC_ACQUIRE, "agent");
            xb_add(&bar[XB_XGEN(b.x)], 1u);
            asm volatile("s_waitcnt vmcnt(0)" ::: "memory");
        } else {
            XB_SPIN(xb_ld(&bar[XB_XGEN(b.x)]) == gen, bar);
            __builtin_amdgcn_fence(__ATOMIC_ACQUIRE, "agent");
            asm volatile("s_waitcnt vmcnt(0)" ::: "memory");
        }
    }
    __syncthreads();
}

struct Args { const float* in[15]; const int* pos; float* out; unsigned char* ws; int ph_lo, ph_hi; };

__device__ __forceinline__ void transpose_item(const float* W, int ldw, int col0, int k0, bf16* WT, int ldt, int row_off, LAS float* scr, int lane) {
#pragma unroll 8
    for (int i = 0; i < 32; ++i) { const int kk = 2 * i + (lane >> 5); scr[kk * 33 + (lane & 31)] = W[(size_t)(k0 + kk) * ldw + col0 + (lane & 31)]; }
    asm volatile("s_waitcnt lgkmcnt(0)" ::: "memory");
    const int c = lane & 7;
#pragma unroll
    for (int j = 0; j < 4; ++j) { const int n = (lane >> 3) + 8 * j; const LAS float* s = scr + (8 * c) * 33 + n;
        u32x4 o; o.x = cvtpk(s[0 * 33], s[1 * 33]); o.y = cvtpk(s[2 * 33], s[3 * 33]); o.z = cvtpk(s[4 * 33], s[5 * 33]); o.w = cvtpk(s[6 * 33], s[7 * 33]);
        *(u32x4*)(WT + (size_t)(row_off + n) * ldt + k0 + 8 * c) = o; }
    asm volatile("s_waitcnt lgkmcnt(0)" ::: "memory");
}

__device__ __forceinline__ void rms_row_to_bf16(const float* xrow, const float* g, bf16* orow, int lane) {
    const f32x4* xr = (const f32x4*)xrow + lane; const f32x4* gr = (const f32x4*)g + lane;
    f32x4 v[4]; float s = 0.f;
#pragma unroll
    for (int j = 0; j < 4; ++j) { v[j] = xr[64 * j]; s += (v[j].x * v[j].x + v[j].y * v[j].y) + (v[j].z * v[j].z + v[j].w * v[j].w); }
    const float rs = 1.f / sqrtf(wave_sum(s) * (1.f / DM) + EPS);
    u32x2* o8 = (u32x2*)orow + lane;
#pragma unroll
    for (int j = 0; j < 4; ++j) { const f32x4 gg = gr[64 * j]; u32x2 w; w.x = cvtpk(v[j].x * rs * gg.x, v[j].y * rs * gg.y); w.y = cvtpk(v[j].z * rs * gg.z, v[j].w * rs * gg.w); o8[64 * j] = w; }
}

template <bool COOP>
__global__ void __launch_bounds__(NTHREADS, 2) mk_fwd(Args args) {
    extern __shared__ __attribute__((aligned(16))) unsigned char lds_raw[];
    LAS unsigned char* lds = (LAS unsigned char*)lds_raw;
    const int tid = threadIdx.x, lane = tid & 63, wave = __builtin_amdgcn_readfirstlane(tid >> 6);
    const int G = gridDim.x, bx = blockIdx.x;
    const int vcu = (G % 8 == 0) ? (bx % 8) * (G / 8) + bx / 8 : bx;
    const int gw = vcu * NWAVES + wave, NGW = G * NWAVES;
    unsigned char* ws = args.ws;
    const float* x = args.in[0];
    bf16* Wt0 = (bf16*)(ws + WS_WT0); bf16* Wqup = (bf16*)(ws + WS_WQUP); bf16* Wkvup = (bf16*)(ws + WS_WKVUP); bf16* Wout0 = (bf16*)(ws + WS_WOUT0);
    bf16* Wt1 = (bf16*)(ws + WS_WT1); bf16* Wout1 = (bf16*)(ws + WS_WOUT1);
    bf16* XN = (bf16*)(ws + WS_XN); bf16* OG = (bf16*)(ws + WS_OG); float* LF = (float*)(ws + WS_LF); float* LC = (float*)(ws + WS_LC); float* CS = (float*)(ws + WS_CS); float* TMAXB = (float*)(ws + WS_TMAX);
    bf16* Z0 = (bf16*)(ws + WS_Z0); bf16* Z1 = (bf16*)(ws + WS_Z1); bf16* CQN = (bf16*)(ws + WS_CQN); bf16* CKVN = (bf16*)(ws + WS_CKVN); bf16* KPE = (bf16*)(ws + WS_KPE);
    bf16* Q0 = (bf16*)(ws + WS_Q0); bf16* KN = (bf16*)(ws + WS_KN); bf16* VM = (bf16*)(ws + WS_VM);
    float* out = args.out;
    const int lo = args.ph_lo, hi_ph = args.ph_hi;
#ifndef REPMASK
#define REPMASK 0
#endif
#define NREP(k) (1 + (((REPMASK) >> (k)) & 1))
#ifndef PHMASK
#define PHMASK 0xfff
#endif
#define IN(k) ((((PHMASK) >> (k)) & 1) && lo <= (k) && (k) < hi_ph)
#define SEAM(k) do { if constexpr (COOP) { if (IN(k) && IN((k) + 1)) { if ((k) == 0) { cg::this_grid().sync(); xbar = xcd_barrier_post(barw, (volatile LAS unsigned*)(lds + LDS_MISC)); } else { xcd_barrier(xbar); } } } } while (0)
    unsigned* qctr = (unsigned*)(ws + 256 * 1024);
    unsigned* barw = (unsigned*)ws;
    XcdBarrier xbar; xbar.bar = barw; xbar.x = 0; xbar.st = (volatile LAS unsigned*)(lds + LDS_MISC);
    if constexpr (COOP) {
        if (tid < 16) ((LAS unsigned*)(lds + LDS_MISC))[tid] = 0u;
        if (bx == 0) { for (int i = tid; i < XCD_BAR_WORDS; i += NTHREADS) barw[i] = 0u; for (int i = tid; i < 16 * 64; i += NTHREADS) qctr[i] = 0u; for (int i = tid; i < 2 * 64 * 64; i += NTHREADS) ((unsigned*)(ws + 64 * 1024))[i] = 0u; }
        __syncthreads();
    }

    if (IN(0)) {
        LAS float* scr = (LAS float*)(lds + wave * 16384);
        constexpr int I_A = 16 * 69, I_B = 4 * 24, I_C = 2 * 32, I_D = 16 * 32, I_E1 = 16 * 96, I_E2 = 16 * 32, I_F = 16 * 32;
        constexpr int NIT = I_A + I_B + I_C + I_D + I_E1 + I_E2 + I_F;
        for (int it = gw; it < NIT; it += NGW) {
            int r = it;
            if (r < I_A) { const int kb = r / 69, nb = r % 69; transpose_item(args.in[3], N0, 32 * nb, 64 * kb, Wt0, 1024, 32 * nb, scr, lane); continue; } r -= I_A;
            if (r < I_B) { const int kb = r / 24, nb = r % 24; transpose_item(args.in[5], 768, 32 * nb, 64 * kb, Wqup, 256, 32 * nb, scr, lane); continue; } r -= I_B;
            if (r < I_C) { const int kb = r / 32, nb = r % 32; const int n0 = 32 * nb, h = n0 >> 7, j0 = n0 & 127; const int dst = (j0 < 64) ? (h * 64 + j0) : (512 + h * 64 + (j0 - 64));
                           transpose_item(args.in[7], 1024, n0, 64 * kb, Wkvup, 256, dst, scr, lane); continue; } r -= I_C;
            if (r < I_D) { const int kb = r / 32, nb = r % 32; transpose_item(args.in[9], 1024, 32 * nb, 64 * kb, Wout0, 1024, 32 * nb, scr, lane); continue; } r -= I_D;
            if (r < I_E1) { const int kb = r / 96, nb = r % 96; transpose_item(args.in[11], N1W, 32 * nb, 64 * kb, Wt1, 1024, 32 * nb, scr, lane); continue; } r -= I_E1;
            if (r < I_E2) { const int kb = r / 32, nb = r % 32; transpose_item(args.in[11], N1W, W1_G + 32 * nb, 64 * kb, Wt1, 1024, C1_G + 32 * nb, scr, lane); continue; } r -= I_E2;
            { const int kb = r / 32, nb = r % 32; transpose_item(args.in[13], 1024, 32 * nb, 64 * kb, Wout1, 1024, 32 * nb, scr, lane); }
        }
        { const u32x4 z = {0u, 0u, 0u, 0u};
          u32x4* p0 = (u32x4*)(Wt0 + (size_t)N0 * 1024);
          for (int i = vcu * NTHREADS + tid; i < 96 * 1024 / 8; i += G * NTHREADS) p0[i] = z;
          for (int i = vcu * NTHREADS + tid; i < 1024 * 16; i += G * NTHREADS) { const int row = i >> 4, c = i & 15; *(u32x4*)(Wkvup + (size_t)row * 256 + 128 + c * 8) = z; } }
        for (int m = gw; m < M; m += NGW) rms_row_to_bf16(x + (size_t)m * DM, args.in[2], XN + (size_t)m * DM, lane);
    }
    SEAM(0);
    if (IN(1)) {
        __syncthreads();
        pg8::Gemm g{XN, Wt0, M, N0P, 1024}; pg8::StaticOrder S; S.init(M, N0P, G, bx);
        pg8::EpiBf16<0> E{Z0, N0P, nullptr, 0, 0, 1.f};
        for (int rep = 0; rep < NREP(1); ++rep) {
        pg8::gemm_phase<pg8::EpiBf16<0>, pg8::StaticOrder, true, true>(lds, g, S, E); __syncthreads(); }
    }
    SEAM(1);
    if (IN(2)) {
        const float* gq = args.in[4]; const float* gkv = args.in[6];
        for (int m = gw; m < M; m += NGW) {
            const bf16* z = Z0 + (size_t)m * N0P;
            const u32x2 a = *(const u32x2*)(z + C_CQ + 4 * lane);
            const unsigned bb = *(const unsigned*)(z + C_CKV + 2 * lane);
            const float a0 = bflo(a.x), a1 = bfhi(a.x), a2 = bflo(a.y), a3 = bfhi(a.y), b0 = bflo(bb), b1 = bfhi(bb);
            const float sa = wave_sum((a0 * a0 + a1 * a1) + (a2 * a2 + a3 * a3)), sb = wave_sum(b0 * b0 + b1 * b1);
            const float ra = 1.f / sqrtf(sa * (1.f / 256.f) + EPS), rb = 1.f / sqrtf(sb * (1.f / 128.f) + EPS);
            const f32x4 ga = *(const f32x4*)(gq + 4 * lane); const f32x2 gb = *(const f32x2*)(gkv + 2 * lane);
            u32x2 w; w.x = cvtpk(a0 * ra * ga.x, a1 * ra * ga.y); w.y = cvtpk(a2 * ra * ga.z, a3 * ra * ga.w);
            *(u32x2*)(CQN + (size_t)m * 256 + 4 * lane) = w;
            *(unsigned*)(CKVN + (size_t)m * 256 + 2 * lane) = cvtpk(b0 * rb * gb.x, b1 * rb * gb.y);
            *(unsigned*)(CKVN + (size_t)m * 256 + 128 + 2 * lane) = 0u;
            if (lane < 16) {
                const float invf = (float)exp2(-(double)lane * 0.8304820237218406);
                const double ang = (double)(float)args.pos[m] * (double)invf;
                const double rev = ang * 0.15915494309189535;
                const float rr = (float)(rev - rint(rev));
                const float cv = __builtin_amdgcn_cosf(rr), sv = __builtin_amdgcn_sinf(rr);
                CS[(size_t)m * 32 + lane] = cv; CS[(size_t)m * 32 + 16 + lane] = sv;
                const float x1 = bf1(z[C_KPE + lane]), x2 = bf1(z[C_KPE + 16 + lane]);
                const unsigned o1 = cvtpk(x1 * cv - x2 * sv, 0.f), o2 = cvtpk(x2 * cv + x1 * sv, 0.f);
                KPE[(size_t)m * 32 + lane] = (bf16)(o1 & 0xffffu); KPE[(size_t)m * 32 + 16 + lane] = (bf16)(o2 & 0xffffu);
            }
        }
    }
    SEAM(2);
    if (IN(3)) {
        __syncthreads();
#ifndef NO_QUP
        { int kq_ = 256; asm volatile("" : "+s"(kq_)); pg8::Gemm g{CQN, Wqup, M, 768, kq_}; pg8::StaticOrder S; S.init(M, 768, G, bx);
          pg8::EpiQRope E{Q0, 768, CS};
          pg8::gemm_phase<pg8::EpiQRope, pg8::StaticOrder, true, true>(lds, g, S, E); }
#endif
        __syncthreads();
#ifndef NO_KVUP
        { int kk_ = 256; asm volatile("" : "+s"(kk_)); pg8::Gemm g{CKVN, Wkvup, M, 1024, kk_}; pg8::StaticOrder S; S.init(M, 1024, G, bx);
          pg8::EpiBf16<0> E{KN, 512, nullptr, 512, (size_t)(WS_VM - WS_KN) / 2, 1.f, 3u, 8};
          pg8::gemm_phase<pg8::EpiBf16<0>, pg8::StaticOrder, true, true>(lds, g, S, E); }
#endif
    }
    SEAM(3);
    if (IN(4)) {
        __syncthreads();
        for (;;) {
            if (tid == 0) *(volatile LAS int*)(lds + LDS_MISC + 64) = (int)atomicAdd(qctr + 64 * (bx & 7), 1u);
            __syncthreads();
            const int tk = *(volatile LAS int*)(lds + LDS_MISC + 64);
            __syncthreads();
            if (tk >= 128) break;
            const bool swa = tk >= 64;
            AttnP p; p.sinkp = args.in[8]; p.h0 = 0;
            if (!swa) {
                const int bh = 8 * (bx & 7) + (tk >> 3), s = tk & 7, b = bh >> 3, h = bh & 7; const size_t rb = (size_t)b * SEQ;
                p.Q = Q0 + rb * 768 + h * 96; p.ldq = 768; p.K = KN + (size_t)bh * SEQ * 64; p.ldk = 64; p.K2 = KPE + rb * 32; p.ldk2 = 32; p.V = VM + (size_t)bh * SEQ * 64; p.ldv = 64;
                p.G = Z0 + rb * N0P + C_G0 + h * 64; p.ldg = N0P; p.O = OG + rb * 1024 + h * 64; p.ldo = 1024; p.lc = nullptr; p.tmax = nullptr; p.c = 0.10206207261596575f * LOG2E; p.sink2 = 0.f; p.slope2 = 0.f;
                attn_unit<96, 0>(p, (15 - s) * 256, lds); attn_unit<96, 0>(p, s * 256, lds);
            } else {
                const int j = tk - 64, pkv = 2 * (bx & 7) + (j >> 5), b = pkv >> 1, kvh = pkv & 1, qb = 2 * (j & 31); const size_t rb = (size_t)b * SEQ;
                p.Q = Z0 + rb * N0P + C_QS + kvh * 256; p.ldq = N0P; p.K = Z0 + rb * N0P + C_KS + kvh * 64; p.ldk = N0P; p.K2 = nullptr; p.ldk2 = 0; p.V = Z0 + rb * N0P + C_VS + kvh * 64; p.ldv = N0P;
                p.G = Z0 + rb * N0P + C_G0 + 512 + kvh * 256; p.ldg = N0P; p.O = OG + rb * 1024 + 512 + kvh * 256; p.ldo = 1024; p.lc = nullptr; p.tmax = nullptr; p.c = 0.125f * LOG2E;
                p.sink2 = 0.f; p.slope2 = 0.f; p.h0 = 4 * kvh;
                attn_unit<64, 1>(p, qb * 64, lds); attn_unit<64, 1>(p, (qb + 1) * 64, lds);
            }
        }
    }
    SEAM(4);
    if (IN(5)) {
        __syncthreads();
        pg8::Gemm g{OG, Wout0, M, 1024, 1024}; pg8::StaticOrder S; S.init(M, 1024, G, bx);
        pg8::EpiResF32 E{x, out, 1024};
        pg8::gemm_phase<pg8::EpiResF32, pg8::StaticOrder, true, true>(lds, g, S, E);
    }
    SEAM(5);
    if (IN(6)) {
        __syncthreads();
        const float* g1 = args.in[10]; const float* w1 = args.in[11]; const float* bfp = args.in[12];
        LAS float* WF = (LAS float*)lds;
        for (int k = tid; k < 1024; k += NTHREADS) {
            const int l = (k & 255) >> 2, j = k >> 8, e = k & 3; const int R = l + 64 * (4 * j + e); const float gk = g1[k];
#pragma unroll
            for (int c = 0; c < 4; ++c) { const f32x4 wv = *(const f32x4*)(w1 + (size_t)k * N1W + W1_F + 4 * c); *(LAS f32x4*)(WF + R * 20 + 4 * c) = wv * gk; }
        }
        __syncthreads();
        for (int m = gw; m < M; m += NGW) {
            const f32x4* xr = (const f32x4*)(out + (size_t)m * DM) + lane; const f32x4* gr = (const f32x4*)g1 + lane;
            f32x4 v[4]; float ss = 0.f;
#pragma unroll
            for (int j = 0; j < 4; ++j) { v[j] = xr[64 * j]; ss += (v[j].x * v[j].x + v[j].y * v[j].y) + (v[j].z * v[j].z + v[j].w * v[j].w); }
            const float rs = 1.f / sqrtf(wave_sum(ss) * (1.f / DM) + EPS);
            u32x2* o8 = (u32x2*)(XN + (size_t)m * DM) + lane;
            float fa[16];
#pragma unroll
            for (int n = 0; n < 16; ++n) fa[n] = 0.f;
#pragma unroll
            for (int j = 0; j < 4; ++j) { const f32x4 gg = gr[64 * j]; u32x2 w; w.x = cvtpk(v[j].x * rs * gg.x, v[j].y * rs * gg.y); w.y = cvtpk(v[j].z * rs * gg.z, v[j].w * rs * gg.w); o8[64 * j] = w;
#pragma unroll
                for (int e = 0; e < 4; ++e) { const float xv = v[j][e]; const LAS float* wr_ = WF + (lane + 64 * (4 * j + e)) * 20;
#pragma unroll
                    for (int c = 0; c < 4; ++c) { const f32x4 wv = *(const LAS f32x4*)(wr_ + 4 * c); fa[4 * c + 0] += xv * wv.x; fa[4 * c + 1] += xv * wv.y; fa[4 * c + 2] += xv * wv.z; fa[4 * c + 3] += xv * wv.w; }
                    asm volatile("" ::: "memory"); } }
            const bool b5 = (lane & 32) != 0, b4 = (lane & 16) != 0, b3 = (lane & 8) != 0, b2 = (lane & 4) != 0;
            float r8[8], r4[4], r2[2];
#pragma unroll
            for (int i = 0; i < 8; ++i) { const float snd = b5 ? fa[i] : fa[8 + i]; r8[i] = (b5 ? fa[8 + i] : fa[i]) + __shfl_xor(snd, 32); }
#pragma unroll
            for (int i = 0; i < 4; ++i) { const float snd = b4 ? r8[i] : r8[4 + i]; r4[i] = (b4 ? r8[4 + i] : r8[i]) + __shfl_xor(snd, 16); }
#pragma unroll
            for (int i = 0; i < 2; ++i) { const float snd = b3 ? r4[i] : r4[2 + i]; r2[i] = (b3 ? r4[2 + i] : r4[i]) + __shfl_xor(snd, 8); }
            float mine = (b2 ? r2[1] : r2[0]) + __shfl_xor(b2 ? r2[0] : r2[1], 4);
            mine += __shfl_xor(mine, 1); mine += __shfl_xor(mine, 2);
            if ((lane & 3) == 0) { const int n = (lane >> 2) & 15; const float f = mine * rs + bfp[n]; const float lsg = fminf(f, 0.f) - log1pf(expf(-fabsf(f))); LF[(size_t)m * 16 + n] = lsg; }
        }
    }
    SEAM(6);
    if (IN(7)) {
        __syncthreads();
        LAS float* sm = (LAS float*)lds;
        for (int bh = bx; bh < 128; bh += G) {
            const int b = bh >> 4, h = bh & 15; float v[8]; float run = 0.f;
#pragma unroll
            for (int e = 0; e < 8; ++e) { run += LF[((size_t)b * SEQ + 8 * tid + e) * 16 + h]; v[e] = run; }
            float sc = run;
#pragma unroll
            for (int o = 1; o < 64; o <<= 1) { const float n = __shfl_up(sc, o); if (lane >= o) sc += n; }
            if (lane == 63) sm[wave] = sc;
            __syncthreads();
            float off = sc - run;
            for (int w = 0; w < wave; ++w) off += sm[w];
            f32x4 o0 = {(v[0] + off) * LOG2E, (v[1] + off) * LOG2E, (v[2] + off) * LOG2E, (v[3] + off) * LOG2E}, o1 = {(v[4] + off) * LOG2E, (v[5] + off) * LOG2E, (v[6] + off) * LOG2E, (v[7] + off) * LOG2E};
            *(f32x4*)(LC + (size_t)bh * SEQ + 8 * tid) = o0; *(f32x4*)(LC + (size_t)bh * SEQ + 8 * tid + 4) = o1;
            __syncthreads();
        }
        pg8::Gemm g{XN, Wt1, M, N1, 1024}; pg8::StaticOrder S; S.init(M, N1, G, bx);
        pg8::EpiBf16<0> E{Z1, 1024, nullptr, 1024, (size_t)M * 1024, 1.f, 6u, 16};
        pg8::gemm_phase<pg8::EpiBf16<0>, pg8::StaticOrder, true, true>(lds, g, S, E);
        __syncthreads();
        { pg8::Unit u; LAS float* smx = (LAS float*)lds;
          for (int i = 0; S.next(i, u); ++i) {
            if (u.pn < 4 || u.pn >= 8) continue;
            const int b = u.pm >> 4, T0 = 4 * (u.pm & 15), h0 = 4 * (u.pn - 4);
            for (int st = 0; st < 4; ++st) {
                const bf16* kbase = Z1 + (size_t)M * 1024 + ((((size_t)(b * 16 + h0 + ((tid & 31) >> 3))) * SEQ + (size_t)(u.pm & 15) * 256 + 64 * st + (tid >> 5)) << 6) + (tid & 7) * 8;
                float mxn = 0.f;
#pragma unroll
                for (int j = 0; j < 4; ++j) {
                    const u32x4 v = *(const u32x4*)(kbase + (size_t)(16 * j) * 64);
                    float s = 0.f;
#pragma unroll
                    for (int e = 0; e < 4; ++e) { const float a = bflo(v[e]), c = bfhi(v[e]); s += a * a + c * c; }
                    s += __shfl_xor(s, 1); s += __shfl_xor(s, 2); s += __shfl_xor(s, 4);
                    mxn = fmaxf(mxn, s);
                }
                if ((tid & 7) == 0) smx[(tid >> 5) * 4 + ((tid & 31) >> 3)] = mxn;
                __syncthreads();
                if (tid < 4) { float m16 = 0.f;
#pragma unroll
                    for (int r = 0; r < 16; ++r) m16 = fmaxf(m16, smx[r * 4 + tid]);
                    TMAXB[((size_t)(b * 16 + h0 + tid)) * 64 + T0 + st] = sqrtf(m16); }
                __syncthreads();
            }
          } }
    }
    SEAM(7);
    if (IN(9)) {
        __syncthreads();
        for (;;) {
            if (tid == 0) *(volatile LAS int*)(lds + LDS_MISC + 64) = (int)atomicAdd(qctr + 64 * (8 + (bx & 7)), 1u);
            __syncthreads();
            const int tk = *(volatile LAS int*)(lds + LDS_MISC + 64);
            __syncthreads();
            if (tk >= 128) break;
            const int bh = 16 * (bx & 7) + (tk >> 3), s = tk & 7, b = bh >> 4, h = bh & 15; const size_t rb = (size_t)b * SEQ;
            AttnP p;
            p.Q = Z1 + rb * 1024 + h * 64; p.ldq = 1024; p.K = Z1 + (size_t)M * 1024 + (size_t)bh * SEQ * 64; p.ldk = 64; p.K2 = nullptr; p.ldk2 = 0; p.V = Z1 + (size_t)2 * M * 1024 + (size_t)bh * SEQ * 64; p.ldv = 64;
            p.G = Z1 + (size_t)3 * M * 1024 + rb * 1024 + h * 64; p.ldg = 1024; p.O = OG + rb * 1024 + h * 64; p.ldo = 1024; p.lc = LC + (size_t)bh * SEQ; p.tmax = TMAXB + (size_t)bh * 64; p.sinkp = args.in[8]; p.h0 = 0; p.c = 0.125f * LOG2E; p.sink2 = 0.f; p.slope2 = 0.f;
            attn_unit<64, 2>(p, (15 - s) * 256, lds); attn_unit<64, 2>(p, s * 256, lds);
        }
    }
    SEAM(9);
    if (IN(10)) {
        __syncthreads();
        for (int sub = 0; sub < 2; ++sub) {
            const size_t r0 = (size_t)sub * 16384;
            pg8::Gemm g{OG + r0 * 1024, Wout1, 16384, 1024, 1024}; pg8::StaticOrder S; S.init(16384, 1024, G, bx);
            pg8::PanelRms st{(float*)(ws + WS_LF) + (size_t)sub * 16384 * 4, (unsigned*)(ws + 64 * 1024) + sub * 64 * 64, EPS};
            pg8::EpiRmsOut E{out + r0 * 1024, out + r0 * 1024, args.in[14], 1024, st};
            pg8::gemm_phase<pg8::EpiRmsOut, pg8::StaticOrder, false, true>(lds, g, S, E);
            __syncthreads();
        }
    }
#undef IN
#undef SEAM
}

constexpr int NPHASES = 11;
extern "C" void kernel_launch(void* const* d_in, const int* in_sizes, int n_in, void* d_out, int out_size, void* d_ws, size_t ws_size, hipStream_t stream) {
    static int grid = 0;
    if (grid == 0) {
        if (n_in != 15 || out_size != M * DM || ws_size < WS_END) { fprintf(stderr, "kernel_launch: unexpected shapes (n_in %d, out %d, ws %zu)\n", n_in, out_size, ws_size); grid = -1; return; }
        int dev = 0, cus = 0, per_cu = 0;
        (void)hipGetDevice(&dev); (void)hipDeviceGetAttribute(&cus, hipDeviceAttributeMultiprocessorCount, dev);
#if MK_COOP
        (void)hipFuncSetAttribute((const void*)mk_fwd<true>, hipFuncAttributeMaxDynamicSharedMemorySize, LDS_BYTES);
        (void)hipOccupancyMaxActiveBlocksPerMultiprocessor(&per_cu, (const void*)mk_fwd<true>, NTHREADS, LDS_BYTES);
#else
        (void)hipFuncSetAttribute((const void*)mk_fwd<false>, hipFuncAttributeMaxDynamicSharedMemorySize, LDS_BYTES);
        (void)hipOccupancyMaxActiveBlocksPerMultiprocessor(&per_cu, (const void*)mk_fwd<false>, NTHREADS, LDS_BYTES);
#endif
        (void)hipGetLastError();
        if (per_cu < 1) per_cu = 1;
        if (cus <= 0) cus = 256;
        grid = cus * 1;
    }
    if (grid < 0) return;
    Args a{};
    for (int i = 0; i < 15; ++i) a.in[i] = (const float*)d_in[i];
    a.pos = (const int*)d_in[1]; a.out = (float*)d_out; a.ws = (unsigned char*)d_ws;
#if MK_COOP
    a.ph_lo = 0; a.ph_hi = NPHASES;
    void* kargs[] = {&a};
    hipError_t e = hipLaunchCooperativeKernel((const void*)mk_fwd<true>, dim3(grid), dim3(NTHREADS), kargs, LDS_BYTES, stream);
    if (e != hipSuccess) fprintf(stderr, "cooperative launch failed: %s (grid %d)\n", hipGetErrorString(e), grid);
#else
    for (int ph = 0; ph < NPHASES; ++ph) { a.ph_lo = ph; a.ph_hi = ph + 1; hipLaunchKernelGGL(mk_fwd<false>, dim3(grid), dim3(NTHREADS), LDS_BYTES, stream, a); }
#endif
}
```

```cpp
#include <hip/hip_runtime.h>
#include <hip/hip_cooperative_groups.h>
#include <cstdio>
#include <cstdint>
#include <cmath>
namespace cg = cooperative_groups;
#ifndef MK_COOP
#define MK_COOP 1
#endif
namespace pg8 {
#define PG8_LAS __attribute__((address_space(3)))
typedef unsigned short bf16_t;
typedef short bf16x8 __attribute__((ext_vector_type(8)));
typedef float f32x4 __attribute__((ext_vector_type(4)));
typedef unsigned u32x4 __attribute__((ext_vector_type(4)));
constexpr int BM = 256, BK = 64, HALF = 128, HTB = HALF * BK * 2  , STAGE_BYTES = 8 * HTB, NXCD = 8, WGM = 8;

__host__ __device__ __forceinline__ int lds_byte(int r, int c) { const int st = (r >> 4) * 2 + (c >> 5), rr = r & 15, cc = c & 31, ob = rr * 64 + cc * 2; return st * 1024 + (ob ^ (((ob >> 9) & 1) << 5)); }
__host__ __device__ __forceinline__ void stage_rc(int b, int& R, int& C) { const int st = b / 1024, sb = b % 1024, swz = sb ^ (((sb >> 9) & 1) << 5); R = (st >> 1) * 16 + swz / 64; C = (st & 1) * 32 + (swz % 64) / 2; }
__host__ __device__ __forceinline__ int perm32(int rho) { const int n = rho >> 4, i = rho & 15; return 8 * (i >> 2) + 4 * n + (i & 3); }

struct Unit { int pm, pn; };
struct Gemm { const bf16_t* A; const bf16_t* Bt; int M, N, K; };

struct StaticOrder {
    int nM, nN, nwg, G, c;
    __host__ __device__ void init(int M, int N, int G_, int c_) { nM = M / BM; nN = N / BM; nwg = nM * nN; G = G_; c = c_; }
    __host__ __device__ bool next(int i, Unit& u) const {
        const long L = (long)i * G + c; if (L >= nwg) return false;
        int wgid = (int)L; { const int q = nwg / NXCD, r = nwg % NXCD, xcd = wgid % NXCD, off = wgid / NXCD; wgid = (xcd < r ? xcd * (q + 1) : r * (q + 1) + (xcd - r) * q) + off; }
        const int nig = WGM * nN, gid = wgid / nig, fm = gid * WGM, gsz = (nM - fm) < WGM ? (nM - fm) : WGM;
        u.pm = fm + ((wgid % nig) % gsz); u.pn = (wgid % nig) / gsz; return true;
    }
    __device__ __forceinline__ void a_ready(const Unit&) const {}
    __device__ __forceinline__ void done(const Unit&) const {}
};

__device__ __forceinline__ unsigned cvt_pk_bf16(float lo, float hi) { unsigned r; asm volatile("v_cvt_pk_bf16_f32 %0, %1, %2" : "=v"(r) : "v"(lo), "v"(hi)); return r; }
typedef float f32x2 __attribute__((ext_vector_type(2)));
__device__ __forceinline__ f32x2 gelu_pk(f32x2 v) {
    const f32x2 av = __builtin_elementwise_abs(v), d = av * 0.2316418882f + 1.0f;
    f32x2 t; t.x = __builtin_amdgcn_rcpf(d.x); t.y = __builtin_amdgcn_rcpf(d.y);
    f32x2 q = t * 0.5307027145f + (-0.7265760135f); q = q * t + 0.7107068705f; q = q * t + (-0.142248368f); q = q * t + 0.127414796f; q = q * t;
    const f32x2 s = (v * v) * (-0.72134752044f);
    f32x2 e; e.x = __builtin_amdgcn_exp2f(s.x); e.y = __builtin_amdgcn_exp2f(s.y);
    const f32x2 m = v * (q * e), r = v - m;
    f32x2 o; o.x = v.x < 0.f ? m.x : r.x; o.y = v.y < 0.f ? m.y : r.y; return o;
}

template <int ACT  > struct EpiBf16 {
    static constexpr bool PERM = true, AFTER_DRAIN = false; static_assert(ACT == 0 || ACT == 1, "EpiBf16: ACT is 0 (none) or 1 (gelu_pk)");
    bf16_t* O; int ldc; const float* bias; int split_cols; size_t split_stride; float scale0; unsigned hm_mask; int hm_heads;
    __device__ __forceinline__ void operator()(const f32x4 (&acc)[2][2][4][2], const Unit& u, int wr, int wc, int fr, int fq) const {
        const int row0 = u.pm * BM + wr * 64 + fr; int colt = u.pn * BM; bf16_t* base = O;
        float sc = 1.f; bool hm = false; if (split_cols) { const int t = colt / split_cols; base += (size_t)t * split_stride; colt -= t * split_cols; if (t == 0) sc = scale0; hm = ((hm_mask >> t) & 1u) != 0u; }
        const int col0 = colt + wc * 32 + 8 * fq, bcol0 = u.pn * BM + wc * 32 + 8 * fq;
        f32x4 bv[2][2];
#pragma unroll
        for (int bj = 0; bj < 2; ++bj)
#pragma unroll
            for (int n = 0; n < 2; ++n) bv[bj][n] = bias ? *(const f32x4*)(bias + bcol0 + bj * HALF + 4 * n) : (f32x4){0.f, 0.f, 0.f, 0.f};
#pragma unroll
        for (int ai = 0; ai < 2; ++ai)
#pragma unroll
            for (int m = 0; m < 4; ++m) { const int rowi = row0 + ai * HALF + m * 16; bf16_t* rowp = base + (size_t)rowi * ldc + col0;
#pragma unroll
                for (int bj = 0; bj < 2; ++bj) { f32x4 v0 = acc[ai][bj][m][0] + bv[bj][0], v1 = acc[ai][bj][m][1] + bv[bj][1];
                    if (ACT == 1) { f32x2 a = gelu_pk((f32x2){v0[0], v0[1]}), b = gelu_pk((f32x2){v0[2], v0[3]}), c = gelu_pk((f32x2){v1[0], v1[1]}), d = gelu_pk((f32x2){v1[2], v1[3]});
                        v0 = (f32x4){a.x, a.y, b.x, b.y}; v1 = (f32x4){c.x, c.y, d.x, d.y}; }
                    v0 = v0 * sc; v1 = v1 * sc; u32x4 w; w.x = cvt_pk_bf16(v0[0], v0[1]); w.y = cvt_pk_bf16(v0[2], v0[3]); w.z = cvt_pk_bf16(v1[0], v1[1]); w.w = cvt_pk_bf16(v1[2], v1[3]);
                    bf16_t* dst = rowp + bj * HALF;
                    if (hm) { const int col = col0 + bj * HALF; dst = base + ((((size_t)(rowi >> 12) * hm_heads + (col >> 6)) << 18) + ((size_t)(rowi & 4095) << 6) + (col & 63)); }
                    *(u32x4*)dst = w; } }
    }
};
typedef unsigned u32x2 __attribute__((ext_vector_type(2)));
struct EpiQRope {
    static constexpr bool PERM = false, AFTER_DRAIN = false;
    bf16_t* O; int ldc; const float* cs;
    __device__ __forceinline__ void operator()(const f32x4 (&acc)[2][2][4][2], const Unit& u, int wr, int wc, int fr, int fq) const {
        const int row0 = u.pm * BM + wr * 64 + fr;
#pragma unroll
        for (int ai = 0; ai < 2; ++ai)
#pragma unroll
            for (int m = 0; m < 4; ++m) {
                const int row = row0 + ai * HALF + m * 16;
                const f32x4 cv = *(const f32x4*)(cs + (size_t)row * 32 + 4 * fq), sv = *(const f32x4*)(cs + (size_t)row * 32 + 16 + 4 * fq);
#pragma unroll
                for (int bj = 0; bj < 2; ++bj) {
                    const int colb = u.pn * BM + bj * HALF + wc * 32;
                    f32x4 v0 = acc[ai][bj][m][0], v1 = acc[ai][bj][m][1];
                    if (((colb >> 5) % 3) == 2) { const f32x4 a = v0 * cv - v1 * sv, b = v1 * cv + v0 * sv; v0 = a; v1 = b; }
                    bf16_t* rp = O + (size_t)row * ldc + colb + 4 * fq;
                    u32x2 w0, w1; w0.x = cvt_pk_bf16(v0[0], v0[1]); w0.y = cvt_pk_bf16(v0[2], v0[3]); w1.x = cvt_pk_bf16(v1[0], v1[1]); w1.y = cvt_pk_bf16(v1[2], v1[3]);
                    *(u32x2*)(rp) = w0; *(u32x2*)(rp + 16) = w1;
                }
                asm volatile("" ::: "memory");
            }
    }
};
struct EpiResF32 {
    static constexpr bool PERM = false, AFTER_DRAIN = false;
    const float* base; float* out; int ldc;
    __device__ __forceinline__ void operator()(const f32x4 (&acc)[2][2][4][2], const Unit& u, int wr, int wc, int fr, int fq) const {
        const int row0 = u.pm * BM + wr * 64 + fr, col0 = u.pn * BM + wc * 32 + 4 * fq;
#pragma unroll
        for (int ai = 0; ai < 2; ++ai)
#pragma unroll
            for (int m = 0; m < 4; ++m) {
                const size_t off = (size_t)(row0 + ai * HALF + m * 16) * ldc + col0;
#pragma unroll
                for (int bj = 0; bj < 2; ++bj)
#pragma unroll
                    for (int n = 0; n < 2; ++n) { const f32x4 b = *(const f32x4*)(base + off + bj * HALF + n * 16); *(f32x4*)(out + off + bj * HALF + n * 16) = b + acc[ai][bj][m][n]; }
                asm volatile("" ::: "memory");
            }
    }
};
struct PanelRms {
    float* xbuf;
    unsigned* cnt;
    float eps;
    __device__ __forceinline__ void run(const f32x4 (&v)[2][2][4][2], const Unit& u, int wr, int wc, int fr, int fq, PG8_LAS unsigned char* lds, int wid, int lane) const {
        PG8_LAS float* P = (PG8_LAS float*)lds;
        PG8_LAS float* S = (PG8_LAS float*)(lds + 4096);
#pragma unroll
        for (int ai = 0; ai < 2; ++ai)
#pragma unroll
            for (int m = 0; m < 4; ++m) {
                float s = 0.f;
#pragma unroll
                for (int bj = 0; bj < 2; ++bj)
#pragma unroll
                    for (int n = 0; n < 2; ++n) { const f32x4 x = v[ai][bj][m][n]; s += (x[0] * x[0] + x[1] * x[1]) + (x[2] * x[2] + x[3] * x[3]); }
                s += __shfl_xor(s, 16); s += __shfl_xor(s, 32);
                if (fq == 0) P[(ai * HALF + wr * 64 + m * 16 + fr) * 4 + wc] = s;
            }
        asm volatile("s_waitcnt lgkmcnt(0)" ::: "memory"); __builtin_amdgcn_s_barrier(); asm volatile("" ::: "memory");
        const int row = wid * 32 + (lane & 31);
        if (lane < 32) {
            const float t = (P[row * 4 + 0] + P[row * 4 + 1]) + (P[row * 4 + 2] + P[row * 4 + 3]);
            __hip_atomic_store(xbuf + ((size_t)(u.pm * BM + row) * 4 + u.pn), t, __ATOMIC_RELAXED, __HIP_MEMORY_SCOPE_AGENT);
        }
        asm volatile("s_waitcnt vmcnt(0)" ::: "memory");
        if (lane == 0) __hip_atomic_fetch_add(cnt + 64 * u.pm, 1u, __ATOMIC_RELAXED, __HIP_MEMORY_SCOPE_AGENT);
        if (wid == 0) {
            unsigned spins = 0;
            while ((unsigned)__builtin_amdgcn_readfirstlane(__hip_atomic_load(cnt + 64 * u.pm, __ATOMIC_RELAXED, __HIP_MEMORY_SCOPE_AGENT)) < 32u) { __builtin_amdgcn_s_sleep(2); if (++spins > (1u << 20)) break; }
            __builtin_amdgcn_fence(__ATOMIC_ACQUIRE, "agent");
        }
        asm volatile("s_waitcnt vmcnt(0) lgkmcnt(0)" ::: "memory"); __builtin_amdgcn_s_barrier(); asm volatile("" ::: "memory");
        if (lane < 32) {
            const float* slot = xbuf + (size_t)(u.pm * BM + row) * 4; float q = 0.f;
#pragma unroll
            for (int t = 0; t < 4; ++t) q += __hip_atomic_load(slot + t, __ATOMIC_RELAXED, __HIP_MEMORY_SCOPE_AGENT);
            S[row] = 1.0f / sqrtf(q * (1.0f / 1024.0f) + eps);
        }
        asm volatile("s_waitcnt lgkmcnt(0)" ::: "memory"); __builtin_amdgcn_s_barrier(); asm volatile("" ::: "memory");
    }
};
struct EpiRmsOut {
    static constexpr bool PERM = false, AFTER_DRAIN = true;
    const float* base; float* out; const float* g; int ldc; PanelRms st;
    __device__ __forceinline__ void fused(f32x4 (&acc)[2][2][4][2], const Unit& u, int wr, int wc, int fr, int fq, PG8_LAS unsigned char* lds, int wid, int lane) const {
        const PG8_LAS float* S = (const PG8_LAS float*)(lds + 4096);
        const int col0 = u.pn * BM + wc * 32 + 4 * fq;
#pragma unroll
        for (int ai = 0; ai < 2; ++ai)
#pragma unroll
            for (int m = 0; m < 4; ++m) { const size_t off = (size_t)(u.pm * BM + ai * HALF + wr * 64 + m * 16 + fr) * ldc + col0;
#pragma unroll
                for (int bj = 0; bj < 2; ++bj)
#pragma unroll
                    for (int n = 0; n < 2; ++n) acc[ai][bj][m][n] += *(const f32x4*)(base + off + bj * HALF + n * 16);
                asm volatile("" : "+v"(acc[ai][0][m][0]), "+v"(acc[ai][0][m][1]), "+v"(acc[ai][1][m][0]), "+v"(acc[ai][1][m][1]));
                if (m & 1) asm volatile("" ::: "memory"); }
        st.run(acc, u, wr, wc, fr, fq, lds, wid, lane);
#pragma unroll
        for (int bj = 0; bj < 2; ++bj)
#pragma unroll
            for (int n = 0; n < 2; ++n) { const f32x4 gv = *(const f32x4*)(g + col0 + bj * HALF + n * 16);
#pragma unroll
                for (int ai = 0; ai < 2; ++ai)
#pragma unroll
                    for (int m = 0; m < 4; ++m) { const int r = ai * HALF + wr * 64 + m * 16 + fr; const float rs = S[r];
                        *(f32x4*)(out + (size_t)(u.pm * BM + r) * ldc + col0 + bj * HALF + n * 16) = acc[ai][bj][m][n] * rs * gv; } }
    }
};
template <class Epi, class Sched, bool ALIGN_EPI = false, bool SP2 = false>
__device__ __forceinline__ void gemm_phase(PG8_LAS unsigned char* lds, const Gemm g, const Sched& S, const Epi& E) {
    const int tid = threadIdx.x, wid = __builtin_amdgcn_readfirstlane(tid >> 6), lane = tid & 63, wr = wid >> 2, wc = wid & 3, fr = lane & 15, fq = lane >> 4;
    const int K = g.K, nt = K / BK;
    unsigned voffA[2], voffB[2];
#pragma unroll
    for (int i = 0; i < 2; ++i) { int R, C; stage_rc(tid * 16 + i * 8192, R, C); const int Rb = Epi::PERM ? ((R & ~31) + perm32(R & 31)) : R;
        voffA[i] = (unsigned)(R * K + C) * 2u; voffB[i] = (unsigned)(Rb * K + C) * 2u; }
    const size_t kstep = (size_t)(BK * 2);
    const size_t hstep = (size_t)HALF * K * 2;
    const size_t tstep = 2 * hstep;
    const unsigned ldsw = (unsigned)wid * 1024u;
    const int aoff = lds_byte(wr * 64 + fr, fq * 8), boff = lds_byte(wc * 32 + fr, fq * 8);
#define PG8_SA(b, h) (((b) * 2 + (h)) * HTB)
#define PG8_SB(b, h) ((4 + (b) * 2 + (h)) * HTB)
#define PG8_STAGE(bufoff, gbase, voff) do { _Pragma("unroll") for (int _i = 0; _i < 2; ++_i) \
        __builtin_amdgcn_global_load_lds((const unsigned*)((const char*)(gbase) + (voff)[_i]), (PG8_LAS unsigned*)(lds + (bufoff) + ldsw + _i * 8192), 16, 0, 0); } while (0)
#define PG8_LDA(dst, b, h) do { _Pragma("unroll") for (int m = 0; m < 4; ++m) _Pragma("unroll") for (int k = 0; k < 2; ++k) dst[m][k] = *(const PG8_LAS bf16x8*)(lds + PG8_SA(b, h) + aoff + m * 2048 + k * 1024); } while (0)
#define PG8_LDB(dst, b, h) do { _Pragma("unroll") for (int n = 0; n < 2; ++n) _Pragma("unroll") for (int k = 0; k < 2; ++k) dst[n][k] = *(const PG8_LAS bf16x8*)(lds + PG8_SB(b, h) + boff + n * 2048 + k * 1024); } while (0)
#define PG8_MMA(ai, bj, At, Bt) do { __builtin_amdgcn_s_setprio(1); _Pragma("unroll") for (int m = 0; m < 4; ++m) _Pragma("unroll") for (int n = 0; n < 2; ++n) _Pragma("unroll") for (int k = 0; k < 2; ++k) \
        acc[ai][bj][m][n] = __builtin_amdgcn_mfma_f32_16x16x32_bf16(Bt[n][k], At[m][k], acc[ai][bj][m][n], 0, 0, 0); __builtin_amdgcn_s_setprio(0); } while (0)
#define PG8_WAIT_V(n) asm volatile("s_waitcnt vmcnt(" #n ")" ::: "memory")
#define PG8_WAIT_L(n) asm volatile("s_waitcnt lgkmcnt(" #n ")" ::: "memory")
#define PG8_BAR __builtin_amdgcn_s_barrier()
#define PG8_SCHED __builtin_amdgcn_sched_barrier(0)
    Unit cur, nxt; int ui = 0;
    if (!S.next(0, cur)) return;
    f32x4 acc[2][2][4][2];
#pragma unroll
    for (int a = 0; a < 2; ++a)
#pragma unroll
        for (int b = 0; b < 2; ++b)
#pragma unroll
            for (int m = 0; m < 4; ++m)
#pragma unroll
                for (int n = 0; n < 2; ++n) acc[a][b][m][n] = (f32x4){0.f, 0.f, 0.f, 0.f};
    bf16x8 At[4][2], B0[2][2], B1[2][2];
    const char* cA = (const char*)g.A + (size_t)cur.pm * tstep; const char* cB = (const char*)g.Bt + (size_t)cur.pn * tstep;
    S.a_ready(cur);
    if constexpr (SP2) {
        PG8_STAGE(PG8_SB(0, 0), cB, voffB); PG8_STAGE(PG8_SB(0, 1), cB + hstep, voffB); PG8_STAGE(PG8_SA(0, 0), cA, voffA); PG8_STAGE(PG8_SA(0, 1), cA + hstep, voffA);
        if (wr == 1) PG8_BAR;
        PG8_WAIT_V(2); PG8_BAR;
        PG8_STAGE(PG8_SB(1, 0), cB + kstep, voffB); PG8_STAGE(PG8_SA(1, 0), cA + kstep, voffA); PG8_STAGE(PG8_SB(1, 1), cB + hstep + kstep, voffB);
        PG8_WAIT_V(6); PG8_BAR;
    } else {
        PG8_STAGE(PG8_SB(0, 0), cB, voffB); PG8_STAGE(PG8_SA(0, 0), cA, voffA); PG8_STAGE(PG8_SB(0, 1), cB + hstep, voffB); PG8_STAGE(PG8_SA(0, 1), cA + hstep, voffA);
        if (wr == 1) PG8_BAR;
        PG8_WAIT_V(4); PG8_BAR;
        PG8_STAGE(PG8_SB(1, 0), cB + kstep, voffB); PG8_STAGE(PG8_SA(1, 0), cA + kstep, voffA); PG8_STAGE(PG8_SB(1, 1), cB + hstep + kstep, voffB);
        PG8_WAIT_V(6); PG8_BAR;
    }
    for (;;) {
        const bool has_next = S.next(ui + 1, nxt);
        const char* nA = has_next ? (const char*)g.A + (size_t)nxt.pm * tstep : cA; const char* nB = has_next ? (const char*)g.Bt + (size_t)nxt.pn * tstep : cB;
        for (int t = 0; t < nt; t += 2) {
            const bool last = (t == nt - 2);
            const char* a1 = cA + (size_t)(t + 1) * kstep;
            const char* a2 = last ? nA : cA + (size_t)(t + 2) * kstep; const char* b2 = last ? nB : cB + (size_t)(t + 2) * kstep;
            const char* a3 = a2 + kstep; const char* b3 = b2 + kstep;
            if (last && has_next) S.a_ready(nxt);
            if constexpr (SP2) {
            PG8_LDB(B0, 0, 0); PG8_LDB(B1, 0, 1); PG8_SCHED; PG8_LDA(At, 0, 0); PG8_STAGE(PG8_SA(1, 1), a1 + hstep, voffA);
            PG8_WAIT_V(8); PG8_WAIT_L(0); PG8_BAR; PG8_MMA(0, 0, At, B0); PG8_MMA(0, 1, At, B1); PG8_BAR; PG8_SCHED;
            PG8_LDA(At, 0, 1); PG8_STAGE(PG8_SB(0, 0), b2, voffB); PG8_STAGE(PG8_SB(0, 1), b2 + hstep, voffB); PG8_STAGE(PG8_SA(0, 0), a2, voffA);
            PG8_WAIT_V(8); PG8_WAIT_L(0); PG8_BAR; PG8_MMA(1, 0, At, B0); PG8_MMA(1, 1, At, B1); PG8_BAR; PG8_SCHED;
            PG8_LDB(B0, 1, 0); PG8_LDB(B1, 1, 1); PG8_SCHED; PG8_LDA(At, 1, 0); PG8_STAGE(PG8_SA(0, 1), a2 + hstep, voffA);
            PG8_WAIT_V(8); PG8_WAIT_L(0); PG8_BAR; PG8_MMA(0, 0, At, B0); PG8_MMA(0, 1, At, B1); PG8_BAR; PG8_SCHED;
            PG8_LDA(At, 1, 1); PG8_STAGE(PG8_SB(1, 0), b3, voffB); PG8_STAGE(PG8_SB(1, 1), b3 + hstep, voffB); PG8_STAGE(PG8_SA(1, 0), a3, voffA);
            PG8_WAIT_V(8); PG8_WAIT_L(0); PG8_BAR; PG8_MMA(1, 0, At, B0); PG8_MMA(1, 1, At, B1); PG8_BAR; PG8_SCHED;
            } else {
            PG8_LDB(B0, 0, 0); PG8_SCHED; PG8_LDA(At, 0, 0); PG8_STAGE(PG8_SA(1, 1), a1 + hstep, voffA);
            PG8_WAIT_L(8); PG8_BAR; PG8_WAIT_L(0); PG8_MMA(0, 0, At, B0); PG8_BAR; PG8_SCHED;
            PG8_LDB(B1, 0, 1); PG8_STAGE(PG8_SB(0, 0), b2, voffB);
            PG8_BAR; PG8_WAIT_L(0); PG8_MMA(0, 1, At, B1); PG8_BAR;
            PG8_LDA(At, 0, 1); PG8_STAGE(PG8_SA(0, 0), a2, voffA);
            PG8_BAR; PG8_WAIT_L(0); PG8_MMA(1, 0, At, B0); PG8_BAR; PG8_SCHED;
            PG8_STAGE(PG8_SB(0, 1), b2 + hstep, voffB);
            PG8_WAIT_V(6); PG8_BAR; PG8_MMA(1, 1, At, B1); PG8_BAR;
            PG8_LDB(B0, 1, 0); PG8_SCHED; PG8_LDA(At, 1, 0); PG8_STAGE(PG8_SA(0, 1), a2 + hstep, voffA);
            PG8_WAIT_L(8); PG8_BAR; PG8_WAIT_L(0); PG8_MMA(0, 0, At, B0); PG8_BAR; PG8_SCHED;
            PG8_LDB(B1, 1, 1); PG8_STAGE(PG8_SB(1, 0), b3, voffB);
            PG8_BAR; PG8_WAIT_L(0); PG8_MMA(0, 1, At, B1); PG8_BAR;
            PG8_LDA(At, 1, 1); PG8_STAGE(PG8_SA(1, 0), a3, voffA);
            PG8_BAR; PG8_WAIT_L(0); PG8_MMA(1, 0, At, B0); PG8_BAR; PG8_SCHED;
            PG8_STAGE(PG8_SB(1, 1), b3 + hstep, voffB);
            PG8_WAIT_V(6); PG8_BAR; PG8_MMA(1, 1, At, B1); PG8_BAR;
            }
        }
        if constexpr (ALIGN_EPI) { if (wr == 0) PG8_BAR; }
        if constexpr (!Epi::AFTER_DRAIN) { E(acc, cur, wr, wc, fr, fq); S.done(cur); }
        if (!has_next) break;
#pragma unroll
        for (int a = 0; a < 2; ++a)
#pragma unroll
            for (int b = 0; b < 2; ++b)
#pragma unroll
                for (int m = 0; m < 4; ++m)
#pragma unroll
                    for (int n = 0; n < 2; ++n) acc[a][b][m][n] = (f32x4){0.f, 0.f, 0.f, 0.f};
        cur = nxt; cA = nA; cB = nB; ++ui;
        if constexpr (ALIGN_EPI) { if (wr == 1) PG8_BAR; }
    }
    PG8_WAIT_V(0);
    if constexpr (!ALIGN_EPI) { if (wr == 0) PG8_BAR; }
    PG8_BAR;
    if constexpr (Epi::AFTER_DRAIN) { E.fused(acc, cur, wr, wc, fr, fq, lds, wid, lane); S.done(cur); }
#undef PG8_SA
#undef PG8_SB
#undef PG8_STAGE
#undef PG8_LDA
#undef PG8_LDB
#undef PG8_MMA
#undef PG8_WAIT_V
#undef PG8_WAIT_L
#undef PG8_BAR
#undef PG8_SCHED
}
}
#define LAS __attribute__((address_space(3)))
typedef unsigned short bf16;
typedef short bf16x8 __attribute__((ext_vector_type(8)));
typedef float f32x16 __attribute__((ext_vector_type(16)));
typedef float f32x4 __attribute__((ext_vector_type(4)));
typedef float f32x2 __attribute__((ext_vector_type(2)));
typedef unsigned u32x4 __attribute__((ext_vector_type(4)));
typedef unsigned u32x2 __attribute__((ext_vector_type(2)));
typedef __bf16 bf16x2_t __attribute__((ext_vector_type(2)));

constexpr int BATCH = 8, SEQ = 4096, DM = 1024, M = BATCH * SEQ;
constexpr int N0 = 2208, N0P = 2304;
constexpr int C_CQ = 0, C_CKV = 256, C_KPE = 384, C_QS = 416, C_KS = 928, C_VS = 1056, C_G0 = 1184;
constexpr int N1W = 4112, N1 = 4096;
constexpr int C1_Q = 0, C1_K = 1024, C1_V = 2048, C1_G = 3072, W1_F = 3072, W1_G = 3088;
constexpr float EPS = 1e-6f, LOG2E = 1.4426950408889634f;
constexpr int NTHREADS = 512, NWAVES = 8;

constexpr size_t MiB = 1u << 20;
constexpr size_t WS_WT0 = 1 * MiB;
constexpr size_t WS_WQUP = 6 * MiB;
constexpr size_t WS_WKVUP = 7 * MiB;
constexpr size_t WS_WOUT0 = 8 * MiB;
constexpr size_t WS_WT1 = 10 * MiB;
constexpr size_t WS_WOUT1 = 18 * MiB;
constexpr size_t WS_XN = 32 * MiB;
constexpr size_t WS_OG = 96 * MiB;
constexpr size_t WS_LF = 160 * MiB;
constexpr size_t WS_LC = 162 * MiB;
constexpr size_t WS_TMAX = 512 * 1024;
constexpr size_t WS_CS = 164 * MiB;
constexpr size_t WS_Z1 = 168 * MiB;
constexpr size_t WS_Z0 = 168 * MiB;
constexpr size_t WS_CQN = 312 * MiB;
constexpr size_t WS_CKVN = 328 * MiB;
constexpr size_t WS_KPE = 344 * MiB;
constexpr size_t WS_Q0 = 346 * MiB;
constexpr size_t WS_KN = 394 * MiB;
constexpr size_t WS_VM = 426 * MiB;
constexpr size_t WS_END = 458 * MiB;
constexpr int LDS_BYTES = 135168, LDS_MISC = 131072 + 1024;

__device__ __forceinline__ unsigned cvtpk(float lo, float hi) { f32x2 v = {lo, hi}; bf16x2_t b = __builtin_convertvector(v, bf16x2_t); return __builtin_bit_cast(unsigned, b); }
__device__ __forceinline__ float bflo(unsigned u) { return __uint_as_float(u << 16); }
__device__ __forceinline__ float bfhi(unsigned u) { return __uint_as_float(u & 0xffff0000u); }
__device__ __forceinline__ float bf1(bf16 v) { return __uint_as_float(((unsigned)v) << 16); }
__device__ __forceinline__ float wave_sum(float v) {
#pragma unroll
    for (int o = 1; o < 64; o <<= 1) v += __shfl_xor(v, o);
    return v;
}

struct AttnP { const bf16 *Q, *K, *K2, *V, *G; bf16* O; const float* lc; const float* tmax; const float* sinkp; int h0; int ldq, ldk, ldk2, ldv, ldg, ldo; float c, sink2, slope2; };

typedef short v4i16_t __attribute__((ext_vector_type(4)));
__device__ __forceinline__ void glds16(const void* gsrc, unsigned lds_dst) { unsigned keep;
    asm volatile("s_mov_b32 %0, m0\n\ts_mov_b32 m0, %2\n\ts_nop 0\n\tglobal_load_lds_dwordx4 %1, off\n\ts_mov_b32 m0, %0" : "=&s"(keep) : "v"(gsrc), "s"(lds_dst) : "memory"); }
__device__ __forceinline__ void glds4(const void* gsrc, unsigned lds_dst) { unsigned keep;
    asm volatile("s_mov_b32 %0, m0\n\ts_mov_b32 m0, %2\n\ts_nop 0\n\tglobal_load_lds_dword %1, off\n\ts_mov_b32 m0, %0" : "=&s"(keep) : "v"(gsrc), "s"(lds_dst) : "memory"); }

#define PSB() __builtin_amdgcn_sched_barrier(0)
__device__ __forceinline__ constexpr int pch_lo(int k, int nch) { return k * (32 / nch) + (k < (32 % nch) ? k : (32 % nch)); }
template <int LO, int HI> __device__ __forceinline__ void p_exp_range(f32x16 (&SC)[2], float c, float m_new, float& l0, float& l1) {
#pragma unroll
    for (int e = LO; e < HI; ++e) { const float y = __builtin_amdgcn_exp2f(SC[e >> 4][e & 15] * c - m_new); SC[e >> 4][e & 15] = y; if (e & 1) l1 += y; else l0 += y; }
}
template <int DK, int K> struct PSeg1 {
    static __device__ __forceinline__ void run(f32x16 (&SC)[2], f32x16 (&SN)[2], const bf16x8 (&kf)[2][DK / 16], const bf16x8 (&qf)[DK / 16], float c, float m_new, float& l0, float& l1) {
        constexpr int NCH = 2 * (DK / 16);
        if constexpr (K < NCH) {
            SN[K & 1] = __builtin_amdgcn_mfma_f32_32x32x16_bf16(kf[K & 1][K >> 1], qf[K >> 1], SN[K & 1], 0, 0, 0);
            PSB();
            p_exp_range<pch_lo(K, NCH), pch_lo(K + 1, NCH)>(SC, c, m_new, l0, l1);
            PSB();
            PSeg1<DK, K + 1>::run(SC, SN, kf, qf, c, m_new, l0, l1);
        }
    }
};
template <int K> struct PSeg2 {
    static __device__ __forceinline__ void run(f32x16 (&SC)[2], f32x16 (&SN)[2], const bf16x8 (&vf)[2][4], bf16x8 (&pk)[4], f32x16 (&ot)[2], float& mx, bool has_next) {
        if constexpr (K < 8) {
            ot[K & 1] = __builtin_amdgcn_mfma_f32_32x32x16_bf16(vf[K & 1][K >> 1], pk[K >> 1], ot[K & 1], 0, 0, 0);
            PSB();
            if constexpr ((K & 1) == 0 && K < 6) { constexpr int cc = (K >> 1) + 1, ph = cc >> 1, o = 8 * (cc & 1); u32x4 w;
                w.x = cvtpk(SC[ph][o + 0], SC[ph][o + 1]); w.y = cvtpk(SC[ph][o + 2], SC[ph][o + 3]); w.z = cvtpk(SC[ph][o + 4], SC[ph][o + 5]); w.w = cvtpk(SC[ph][o + 6], SC[ph][o + 7]);
                pk[cc] = __builtin_bit_cast(bf16x8, w); }
            if (has_next) { constexpr int e = 4 * K, ph = e >> 4, r = e & 15;
                mx = __builtin_fmaxf(__builtin_fmaxf(mx, SN[ph][r]), SN[ph][r + 1]); mx = __builtin_fmaxf(__builtin_fmaxf(mx, SN[ph][r + 2]), SN[ph][r + 3]); }
            PSB();
            PSeg2<K + 1>::run(SC, SN, vf, pk, ot, mx, has_next);
        }
    }
};
#define AT_WAITV(n) asm volatile("s_waitcnt vmcnt(%0) lgkmcnt(0)" :: "n"(n) : "memory")
template <int DK, int MODE>
__device__ __forceinline__ void attn_unit(const AttnP& p, const int q0, LAS unsigned char* lds) {
    constexpr int NS = 4, KN_B = 8192, KP_B = (DK == 96) ? 4096 : 0, VHALF = 4160, V_B = 2 * VHALF, LC_B = (MODE == 2) ? 256 : 0;
    constexpr int OFF_KP = KN_B, OFF_V = KN_B + KP_B, OFF_LC = OFF_V + V_B, SLOT = OFF_LC + LC_B, OFF_FLAG = NS * SLOT;
    constexpr int NPT = 2 + ((DK == 96 || MODE == 2) ? 1 : 0);
    const int tid = threadIdx.x, lane = tid & 63, wid = __builtin_amdgcn_readfirstlane(tid >> 6), r32 = lane & 31, hi = lane >> 5;
    const int hsel = (MODE == 1) ? (wid >> 1) : 0;
    const int qw0 = q0 + 32 * ((MODE == 1) ? (wid & 1) : wid), q = qw0 + r32;
    const bf16* Qp = p.Q + hsel * 64; const bf16* Gp = p.G + hsel * 64; bf16* Op = p.O + hsel * 64;
    float sink2 = 0.f, slope2 = 0.f;
    if (MODE == 1) { const int hh = p.h0 + hsel; sink2 = p.sinkp[hh] * LOG2E; slope2 = exp2f(-(float)(hh + 1)) * LOG2E; }
    const unsigned lds0 = (unsigned)(uintptr_t)lds;
    bf16x8 qf[DK / 16];
#pragma unroll
    for (int d0 = 0; d0 < DK / 16; ++d0) qf[d0] = *(const bf16x8*)(Qp + (size_t)q * p.ldq + 16 * d0 + 8 * hi);
#pragma unroll
    for (int d0 = 0; d0 < DK / 16; ++d0) asm volatile("" : "+v"(qf[d0]));
    const int t_hi = (MODE == 1) ? (q0 >> 6) : (((q0 + 256) >> 6) - 1);
    const int t_lo = (MODE == 1) ? (((q0 >> 6) >= 2) ? (q0 >> 6) - 2 : 0) : 0;
    const int ntile = t_hi - t_lo + 1;
    const int krow = 8 * wid + (lane >> 3), kch = (lane & 7) ^ ((krow >> 1) & 7);
    const bf16* ksrc = p.K + (size_t)krow * p.ldk + kch * 8;
    const int prow = 8 * wid + ((lane & 31) >> 2), pch = (lane & 3) ^ ((prow >> 2) & 3);
    const bf16* psrc = (DK == 96) ? (p.K2 + (size_t)prow * p.ldk2 + pch * 8) : p.K;
    const int vrow = 16 * (wid & 3) + (lane >> 2);
    const bf16* vsrc = p.V + (size_t)vrow * p.ldv + ((wid >> 2) * 4 + (lane & 3)) * 8;
    const float* lsrc = (MODE == 2) ? (p.lc + 8 * wid + (lane & 7)) : (const float*)p.K;
#define AT_DMA(t, slot) do { const size_t ro_ = (size_t)(t) * 64; const unsigned sb_ = lds0 + (unsigned)((slot) * SLOT); \
        glds16(ksrc + ro_ * p.ldk, (unsigned)__builtin_amdgcn_readfirstlane(sb_ + wid * 1024)); \
        glds16(vsrc + ro_ * p.ldv, (unsigned)__builtin_amdgcn_readfirstlane(sb_ + OFF_V + (wid >> 2) * VHALF + (wid & 3) * 1024)); \
        if (DK == 96) { if (lane < 32) glds16(psrc + ro_ * p.ldk2, (unsigned)__builtin_amdgcn_readfirstlane(sb_ + OFF_KP + wid * 512)); } \
        if (MODE == 2) { if (lane < 8) glds4(lsrc + ro_, (unsigned)__builtin_amdgcn_readfirstlane(sb_ + OFF_LC + wid * 32)); } } while (0)

    float m_run = (MODE == 1) ? sink2 : -INFINITY;
    float l_run = (MODE == 1 && hi == 0) ? 1.f : 0.f;
    f32x16 ot[2];
#pragma unroll
    for (int r = 0; r < 16; ++r) { ot[0][r] = 0.f; ot[1][r] = 0.f; }
    const int pim = 16 * (r32 >> 4) + 8 * ((r32 >> 2) & 1) + 4 * ((r32 >> 3) & 1) + (r32 & 3);
    const int vrd = (8 * hi + ((lane & 15) >> 2)) * 64 + ((lane >> 4) & 1) * 32 + (lane & 3) * 8;
    int koff[4], poff[2];
#pragma unroll
    for (int d0 = 0; d0 < 4; ++d0) koff[d0] = pim * 128 + (((2 * d0 + hi) ^ ((pim >> 1) & 7)) * 16);
#pragma unroll
    for (int j = 0; j < 2; ++j) poff[j] = OFF_KP + pim * 64 + (((2 * j + hi) ^ ((pim >> 2) & 3)) * 16);
    float pmv = 0.f, lcev = 0.f, qn = 0.f;
    if (MODE == 2) {
        pmv = (lane <= t_hi) ? p.tmax[lane] : 0.f;
#pragma unroll
        for (int o = 1; o < 64; o <<= 1) { const float n = __shfl_up(pmv, o); if (lane >= o) pmv = fmaxf(pmv, n); }
        lcev = (lane <= t_hi) ? p.lc[64 * lane + 63] : 0.f;
        float qs = 0.f;
#pragma unroll
        for (int d0 = 0; d0 < DK / 16; ++d0)
#pragma unroll
            for (int e = 0; e < 8; ++e) { const float f = bf1((bf16)qf[d0][e]); qs += f * f; }
        qs += __shfl_xor(qs, 32);
        qn = sqrtf(qs) * p.c * 1.002f;
    }
    AT_DMA(t_hi, 0);
    if (ntile > 1) AT_DMA(t_hi - 1, 1);
    if (ntile > 2) AT_DMA(t_hi - 2, 2);
    const int nfirst = (MODE == 0 && ntile > 4) ? 4 : ntile;
    for (int i = 0; i < nfirst; ++i) {
        const int t = t_hi - i, kv0 = t * 64, rem = ntile - 1 - i;
        if (rem >= 2) AT_WAITV(2 * NPT); else if (rem == 1) AT_WAITV(NPT); else AT_WAITV(0);
        __builtin_amdgcn_s_barrier();
        asm volatile("" ::: "memory");
        if (MODE == 2) { if (i > 0) {
            const LAS unsigned char* fp = lds + OFF_FLAG + ((i - 1) & 1) * 32;
            const u32x4 f0 = *(const LAS u32x4*)(fp), f1 = *(const LAS u32x4*)(fp + 16);
            if ((f0.x & f0.y & f0.z & f0.w & f1.x & f1.y & f1.z & f1.w) != 0u) break; } }
        if (rem >= 3) AT_DMA(t - 3, (i + 3) & 3);
        const LAS unsigned char* sb = lds + (i & 3) * SLOT;
        bool act = kv0 <= qw0 + 31;
        if (MODE == 1) act = act && (kv0 + 63 >= qw0 - 127);
        if (act) {
            f32x16 s[2];
            {
                bf16x8 kf[2][DK / 16];
#pragma unroll
                for (int ph = 0; ph < 2; ++ph) {
#pragma unroll
                    for (int d0 = 0; d0 < 4; ++d0) kf[ph][d0] = *(const LAS bf16x8*)(sb + koff[d0] + ph * 4096);
                    if (DK == 96) {
#pragma unroll
                        for (int j = 0; j < 2; ++j) kf[ph][(DK == 96) ? 4 + j : 0] = *(const LAS bf16x8*)(sb + poff[j] + ph * 2048);
                    }
                }
#pragma unroll
                for (int r = 0; r < 16; ++r) { s[0][r] = 0.f; s[1][r] = 0.f; }
                __builtin_amdgcn_sched_barrier(0);
#pragma unroll
                for (int d0 = 0; d0 < DK / 16; ++d0) {
                    s[0] = __builtin_amdgcn_mfma_f32_32x32x16_bf16(kf[0][d0], qf[d0], s[0], 0, 0, 0);
                    s[1] = __builtin_amdgcn_mfma_f32_32x32x16_bf16(kf[1][d0], qf[d0], s[1], 0, 0, 0);
                }
                __builtin_amdgcn_sched_barrier(0);
            }
            if (MODE == 2) {
                const LAS float* lcb = (const LAS float*)(sb + OFF_LC);
#pragma unroll
                for (int ph = 0; ph < 2; ++ph)
#pragma unroll
                    for (int j = 0; j < 4; ++j) { const f32x4 lk = *(const LAS f32x4*)(lcb + 32 * ph + 16 * (j >> 1) + 8 * hi + 4 * (j & 1));
#pragma unroll
                        for (int ii = 0; ii < 4; ++ii) s[ph][4 * j + ii] = s[ph][4 * j + ii] * p.c - lk[ii]; }
            } else if (MODE == 1) {
                const float dq = (float)(q - kv0 - 8 * hi);
#pragma unroll
                for (int ph = 0; ph < 2; ++ph)
#pragma unroll
                    for (int r = 0; r < 16; ++r) { const int kk = 32 * ph + 16 * (r >> 3) + 4 * ((r >> 2) & 1) + (r & 3); s[ph][r] = s[ph][r] * p.c - slope2 * (dq - (float)kk); }
            }
            bool needmask = (kv0 + 63 > qw0);
            if (MODE == 1) needmask = needmask || (kv0 < qw0 + 31 - 127);
            if (needmask) {
                const int dqi = q - kv0 - 8 * hi;
#pragma unroll
                for (int ph = 0; ph < 2; ++ph)
#pragma unroll
                    for (int r = 0; r < 16; ++r) { const int kk = 32 * ph + 16 * (r >> 3) + 4 * ((r >> 2) & 1) + (r & 3); const int dist = dqi - kk;
                        bool ok = dist >= 0; if (MODE == 1) ok = ok && (dist < 128); s[ph][r] = ok ? s[ph][r] : -INFINITY; }
            }
            float mx = fmaxf(fmaxf(s[0][0], s[0][1]), s[0][2]);
#pragma unroll
            for (int r = 3; r < 15; r += 2) mx = fmaxf(fmaxf(mx, s[0][r]), s[0][r + 1]);
            mx = fmaxf(mx, s[0][15]);
#pragma unroll
            for (int r = 0; r < 16; r += 2) mx = fmaxf(fmaxf(mx, s[1][r]), s[1][r + 1]);
            mx = fmaxf(mx, __shfl_xor(mx, 32));
            if (MODE == 0) mx *= p.c;
            const bool dead = (MODE == 2) && __all(mx < m_run - 40.f);
            if (!dead) {
                const float m_new = fmaxf(m_run, mx);
                const float alpha = __builtin_amdgcn_exp2f(m_run - m_new);
                m_run = m_new;
                float ls0 = 0.f, ls1 = 0.f;
#pragma unroll
                for (int ph = 0; ph < 2; ++ph)
#pragma unroll
                    for (int r = 0; r < 16; r += 2) {
                        const float e0 = __builtin_amdgcn_exp2f(MODE == 0 ? (s[ph][r] * p.c - m_new) : (s[ph][r] - m_new));
                        const float e1 = __builtin_amdgcn_exp2f(MODE == 0 ? (s[ph][r + 1] * p.c - m_new) : (s[ph][r + 1] - m_new));
                        s[ph][r] = e0; s[ph][r + 1] = e1; ls0 += e0; ls1 += e1; }
                if (__any(alpha != 1.f)) {
                    l_run *= alpha;
#pragma unroll
                    for (int r = 0; r < 16; ++r) { ot[0][r] *= alpha; ot[1][r] *= alpha; }
                }
                l_run += ls0 + ls1;
                bf16x8 pk[4];
#pragma unroll
                for (int cc = 0; cc < 4; ++cc) { const int ph = cc >> 1, o = 8 * (cc & 1); u32x4 w;
                    w.x = cvtpk(s[ph][o + 0], s[ph][o + 1]); w.y = cvtpk(s[ph][o + 2], s[ph][o + 3]); w.z = cvtpk(s[ph][o + 4], s[ph][o + 5]); w.w = cvtpk(s[ph][o + 6], s[ph][o + 7]);
                    pk[cc] = __builtin_bit_cast(bf16x8, w); }
                const LAS unsigned char* vb = sb + OFF_V + vrd;
                bf16x8 vf[2][4];
#pragma unroll
                for (int dh = 0; dh < 2; ++dh)
#pragma unroll
                    for (int cc = 0; cc < 4; ++cc) {
                        const v4i16_t v0 = __builtin_amdgcn_ds_read_tr16_b64_v4i16((LAS v4i16_t*)(vb + dh * VHALF + cc * 1024));
                        const v4i16_t v1 = __builtin_amdgcn_ds_read_tr16_b64_v4i16((LAS v4i16_t*)(vb + dh * VHALF + cc * 1024 + 256));
                        vf[dh][cc] = (bf16x8){v0[0], v0[1], v0[2], v0[3], v1[0], v1[1], v1[2], v1[3]}; }
                __builtin_amdgcn_sched_barrier(0);
#pragma unroll
                for (int cc = 0; cc < 4; ++cc) {
                    ot[0] = __builtin_amdgcn_mfma_f32_32x32x16_bf16(vf[0][cc], pk[cc], ot[0], 0, 0, 0);
                    ot[1] = __builtin_amdgcn_mfma_f32_32x32x16_bf16(vf[1][cc], pk[cc], ot[1], 0, 0, 0);
                }
                __builtin_amdgcn_sched_barrier(0);
            }
        }
        if (MODE == 2) {
            bool dn = false;
            if (rem >= 1) { const float bnd = qn * __shfl(pmv, t - 1) - __shfl(lcev, t - 1); dn = __all(bnd < m_run - 40.f); }
            if (lane == 0) *(LAS unsigned*)(lds + OFF_FLAG + (i & 1) * 32 + wid * 4) = dn ? 1u : 0u;
        }
    }
    if (MODE == 0) { if (ntile > 4) {
        f32x16 SA[2], SB[2];
        float m_new, alpha;
        { const int y = ((ntile - 1 < 6) ? (ntile - 1) : 6) - 4;
          if (y >= 2) AT_WAITV(2 * NPT); else if (y == 1) AT_WAITV(NPT); else AT_WAITV(0); }
        __builtin_amdgcn_s_barrier(); asm volatile("" ::: "memory");
        { const LAS unsigned char* sb = lds + (4 & 3) * SLOT;
          bf16x8 kf[2][DK / 16];
#pragma unroll
          for (int ph = 0; ph < 2; ++ph) {
#pragma unroll
              for (int d0 = 0; d0 < 4; ++d0) kf[ph][d0] = *(const LAS bf16x8*)(sb + koff[d0] + ph * 4096);
              if (DK == 96) {
#pragma unroll
                  for (int j = 0; j < 2; ++j) kf[ph][(DK == 96) ? 4 + j : 0] = *(const LAS bf16x8*)(sb + poff[j] + ph * 2048);
              }
          }
#pragma unroll
          for (int r = 0; r < 16; ++r) { SA[0][r] = 0.f; SA[1][r] = 0.f; }
#pragma unroll
          for (int d0 = 0; d0 < DK / 16; ++d0) { SA[0] = __builtin_amdgcn_mfma_f32_32x32x16_bf16(kf[0][d0], qf[d0], SA[0], 0, 0, 0); SA[1] = __builtin_amdgcn_mfma_f32_32x32x16_bf16(kf[1][d0], qf[d0], SA[1], 0, 0, 0); }
          float mx = SA[0][0];
#pragma unroll
          for (int r = 1; r < 16; ++r) mx = fmaxf(mx, SA[0][r]);
#pragma unroll
          for (int r = 0; r < 16; ++r) mx = fmaxf(mx, SA[1][r]);
          mx = fmaxf(mx, __shfl_xor(mx, 32)) * p.c;
          m_new = fmaxf(m_run, mx); alpha = __builtin_amdgcn_exp2f(m_run - m_new); m_run = m_new; }
#define P_STEP(SC, SN, i_) do { const int i__ = (i_); const bool has_next = (i__ + 1 < ntile); \
        if (i__ + 2 < ntile) AT_WAITV(NPT); else AT_WAITV(0);                      \
        __builtin_amdgcn_s_barrier(); asm volatile("" ::: "memory"); \
        if (i__ + 3 < ntile) AT_DMA(t_hi - (i__ + 3), (i__ + 3) & 3); \
        const LAS unsigned char* sbc_ = lds + (i__ & 3) * SLOT; const LAS unsigned char* sbn_ = lds + ((i__ + 1) & 3) * SLOT; \
        float l0_ = 0.f, l1_ = 0.f; \
        if (has_next) { \
            bf16x8 kf_[2][DK / 16]; \
            _Pragma("unroll") for (int ph = 0; ph < 2; ++ph) { \
                _Pragma("unroll") for (int d0 = 0; d0 < 4; ++d0) kf_[ph][d0] = *(const LAS bf16x8*)(sbn_ + koff[d0] + ph * 4096); \
                if (DK == 96) { _Pragma("unroll") for (int j = 0; j < 2; ++j) kf_[ph][(DK == 96) ? 4 + j : 0] = *(const LAS bf16x8*)(sbn_ + poff[j] + ph * 2048); } } \
            _Pragma("unroll") for (int r = 0; r < 16; ++r) { SN[0][r] = 0.f; SN[1][r] = 0.f; } \
            PSB(); \
            PSeg1<DK, 0>::run(SC, SN, kf_, qf, p.c, m_new, l0_, l1_); \
        } else { p_exp_range<0, 32>(SC, p.c, m_new, l0_, l1_); } \
        if (__any(alpha != 1.f)) { l_run *= alpha; _Pragma("unroll") for (int r = 0; r < 16; ++r) { ot[0][r] *= alpha; ot[1][r] *= alpha; } } \
        l_run += l0_ + l1_; \
        { bf16x8 vf_[2][4], pk_[4]; const LAS unsigned char* vb_ = sbc_ + OFF_V + vrd; \
          _Pragma("unroll") for (int dh = 0; dh < 2; ++dh) _Pragma("unroll") for (int cc = 0; cc < 4; ++cc) { \
              const v4i16_t v0 = __builtin_amdgcn_ds_read_tr16_b64_v4i16((LAS v4i16_t*)(vb_ + dh * VHALF + cc * 1024)); \
              const v4i16_t v1 = __builtin_amdgcn_ds_read_tr16_b64_v4i16((LAS v4i16_t*)(vb_ + dh * VHALF + cc * 1024 + 256)); \
              vf_[dh][cc] = (bf16x8){v0[0], v0[1], v0[2], v0[3], v1[0], v1[1], v1[2], v1[3]}; } \
          { u32x4 w; w.x = cvtpk(SC[0][0], SC[0][1]); w.y = cvtpk(SC[0][2], SC[0][3]); w.z = cvtpk(SC[0][4], SC[0][5]); w.w = cvtpk(SC[0][6], SC[0][7]); pk_[0] = __builtin_bit_cast(bf16x8, w); } \
          float mx_ = -INFINITY; \
          PSB(); \
          PSeg2<0>::run(SC, SN, vf_, pk_, ot, mx_, has_next); \
          if (has_next) { mx_ = fmaxf(mx_, __shfl_xor(mx_, 32)) * p.c; m_new = fmaxf(m_run, mx_); alpha = __builtin_amdgcn_exp2f(m_run - m_new); m_run = m_new; } } \
    } while (0)
        for (int i = 4; i < ntile; i += 2) {
            P_STEP(SA, SB, i);
            if (i + 1 < ntile) P_STEP(SB, SA, i + 1);
        }
#undef P_STEP
    } }
    AT_WAITV(0);
    __builtin_amdgcn_s_barrier();
    asm volatile("" ::: "memory");
    const float lt = l_run + __shfl_xor(l_run, 32);
    const float inv = 1.f / lt;
#pragma unroll
    for (int dh = 0; dh < 2; ++dh)
#pragma unroll
        for (int j = 0; j < 4; ++j) {
            const int d = 32 * dh + 8 * j + 4 * hi;
            const u32x2 g = *(const u32x2*)(Gp + (size_t)q * p.ldg + d);
            const float g0 = bflo(g.x), g1 = bfhi(g.x), g2 = bflo(g.y), g3 = bfhi(g.y);
            const float o0 = ot[dh][4 * j + 0] * inv * (g0 / (1.f + __expf(-g0)));
            const float o1 = ot[dh][4 * j + 1] * inv * (g1 / (1.f + __expf(-g1)));
            const float o2 = ot[dh][4 * j + 2] * inv * (g2 / (1.f + __expf(-g2)));
            const float o3 = ot[dh][4 * j + 3] * inv * (g3 / (1.f + __expf(-g3)));
            u32x2 w; w.x = cvtpk(o0, o1); w.y = cvtpk(o2, o3);
            *(u32x2*)(Op + (size_t)q * p.ldo + d) = w;
        }
#undef AT_DMA
}

#define XB_TMO      128
#define XB_XCNT(j)  (256  + 64 * (j))
#define XB_XSUB(j)  (1280 + 64 * (j))
#define XB_XGEN(j)  (2304 + 64 * (j))
#define XB_TOP      3328
#define XB_TOPGEN   3392
#define XCD_BAR_WORDS 3456
#define XB_SPIN_CAP (1u << 18)

__device__ __forceinline__ unsigned xb_ld(unsigned* p)              { return __hip_atomic_load(p, __ATOMIC_RELAXED, __HIP_MEMORY_SCOPE_AGENT); }
__device__ __forceinline__ unsigned xb_add(unsigned* p, unsigned v) { return __hip_atomic_fetch_add(p, v, __ATOMIC_RELAXED, __HIP_MEMORY_SCOPE_AGENT); }
__device__ __forceinline__ unsigned xb_xcc_id() { return (unsigned)__builtin_amdgcn_s_getreg((3 << 11) | 20) & 0xFu; }
#define XB_SPIN(cond, bar) do { unsigned _sp = 0; while (cond) { __builtin_amdgcn_s_sleep(1); \
    if ((++_sp & 255u) == 0u) { if (xb_ld(&(bar)[XB_TMO])) break; if (_sp > XB_SPIN_CAP) { atomicAdd(&(bar)[XB_TMO], 1u); break; } } } } while (0)

struct XcdBarrier {
    unsigned* bar; unsigned x;
    volatile LAS unsigned* st;
};

__device__ __forceinline__ XcdBarrier xcd_barrier_post(unsigned* bar, volatile LAS unsigned* st) {
    XcdBarrier b; b.bar = bar; b.x = xb_xcc_id(); b.st = st;
    if (threadIdx.x == 0) (void)xb_add(&bar[XB_XCNT(b.x)], 1u);
    return b;
}
__device__ __forceinline__ void xcd_barrier_complete(unsigned* bar, unsigned x, unsigned& nloc, unsigned& nx) {
    const unsigned G = gridDim.x * gridDim.y * gridDim.z;
    unsigned sum, cnt, mine, sp = 0u;
    for (;;) {
        sum = 0u; cnt = 0u; mine = 0u;
#pragma unroll
        for (unsigned j = 0; j < 16; ++j) { const unsigned c = xb_ld(&bar[XB_XCNT(j)]); sum += c; cnt += (c > 0u) ? 1u : 0u; mine = (j == x) ? c : mine; }
        if (sum == G) break;
        __builtin_amdgcn_s_sleep(1);
        if ((++sp & 255u) == 0u) { if (xb_ld(&bar[XB_TMO])) break; if (sp > XB_SPIN_CAP) { atomicAdd(&bar[XB_TMO], 1u); break; } }
    }
    nloc = mine > 0u ? mine : 1u; nx = cnt > 0u ? cnt : 1u;
}

__device__ __forceinline__ void xcd_barrier(const XcdBarrier& b) {
    asm volatile("s_waitcnt vmcnt(0)" ::: "memory");
    __syncthreads();
    if (threadIdx.x == 0) {
        unsigned* bar = b.bar;
        __builtin_amdgcn_s_waitcnt(0);
        unsigned nloc = b.st[0], nx = b.st[1];
        if (nloc == 0u) { xcd_barrier_complete(bar, b.x, nloc, nx); b.st[0] = nloc; b.st[1] = nx; }
        const unsigned old = xb_add(&bar[XB_XSUB(b.x)], 1u);
        const unsigned gen = old / nloc;
        if (old + 1u == (gen + 1u) * nloc) {
            __builtin_amdgcn_fence(__ATOMIC_RELEASE, "agent");
            asm volatile("s_waitcnt vmcnt(0)" ::: "memory");
            const unsigned og = xb_add(&bar[XB_TOP], 1u);
            const unsigned tg = og / nx;
            if (og + 1u == (tg + 1u) * nx) xb_add(&bar[XB_TOPGEN], 1u);
            else XB_SPIN(xb_ld(&bar[XB_TOPGEN]) == tg, bar);
            __builtin_amdgcn_fence(__ATOMIC_ACQUIRE, "agent");
            xb_add(&bar[XB_XGEN(b.x)], 1u);
            asm volatile("s_waitcnt vmcnt(0)" ::: "memory");
        } else {
            XB_SPIN(xb_ld(&bar[XB_XGEN(b.x)]) == gen, bar);
            __builtin_amdgcn_fence(__ATOMIC_ACQUIRE, "agent");
            asm volatile("s_waitcnt vmcnt(0)" ::: "memory");
        }
    }
    __syncthreads();
}

struct Args { const float* in[15]; const int* pos; float* out; unsigned char* ws; int ph_lo, ph_hi; };

__device__ __forceinline__ void transpose_item(const float* W, int ldw, int col0, int k0, bf16* WT, int ldt, int row_off, LAS float* scr, int lane) {
#pragma unroll 8
    for (int i = 0; i < 32; ++i) { const int kk = 2 * i + (lane >> 5); scr[kk * 33 + (lane & 31)] = W[(size_t)(k0 + kk) * ldw + col0 + (lane & 31)]; }
    asm volatile("s_waitcnt lgkmcnt(0)" ::: "memory");
    const int c = lane & 7;
#pragma unroll
    for (int j = 0; j < 4; ++j) { const int n = (lane >> 3) + 8 * j; const LAS float* s = scr + (8 * c) * 33 + n;
        u32x4 o; o.x = cvtpk(s[0 * 33], s[1 * 33]); o.y = cvtpk(s[2 * 33], s[3 * 33]); o.z = cvtpk(s[4 * 33], s[5 * 33]); o.w = cvtpk(s[6 * 33], s[7 * 33]);
        *(u32x4*)(WT + (size_t)(row_off + n) * ldt + k0 + 8 * c) = o; }
    asm volatile("s_waitcnt lgkmcnt(0)" ::: "memory");
}

__device__ __forceinline__ void rms_row_to_bf16(const float* xrow, const float* g, bf16* orow, int lane) {
    const f32x4* xr = (const f32x4*)xrow + lane; const f32x4* gr = (const f32x4*)g + lane;
    f32x4 v[4]; float s = 0.f;
#pragma unroll
    for (int j = 0; j < 4; ++j) { v[j] = xr[64 * j]; s += (v[j].x * v[j].x + v[j].y * v[j].y) + (v[j].z * v[j].z + v[j].w * v[j].w); }
    const float rs = 1.f / sqrtf(wave_sum(s) * (1.f / DM) + EPS);
    u32x2* o8 = (u32x2*)orow + lane;
#pragma unroll
    for (int j = 0; j < 4; ++j) { const f32x4 gg = gr[64 * j]; u32x2 w; w.x = cvtpk(v[j].x * rs * gg.x, v[j].y * rs * gg.y); w.y = cvtpk(v[j].z * rs * gg.z, v[j].w * rs * gg.w); o8[64 * j] = w; }
}

template <bool COOP>
__global__ void __launch_bounds__(NTHREADS, 2) mk_fwd(Args args) {
    extern __shared__ __attribute__((aligned(16))) unsigned char lds_raw[];
    LAS unsigned char* lds = (LAS unsigned char*)lds_raw;
    const int tid = threadIdx.x, lane = tid & 63, wave = __builtin_amdgcn_readfirstlane(tid >> 6);
    const int G = gridDim.x, bx = blockIdx.x;
    const int vcu = (G % 8 == 0) ? (bx % 8) * (G / 8) + bx / 8 : bx;
    const int gw = vcu * NWAVES + wave, NGW = G * NWAVES;
    unsigned char* ws = args.ws;
    const float* x = args.in[0];
    bf16* Wt0 = (bf16*)(ws + WS_WT0); bf16* Wqup = (bf16*)(ws + WS_WQUP); bf16* Wkvup = (bf16*)(ws + WS_WKVUP); bf16* Wout0 = (bf16*)(ws + WS_WOUT0);
    bf16* Wt1 = (bf16*)(ws + WS_WT1); bf16* Wout1 = (bf16*)(ws + WS_WOUT1);
    bf16* XN = (bf16*)(ws + WS_XN); bf16* OG = (bf16*)(ws + WS_OG); float* LF = (float*)(ws + WS_LF); float* LC = (float*)(ws + WS_LC); float* CS = (float*)(ws + WS_CS); float* TMAXB = (float*)(ws + WS_TMAX);
    bf16* Z0 = (bf16*)(ws + WS_Z0); bf16* Z1 = (bf16*)(ws + WS_Z1); bf16* CQN = (bf16*)(ws + WS_CQN); bf16* CKVN = (bf16*)(ws + WS_CKVN); bf16* KPE = (bf16*)(ws + WS_KPE);
    bf16* Q0 = (bf16*)(ws + WS_Q0); bf16* KN = (bf16*)(ws + WS_KN); bf16* VM = (bf16*)(ws + WS_VM);
    float* out = args.out;
    const int lo = args.ph_lo, hi_ph = args.ph_hi;
#ifndef REPMASK
#define REPMASK 0
#endif
#define NREP(k) (1 + (((REPMASK) >> (k)) & 1))
#ifndef PHMASK
#define PHMASK 0xfff
#endif
#define IN(k) ((((PHMASK) >> (k)) & 1) && lo <= (k) && (k) < hi_ph)
#define SEAM(k) do { if constexpr (COOP) { if (IN(k) && IN((k) + 1)) { if ((k) == 0) { cg::this_grid().sync(); xbar = xcd_barrier_post(barw, (volatile LAS unsigned*)(lds + LDS_MISC)); } else { xcd_barrier(xbar); } } } } while (0)
    unsigned* qctr = (unsigned*)(ws + 256 * 1024);
    unsigned* barw = (unsigned*)ws;
    XcdBarrier xbar; xbar.bar = barw; xbar.x = 0; xbar.st = (volatile LAS unsigned*)(lds + LDS_MISC);
    if constexpr (COOP) {
        if (tid < 16) ((LAS unsigned*)(lds + LDS_MISC))[tid] = 0u;
        if (bx == 0) { for (int i = tid; i < XCD_BAR_WORDS; i += NTHREADS) barw[i] = 0u; for (int i = tid; i < 16 * 64; i += NTHREADS) qctr[i] = 0u; for (int i = tid; i < 2 * 64 * 64; i += NTHREADS) ((unsigned*)(ws + 64 * 1024))[i] = 0u; }
        __syncthreads();
    }

    if (IN(0)) {
        LAS float* scr = (LAS float*)(lds + wave * 16384);
        constexpr int I_A = 16 * 69, I_B = 4 * 24, I_C = 2 * 32, I_D = 16 * 32, I_E1 = 16 * 96, I_E2 = 16 * 32, I_F = 16 * 32;
        constexpr int NIT = I_A + I_B + I_C + I_D + I_E1 + I_E2 + I_F;
        for (int it = gw; it < NIT; it += NGW) {
            int r = it;
            if (r < I_A) { const int kb = r / 69, nb = r % 69; transpose_item(args.in[3], N0, 32 * nb, 64 * kb, Wt0, 1024, 32 * nb, scr, lane); continue; } r -= I_A;
            if (r < I_B) { const int kb = r / 24, nb = r % 24; transpose_item(args.in[5], 768, 32 * nb, 64 * kb, Wqup, 256, 32 * nb, scr, lane); continue; } r -= I_B;
            if (r < I_C) { const int kb = r / 32, nb = r % 32; const int n0 = 32 * nb, h = n0 >> 7, j0 = n0 & 127; const int dst = (j0 < 64) ? (h * 64 + j0) : (512 + h * 64 + (j0 - 64));
                           transpose_item(args.in[7], 1024, n0, 64 * kb, Wkvup, 256, dst, scr, lane); continue; } r -= I_C;
            if (r < I_D) { const int kb = r / 32, nb = r % 32; transpose_item(args.in[9], 1024, 32 * nb, 64 * kb, Wout0, 1024, 32 * nb, scr, lane); continue; } r -= I_D;
            if (r < I_E1) { const int kb = r / 96, nb = r % 96; transpose_item(args.in[11], N1W, 32 * nb, 64 * kb, Wt1, 1024, 32 * nb, scr, lane); continue; } r -= I_E1;
            if (r < I_E2) { const int kb = r / 32, nb = r % 32; transpose_item(args.in[11], N1W, W1_G + 32 * nb, 64 * kb, Wt1, 1024, C1_G + 32 * nb, scr, lane); continue; } r -= I_E2;
            { const int kb = r / 32, nb = r % 32; transpose_item(args.in[13], 1024, 32 * nb, 64 * kb, Wout1, 1024, 32 * nb, scr, lane); }
        }
        { const u32x4 z = {0u, 0u, 0u, 0u};
          u32x4* p0 = (u32x4*)(Wt0 + (size_t)N0 * 1024);
          for (int i = vcu * NTHREADS + tid; i < 96 * 1024 / 8; i += G * NTHREADS) p0[i] = z;
          for (int i = vcu * NTHREADS + tid; i < 1024 * 16; i += G * NTHREADS) { const int row = i >> 4, c = i & 15; *(u32x4*)(Wkvup + (size_t)row * 256 + 128 + c * 8) = z; } }
        for (int m = gw; m < M; m += NGW) rms_row_to_bf16(x + (size_t)m * DM, args.in[2], XN + (size_t)m * DM, lane);
    }
    SEAM(0);
    if (IN(1)) {
        __syncthreads();
        pg8::Gemm g{XN, Wt0, M, N0P, 1024}; pg8::StaticOrder S; S.init(M, N0P, G, bx);
        pg8::EpiBf16<0> E{Z0, N0P, nullptr, 0, 0, 1.f};
        for (int rep = 0; rep < NREP(1); ++rep) {
        pg8::gemm_phase<pg8::EpiBf16<0>, pg8::StaticOrder, true, true>(lds, g, S, E); __syncthreads(); }
    }
    SEAM(1);
    if (IN(2)) {
        const float* gq = args.in[4]; const float* gkv = args.in[6];
        for (int m = gw; m < M; m += NGW) {
            const bf16* z = Z0 + (size_t)m * N0P;
            const u32x2 a = *(const u32x2*)(z + C_CQ + 4 * lane);
            const unsigned bb = *(const unsigned*)(z + C_CKV + 2 * lane);
            const float a0 = bflo(a.x), a1 = bfhi(a.x), a2 = bflo(a.y), a3 = bfhi(a.y), b0 = bflo(bb), b1 = bfhi(bb);
            const float sa = wave_sum((a0 * a0 + a1 * a1) + (a2 * a2 + a3 * a3)), sb = wave_sum(b0 * b0 + b1 * b1);
            const float ra = 1.f / sqrtf(sa * (1.f / 256.f) + EPS), rb = 1.f / sqrtf(sb * (1.f / 128.f) + EPS);
            const f32x4 ga = *(const f32x4*)(gq + 4 * lane); const f32x2 gb = *(const f32x2*)(gkv + 2 * lane);
            u32x2 w; w.x = cvtpk(a0 * ra * ga.x, a1 * ra * ga.y); w.y = cvtpk(a2 * ra * ga.z, a3 * ra * ga.w);
            *(u32x2*)(CQN + (size_t)m * 256 + 4 * lane) = w;
            *(unsigned*)(CKVN + (size_t)m * 256 + 2 * lane) = cvtpk(b0 * rb * gb.x, b1 * rb * gb.y);
            *(unsigned*)(CKVN + (size_t)m * 256 + 128 + 2 * lane) = 0u;
            if (lane < 16) {
                const float invf = (float)exp2(-(double)lane * 0.8304820237218406);
                const double ang = (double)(float)args.pos[m] * (double)invf;
                const double rev = ang * 0.15915494309189535;
                const float rr = (float)(rev - rint(rev));
                const float cv = __builtin_amdgcn_cosf(rr), sv = __builtin_amdgcn_sinf(rr);
                CS[(size_t)m * 32 + lane] = cv; CS[(size_t)m * 32 + 16 + lane] = sv;
                const float x1 = bf1(z[C_KPE + lane]), x2 = bf1(z[C_KPE + 16 + lane]);
                const unsigned o1 = cvtpk(x1 * cv - x2 * sv, 0.f), o2 = cvtpk(x2 * cv + x1 * sv, 0.f);
                KPE[(size_t)m * 32 + lane] = (bf16)(o1 & 0xffffu); KPE[(size_t)m * 32 + 16 + lane] = (bf16)(o2 & 0xffffu);
            }
        }
    }
    SEAM(2);
    if (IN(3)) {
        __syncthreads();
#ifndef NO_QUP
        { int kq_ = 256; asm volatile("" : "+s"(kq_)); pg8::Gemm g{CQN, Wqup, M, 768, kq_}; pg8::StaticOrder S; S.init(M, 768, G, bx);
          pg8::EpiQRope E{Q0, 768, CS};
          pg8::gemm_phase<pg8::EpiQRope, pg8::StaticOrder, true, true>(lds, g, S, E); }
#endif
        __syncthreads();
#ifndef NO_KVUP
        { int kk_ = 256; asm volatile("" : "+s"(kk_)); pg8::Gemm g{CKVN, Wkvup, M, 1024, kk_}; pg8::StaticOrder S; S.init(M, 1024, G, bx);
          pg8::EpiBf16<0> E{KN, 512, nullptr, 512, (size_t)(WS_VM - WS_KN) / 2, 1.f, 3u, 8};
          pg8::gemm_phase<pg8::EpiBf16<0>, pg8::StaticOrder, true, true>(lds, g, S, E); }
#endif
    }
    SEAM(3);
    if (IN(4)) {
        __syncthreads();
        for (;;) {
            if (tid == 0) *(volatile LAS int*)(lds + LDS_MISC + 64) = (int)atomicAdd(qctr + 64 * (bx & 7), 1u);
            __syncthreads();
            const int tk = *(volatile LAS int*)(lds + LDS_MISC + 64);
            __syncthreads();
            if (tk >= 128) break;
            const bool swa = tk >= 64;
            AttnP p; p.sinkp = args.in[8]; p.h0 = 0;
            if (!swa) {
                const int bh = 8 * (bx & 7) + (tk >> 3), s = tk & 7, b = bh >> 3, h = bh & 7; const size_t rb = (size_t)b * SEQ;
                p.Q = Q0 + rb * 768 + h * 96; p.ldq = 768; p.K = KN + (size_t)bh * SEQ * 64; p.ldk = 64; p.K2 = KPE + rb * 32; p.ldk2 = 32; p.V = VM + (size_t)bh * SEQ * 64; p.ldv = 64;
                p.G = Z0 + rb * N0P + C_G0 + h * 64; p.ldg = N0P; p.O = OG + rb * 1024 + h * 64; p.ldo = 1024; p.lc = nullptr; p.tmax = nullptr; p.c = 0.10206207261596575f * LOG2E; p.sink2 = 0.f; p.slope2 = 0.f;
                attn_unit<96, 0>(p, (15 - s) * 256, lds); attn_unit<96, 0>(p, s * 256, lds);
            } else {
                const int j = tk - 64, pkv = 2 * (bx & 7) + (j >> 5), b = pkv >> 1, kvh = pkv & 1, qb = 2 * (j & 31); const size_t rb = (size_t)b * SEQ;
                p.Q = Z0 + rb * N0P + C_QS + kvh * 256; p.ldq = N0P; p.K = Z0 + rb * N0P + C_KS + kvh * 64; p.ldk = N0P; p.K2 = nullptr; p.ldk2 = 0; p.V = Z0 + rb * N0P + C_VS + kvh * 64; p.ldv = N0P;
                p.G = Z0 + rb * N0P + C_G0 + 512 + kvh * 256; p.ldg = N0P; p.O = OG + rb * 1024 + 512 + kvh * 256; p.ldo = 1024; p.lc = nullptr; p.tmax = nullptr; p.c = 0.125f * LOG2E;
                p.sink2 = 0.f; p.slope2 = 0.f; p.h0 = 4 * kvh;
                attn_unit<64, 1>(p, qb * 64, lds); attn_unit<64, 1>(p, (qb + 1) * 64, lds);
            }
        }
    }
    SEAM(4);
    if (IN(5)) {
        __syncthreads();
        pg8::Gemm g{OG, Wout0, M, 1024, 1024}; pg8::StaticOrder S; S.init(M, 1024, G, bx);
        pg8::EpiResF32 E{x, out, 1024};
        pg8::gemm_phase<pg8::EpiResF32, pg8::StaticOrder, true, true>(lds, g, S, E);
    }
    SEAM(5);
    if (IN(6)) {
        __syncthreads();
        const float* g1 = args.in[10]; const float* w1 = args.in[11]; const float* bfp = args.in[12];
        LAS float* WF = (LAS float*)lds;
        for (int k = tid; k < 1024; k += NTHREADS) {
            const int l = (k & 255) >> 2, j = k >> 8, e = k & 3; const int R = l + 64 * (4 * j + e); const float gk = g1[k];
#pragma unroll
            for (int c = 0; c < 4; ++c) { const f32x4 wv = *(const f32x4*)(w1 + (size_t)k * N1W + W1_F + 4 * c); *(LAS f32x4*)(WF + R * 20 + 4 * c) = wv * gk; }
        }
        __syncthreads();
        for (int m = gw; m < M; m += NGW) {
            const f32x4* xr = (const f32x4*)(out + (size_t)m * DM) + lane; const f32x4* gr = (const f32x4*)g1 + lane;
            f32x4 v[4]; float ss = 0.f;
#pragma unroll
            for (int j = 0; j < 4; ++j) { v[j] = xr[64 * j]; ss += (v[j].x * v[j].x + v[j].y * v[j].y) + (v[j].z * v[j].z + v[j].w * v[j].w); }
            const float rs = 1.f / sqrtf(wave_sum(ss) * (1.f / DM) + EPS);
            u32x2* o8 = (u32x2*)(XN + (size_t)m * DM) + lane;
            float fa[16];
#pragma unroll
            for (int n = 0; n < 16; ++n) fa[n] = 0.f;
#pragma unroll
            for (int j = 0; j < 4; ++j) { const f32x4 gg = gr[64 * j]; u32x2 w; w.x = cvtpk(v[j].x * rs * gg.x, v[j].y * rs * gg.y); w.y = cvtpk(v[j].z * rs * gg.z, v[j].w * rs * gg.w); o8[64 * j] = w;
#pragma unroll
                for (int e = 0; e < 4; ++e) { const float xv = v[j][e]; const LAS float* wr_ = WF + (lane + 64 * (4 * j + e)) * 20;
#pragma unroll
                    for (int c = 0; c < 4; ++c) { const f32x4 wv = *(const LAS f32x4*)(wr_ + 4 * c); fa[4 * c + 0] += xv * wv.x; fa[4 * c + 1] += xv * wv.y; fa[4 * c + 2] += xv * wv.z; fa[4 * c + 3] += xv * wv.w; }
                    asm volatile("" ::: "memory"); } }
            const bool b5 = (lane & 32) != 0, b4 = (lane & 16) != 0, b3 = (lane & 8) != 0, b2 = (lane & 4) != 0;
            float r8[8], r4[4], r2[2];
#pragma unroll
            for (int i = 0; i < 8; ++i) { const float snd = b5 ? fa[i] : fa[8 + i]; r8[i] = (b5 ? fa[8 + i] : fa[i]) + __shfl_xor(snd, 32); }
#pragma unroll
            for (int i = 0; i < 4; ++i) { const float snd = b4 ? r8[i] : r8[4 + i]; r4[i] = (b4 ? r8[4 + i] : r8[i]) + __shfl_xor(snd, 16); }
#pragma unroll
            for (int i = 0; i < 2; ++i) { const float snd = b3 ? r4[i] : r4[2 + i]; r2[i] = (b3 ? r4[2 + i] : r4[i]) + __shfl_xor(snd, 8); }
            float mine = (b2 ? r2[1] : r2[0]) + __shfl_xor(b2 ? r2[0] : r2[1], 4);
            mine += __shfl_xor(mine, 1); mine += __shfl_xor(mine, 2);
            if ((lane & 3) == 0) { const int n = (lane >> 2) & 15; const float f = mine * rs + bfp[n]; const float lsg = fminf(f, 0.f) - log1pf(expf(-fabsf(f))); LF[(size_t)m * 16 + n] = lsg; }
        }
    }
    SEAM(6);
    if (IN(7)) {
        __syncthreads();
        LAS float* sm = (LAS float*)lds;
        for (int bh = bx; bh < 128; bh += G) {
            const int b = bh >> 4, h = bh & 15; float v[8]; float run = 0.f;
#pragma unroll
            for (int e = 0; e < 8; ++e) { run += LF[((size_t)b * SEQ + 8 * tid + e) * 16 + h]; v[e] = run; }
            float sc = run;
#pragma unroll
            for (int o = 1; o < 64; o <<= 1) { const float n = __shfl_up(sc, o); if (lane >= o) sc += n; }
            if (lane == 63) sm[wave] = sc;
            __syncthreads();
            float off = sc - run;
            for (int w = 0; w < wave; ++w) off += sm[w];
            f32x4 o0 = {(v[0] + off) * LOG2E, (v[1] + off) * LOG2E, (v[2] + off) * LOG2E, (v[3] + off) * LOG2E}, o1 = {(v[4] + off) * LOG2E, (v[5] + off) * LOG2E, (v[6] + off) * LOG2E, (v[7] + off) * LOG2E};
            *(f32x4*)(LC + (size_t)bh * SEQ + 8 * tid) = o0; *(f32x4*)(LC + (size_t)bh * SEQ + 8 * tid + 4) = o1;
            __syncthreads();
        }
        pg8::Gemm g{XN, Wt1, M, N1, 1024}; pg8::StaticOrder S; S.init(M, N1, G, bx);
        pg8::EpiBf16<0> E{Z1, 1024, nullptr, 1024, (size_t)M * 1024, 1.f, 6u, 16};
        pg8::gemm_phase<pg8::EpiBf16<0>, pg8::StaticOrder, true, true>(lds, g, S, E);
        __syncthreads();
        { pg8::Unit u; LAS float* smx = (LAS float*)lds;
          for (int i = 0; S.next(i, u); ++i) {
            if (u.pn < 4 || u.pn >= 8) continue;
            const int b = u.pm >> 4, T0 = 4 * (u.pm & 15), h0 = 4 * (u.pn - 4);
            for (int st = 0; st < 4; ++st) {
                const bf16* kbase = Z1 + (size_t)M * 1024 + ((((size_t)(b * 16 + h0 + ((tid & 31) >> 3))) * SEQ + (size_t)(u.pm & 15) * 256 + 64 * st + (tid >> 5)) << 6) + (tid & 7) * 8;
                float mxn = 0.f;
#pragma unroll
                for (int j = 0; j < 4; ++j) {
                    const u32x4 v = *(const u32x4*)(kbase + (size_t)(16 * j) * 64);
                    float s = 0.f;
#pragma unroll
                    for (int e = 0; e < 4; ++e) { const float a = bflo(v[e]), c = bfhi(v[e]); s += a * a + c * c; }
                    s += __shfl_xor(s, 1); s += __shfl_xor(s, 2); s += __shfl_xor(s, 4);
                    mxn = fmaxf(mxn, s);
                }
                if ((tid & 7) == 0) smx[(tid >> 5) * 4 + ((tid & 31) >> 3)] = mxn;
                __syncthreads();
                if (tid < 4) { float m16 = 0.f;
#pragma unroll
                    for (int r = 0; r < 16; ++r) m16 = fmaxf(m16, smx[r * 4 + tid]);
                    TMAXB[((size_t)(b * 16 + h0 + tid)) * 64 + T0 + st] = sqrtf(m16); }
                __syncthreads();
            }
          } }
    }
    SEAM(7);
    if (IN(9)) {
        __syncthreads();
        for (;;) {
            if (tid == 0) *(volatile LAS int*)(lds + LDS_MISC + 64) = (int)atomicAdd(qctr + 64 * (8 + (bx & 7)), 1u);
            __syncthreads();
            const int tk = *(volatile LAS int*)(lds + LDS_MISC + 64);
            __syncthreads();
            if (tk >= 128) break;
            const int bh = 16 * (bx & 7) + (tk >> 3), s = tk & 7, b = bh >> 4, h = bh & 15; const size_t rb = (size_t)b * SEQ;
            AttnP p;
            p.Q = Z1 + rb * 1024 + h * 64; p.ldq = 1024; p.K = Z1 + (size_t)M * 1024 + (size_t)bh * SEQ * 64; p.ldk = 64; p.K2 = nullptr; p.ldk2 = 0; p.V = Z1 + (size_t)2 * M * 1024 + (size_t)bh * SEQ * 64; p.ldv = 64;
            p.G = Z1 + (size_t)3 * M * 1024 + rb * 1024 + h * 64; p.ldg = 1024; p.O = OG + rb * 1024 + h * 64; p.ldo = 1024; p.lc = LC + (size_t)bh * SEQ; p.tmax = TMAXB + (size_t)bh * 64; p.sinkp = args.in[8]; p.h0 = 0; p.c = 0.125f * LOG2E; p.sink2 = 0.f; p.slope2 = 0.f;
            attn_unit<64, 2>(p, (15 - s) * 256, lds); attn_unit<64, 2>(p, s * 256, lds);
        }
    }
    SEAM(9);
    if (IN(10)) {
        __syncthreads();
        for (int sub = 0; sub < 2; ++sub) {
            const size_t r0 = (size_t)sub * 16384;
            pg8::Gemm g{OG + r0 * 1024, Wout1, 16384, 1024, 1024}; pg8::StaticOrder S; S.init(16384, 1024, G, bx);
            pg8::PanelRms st{(float*)(ws + WS_LF) + (size_t)sub * 16384 * 4, (unsigned*)(ws + 64 * 1024) + sub * 64 * 64, EPS};
            pg8::EpiRmsOut E{out + r0 * 1024, out + r0 * 1024, args.in[14], 1024, st};
            pg8::gemm_phase<pg8::EpiRmsOut, pg8::StaticOrder, false, true>(lds, g, S, E);
            __syncthreads();
        }
    }
#undef IN
#undef SEAM
}

constexpr int NPHASES = 11;
extern "C" void kernel_launch(void* const* d_in, const int* in_sizes, int n_in, void* d_out, int out_size, void* d_ws, size_t ws_size, hipStream_t stream) {
    static int grid = 0;
    if (grid == 0) {
        if (n_in != 15 || out_size != M * DM || ws_size < WS_END) { fprintf(stderr, "kernel_launch: unexpected shapes (n_in %d, out %d, ws %zu)\n", n_in, out_size, ws_size); grid = -1; return; }
        int dev = 0, cus = 0, per_cu = 0;
        (void)hipGetDevice(&dev); (void)hipDeviceGetAttribute(&cus, hipDeviceAttributeMultiprocessorCount, dev);
#if MK_COOP
        (void)hipFuncSetAttribute((const void*)mk_fwd<true>, hipFuncAttributeMaxDynamicSharedMemorySize, LDS_BYTES);
        (void)hipOccupancyMaxActiveBlocksPerMultiprocessor(&per_cu, (const void*)mk_fwd<true>, NTHREADS, LDS_BYTES);
#else
        (void)hipFuncSetAttribute((const void*)mk_fwd<false>, hipFuncAttributeMaxDynamicSharedMemorySize, LDS_BYTES);
        (void)hipOccupancyMaxActiveBlocksPerMultiprocessor(&per_cu, (const void*)mk_fwd<false>, NTHREADS, LDS_BYTES);
#endif
        (void)hipGetLastError();
        if (per_cu < 1) per_cu = 1;
        if (cus <= 0) cus = 256;
        grid = cus * 1;
    }
    if (grid < 0) return;
    Args a{};
    for (int i = 0; i < 15; ++i) a.in[i] = (const float*)d_in[i];
    a.pos = (const int*)d_in[1]; a.out = (float*)d_out; a.ws = (unsigned char*)d_ws;
#if MK_COOP
    a.ph_lo = 0; a.ph_hi = NPHASES;
    void* kargs[] = {&a};
    hipError_t e = hipLaunchCooperativeKernel((const void*)mk_fwd<true>, dim3(grid), dim3(NTHREADS), kargs, LDS_BYTES, stream);
    if (e != hipSuccess) fprintf(stderr, "cooperative launch failed: %s (grid %d)\n", hipGetErrorString(e), grid);
#else
    for (int ph = 0; ph < NPHASES; ++ph) { a.ph_lo = ph; a.ph_hi = ph + 1; hipLaunchKernelGGL(mk_fwd<false>, dim3(grid), dim3(NTHREADS), LDS_BYTES, stream, a); }
#endif
}
```

```cpp
#include <hip/hip_runtime.h>
#include <hip/hip_cooperative_groups.h>
#include <cstdio>
#include <cstdint>
#include <cmath>
namespace cg = cooperative_groups;
#ifndef MK_COOP
#define MK_COOP 1
#endif
namespace pg8 {
#define PG8_LAS __attribute__((address_space(3)))
typedef unsigned short bf16_t;
typedef short bf16x8 __attribute__((ext_vector_type(8)));
typedef float f32x4 __attribute__((ext_vector_type(4)));
typedef unsigned u32x4 __attribute__((ext_vector_type(4)));
constexpr int BM = 256, BK = 64, HALF = 128, HTB = HALF * BK * 2  , STAGE_BYTES = 8 * HTB, NXCD = 8, WGM = 8;

__host__ __device__ __forceinline__ int lds_byte(int r, int c) { const int st = (r >> 4) * 2 + (c >> 5), rr = r & 15, cc = c & 31, ob = rr * 64 + cc * 2; return st * 1024 + (ob ^ (((ob >> 9) & 1) << 5)); }
__host__ __device__ __forceinline__ void stage_rc(int b, int& R, int& C) { const int st = b / 1024, sb = b % 1024, swz = sb ^ (((sb >> 9) & 1) << 5); R = (st >> 1) * 16 + swz / 64; C = (st & 1) * 32 + (swz % 64) / 2; }
__host__ __device__ __forceinline__ int perm32(int rho) { const int n = rho >> 4, i = rho & 15; return 8 * (i >> 2) + 4 * n + (i & 3); }

struct Unit { int pm, pn; };
struct Gemm { const bf16_t* A; const bf16_t* Bt; int M, N, K; };

struct StaticOrder {
    int nM, nN, nwg, G, c;
    __host__ __device__ void init(int M, int N, int G_, int c_) { nM = M / BM; nN = N / BM; nwg = nM * nN; G = G_; c = c_; }
    __host__ __device__ bool next(int i, Unit& u) const {
        const long L = (long)i * G + c; if (L >= nwg) return false;
        int wgid = (int)L; { const int q = nwg / NXCD, r = nwg % NXCD, xcd = wgid % NXCD, off = wgid / NXCD; wgid = (xcd < r ? xcd * (q + 1) : r * (q + 1) + (xcd - r) * q) + off; }
        const int nig = WGM * nN, gid = wgid / nig, fm = gid * WGM, gsz = (nM - fm) < WGM ? (nM - fm) : WGM;
        u.pm = fm + ((wgid % nig) % gsz); u.pn = (wgid % nig) / gsz; return true;
    }
    __device__ __forceinline__ void a_ready(const Unit&) const {}
    __device__ __forceinline__ void done(const Unit&) const {}
};

__device__ __forceinline__ unsigned cvt_pk_bf16(float lo, float hi) { unsigned r; asm volatile("v_cvt_pk_bf16_f32 %0, %1, %2" : "=v"(r) : "v"(lo), "v"(hi)); return r; }
typedef float f32x2 __attribute__((ext_vector_type(2)));
__device__ __forceinline__ f32x2 gelu_pk(f32x2 v) {
    const f32x2 av = __builtin_elementwise_abs(v), d = av * 0.2316418882f + 1.0f;
    f32x2 t; t.x = __builtin_amdgcn_rcpf(d.x); t.y = __builtin_amdgcn_rcpf(d.y);
    f32x2 q = t * 0.5307027145f + (-0.7265760135f); q = q * t + 0.7107068705f; q = q * t + (-0.142248368f); q = q * t + 0.127414796f; q = q * t;
    const f32x2 s = (v * v) * (-0.72134752044f);
    f32x2 e; e.x = __builtin_amdgcn_exp2f(s.x); e.y = __builtin_amdgcn_exp2f(s.y);
    const f32x2 m = v * (q * e), r = v - m;
    f32x2 o; o.x = v.x < 0.f ? m.x : r.x; o.y = v.y < 0.f ? m.y : r.y; return o;
}

template <int ACT  > struct EpiBf16 {
    static constexpr bool PERM = true, AFTER_DRAIN = false; static_assert(ACT == 0 || ACT == 1, "EpiBf16: ACT is 0 (none) or 1 (gelu_pk)");
    bf16_t* O; int ldc; const float* bias; int split_cols; size_t split_stride; float scale0; unsigned hm_mask; int hm_heads;
    __device__ __forceinline__ void operator()(const f32x4 (&acc)[2][2][4][2], const Unit& u, int wr, int wc, int fr, int fq) const {
        const int row0 = u.pm * BM + wr * 64 + fr; int colt = u.pn * BM; bf16_t* base = O;
        float sc = 1.f; bool hm = false; if (split_cols) { const int t = colt / split_cols; base += (size_t)t * split_stride; colt -= t * split_cols; if (t == 0) sc = scale0; hm = ((hm_mask >> t) & 1u) != 0u; }
        const int col0 = colt + wc * 32 + 8 * fq, bcol0 = u.pn * BM + wc * 32 + 8 * fq;
        f32x4 bv[2][2];
#pragma unroll
        for (int bj = 0; bj < 2; ++bj)
#pragma unroll
            for (int n = 0; n < 2; ++n) bv[bj][n] = bias ? *(const f32x4*)(bias + bcol0 + bj * HALF + 4 * n) : (f32x4){0.f, 0.f, 0.f, 0.f};
#pragma unroll
        for (int ai = 0; ai < 2; ++ai)
#pragma unroll
            for (int m = 0; m < 4; ++m) { const int rowi = row0 + ai * HALF + m * 16; bf16_t* rowp = base + (size_t)rowi * ldc + col0;
#pragma unroll
                for (int bj = 0; bj < 2; ++bj) { f32x4 v0 = acc[ai][bj][m][0] + bv[bj][0], v1 = acc[ai][bj][m][1] + bv[bj][1];
                    if (ACT == 1) { f32x2 a = gelu_pk((f32x2){v0[0], v0[1]}), b = gelu_pk((f32x2){v0[2], v0[3]}), c = gelu_pk((f32x2){v1[0], v1[1]}), d = gelu_pk((f32x2){v1[2], v1[3]});
                        v0 = (f32x4){a.x, a.y, b.x, b.y}; v1 = (f32x4){c.x, c.y, d.x, d.y}; }
                    v0 = v0 * sc; v1 = v1 * sc; u32x4 w; w.x = cvt_pk_bf16(v0[0], v0[1]); w.y = cvt_pk_bf16(v0[2], v0[3]); w.z = cvt_pk_bf16(v1[0], v1[1]); w.w = cvt_pk_bf16(v1[2], v1[3]);
                    bf16_t* dst = rowp + bj * HALF;
                    if (hm) { const int col = col0 + bj * HALF; dst = base + ((((size_t)(rowi >> 12) * hm_heads + (col >> 6)) << 18) + ((size_t)(rowi & 4095) << 6) + (col & 63)); }
                    *(u32x4*)dst = w; } }
    }
};
typedef unsigned u32x2 __attribute__((ext_vector_type(2)));
struct EpiQRope {
    static constexpr bool PERM = false, AFTER_DRAIN = false;
    bf16_t* O; int ldc; const float* cs;
    __device__ __forceinline__ void operator()(const f32x4 (&acc)[2][2][4][2], const Unit& u, int wr, int wc, int fr, int fq) const {
        const int row0 = u.pm * BM + wr * 64 + fr;
#pragma unroll
        for (int ai = 0; ai < 2; ++ai)
#pragma unroll
            for (int m = 0; m < 4; ++m) {
                const int row = row0 + ai * HALF + m * 16;
                const f32x4 cv = *(const f32x4*)(cs + (size_t)row * 32 + 4 * fq), sv = *(const f32x4*)(cs + (size_t)row * 32 + 16 + 4 * fq);
#pragma unroll
                for (int bj = 0; bj < 2; ++bj) {
                    const int colb = u.pn * BM + bj * HALF + wc * 32;
                    f32x4 v0 = acc[ai][bj][m][0], v1 = acc[ai][bj][m][1];
                    if (((colb >> 5) % 3) == 2) { const f32x4 a = v0 * cv - v1 * sv, b = v1 * cv + v0 * sv; v0 = a; v1 = b; }
                    bf16_t* rp = O + (size_t)row * ldc + colb + 4 * fq;
                    u32x2 w0, w1; w0.x = cvt_pk_bf16(v0[0], v0[1]); w0.y = cvt_pk_bf16(v0[2], v0[3]); w1.x = cvt_pk_bf16(v1[0], v1[1]); w1.y = cvt_pk_bf16(v1[2], v1[3]);
                    *(u32x2*)(rp) = w0; *(u32x2*)(rp + 16) = w1;
                }
                asm volatile("" ::: "memory");
            }
    }
};
struct EpiResF32 {
    static constexpr bool PERM = false, AFTER_DRAIN = false;
    const float* base; float* out; int ldc;
    __device__ __forceinline__ void operator()(const f32x4 (&acc)[2][2][4][2], const Unit& u, int wr, int wc, int fr, int fq) const {
        const int row0 = u.pm * BM + wr * 64 + fr, col0 = u.pn * BM + wc * 32 + 4 * fq;
#pragma unroll
        for (int ai = 0; ai < 2; ++ai)
#pragma unroll
            for (int m = 0; m < 4; ++m) {
                const size_t off = (size_t)(row0 + ai * HALF + m * 16) * ldc + col0;
#pragma unroll
                for (int bj = 0; bj < 2; ++bj)
#pragma unroll
                    for (int n = 0; n < 2; ++n) { const f32x4 b = *(const f32x4*)(base + off + bj * HALF + n * 16); *(f32x4*)(out + off + bj * HALF + n * 16) = b + acc[ai][bj][m][n]; }
                asm volatile("" ::: "memory");
            }
    }
};
struct PanelRms {
    float* xbuf;
    unsigned* cnt;
    float eps;
    __device__ __forceinline__ void run(const f32x4 (&v)[2][2][4][2], const Unit& u, int wr, int wc, int fr, int fq, PG8_LAS unsigned char* lds, int wid, int lane) const {
        PG8_LAS float* P = (PG8_LAS float*)lds;
        PG8_LAS float* S = (PG8_LAS float*)(lds + 4096);
#pragma unroll
        for (int ai = 0; ai < 2; ++ai)
#pragma unroll
            for (int m = 0; m < 4; ++m) {
                float s = 0.f;
#pragma unroll
                for (int bj = 0; bj < 2; ++bj)
#pragma unroll
                    for (int n = 0; n < 2; ++n) { const f32x4 x = v[ai][bj][m][n]; s += (x[0] * x[0] + x[1] * x[1]) + (x[2] * x[2] + x[3] * x[3]); }
                s += __shfl_xor(s, 16); s += __shfl_xor(s, 32);
                if (fq == 0) P[(ai * HALF + wr * 64 + m * 16 + fr) * 4 + wc] = s;
            }
        asm volatile("s_waitcnt lgkmcnt(0)" ::: "memory"); __builtin_amdgcn_s_barrier(); asm volatile("" ::: "memory");
        const int row = wid * 32 + (lane & 31);
        if (lane < 32) {
            const float t = (P[row * 4 + 0] + P[row * 4 + 1]) + (P[row * 4 + 2] + P[row * 4 + 3]);
            __hip_atomic_store(xbuf + ((size_t)(u.pm * BM + row) * 4 + u.pn), t, __ATOMIC_RELAXED, __HIP_MEMORY_SCOPE_AGENT);
        }
        asm volatile("s_waitcnt vmcnt(0)" ::: "memory");
        if (lane == 0) __hip_atomic_fetch_add(cnt + 64 * u.pm, 1u, __ATOMIC_RELAXED, __HIP_MEMORY_SCOPE_AGENT);
        if (wid == 0) {
            unsigned spins = 0;
            while ((unsigned)__builtin_amdgcn_readfirstlane(__hip_atomic_load(cnt + 64 * u.pm, __ATOMIC_RELAXED, __HIP_MEMORY_SCOPE_AGENT)) < 32u) { __builtin_amdgcn_s_sleep(2); if (++spins > (1u << 20)) break; }
            __builtin_amdgcn_fence(__ATOMIC_ACQUIRE, "agent");
        }
        asm volatile("s_waitcnt vmcnt(0) lgkmcnt(0)" ::: "memory"); __builtin_amdgcn_s_barrier(); asm volatile("" ::: "memory");
        if (lane < 32) {
            const float* slot = xbuf + (size_t)(u.pm * BM + row) * 4; float q = 0.f;
#pragma unroll
            for (int t = 0; t < 4; ++t) q += __hip_atomic_load(slot + t, __ATOMIC_RELAXED, __HIP_MEMORY_SCOPE_AGENT);
            S[row] = 1.0f / sqrtf(q * (1.0f / 1024.0f) + eps);
        }
        asm volatile("s_waitcnt lgkmcnt(0)" ::: "memory"); __builtin_amdgcn_s_barrier(); asm volatile("" ::: "memory");
    }
};
struct EpiRmsOut {
    static constexpr bool PERM = false, AFTER_DRAIN = true;
    const float* base; float* out; const float* g; int ldc; PanelRms st;
    __device__ __forceinline__ void fused(f32x4 (&acc)[2][2][4][2], const Unit& u, int wr, int wc, int fr, int fq, PG8_LAS unsigned char* lds, int wid, int lane) const {
        const PG8_LAS float* S = (const PG8_LAS float*)(lds + 4096);
        const int col0 = u.pn * BM + wc * 32 + 4 * fq;
#pragma unroll
        for (int ai = 0; ai < 2; ++ai)
#pragma unroll
            for (int m = 0; m < 4; ++m) { const size_t off = (size_t)(u.pm * BM + ai * HALF + wr * 64 + m * 16 + fr) * ldc + col0;
#pragma unroll
                for (int bj = 0; bj < 2; ++bj)
#pragma unroll
                    for (int n = 0; n < 2; ++n) acc[ai][bj][m][n] += *(const f32x4*)(base + off + bj * HALF + n * 16);
                asm volatile("" : "+v"(acc[ai][0][m][0]), "+v"(acc[ai][0][m][1]), "+v"(acc[ai][1][m][0]), "+v"(acc[ai][1][m][1]));
                if (m & 1) asm volatile("" ::: "memory"); }
        st.run(acc, u, wr, wc, fr, fq, lds, wid, lane);
#pragma unroll
        for (int bj = 0; bj < 2; ++bj)
#pragma unroll
            for (int n = 0; n < 2; ++n) { const f32x4 gv = *(const f32x4*)(g + col0 + bj * HALF + n * 16);
#pragma unroll
                for (int ai = 0; ai < 2; ++ai)
#pragma unroll
                    for (int m = 0; m < 4; ++m) { const int r = ai * HALF + wr * 64 + m * 16 + fr; const float rs = S[r];
                        *(f32x4*)(out + (size_t)(u.pm * BM + r) * ldc + col0 + bj * HALF + n * 16) = acc[ai][bj][m][n] * rs * gv; } }
    }
};
template <class Epi, class Sched, bool ALIGN_EPI = false, bool SP2 = false>
__device__ __forceinline__ void gemm_phase(PG8_LAS unsigned char* lds, const Gemm g, const Sched& S, const Epi& E) {
    const int tid = threadIdx.x, wid = __builtin_amdgcn_readfirstlane(tid >> 6), lane = tid & 63, wr = wid >> 2, wc = wid & 3, fr = lane & 15, fq = lane >> 4;
    const int K = g.K, nt = K / BK;
    unsigned voffA[2], voffB[2];
#pragma unroll
    for (int i = 0; i < 2; ++i) { int R, C; stage_rc(tid * 16 + i * 8192, R, C); const int Rb = Epi::PERM ? ((R & ~31) + perm32(R & 31)) : R;
        voffA[i] = (unsigned)(R * K + C) * 2u; voffB[i] = (unsigned)(Rb * K + C) * 2u; }
    const size_t kstep = (size_t)(BK * 2);
    const size_t hstep = (size_t)HALF * K * 2;
    const size_t tstep = 2 * hstep;
    const unsigned ldsw = (unsigned)wid * 1024u;
    const int aoff = lds_byte(wr * 64 + fr, fq * 8), boff = lds_byte(wc * 32 + fr, fq * 8);
#define PG8_SA(b, h) (((b) * 2 + (h)) * HTB)
#define PG8_SB(b, h) ((4 + (b) * 2 + (h)) * HTB)
#define PG8_STAGE(bufoff, gbase, voff) do { _Pragma("unroll") for (int _i = 0; _i < 2; ++_i) \
        __builtin_amdgcn_global_load_lds((const unsigned*)((const char*)(gbase) + (voff)[_i]), (PG8_LAS unsigned*)(lds + (bufoff) + ldsw + _i * 8192), 16, 0, 0); } while (0)
#define PG8_LDA(dst, b, h) do { _Pragma("unroll") for (int m = 0; m < 4; ++m) _Pragma("unroll") for (int k = 0; k < 2; ++k) dst[m][k] = *(const PG8_LAS bf16x8*)(lds + PG8_SA(b, h) + aoff + m * 2048 + k * 1024); } while (0)
#define PG8_LDB(dst, b, h) do { _Pragma("unroll") for (int n = 0; n < 2; ++n) _Pragma("unroll") for (int k = 0; k < 2; ++k) dst[n][k] = *(const PG8_LAS bf16x8*)(lds + PG8_SB(b, h) + boff + n * 2048 + k * 1024); } while (0)
#define PG8_MMA(ai, bj, At, Bt) do { __builtin_amdgcn_s_setprio(1); _Pragma("unroll") for (int m = 0; m < 4; ++m) _Pragma("unroll") for (int n = 0; n < 2; ++n) _Pragma("unroll") for (int k = 0; k < 2; ++k) \
        acc[ai][bj][m][n] = __builtin_amdgcn_mfma_f32_16x16x32_bf16(Bt[n][k], At[m][k], acc[ai][bj][m][n], 0, 0, 0); __builtin_amdgcn_s_setprio(0); } while (0)
#define PG8_WAIT_V(n) asm volatile("s_waitcnt vmcnt(" #n ")" ::: "memory")
#define PG8_WAIT_L(n) asm volatile("s_waitcnt lgkmcnt(" #n ")" ::: "memory")
#define PG8_BAR __builtin_amdgcn_s_barrier()
#define PG8_SCHED __builtin_amdgcn_sched_barrier(0)
    Unit cur, nxt; int ui = 0;
    if (!S.next(0, cur)) return;
    f32x4 acc[2][2][4][2];
#pragma unroll
    for (int a = 0; a < 2; ++a)
#pragma unroll
        for (int b = 0; b < 2; ++b)
#pragma unroll
            for (int m = 0; m < 4; ++m)
#pragma unroll
                for (int n = 0; n < 2; ++n) acc[a][b][m][n] = (f32x4){0.f, 0.f, 0.f, 0.f};
    bf16x8 At[4][2], B0[2][2], B1[2][2];
    const char* cA = (const char*)g.A + (size_t)cur.pm * tstep; const char* cB = (const char*)g.Bt + (size_t)cur.pn * tstep;
    S.a_ready(cur);
    if constexpr (SP2) {
        PG8_STAGE(PG8_SB(0, 0), cB, voffB); PG8_STAGE(PG8_SB(0, 1), cB + hstep, voffB); PG8_STAGE(PG8_SA(0, 0), cA, voffA); PG8_STAGE(PG8_SA(0, 1), cA + hstep, voffA);
        if (wr == 1) PG8_BAR;
        PG8_WAIT_V(2); PG8_BAR;
        PG8_STAGE(PG8_SB(1, 0), cB + kstep, voffB); PG8_STAGE(PG8_SA(1, 0), cA + kstep, voffA); PG8_STAGE(PG8_SB(1, 1), cB + hstep + kstep, voffB);
        PG8_WAIT_V(6); PG8_BAR;
    } else {
        PG8_STAGE(PG8_SB(0, 0), cB, voffB); PG8_STAGE(PG8_SA(0, 0), cA, voffA); PG8_STAGE(PG8_SB(0, 1), cB + hstep, voffB); PG8_STAGE(PG8_SA(0, 1), cA + hstep, voffA);
        if (wr == 1) PG8_BAR;
        PG8_WAIT_V(4); PG8_BAR;
        PG8_STAGE(PG8_SB(1, 0), cB + kstep, voffB); PG8_STAGE(PG8_SA(1, 0), cA + kstep, voffA); PG8_STAGE(PG8_SB(1, 1), cB + hstep + kstep, voffB);
        PG8_WAIT_V(6); PG8_BAR;
    }
    for (;;) {
        const bool has_next = S.next(ui + 1, nxt);
        const char* nA = has_next ? (const char*)g.A + (size_t)nxt.pm * tstep : cA; const char* nB = has_next ? (const char*)g.Bt + (size_t)nxt.pn * tstep : cB;
        for (int t = 0; t < nt; t += 2) {
            const bool last = (t == nt - 2);
            const char* a1 = cA + (size_t)(t + 1) * kstep;
            const char* a2 = last ? nA : cA + (size_t)(t + 2) * kstep; const char* b2 = last ? nB : cB + (size_t)(t + 2) * kstep;
            const char* a3 = a2 + kstep; const char* b3 = b2 + kstep;
            if (last && has_next) S.a_ready(nxt);
            if constexpr (SP2) {
            PG8_LDB(B0, 0, 0); PG8_LDB(B1, 0, 1); PG8_SCHED; PG8_LDA(At, 0, 0); PG8_STAGE(PG8_SA(1, 1), a1 + hstep, voffA);
            PG8_WAIT_V(8); PG8_WAIT_L(0); PG8_BAR; PG8_MMA(0, 0, At, B0); PG8_MMA(0, 1, At, B1); PG8_BAR; PG8_SCHED;
            PG8_LDA(At, 0, 1); PG8_STAGE(PG8_SB(0, 0), b2, voffB); PG8_STAGE(PG8_SB(0, 1), b2 + hstep, voffB); PG8_STAGE(PG8_SA(0, 0), a2, voffA);
            PG8_WAIT_V(8); PG8_WAIT_L(0); PG8_BAR; PG8_MMA(1, 0, At, B0); PG8_MMA(1, 1, At, B1); PG8_BAR; PG8_SCHED;
            PG8_LDB(B0, 1, 0); PG8_LDB(B1, 1, 1); PG8_SCHED; PG8_LDA(At, 1, 0); PG8_STAGE(PG8_SA(0, 1), a2 + hstep, voffA);
            PG8_WAIT_V(8); PG8_WAIT_L(0); PG8_BAR; PG8_MMA(0, 0, At, B0); PG8_MMA(0, 1, At, B1); PG8_BAR; PG8_SCHED;
            PG8_LDA(At, 1, 1); PG8_STAGE(PG8_SB(1, 0), b3, voffB); PG8_STAGE(PG8_SB(1, 1), b3 + hstep, voffB); PG8_STAGE(PG8_SA(1, 0), a3, voffA);
            PG8_WAIT_V(8); PG8_WAIT_L(0); PG8_BAR; PG8_MMA(1, 0, At, B0); PG8_MMA(1, 1, At, B1); PG8_BAR; PG8_SCHED;
            } else {
            PG8_LDB(B0, 0, 0); PG8_SCHED; PG8_LDA(At, 0, 0); PG8_STAGE(PG8_SA(1, 1), a1 + hstep, voffA);
            PG8_WAIT_L(8); PG8_BAR; PG8_WAIT_L(0); PG8_MMA(0, 0, At, B0); PG8_BAR; PG8_SCHED;
            PG8_LDB(B1, 0, 1); PG8_STAGE(PG8_SB(0, 0), b2, voffB);
            PG8_BAR; PG8_WAIT_L(0); PG8_MMA(0, 1, At, B1); PG8_BAR;
            PG8_LDA(At, 0, 1); PG8_STAGE(PG8_SA(0, 0), a2, voffA);
            PG8_BAR; PG8_WAIT_L(0); PG8_MMA(1, 0, At, B0); PG8_BAR; PG8_SCHED;
            PG8_STAGE(PG8_SB(0, 1), b2 + hstep, voffB);
            PG8_WAIT_V(6); PG8_BAR; PG8_MMA(1, 1, At, B1); PG8_BAR;
            PG8_LDB(B0, 1, 0); PG8_SCHED; PG8_LDA(At, 1, 0); PG8_STAGE(PG8_SA(0, 1), a2 + hstep, voffA);
            PG8_WAIT_L(8); PG8_BAR; PG8_WAIT_L(0); PG8_MMA(0, 0, At, B0); PG8_BAR; PG8_SCHED;
            PG8_LDB(B1, 1, 1); PG8_STAGE(PG8_SB(1, 0), b3, voffB);
            PG8_BAR; PG8_WAIT_L(0); PG8_MMA(0, 1, At, B1); PG8_BAR;
            PG8_LDA(At, 1, 1); PG8_STAGE(PG8_SA(1, 0), a3, voffA);
            PG8_BAR; PG8_WAIT_L(0); PG8_MMA(1, 0, At, B0); PG8_BAR; PG8_SCHED;
            PG8_STAGE(PG8_SB(1, 1), b3 + hstep, voffB);
            PG8_WAIT_V(6); PG8_BAR; PG8_MMA(1, 1, At, B1); PG8_BAR;
            }
        }
        if constexpr (ALIGN_EPI) { if (wr == 0) PG8_BAR; }
        if constexpr (!Epi::AFTER_DRAIN) { E(acc, cur, wr, wc, fr, fq); S.done(cur); }
        if (!has_next) break;
#pragma unroll
        for (int a = 0; a < 2; ++a)
#pragma unroll
            for (int b = 0; b < 2; ++b)
#pragma unroll
                for (int m = 0; m < 4; ++m)
#pragma unroll
                    for (int n = 0; n < 2; ++n) acc[a][b][m][n] = (f32x4){0.f, 0.f, 0.f, 0.f};
        cur = nxt; cA = nA; cB = nB; ++ui;
        if constexpr (ALIGN_EPI) { if (wr == 1) PG8_BAR; }
    }
    PG8_WAIT_V(0);
    if constexpr (!ALIGN_EPI) { if (wr == 0) PG8_BAR; }
    PG8_BAR;
    if constexpr (Epi::AFTER_DRAIN) { E.fused(acc, cur, wr, wc, fr, fq, lds, wid, lane); S.done(cur); }
#undef PG8_SA
#undef PG8_SB
#undef PG8_STAGE
#undef PG8_LDA
#undef PG8_LDB
#undef PG8_MMA
#undef PG8_WAIT_V
#undef PG8_WAIT_L
#undef PG8_BAR
#undef PG8_SCHED
}
}
#define LAS __attribute__((address_space(3)))
typedef unsigned short bf16;
typedef short bf16x8 __attribute__((ext_vector_type(8)));
typedef float f32x16 __attribute__((ext_vector_type(16)));
typedef float f32x4 __attribute__((ext_vector_type(4)));
typedef float f32x2 __attribute__((ext_vector_type(2)));
typedef unsigned u32x4 __attribute__((ext_vector_type(4)));
typedef unsigned u32x2 __attribute__((ext_vector_type(2)));
typedef __bf16 bf16x2_t __attribute__((ext_vector_type(2)));

constexpr int BATCH = 8, SEQ = 4096, DM = 1024, M = BATCH * SEQ;
constexpr int N0 = 2208, N0P = 2304;
constexpr int C_CQ = 0, C_CKV = 256, C_KPE = 384, C_QS = 416, C_KS = 928, C_VS = 1056, C_G0 = 1184;
constexpr int N1W = 4112, N1 = 4096;
constexpr int C1_Q = 0, C1_K = 1024, C1_V = 2048, C1_G = 3072, W1_F = 3072, W1_G = 3088;
constexpr float EPS = 1e-6f, LOG2E = 1.4426950408889634f;
constexpr int NTHREADS = 512, NWAVES = 8;

constexpr size_t MiB = 1u << 20;
constexpr size_t WS_WT0 = 1 * MiB;
constexpr size_t WS_WQUP = 6 * MiB;
constexpr size_t WS_WKVUP = 7 * MiB;
constexpr size_t WS_WOUT0 = 8 * MiB;
constexpr size_t WS_WT1 = 10 * MiB;
constexpr size_t WS_WOUT1 = 18 * MiB;
constexpr size_t WS_XN = 32 * MiB;
constexpr size_t WS_OG = 96 * MiB;
constexpr size_t WS_LF = 160 * MiB;
constexpr size_t WS_LC = 162 * MiB;
constexpr size_t WS_TMAX = 512 * 1024;
constexpr size_t WS_CS = 164 * MiB;
constexpr size_t WS_Z1 = 168 * MiB;
constexpr size_t WS_Z0 = 168 * MiB;
constexpr size_t WS_CQN = 312 * MiB;
constexpr size_t WS_CKVN = 328 * MiB;
constexpr size_t WS_KPE = 344 * MiB;
constexpr size_t WS_Q0 = 346 * MiB;
constexpr size_t WS_KN = 394 * MiB;
constexpr size_t WS_VM = 426 * MiB;
constexpr size_t WS_END = 458 * MiB;
constexpr int LDS_BYTES = 135168, LDS_MISC = 131072 + 1024;

__device__ __forceinline__ unsigned cvtpk(float lo, float hi) { f32x2 v = {lo, hi}; bf16x2_t b = __builtin_convertvector(v, bf16x2_t); return __builtin_bit_cast(unsigned, b); }
__device__ __forceinline__ float bflo(unsigned u) { return __uint_as_float(u << 16); }
__device__ __forceinline__ float bfhi(unsigned u) { return __uint_as_float(u & 0xffff0000u); }
__device__ __forceinline__ float bf1(bf16 v) { return __uint_as_float(((unsigned)v) << 16); }
__device__ __forceinline__ float wave_sum(float v) {
#pragma unroll
    for (int o = 1; o < 64; o <<= 1) v += __shfl_xor(v, o);
    return v;
}

struct AttnP { const bf16 *Q, *K, *K2, *V, *G; bf16* O; const float* lc; const float* tmax; const float* sinkp; int h0; int ldq, ldk, ldk2, ldv, ldg, ldo; float c, sink2, slope2; };

typedef short v4i16_t __attribute__((ext_vector_type(4)));
__device__ __forceinline__ void glds16(const void* gsrc, unsigned lds_dst) { unsigned keep;
    asm volatile("s_mov_b32 %0, m0\n\ts_mov_b32 m0, %2\n\ts_nop 0\n\tglobal_load_lds_dwordx4 %1, off\n\ts_mov_b32 m0, %0" : "=&s"(keep) : "v"(gsrc), "s"(lds_dst) : "memory"); }
__device__ __forceinline__ void glds4(const void* gsrc, unsigned lds_dst) { unsigned keep;
    asm volatile("s_mov_b32 %0, m0\n\ts_mov_b32 m0, %2\n\ts_nop 0\n\tglobal_load_lds_dword %1, off\n\ts_mov_b32 m0, %0" : "=&s"(keep) : "v"(gsrc), "s"(lds_dst) : "memory"); }

#define PSB() __builtin_amdgcn_sched_barrier(0)
__device__ __forceinline__ constexpr int pch_lo(int k, int nch) { return k * (32 / nch) + (k < (32 % nch) ? k : (32 % nch)); }
template <int LO, int HI> __device__ __forceinline__ void p_exp_range(f32x16 (&SC)[2], float c, float m_new, float& l0, float& l1) {
#pragma unroll
    for (int e = LO; e < HI; ++e) { const float y = __builtin_amdgcn_exp2f(SC[e >> 4][e & 15] * c - m_new); SC[e >> 4][e & 15] = y; if (e & 1) l1 += y; else l0 += y; }
}
template <int DK, int K> struct PSeg1 {
    static __device__ __forceinline__ void run(f32x16 (&SC)[2], f32x16 (&SN)[2], const bf16x8 (&kf)[2][DK / 16], const bf16x8 (&qf)[DK / 16], float c, float m_new, float& l0, float& l1) {
        constexpr int NCH = 2 * (DK / 16);
        if constexpr (K < NCH) {
            SN[K & 1] = __builtin_amdgcn_mfma_f32_32x32x16_bf16(kf[K & 1][K >> 1], qf[K >> 1], SN[K & 1], 0, 0, 0);
            PSB();
            p_exp_range<pch_lo(K, NCH), pch_lo(K + 1, NCH)>(SC, c, m_new, l0, l1);
            PSB();
            PSeg1<DK, K + 1>::run(SC, SN, kf, qf, c, m_new, l0, l1);
        }
    }
};
template <int K> struct PSeg2 {
    static __device__ __forceinline__ void run(f32x16 (&SC)[2], f32x16 (&SN)[2], const bf16x8 (&vf)[2][4], bf16x8 (&pk)[4], f32x16 (&ot)[2], float& mx, bool has_next) {
        if constexpr (K < 8) {
            ot[K & 1] = __builtin_amdgcn_mfma_f32_32x32x16_bf16(vf[K & 1][K >> 1], pk[K >> 1], ot[K & 1], 0, 0, 0);
            PSB();
            if constexpr ((K & 1) == 0 && K < 6) { constexpr int cc = (K >> 1) + 1, ph = cc >> 1, o = 8 * (cc & 1); u32x4 w;
                w.x = cvtpk(SC[ph][o + 0], SC[ph][o + 1]); w.y = cvtpk(SC[ph][o + 2], SC[ph][o + 3]); w.z = cvtpk(SC[ph][o + 4], SC[ph][o + 5]); w.w = cvtpk(SC[ph][o + 6], SC[ph][o + 7]);
                pk[cc] = __builtin_bit_cast(bf16x8, w); }
            if (has_next) { constexpr int e = 4 * K, ph = e >> 4, r = e & 15;
                mx = __builtin_fmaxf(__builtin_fmaxf(mx, SN[ph][r]), SN[ph][r + 1]); mx = __builtin_fmaxf(__builtin_fmaxf(mx, SN[ph][r + 2]), SN[ph][r + 3]); }
            PSB();
            PSeg2<K + 1>::run(SC, SN, vf, pk, ot, mx, has_next);
        }
    }
};
#define AT_WAITV(n) asm volatile("s_waitcnt vmcnt(%0) lgkmcnt(0)" :: "n"(n) : "memory")
template <int DK, int MODE>
__device__ __forceinline__ void attn_unit(const AttnP& p, const int q0, LAS unsigned char* lds) {
    constexpr bool SKEW = (MODE == 2);
    constexpr int NS = SKEW ? 7 : 4, KN_B = 8192, KP_B = (DK == 96) ? 4096 : 0, VHALF = 4160, V_B = 2 * VHALF, LC_B = (MODE == 2) ? 256 : 0;
    constexpr int OFF_KP = KN_B, OFF_V = KN_B + KP_B, OFF_LC = OFF_V + V_B, SLOT = OFF_LC + LC_B, OFF_FLAG = NS * SLOT;
    constexpr int NPT = 2 + ((DK == 96 || MODE == 2) ? 1 : 0);
    const int tid = threadIdx.x, lane = tid & 63, wid = __builtin_amdgcn_readfirstlane(tid >> 6), r32 = lane & 31, hi = lane >> 5;
    const int hsel = (MODE == 1) ? (wid >> 1) : 0;
    const int qw0 = q0 + 32 * ((MODE == 1) ? (wid & 1) : wid), q = qw0 + r32;
    const bf16* Qp = p.Q + hsel * 64; const bf16* Gp = p.G + hsel * 64; bf16* Op = p.O + hsel * 64;
    float sink2 = 0.f, slope2 = 0.f;
    if (MODE == 1) { const int hh = p.h0 + hsel; sink2 = p.sinkp[hh] * LOG2E; slope2 = exp2f(-(float)(hh + 1)) * LOG2E; }
    const unsigned lds0 = (unsigned)(uintptr_t)lds;
    bf16x8 qf[DK / 16];
#pragma unroll
    for (int d0 = 0; d0 < DK / 16; ++d0) qf[d0] = *(const bf16x8*)(Qp + (size_t)q * p.ldq + 16 * d0 + 8 * hi);
#pragma unroll
    for (int d0 = 0; d0 < DK / 16; ++d0) asm volatile("" : "+v"(qf[d0]));
    const int t_hi = (MODE == 1) ? (q0 >> 6) : (((q0 + 256) >> 6) - 1);
    const int t_lo = (MODE == 1) ? (((q0 >> 6) >= 2) ? (q0 >> 6) - 2 : 0) : 0;
    const int ntile = t_hi - t_lo + 1;
    const int krow = 8 * wid + (lane >> 3), kch = (lane & 7) ^ ((krow >> 1) & 7);
    const bf16* ksrc = p.K + (size_t)krow * p.ldk + kch * 8;
    const int prow = 8 * wid + ((lane & 31) >> 2), pch = (lane & 3) ^ ((prow >> 2) & 3);
    const bf16* psrc = (DK == 96) ? (p.K2 + (size_t)prow * p.ldk2 + pch * 8) : p.K;
    const int vrow = 16 * (wid & 3) + (lane >> 2);
    const bf16* vsrc = p.V + (size_t)vrow * p.ldv + ((wid >> 2) * 4 + (lane & 3)) * 8;
    const float* lsrc = (MODE == 2) ? (p.lc + 8 * wid + (lane & 7)) : (const float*)p.K;
#define AT_DMA(t, slot) do { const size_t ro_ = (size_t)(t) * 64; const unsigned sb_ = lds0 + (unsigned)((slot) * SLOT); \
        glds16(ksrc + ro_ * p.ldk, (unsigned)__builtin_amdgcn_readfirstlane(sb_ + wid * 1024)); \
        glds16(vsrc + ro_ * p.ldv, (unsigned)__builtin_amdgcn_readfirstlane(sb_ + OFF_V + (wid >> 2) * VHALF + (wid & 3) * 1024)); \
        if (DK == 96) { if (lane < 32) glds16(psrc + ro_ * p.ldk2, (unsigned)__builtin_amdgcn_readfirstlane(sb_ + OFF_KP + wid * 512)); } \
        if (MODE == 2) { if (lane < 8) glds4(lsrc + ro_, (unsigned)__builtin_amdgcn_readfirstlane(sb_ + OFF_LC + wid * 32)); } } while (0)

    float m_run = (MODE == 1) ? sink2 : -INFINITY;
    float l_run = (MODE == 1 && hi == 0) ? 1.f : 0.f;
    f32x16 ot[2];
#pragma unroll
    for (int r = 0; r < 16; ++r) { ot[0][r] = 0.f; ot[1][r] = 0.f; }
    const int pim = 16 * (r32 >> 4) + 8 * ((r32 >> 2) & 1) + 4 * ((r32 >> 3) & 1) + (r32 & 3);
    const int vrd = (8 * hi + ((lane & 15) >> 2)) * 64 + ((lane >> 4) & 1) * 32 + (lane & 3) * 8;
    int koff[4], poff[2];
#pragma unroll
    for (int d0 = 0; d0 < 4; ++d0) koff[d0] = pim * 128 + (((2 * d0 + hi) ^ ((pim >> 1) & 7)) * 16);
#pragma unroll
    for (int j = 0; j < 2; ++j) poff[j] = OFF_KP + pim * 64 + (((2 * j + hi) ^ ((pim >> 2) & 3)) * 16);
    float pmv = 0.f, lcev = 0.f, qn = 0.f;
    if (MODE == 2) {
        pmv = (lane <= t_hi) ? p.tmax[lane] : 0.f;
#pragma unroll
        for (int o = 1; o < 64; o <<= 1) { const float n = __shfl_up(pmv, o); if (lane >= o) pmv = fmaxf(pmv, n); }
        lcev = (lane <= t_hi) ? p.lc[64 * lane + 63] : 0.f;
        float qs = 0.f;
#pragma unroll
        for (int d0 = 0; d0 < DK / 16; ++d0)
#pragma unroll
            for (int e = 0; e < 8; ++e) { const float f = bf1((bf16)qf[d0][e]); qs += f * f; }
        qs += __shfl_xor(qs, 32);
        qn = sqrtf(qs) * p.c * 1.002f;
    }
    const int sk = SKEW ? (3 - (wid >> 1)) : 0;
    int sw = sk, sd = 6;
    bool done_w = false;
    if (SKEW) {
#pragma unroll
        for (int d = 0; d < 6; ++d) if (d < ntile) AT_DMA(t_hi - d, d);
    } else {
        AT_DMA(t_hi, 0);
        if (ntile > 1) AT_DMA(t_hi - 1, 1);
        if (ntile > 2) AT_DMA(t_hi - 2, 2);
    }
    const int nfirst = (MODE == 0 && ntile > 4) ? 4 : ntile;
    for (int i = 0; i < nfirst; ++i) {
        const int t = t_hi - i - sk, kv0 = t * 64, rem = SKEW ? (ntile - 1 - (i + 3)) : (ntile - 1 - i);
        if (rem >= 2) AT_WAITV(2 * NPT); else if (rem == 1) AT_WAITV(NPT); else AT_WAITV(0);
        __builtin_amdgcn_s_barrier();
        asm volatile("" ::: "memory");
        if (MODE == 2) { if (i > 0) {
            const LAS unsigned char* fp = lds + OFF_FLAG + ((i - 1) & 1) * 32;
            const u32x4 f0 = *(const LAS u32x4*)(fp), f1 = *(const LAS u32x4*)(fp + 16);
            if ((f0.x & f0.y & f0.z & f0.w & f1.x & f1.y & f1.z & f1.w) != 0u) break; } }
        if (SKEW) { if (i + 6 < ntile) AT_DMA(t_hi - (i + 6), sd); sd = (sd == 6) ? 0 : sd + 1; }
        else { if (rem >= 3) AT_DMA(t - 3, (i + 3) & 3); }
        const LAS unsigned char* sb = lds + (SKEW ? sw : (i & 3)) * SLOT;
        if (SKEW) sw = (sw == 6) ? 0 : sw + 1;
        bool act = kv0 <= qw0 + 31;
        if (MODE == 1) act = act && (kv0 + 63 >= qw0 - 127);
        if (SKEW) act = act && (t >= 0) && !done_w;
        if (act) {
            f32x16 s[2];
            {
                bf16x8 kf[2][DK / 16];
#pragma unroll
                for (int ph = 0; ph < 2; ++ph) {
#pragma unroll
                    for (int d0 = 0; d0 < 4; ++d0) kf[ph][d0] = *(const LAS bf16x8*)(sb + koff[d0] + ph * 4096);
                    if (DK == 96) {
#pragma unroll
                        for (int j = 0; j < 2; ++j) kf[ph][(DK == 96) ? 4 + j : 0] = *(const LAS bf16x8*)(sb + poff[j] + ph * 2048);
                    }
                }
#pragma unroll
                for (int r = 0; r < 16; ++r) { s[0][r] = 0.f; s[1][r] = 0.f; }
                __builtin_amdgcn_sched_barrier(0);
#pragma unroll
                for (int d0 = 0; d0 < DK / 16; ++d0) {
                    s[0] = __builtin_amdgcn_mfma_f32_32x32x16_bf16(kf[0][d0], qf[d0], s[0], 0, 0, 0);
                    s[1] = __builtin_amdgcn_mfma_f32_32x32x16_bf16(kf[1][d0], qf[d0], s[1], 0, 0, 0);
                }
                __builtin_amdgcn_sched_barrier(0);
            }
            if (MODE == 2) {
                const LAS float* lcb = (const LAS float*)(sb + OFF_LC);
#pragma unroll
                for (int ph = 0; ph < 2; ++ph)
#pragma unroll
                    for (int j = 0; j < 4; ++j) { const f32x4 lk = *(const LAS f32x4*)(lcb + 32 * ph + 16 * (j >> 1) + 8 * hi + 4 * (j & 1));
#pragma unroll
                        for (int ii = 0; ii < 4; ++ii) s[ph][4 * j + ii] = s[ph][4 * j + ii] * p.c - lk[ii]; }
            } else if (MODE == 1) {
                const float dq = (float)(q - kv0 - 8 * hi);
#pragma unroll
                for (int ph = 0; ph < 2; ++ph)
#pragma unroll
                    for (int r = 0; r < 16; ++r) { const int kk = 32 * ph + 16 * (r >> 3) + 4 * ((r >> 2) & 1) + (r & 3); s[ph][r] = s[ph][r] * p.c - slope2 * (dq - (float)kk); }
            }
            bool needmask = (kv0 + 63 > qw0);
            if (MODE == 1) needmask = needmask || (kv0 < qw0 + 31 - 127);
            if (needmask) {
                const int dqi = q - kv0 - 8 * hi;
#pragma unroll
                for (int ph = 0; ph < 2; ++ph)
#pragma unroll
                    for (int r = 0; r < 16; ++r) { const int kk = 32 * ph + 16 * (r >> 3) + 4 * ((r >> 2) & 1) + (r & 3); const int dist = dqi - kk;
                        bool ok = dist >= 0; if (MODE == 1) ok = ok && (dist < 128); s[ph][r] = ok ? s[ph][r] : -INFINITY; }
            }
            float mx = fmaxf(fmaxf(s[0][0], s[0][1]), s[0][2]);
#pragma unroll
            for (int r = 3; r < 15; r += 2) mx = fmaxf(fmaxf(mx, s[0][r]), s[0][r + 1]);
            mx = fmaxf(mx, s[0][15]);
#pragma unroll
            for (int r = 0; r < 16; r += 2) mx = fmaxf(fmaxf(mx, s[1][r]), s[1][r + 1]);
            mx = fmaxf(mx, __shfl_xor(mx, 32));
            if (MODE == 0) mx *= p.c;
            const bool dead = (MODE == 2) && __all(mx < m_run - 40.f);
            if (!dead) {
                const float m_new = fmaxf(m_run, mx);
                const float alpha = __builtin_amdgcn_exp2f(m_run - m_new);
                m_run = m_new;
                float ls0 = 0.f, ls1 = 0.f;
#pragma unroll
                for (int ph = 0; ph < 2; ++ph)
#pragma unroll
                    for (int r = 0; r < 16; r += 2) {
                        const float e0 = __builtin_amdgcn_exp2f(MODE == 0 ? (s[ph][r] * p.c - m_new) : (s[ph][r] - m_new));
                        const float e1 = __builtin_amdgcn_exp2f(MODE == 0 ? (s[ph][r + 1] * p.c - m_new) : (s[ph][r + 1] - m_new));
                        s[ph][r] = e0; s[ph][r + 1] = e1; ls0 += e0; ls1 += e1; }
                if (__any(alpha != 1.f)) {
                    l_run *= alpha;
#pragma unroll
                    for (int r = 0; r < 16; ++r) { ot[0][r] *= alpha; ot[1][r] *= alpha; }
                }
                l_run += ls0 + ls1;
                bf16x8 pk[4];
#pragma unroll
                for (int cc = 0; cc < 4; ++cc) { const int ph = cc >> 1, o = 8 * (cc & 1); u32x4 w;
                    w.x = cvtpk(s[ph][o + 0], s[ph][o + 1]); w.y = cvtpk(s[ph][o + 2], s[ph][o + 3]); w.z = cvtpk(s[ph][o + 4], s[ph][o + 5]); w.w = cvtpk(s[ph][o + 6], s[ph][o + 7]);
                    pk[cc] = __builtin_bit_cast(bf16x8, w); }
                const LAS unsigned char* vb = sb + OFF_V + vrd;
                bf16x8 vf[2][4];
#pragma unroll
                for (int dh = 0; dh < 2; ++dh)
#pragma unroll
                    for (int cc = 0; cc < 4; ++cc) {
                        const v4i16_t v0 = __builtin_amdgcn_ds_read_tr16_b64_v4i16((LAS v4i16_t*)(vb + dh * VHALF + cc * 1024));
                        const v4i16_t v1 = __builtin_amdgcn_ds_read_tr16_b64_v4i16((LAS v4i16_t*)(vb + dh * VHALF + cc * 1024 + 256));
                        vf[dh][cc] = (bf16x8){v0[0], v0[1], v0[2], v0[3], v1[0], v1[1], v1[2], v1[3]}; }
                __builtin_amdgcn_sched_barrier(0);
#pragma unroll
                for (int cc = 0; cc < 4; ++cc) {
                    ot[0] = __builtin_amdgcn_mfma_f32_32x32x16_bf16(vf[0][cc], pk[cc], ot[0], 0, 0, 0);
                    ot[1] = __builtin_amdgcn_mfma_f32_32x32x16_bf16(vf[1][cc], pk[cc], ot[1], 0, 0, 0);
                }
                __builtin_amdgcn_sched_barrier(0);
            }
        }
        if (MODE == 2) {
            bool dn = true;
            if (t >= 1) { const float bnd = qn * __shfl(pmv, t - 1) - __shfl(lcev, t - 1); dn = __all(bnd < m_run - 40.f); }
            done_w = done_w || dn;
            if (lane == 0) *(LAS unsigned*)(lds + OFF_FLAG + (i & 1) * 32 + wid * 4) = done_w ? 1u : 0u;
        }
    }
    if (MODE == 0) { if (ntile > 4) {
        f32x16 SA[2], SB[2];
        float m_new, alpha;
        { const int y = ((ntile - 1 < 6) ? (ntile - 1) : 6) - 4;
          if (y >= 2) AT_WAITV(2 * NPT); else if (y == 1) AT_WAITV(NPT); else AT_WAITV(0); }
        __builtin_amdgcn_s_barrier(); asm volatile("" ::: "memory");
        { const LAS unsigned char* sb = lds + (4 & 3) * SLOT;
          bf16x8 kf[2][DK / 16];
#pragma unroll
          for (int ph = 0; ph < 2; ++ph) {
#pragma unroll
              for (int d0 = 0; d0 < 4; ++d0) kf[ph][d0] = *(const LAS bf16x8*)(sb + koff[d0] + ph * 4096);
              if (DK == 96) {
#pragma unroll
                  for (int j = 0; j < 2; ++j) kf[ph][(DK == 96) ? 4 + j : 0] = *(const LAS bf16x8*)(sb + poff[j] + ph * 2048);
              }
          }
#pragma unroll
          for (int r = 0; r < 16; ++r) { SA[0][r] = 0.f; SA[1][r] = 0.f; }
#pragma unroll
          for (int d0 = 0; d0 < DK / 16; ++d0) { SA[0] = __builtin_amdgcn_mfma_f32_32x32x16_bf16(kf[0][d0], qf[d0], SA[0], 0, 0, 0); SA[1] = __builtin_amdgcn_mfma_f32_32x32x16_bf16(kf[1][d0], qf[d0], SA[1], 0, 0, 0); }
          float mx = SA[0][0];
#pragma unroll
          for (int r = 1; r < 16; ++r) mx = fmaxf(mx, SA[0][r]);
#pragma unroll
          for (int r = 0; r < 16; ++r) mx = fmaxf(mx, SA[1][r]);
          mx = fmaxf(mx, __shfl_xor(mx, 32)) * p.c;
          m_new = fmaxf(m_run, mx); alpha = __builtin_amdgcn_exp2f(m_run - m_new); m_run = m_new; }
#define P_STEP(SC, SN, i_) do { const int i__ = (i_); const bool has_next = (i__ + 1 < ntile); \
        if (i__ + 2 < ntile) AT_WAITV(NPT); else AT_WAITV(0);                      \
        __builtin_amdgcn_s_barrier(); asm volatile("" ::: "memory"); \
        if (i__ + 3 < ntile) AT_DMA(t_hi - (i__ + 3), (i__ + 3) & 3); \
        const LAS unsigned char* sbc_ = lds + (i__ & 3) * SLOT; const LAS unsigned char* sbn_ = lds + ((i__ + 1) & 3) * SLOT; \
        float l0_ = 0.f, l1_ = 0.f; \
        if (has_next) { \
            bf16x8 kf_[2][DK / 16]; \
            _Pragma("unroll") for (int ph = 0; ph < 2; ++ph) { \
                _Pragma("unroll") for (int d0 = 0; d0 < 4; ++d0) kf_[ph][d0] = *(const LAS bf16x8*)(sbn_ + koff[d0] + ph * 4096); \
                if (DK == 96) { _Pragma("unroll") for (int j = 0; j < 2; ++j) kf_[ph][(DK == 96) ? 4 + j : 0] = *(const LAS bf16x8*)(sbn_ + poff[j] + ph * 2048); } } \
            _Pragma("unroll") for (int r = 0; r < 16; ++r) { SN[0][r] = 0.f; SN[1][r] = 0.f; } \
            PSB(); \
            PSeg1<DK, 0>::run(SC, SN, kf_, qf, p.c, m_new, l0_, l1_); \
        } else { p_exp_range<0, 32>(SC, p.c, m_new, l0_, l1_); } \
        if (__any(alpha != 1.f)) { l_run *= alpha; _Pragma("unroll") for (int r = 0; r < 16; ++r) { ot[0][r] *= alpha; ot[1][r] *= alpha; } } \
        l_run += l0_ + l1_; \
        { bf16x8 vf_[2][4], pk_[4]; const LAS unsigned char* vb_ = sbc_ + OFF_V + vrd; \
          _Pragma("unroll") for (int dh = 0; dh < 2; ++dh) _Pragma("unroll") for (int cc = 0; cc < 4; ++cc) { \
              const v4i16_t v0 = __builtin_amdgcn_ds_read_tr16_b64_v4i16((LAS v4i16_t*)(vb_ + dh * VHALF + cc * 1024)); \
              const v4i16_t v1 = __builtin_amdgcn_ds_read_tr16_b64_v4i16((LAS v4i16_t*)(vb_ + dh * VHALF + cc * 1024 + 256)); \
              vf_[dh][cc] = (bf16x8){v0[0], v0[1], v0[2], v0[3], v1[0], v1[1], v1[2], v1[3]}; } \
          { u32x4 w; w.x = cvtpk(SC[0][0], SC[0][1]); w.y = cvtpk(SC[0][2], SC[0][3]); w.z = cvtpk(SC[0][4], SC[0][5]); w.w = cvtpk(SC[0][6], SC[0][7]); pk_[0] = __builtin_bit_cast(bf16x8, w); } \
          float mx_ = -INFINITY; \
          PSB(); \
          PSeg2<0>::run(SC, SN, vf_, pk_, ot, mx_, has_next); \
          if (has_next) { mx_ = fmaxf(mx_, __shfl_xor(mx_, 32)) * p.c; m_new = fmaxf(m_run, mx_); alpha = __builtin_amdgcn_exp2f(m_run - m_new); m_run = m_new; } } \
    } while (0)
        for (int i = 4; i < ntile; i += 2) {
            P_STEP(SA, SB, i);
            if (i + 1 < ntile) P_STEP(SB, SA, i + 1);
        }
#undef P_STEP
    } }
    AT_WAITV(0);
    __builtin_amdgcn_s_barrier();
    asm volatile("" ::: "memory");
    const float lt = l_run + __shfl_xor(l_run, 32);
    const float inv = 1.f / lt;
#pragma unroll
    for (int dh = 0; dh < 2; ++dh)
#pragma unroll
        for (int j = 0; j < 4; ++j) {
            const int d = 32 * dh + 8 * j + 4 * hi;
            const u32x2 g = *(const u32x2*)(Gp + (size_t)q * p.ldg + d);
            const float g0 = bflo(g.x), g1 = bfhi(g.x), g2 = bflo(g.y), g3 = bfhi(g.y);
            const float o0 = ot[dh][4 * j + 0] * inv * (g0 / (1.f + __expf(-g0)));
            const float o1 = ot[dh][4 * j + 1] * inv * (g1 / (1.f + __expf(-g1)));
            const float o2 = ot[dh][4 * j + 2] * inv * (g2 / (1.f + __expf(-g2)));
            const float o3 = ot[dh][4 * j + 3] * inv * (g3 / (1.f + __expf(-g3)));
            u32x2 w; w.x = cvtpk(o0, o1); w.y = cvtpk(o2, o3);
            *(u32x2*)(Op + (size_t)q * p.ldo + d) = w;
        }
#undef AT_DMA
}

#define XB_TMO      128
#define XB_XCNT(j)  (256  + 64 * (j))
#define XB_XSUB(j)  (1280 + 64 * (j))
#define XB_XGEN(j)  (2304 + 64 * (j))
#define XB_TOP      3328
#define XB_TOPGEN   3392
#define XCD_BAR_WORDS 3456
#define XB_SPIN_CAP (1u << 18)

__device__ __forceinline__ unsigned xb_ld(unsigned* p)              { return __hip_atomic_load(p, __ATOMIC_RELAXED, __HIP_MEMORY_SCOPE_AGENT); }
__device__ __forceinline__ unsigned xb_add(unsigned* p, unsigned v) { return __hip_atomic_fetch_add(p, v, __ATOMIC_RELAXED, __HIP_MEMORY_SCOPE_AGENT); }
__device__ __forceinline__ unsigned xb_xcc_id() { return (unsigned)__builtin_amdgcn_s_getreg((3 << 11) | 20) & 0xFu; }
#define XB_SPIN(cond, bar) do { unsigned _sp = 0; while (cond) { __builtin_amdgcn_s_sleep(1); \
    if ((++_sp & 255u) == 0u) { if (xb_ld(&(bar)[XB_TMO])) break; if (_sp > XB_SPIN_CAP) { atomicAdd(&(bar)[XB_TMO], 1u); break; } } } } while (0)

struct XcdBarrier {
    unsigned* bar; unsigned x;
    volatile LAS unsigned* st;
};

__device__ __forceinline__ XcdBarrier xcd_barrier_post(unsigned* bar, volatile LAS unsigned* st) {
    XcdBarrier b; b.bar = bar; b.x = xb_xcc_id(); b.st = st;
    if (threadIdx.x == 0) (void)xb_add(&bar[XB_XCNT(b.x)], 1u);
    return b;
}
__device__ __forceinline__ void xcd_barrier_complete(unsigned* bar, unsigned x, unsigned& nloc, unsigned& nx) {
    const unsigned G = gridDim.x * gridDim.y * gridDim.z;
    unsigned sum, cnt, mine, sp = 0u;
    for (;;) {
        sum = 0u; cnt = 0u; mine = 0u;
#pragma unroll
        for (unsigned j = 0; j < 16; ++j) { const unsigned c = xb_ld(&bar[XB_XCNT(j)]); sum += c; cnt += (c > 0u) ? 1u : 0u; mine = (j == x) ? c : mine; }
        if (sum == G) break;
        __builtin_amdgcn_s_sleep(1);
        if ((++sp & 255u) == 0u) { if (xb_ld(&bar[XB_TMO])) break; if (sp > XB_SPIN_CAP) { atomicAdd(&bar[XB_TMO], 1u); break; } }
    }
    nloc = mine > 0u ? mine : 1u; nx = cnt > 0u ? cnt : 1u;
}

__device__ __forceinline__ void xcd_barrier(const XcdBarrier& b) {
    asm volatile("s_waitcnt vmcnt(0)" ::: "memory");
    __syncthreads();
    if (threadIdx.x == 0) {
        unsigned* bar = b.bar;
        __builtin_amdgcn_s_waitcnt(0);
        unsigned nloc = b.st[0], nx = b.st[1];
        if (nloc == 0u) { xcd_barrier_complete(bar, b.x, nloc, nx); b.st[0] = nloc; b.st[1] = nx; }
        const unsigned old = xb_add(&bar[XB_XSUB(b.x)], 1u);
        const unsigned gen = old / nloc;
        if (old + 1u == (gen + 1u) * nloc) {
            __builtin_amdgcn_fence(__ATOMIC_RELEASE, "agent");
            asm volatile("s_waitcnt vmcnt(0)" ::: "memory");
            const unsigned og = xb_add(&bar[XB_TOP], 1u);
            const unsigned tg = og / nx;
            if (og + 1u == (tg + 1u) * nx) xb_add(&bar[XB_TOPGEN], 1u);
            else XB_SPIN(xb_ld(&bar[XB_TOPGEN]) == tg, bar);
            __builtin_amdgcn_fence(__ATOMIC_ACQUIRE, "agent");
            xb_add(&bar[XB_XGEN(b.x)], 1u);
            asm volatile("s_waitcnt vmcnt(0)" ::: "memory");
        } else {
            XB_SPIN(xb_ld(&bar[XB_XGEN(b.x)]) == gen, bar);
            __builtin_amdgcn_fence(__ATOMIC_ACQUIRE, "agent");
            asm volatile("s_waitcnt vmcnt(0)" ::: "memory");
        }
    }
    __syncthreads();
}

struct Args { const float* in[15]; const int* pos; float* out; unsigned char* ws; int ph_lo, ph_hi; };

__device__ __forceinline__ void transpose_item(const float* W, int ldw, int col0, int k0, bf16* WT, int ldt, int row_off, LAS float* scr, int lane) {
#pragma unroll 8
    for (int i = 0; i < 32; ++i) { const int kk = 2 * i + (lane >> 5); scr[kk * 33 + (lane & 31)] = W[(size_t)(k0 + kk) * ldw + col0 + (lane & 31)]; }
    asm volatile("s_waitcnt lgkmcnt(0)" ::: "memory");
    const int c = lane & 7;
#pragma unroll
    for (int j = 0; j < 4; ++j) { const int n = (lane >> 3) + 8 * j; const LAS float* s = scr + (8 * c) * 33 + n;
        u32x4 o; o.x = cvtpk(s[0 * 33], s[1 * 33]); o.y = cvtpk(s[2 * 33], s[3 * 33]); o.z = cvtpk(s[4 * 33], s[5 * 33]); o.w = cvtpk(s[6 * 33], s[7 * 33]);
        *(u32x4*)(WT + (size_t)(row_off + n) * ldt + k0 + 8 * c) = o; }
    asm volatile("s_waitcnt lgkmcnt(0)" ::: "memory");
}

__device__ __forceinline__ void rms_row_to_bf16(const float* xrow, const float* g, bf16* orow, int lane) {
    const f32x4* xr = (const f32x4*)xrow + lane; const f32x4* gr = (const f32x4*)g + lane;
    f32x4 v[4]; float s = 0.f;
#pragma unroll
    for (int j = 0; j < 4; ++j) { v[j] = xr[64 * j]; s += (v[j].x * v[j].x + v[j].y * v[j].y) + (v[j].z * v[j].z + v[j].w * v[j].w); }
    const float rs = 1.f / sqrtf(wave_sum(s) * (1.f / DM) + EPS);
    u32x2* o8 = (u32x2*)orow + lane;
#pragma unroll
    for (int j = 0; j < 4; ++j) { const f32x4 gg = gr[64 * j]; u32x2 w; w.x = cvtpk(v[j].x * rs * gg.x, v[j].y * rs * gg.y); w.y = cvtpk(v[j].z * rs * gg.z, v[j].w * rs * gg.w); o8[64 * j] = w; }
}

template <bool COOP>
__global__ void __launch_bounds__(NTHREADS, 2) mk_fwd(Args args) {
    extern __shared__ __attribute__((aligned(16))) unsigned char lds_raw[];
    LAS unsigned char* lds = (LAS unsigned char*)lds_raw;
    const int tid = threadIdx.x, lane = tid & 63, wave = __builtin_amdgcn_readfirstlane(tid >> 6);
    const int G = gridDim.x, bx = blockIdx.x;
    const int vcu = (G % 8 == 0) ? (bx % 8) * (G / 8) + bx / 8 : bx;
    const int gw = vcu * NWAVES + wave, NGW = G * NWAVES;
    unsigned char* ws = args.ws;
    const float* x = args.in[0];
    bf16* Wt0 = (bf16*)(ws + WS_WT0); bf16* Wqup = (bf16*)(ws + WS_WQUP); bf16* Wkvup = (bf16*)(ws + WS_WKVUP); bf16* Wout0 = (bf16*)(ws + WS_WOUT0);
    bf16* Wt1 = (bf16*)(ws + WS_WT1); bf16* Wout1 = (bf16*)(ws + WS_WOUT1);
    bf16* XN = (bf16*)(ws + WS_XN); bf16* OG = (bf16*)(ws + WS_OG); float* LF = (float*)(ws + WS_LF); float* LC = (float*)(ws + WS_LC); float* CS = (float*)(ws + WS_CS); float* TMAXB = (float*)(ws + WS_TMAX);
    bf16* Z0 = (bf16*)(ws + WS_Z0); bf16* Z1 = (bf16*)(ws + WS_Z1); bf16* CQN = (bf16*)(ws + WS_CQN); bf16* CKVN = (bf16*)(ws + WS_CKVN); bf16* KPE = (bf16*)(ws + WS_KPE);
    bf16* Q0 = (bf16*)(ws + WS_Q0); bf16* KN = (bf16*)(ws + WS_KN); bf16* VM = (bf16*)(ws + WS_VM);
    float* out = args.out;
    const int lo = args.ph_lo, hi_ph = args.ph_hi;
#ifndef REPMASK
#define REPMASK 0
#endif
#define NREP(k) (1 + (((REPMASK) >> (k)) & 1))
#ifndef PHMASK
#define PHMASK 0xfff
#endif
#define IN(k) ((((PHMASK) >> (k)) & 1) && lo <= (k) && (k) < hi_ph)
#define SEAM(k) do { if constexpr (COOP) { if (IN(k) && IN((k) + 1)) { if ((k) == 0) { cg::this_grid().sync(); xbar = xcd_barrier_post(barw, (volatile LAS unsigned*)(lds + LDS_MISC)); } else { xcd_barrier(xbar); } } } } while (0)
    unsigned* qctr = (unsigned*)(ws + 256 * 1024);
    unsigned* barw = (unsigned*)ws;
    XcdBarrier xbar; xbar.bar = barw; xbar.x = 0; xbar.st = (volatile LAS unsigned*)(lds + LDS_MISC);
    if constexpr (COOP) {
        if (tid < 16) ((LAS unsigned*)(lds + LDS_MISC))[tid] = 0u;
        if (bx == 0) { for (int i = tid; i < XCD_BAR_WORDS; i += NTHREADS) barw[i] = 0u; for (int i = tid; i < 16 * 64; i += NTHREADS) qctr[i] = 0u; for (int i = tid; i < 2 * 64 * 64; i += NTHREADS) ((unsigned*)(ws + 64 * 1024))[i] = 0u; }
        __syncthreads();
    }

    if (IN(0)) {
        LAS float* scr = (LAS float*)(lds + wave * 16384);
        constexpr int I_A = 16 * 69, I_B = 4 * 24, I_C = 2 * 32, I_D = 16 * 32, I_E1 = 16 * 96, I_E2 = 16 * 32, I_F = 16 * 32;
        constexpr int NIT = I_A + I_B + I_C + I_D + I_E1 + I_E2 + I_F;
        for (int it = gw; it < NIT; it += NGW) {
            int r = it;
            if (r < I_A) { const int kb = r / 69, nb = r % 69; transpose_item(args.in[3], N0, 32 * nb, 64 * kb, Wt0, 1024, 32 * nb, scr, lane); continue; } r -= I_A;
            if (r < I_B) { const int kb = r / 24, nb = r % 24; transpose_item(args.in[5], 768, 32 * nb, 64 * kb, Wqup, 256, 32 * nb, scr, lane); continue; } r -= I_B;
            if (r < I_C) { const int kb = r / 32, nb = r % 32; const int n0 = 32 * nb, h = n0 >> 7, j0 = n0 & 127; const int dst = (j0 < 64) ? (h * 64 + j0) : (512 + h * 64 + (j0 - 64));
                           transpose_item(args.in[7], 1024, n0, 64 * kb, Wkvup, 256, dst, scr, lane); continue; } r -= I_C;
            if (r < I_D) { const int kb = r / 32, nb = r % 32; transpose_item(args.in[9], 1024, 32 * nb, 64 * kb, Wout0, 1024, 32 * nb, scr, lane); continue; } r -= I_D;
            if (r < I_E1) { const int kb = r / 96, nb = r % 96; transpose_item(args.in[11], N1W, 32 * nb, 64 * kb, Wt1, 1024, 32 * nb, scr, lane); continue; } r -= I_E1;
            if (r < I_E2) { const int kb = r / 32, nb = r % 32; transpose_item(args.in[11], N1W, W1_G + 32 * nb, 64 * kb, Wt1, 1024, C1_G + 32 * nb, scr, lane); continue; } r -= I_E2;
            { const int kb = r / 32, nb = r % 32; transpose_item(args.in[13], 1024, 32 * nb, 64 * kb, Wout1, 1024, 32 * nb, scr, lane); }
        }
        { const u32x4 z = {0u, 0u, 0u, 0u};
          u32x4* p0 = (u32x4*)(Wt0 + (size_t)N0 * 1024);
          for (int i = vcu * NTHREADS + tid; i < 96 * 1024 / 8; i += G * NTHREADS) p0[i] = z;
          for (int i = vcu * NTHREADS + tid; i < 1024 * 16; i += G * NTHREADS) { const int row = i >> 4, c = i & 15; *(u32x4*)(Wkvup + (size_t)row * 256 + 128 + c * 8) = z; } }
        for (int m = gw; m < M; m += NGW) rms_row_to_bf16(x + (size_t)m * DM, args.in[2], XN + (size_t)m * DM, lane);
    }
    SEAM(0);
    if (IN(1)) {
        __syncthreads();
        pg8::Gemm g{XN, Wt0, M, N0P, 1024}; pg8::StaticOrder S; S.init(M, N0P, G, bx);
        pg8::EpiBf16<0> E{Z0, N0P, nullptr, 0, 0, 1.f};
        for (int rep = 0; rep < NREP(1); ++rep) {
        pg8::gemm_phase<pg8::EpiBf16<0>, pg8::StaticOrder, true, true>(lds, g, S, E); __syncthreads(); }
    }
    SEAM(1);
    if (IN(2)) {
        const float* gq = args.in[4]; const float* gkv = args.in[6];
        for (int m = gw; m < M; m += NGW) {
            const bf16* z = Z0 + (size_t)m * N0P;
            const u32x2 a = *(const u32x2*)(z + C_CQ + 4 * lane);
            const unsigned bb = *(const unsigned*)(z + C_CKV + 2 * lane);
            const float a0 = bflo(a.x), a1 = bfhi(a.x), a2 = bflo(a.y), a3 = bfhi(a.y), b0 = bflo(bb), b1 = bfhi(bb);
            const float sa = wave_sum((a0 * a0 + a1 * a1) + (a2 * a2 + a3 * a3)), sb = wave_sum(b0 * b0 + b1 * b1);
            const float ra = 1.f / sqrtf(sa * (1.f / 256.f) + EPS), rb = 1.f / sqrtf(sb * (1.f / 128.f) + EPS);
            const f32x4 ga = *(const f32x4*)(gq + 4 * lane); const f32x2 gb = *(const f32x2*)(gkv + 2 * lane);
            u32x2 w; w.x = cvtpk(a0 * ra * ga.x, a1 * ra * ga.y); w.y = cvtpk(a2 * ra * ga.z, a3 * ra * ga.w);
            *(u32x2*)(CQN + (size_t)m * 256 + 4 * lane) = w;
            *(unsigned*)(CKVN + (size_t)m * 256 + 2 * lane) = cvtpk(b0 * rb * gb.x, b1 * rb * gb.y);
            *(unsigned*)(CKVN + (size_t)m * 256 + 128 + 2 * lane) = 0u;
            if (lane < 16) {
                const float invf = (float)exp2(-(double)lane * 0.8304820237218406);
                const double ang = (double)(float)args.pos[m] * (double)invf;
                const double rev = ang * 0.15915494309189535;
                const float rr = (float)(rev - rint(rev));
                const float cv = __builtin_amdgcn_cosf(rr), sv = __builtin_amdgcn_sinf(rr);
                CS[(size_t)m * 32 + lane] = cv; CS[(size_t)m * 32 + 16 + lane] = sv;
                const float x1 = bf1(z[C_KPE + lane]), x2 = bf1(z[C_KPE + 16 + lane]);
                const unsigned o1 = cvtpk(x1 * cv - x2 * sv, 0.f), o2 = cvtpk(x2 * cv + x1 * sv, 0.f);
                KPE[(size_t)m * 32 + lane] = (bf16)(o1 & 0xffffu); KPE[(size_t)m * 32 + 16 + lane] = (bf16)(o2 & 0xffffu);
            }
        }
    }
    SEAM(2);
    if (IN(3)) {
        __syncthreads();
#ifndef NO_QUP
        { int kq_ = 256; asm volatile("" : "+s"(kq_)); pg8::Gemm g{CQN, Wqup, M, 768, kq_}; pg8::StaticOrder S; S.init(M, 768, G, bx);
          pg8::EpiQRope E{Q0, 768, CS};
          pg8::gemm_phase<pg8::EpiQRope, pg8::StaticOrder, true, true>(lds, g, S, E); }
#endif
        __syncthreads();
#ifndef NO_KVUP
        { int kk_ = 256; asm volatile("" : "+s"(kk_)); pg8::Gemm g{CKVN, Wkvup, M, 1024, kk_}; pg8::StaticOrder S; S.init(M, 1024, G, bx);
          pg8::EpiBf16<0> E{KN, 512, nullptr, 512, (size_t)(WS_VM - WS_KN) / 2, 1.f, 3u, 8};
          pg8::gemm_phase<pg8::EpiBf16<0>, pg8::StaticOrder, true, true>(lds, g, S, E); }
#endif
    }
    SEAM(3);
    if (IN(4)) {
        __syncthreads();
        for (;;) {
            if (tid == 0) *(volatile LAS int*)(lds + LDS_MISC + 64) = (int)atomicAdd(qctr + 64 * (bx & 7), 1u);
            __syncthreads();
            const int tk = *(volatile LAS int*)(lds + LDS_MISC + 64);
            __syncthreads();
            if (tk >= 128) break;
            const bool swa = tk >= 64;
            AttnP p; p.sinkp = args.in[8]; p.h0 = 0;
            if (!swa) {
                const int bh = 8 * (bx & 7) + (tk >> 3), s = tk & 7, b = bh >> 3, h = bh & 7; const size_t rb = (size_t)b * SEQ;
                p.Q = Q0 + rb * 768 + h * 96; p.ldq = 768; p.K = KN + (size_t)bh * SEQ * 64; p.ldk = 64; p.K2 = KPE + rb * 32; p.ldk2 = 32; p.V = VM + (size_t)bh * SEQ * 64; p.ldv = 64;
                p.G = Z0 + rb * N0P + C_G0 + h * 64; p.ldg = N0P; p.O = OG + rb * 1024 + h * 64; p.ldo = 1024; p.lc = nullptr; p.tmax = nullptr; p.c = 0.10206207261596575f * LOG2E; p.sink2 = 0.f; p.slope2 = 0.f;
                attn_unit<96, 0>(p, (15 - s) * 256, lds); attn_unit<96, 0>(p, s * 256, lds);
            } else {
                const int j = tk - 64, pkv = 2 * (bx & 7) + (j >> 5), b = pkv >> 1, kvh = pkv & 1, qb = 2 * (j & 31); const size_t rb = (size_t)b * SEQ;
                p.Q = Z0 + rb * N0P + C_QS + kvh * 256; p.ldq = N0P; p.K = Z0 + rb * N0P + C_KS + kvh * 64; p.ldk = N0P; p.K2 = nullptr; p.ldk2 = 0; p.V = Z0 + rb * N0P + C_VS + kvh * 64; p.ldv = N0P;
                p.G = Z0 + rb * N0P + C_G0 + 512 + kvh * 256; p.ldg = N0P; p.O = OG + rb * 1024 + 512 + kvh * 256; p.ldo = 1024; p.lc = nullptr; p.tmax = nullptr; p.c = 0.125f * LOG2E;
                p.sink2 = 0.f; p.slope2 = 0.f; p.h0 = 4 * kvh;
                attn_unit<64, 1>(p, qb * 64, lds); attn_unit<64, 1>(p, (qb + 1) * 64, lds);
            }
        }
    }
    SEAM(4);
    if (IN(5)) {
        __syncthreads();
        pg8::Gemm g{OG, Wout0, M, 1024, 1024}; pg8::StaticOrder S; S.init(M, 1024, G, bx);
        pg8::EpiResF32 E{x, out, 1024};
        pg8::gemm_phase<pg8::EpiResF32, pg8::StaticOrder, true, true>(lds, g, S, E);
    }
    SEAM(5);
    if (IN(6)) {
        __syncthreads();
        const float* g1 = args.in[10]; const float* w1 = args.in[11]; const float* bfp = args.in[12];
        LAS float* WF = (LAS float*)lds;
        for (int k = tid; k < 1024; k += NTHREADS) {
            const int l = (k & 255) >> 2, j = k >> 8, e = k & 3; const int R = l + 64 * (4 * j + e); const float gk = g1[k];
#pragma unroll
            for (int c = 0; c < 4; ++c) { const f32x4 wv = *(const f32x4*)(w1 + (size_t)k * N1W + W1_F + 4 * c); *(LAS f32x4*)(WF + R * 20 + 4 * c) = wv * gk; }
        }
        __syncthreads();
        for (int m = gw; m < M; m += NGW) {
            const f32x4* xr = (const f32x4*)(out + (size_t)m * DM) + lane; const f32x4* gr = (const f32x4*)g1 + lane;
            f32x4 v[4]; float ss = 0.f;
#pragma unroll
            for (int j = 0; j < 4; ++j) { v[j] = xr[64 * j]; ss += (v[j].x * v[j].x + v[j].y * v[j].y) + (v[j].z * v[j].z + v[j].w * v[j].w); }
            const float rs = 1.f / sqrtf(wave_sum(ss) * (1.f / DM) + EPS);
            u32x2* o8 = (u32x2*)(XN + (size_t)m * DM) + lane;
            float fa[16];
#pragma unroll
            for (int n = 0; n < 16; ++n) fa[n] = 0.f;
#pragma unroll
            for (int j = 0; j < 4; ++j) { const f32x4 gg = gr[64 * j]; u32x2 w; w.x = cvtpk(v[j].x * rs * gg.x, v[j].y * rs * gg.y); w.y = cvtpk(v[j].z * rs * gg.z, v[j].w * rs * gg.w); o8[64 * j] = w;
#pragma unroll
                for (int e = 0; e < 4; ++e) { const float xv = v[j][e]; const LAS float* wr_ = WF + (lane + 64 * (4 * j + e)) * 20;
#pragma unroll
                    for (int c = 0; c < 4; ++c) { const f32x4 wv = *(const LAS f32x4*)(wr_ + 4 * c); fa[4 * c + 0] += xv * wv.x; fa[4 * c + 1] += xv * wv.y; fa[4 * c + 2] += xv * wv.z; fa[4 * c + 3] += xv * wv.w; }
                    asm volatile("" ::: "memory"); } }
            const bool b5 = (lane & 32) != 0, b4 = (lane & 16) != 0, b3 = (lane & 8) != 0, b2 = (lane & 4) != 0;
            float r8[8], r4[4], r2[2];
#pragma unroll
            for (int i = 0; i < 8; ++i) { const float snd = b5 ? fa[i] : fa[8 + i]; r8[i] = (b5 ? fa[8 + i] : fa[i]) + __shfl_xor(snd, 32); }
#pragma unroll
            for (int i = 0; i < 4; ++i) { const float snd = b4 ? r8[i] : r8[4 + i]; r4[i] = (b4 ? r8[4 + i] : r8[i]) + __shfl_xor(snd, 16); }
#pragma unroll
            for (int i = 0; i < 2; ++i) { const float snd = b3 ? r4[i] : r4[2 + i]; r2[i] = (b3 ? r4[2 + i] : r4[i]) + __shfl_xor(snd, 8); }
            float mine = (b2 ? r2[1] : r2[0]) + __shfl_xor(b2 ? r2[0] : r2[1], 4);
            mine += __shfl_xor(mine, 1); mine += __shfl_xor(mine, 2);
            if ((lane & 3) == 0) { const int n = (lane >> 2) & 15; const float f = mine * rs + bfp[n]; const float lsg = fminf(f, 0.f) - log1pf(expf(-fabsf(f))); LF[(size_t)m * 16 + n] = lsg; }
        }
    }
    SEAM(6);
    if (IN(7)) {
        __syncthreads();
        LAS float* sm = (LAS float*)lds;
        for (int bh = bx; bh < 128; bh += G) {
            const int b = bh >> 4, h = bh & 15; float v[8]; float run = 0.f;
#pragma unroll
            for (int e = 0; e < 8; ++e) { run += LF[((size_t)b * SEQ + 8 * tid + e) * 16 + h]; v[e] = run; }
            float sc = run;
#pragma unroll
            for (int o = 1; o < 64; o <<= 1) { const float n = __shfl_up(sc, o); if (lane >= o) sc += n; }
            if (lane == 63) sm[wave] = sc;
            __syncthreads();
            float off = sc - run;
            for (int w = 0; w < wave; ++w) off += sm[w];
            f32x4 o0 = {(v[0] + off) * LOG2E, (v[1] + off) * LOG2E, (v[2] + off) * LOG2E, (v[3] + off) * LOG2E}, o1 = {(v[4] + off) * LOG2E, (v[5] + off) * LOG2E, (v[6] + off) * LOG2E, (v[7] + off) * LOG2E};
            *(f32x4*)(LC + (size_t)bh * SEQ + 8 * tid) = o0; *(f32x4*)(LC + (size_t)bh * SEQ + 8 * tid + 4) = o1;
            __syncthreads();
        }
        pg8::Gemm g{XN, Wt1, M, N1, 1024}; pg8::StaticOrder S; S.init(M, N1, G, bx);
        pg8::EpiBf16<0> E{Z1, 1024, nullptr, 1024, (size_t)M * 1024, 1.f, 6u, 16};
        pg8::gemm_phase<pg8::EpiBf16<0>, pg8::StaticOrder, true, true>(lds, g, S, E);
        __syncthreads();
        { pg8::Unit u; LAS float* smx = (LAS float*)lds;
          for (int i = 0; S.next(i, u); ++i) {
            if (u.pn < 4 || u.pn >= 8) continue;
            const int b = u.pm >> 4, T0 = 4 * (u.pm & 15), h0 = 4 * (u.pn - 4);
            for (int st = 0; st < 4; ++st) {
                const bf16* kbase = Z1 + (size_t)M * 1024 + ((((size_t)(b * 16 + h0 + ((tid & 31) >> 3))) * SEQ + (size_t)(u.pm & 15) * 256 + 64 * st + (tid >> 5)) << 6) + (tid & 7) * 8;
                float mxn = 0.f;
#pragma unroll
                for (int j = 0; j < 4; ++j) {
                    const u32x4 v = *(const u32x4*)(kbase + (size_t)(16 * j) * 64);
                    float s = 0.f;
#pragma unroll
                    for (int e = 0; e < 4; ++e) { const float a = bflo(v[e]), c = bfhi(v[e]); s += a * a + c * c; }
                    s += __shfl_xor(s, 1); s += __shfl_xor(s, 2); s += __shfl_xor(s, 4);
                    mxn = fmaxf(mxn, s);
                }
                if ((tid & 7) == 0) smx[(tid >> 5) * 4 + ((tid & 31) >> 3)] = mxn;
                __syncthreads();
                if (tid < 4) { float m16 = 0.f;
#pragma unroll
                    for (int r = 0; r < 16; ++r) m16 = fmaxf(m16, smx[r * 4 + tid]);
                    TMAXB[((size_t)(b * 16 + h0 + tid)) * 64 + T0 + st] = sqrtf(m16); }
                __syncthreads();
            }
          } }
    }
    SEAM(7);
    if (IN(9)) {
        __syncthreads();
        for (;;) {
            if (tid == 0) *(volatile LAS int*)(lds + LDS_MISC + 64) = (int)atomicAdd(qctr + 64 * (8 + (bx & 7)), 1u);
            __syncthreads();
            const int tk = *(volatile LAS int*)(lds + LDS_MISC + 64);
            __syncthreads();
            if (tk >= 128) break;
            const int bh = 16 * (bx & 7) + (tk >> 3), s = tk & 7, b = bh >> 4, h = bh & 15; const size_t rb = (size_t)b * SEQ;
            AttnP p;
            p.Q = Z1 + rb * 1024 + h * 64; p.ldq = 1024; p.K = Z1 + (size_t)M * 1024 + (size_t)bh * SEQ * 64; p.ldk = 64; p.K2 = nullptr; p.ldk2 = 0; p.V = Z1 + (size_t)2 * M * 1024 + (size_t)bh * SEQ * 64; p.ldv = 64;
            p.G = Z1 + (size_t)3 * M * 1024 + rb * 1024 + h * 64; p.ldg = 1024; p.O = OG + rb * 1024 + h * 64; p.ldo = 1024; p.lc = LC + (size_t)bh * SEQ; p.tmax = TMAXB + (size_t)bh * 64; p.sinkp = args.in[8]; p.h0 = 0; p.c = 0.125f * LOG2E; p.sink2 = 0.f; p.slope2 = 0.f;
            attn_unit<64, 2>(p, (15 - s) * 256, lds); attn_unit<64, 2>(p, s * 256, lds);
        }
    }
    SEAM(9);
    if (IN(10)) {
        __syncthreads();
        for (int sub = 0; sub < 2; ++sub) {
            const size_t r0 = (size_t)sub * 16384;
            pg8::Gemm g{OG + r0 * 1024, Wout1, 16384, 1024, 1024}; pg8::StaticOrder S; S.init(16384, 1024, G, bx);
            pg8::PanelRms st{(float*)(ws + WS_LF) + (size_t)sub * 16384 * 4, (unsigned*)(ws + 64 * 1024) + sub * 64 * 64, EPS};
            pg8::EpiRmsOut E{out + r0 * 1024, out + r0 * 1024, args.in[14], 1024, st};
            pg8::gemm_phase<pg8::EpiRmsOut, pg8::StaticOrder, false, true>(lds, g, S, E);
            __syncthreads();
        }
    }
#undef IN
#undef SEAM
}

constexpr int NPHASES = 11;
extern "C" void kernel_launch(void* const* d_in, const int* in_sizes, int n_in, void* d_out, int out_size, void* d_ws, size_t ws_size, hipStream_t stream) {
    static int grid = 0;
    if (grid == 0) {
        if (n_in != 15 || out_size != M * DM || ws_size < WS_END) { fprintf(stderr, "kernel_launch: unexpected shapes (n_in %d, out %d, ws %zu)\n", n_in, out_size, ws_size); grid = -1; return; }
        int dev = 0, cus = 0, per_cu = 0;
        (void)hipGetDevice(&dev); (void)hipDeviceGetAttribute(&cus, hipDeviceAttributeMultiprocessorCount, dev);
#if MK_COOP
        (void)hipFuncSetAttribute((const void*)mk_fwd<true>, hipFuncAttributeMaxDynamicSharedMemorySize, LDS_BYTES);
        (void)hipOccupancyMaxActiveBlocksPerMultiprocessor(&per_cu, (const void*)mk_fwd<true>, NTHREADS, LDS_BYTES);
#else
        (void)hipFuncSetAttribute((const void*)mk_fwd<false>, hipFuncAttributeMaxDynamicSharedMemorySize, LDS_BYTES);
        (void)hipOccupancyMaxActiveBlocksPerMultiprocessor(&per_cu, (const void*)mk_fwd<false>, NTHREADS, LDS_BYTES);
#endif
        (void)hipGetLastError();
        if (per_cu < 1) per_cu = 1;
        if (cus <= 0) cus = 256;
        grid = cus * 1;
    }
    if (grid < 0) return;
    Args a{};
    for (int i = 0; i < 15; ++i) a.in[i] = (const float*)d_in[i];
    a.pos = (const int*)d_in[1]; a.out = (float*)d_out; a.ws = (unsigned char*)d_ws;
#if MK_COOP
    a.ph_lo = 0; a.ph_hi = NPHASES;
    void* kargs[] = {&a};
    hipError_t e = hipLaunchCooperativeKernel((const void*)mk_fwd<true>, dim3(grid), dim3(NTHREADS), kargs, LDS_BYTES, stream);
    if (e != hipSuccess) fprintf(stderr, "cooperative launch failed: %s (grid %d)\n", hipGetErrorString(e), grid);
#else
    for (int ph = 0; ph < NPHASES; ++ph) { a.ph_lo = ph; a.ph_hi = ph + 1; hipLaunchKernelGGL(mk_fwd<false>, dim3(grid), dim3(NTHREADS), LDS_BYTES, stream, a); }
#endif
}
```

```cpp
#include <hip/hip_runtime.h>
#include <hip/hip_cooperative_groups.h>
#include <cstdio>
#include <cstdint>
#include <cmath>
namespace cg = cooperative_groups;
#ifndef MK_COOP
#define MK_COOP 1
#endif
namespace pg8 {
#define PG8_LAS __attribute__((address_space(3)))
typedef unsigned short bf16_t;
typedef short bf16x8 __attribute__((ext_vector_type(8)));
typedef float f32x4 __attribute__((ext_vector_type(4)));
typedef unsigned u32x4 __attribute__((ext_vector_type(4)));
constexpr int BM = 256, BK = 64, HALF = 128, HTB = HALF * BK * 2  , STAGE_BYTES = 8 * HTB, NXCD = 8, WGM = 8;

__host__ __device__ __forceinline__ int lds_byte(int r, int c) { const int st = (r >> 4) * 2 + (c >> 5), rr = r & 15, cc = c & 31, ob = rr * 64 + cc * 2; return st * 1024 + (ob ^ (((ob >> 9) & 1) << 5)); }
__host__ __device__ __forceinline__ void stage_rc(int b, int& R, int& C) { const int st = b / 1024, sb = b % 1024, swz = sb ^ (((sb >> 9) & 1) << 5); R = (st >> 1) * 16 + swz / 64; C = (st & 1) * 32 + (swz % 64) / 2; }
__host__ __device__ __forceinline__ int perm32(int rho) { const int n = rho >> 4, i = rho & 15; return 8 * (i >> 2) + 4 * n + (i & 3); }

struct Unit { int pm, pn; };
struct Gemm { const bf16_t* A; const bf16_t* Bt; int M, N, K; };

struct StaticOrder {
    int nM, nN, nwg, G, c;
    __host__ __device__ void init(int M, int N, int G_, int c_) { nM = M / BM; nN = N / BM; nwg = nM * nN; G = G_; c = c_; }
    __host__ __device__ bool next(int i, Unit& u) const {
        const long L = (long)i * G + c; if (L >= nwg) return false;
        int wgid = (int)L; { const int q = nwg / NXCD, r = nwg % NXCD, xcd = wgid % NXCD, off = wgid / NXCD; wgid = (xcd < r ? xcd * (q + 1) : r * (q + 1) + (xcd - r) * q) + off; }
        const int nig = WGM * nN, gid = wgid / nig, fm = gid * WGM, gsz = (nM - fm) < WGM ? (nM - fm) : WGM;
        u.pm = fm + ((wgid % nig) % gsz); u.pn = (wgid % nig) / gsz; return true;
    }
    __device__ __forceinline__ void a_ready(const Unit&) const {}
    __device__ __forceinline__ void done(const Unit&) const {}
};

__device__ __forceinline__ unsigned cvt_pk_bf16(float lo, float hi) { unsigned r; asm volatile("v_cvt_pk_bf16_f32 %0, %1, %2" : "=v"(r) : "v"(lo), "v"(hi)); return r; }
typedef float f32x2 __attribute__((ext_vector_type(2)));
__device__ __forceinline__ f32x2 gelu_pk(f32x2 v) {
    const f32x2 av = __builtin_elementwise_abs(v), d = av * 0.2316418882f + 1.0f;
    f32x2 t; t.x = __builtin_amdgcn_rcpf(d.x); t.y = __builtin_amdgcn_rcpf(d.y);
    f32x2 q = t * 0.5307027145f + (-0.7265760135f); q = q * t + 0.7107068705f; q = q * t + (-0.142248368f); q = q * t + 0.127414796f; q = q * t;
    const f32x2 s = (v * v) * (-0.72134752044f);
    f32x2 e; e.x = __builtin_amdgcn_exp2f(s.x); e.y = __builtin_amdgcn_exp2f(s.y);
    const f32x2 m = v * (q * e), r = v - m;
    f32x2 o; o.x = v.x < 0.f ? m.x : r.x; o.y = v.y < 0.f ? m.y : r.y; return o;
}

template <int ACT  > struct EpiBf16 {
    static constexpr bool PERM = true, AFTER_DRAIN = false; static_assert(ACT == 0 || ACT == 1, "EpiBf16: ACT is 0 (none) or 1 (gelu_pk)");
    bf16_t* O; int ldc; const float* bias; int split_cols; size_t split_stride; float scale0; unsigned hm_mask; int hm_heads;
    __device__ __forceinline__ void operator()(const f32x4 (&acc)[2][2][4][2], const Unit& u, int wr, int wc, int fr, int fq) const {
        const int row0 = u.pm * BM + wr * 64 + fr; int colt = u.pn * BM; bf16_t* base = O;
        float sc = 1.f; bool hm = false; if (split_cols) { const int t = colt / split_cols; base += (size_t)t * split_stride; colt -= t * split_cols; if (t == 0) sc = scale0; hm = ((hm_mask >> t) & 1u) != 0u; }
        const int col0 = colt + wc * 32 + 8 * fq, bcol0 = u.pn * BM + wc * 32 + 8 * fq;
        f32x4 bv[2][2];
#pragma unroll
        for (int bj = 0; bj < 2; ++bj)
#pragma unroll
            for (int n = 0; n < 2; ++n) bv[bj][n] = bias ? *(const f32x4*)(bias + bcol0 + bj * HALF + 4 * n) : (f32x4){0.f, 0.f, 0.f, 0.f};
#pragma unroll
        for (int ai = 0; ai < 2; ++ai)
#pragma unroll
            for (int m = 0; m < 4; ++m) { const int rowi = row0 + ai * HALF + m * 16; bf16_t* rowp = base + (size_t)rowi * ldc + col0;
#pragma unroll
                for (int bj = 0; bj < 2; ++bj) { f32x4 v0 = acc[ai][bj][m][0] + bv[bj][0], v1 = acc[ai][bj][m][1] + bv[bj][1];
                    if (ACT == 1) { f32x2 a = gelu_pk((f32x2){v0[0], v0[1]}), b = gelu_pk((f32x2){v0[2], v0[3]}), c = gelu_pk((f32x2){v1[0], v1[1]}), d = gelu_pk((f32x2){v1[2], v1[3]});
                        v0 = (f32x4){a.x, a.y, b.x, b.y}; v1 = (f32x4){c.x, c.y, d.x, d.y}; }
                    v0 = v0 * sc; v1 = v1 * sc; u32x4 w; w.x = cvt_pk_bf16(v0[0], v0[1]); w.y = cvt_pk_bf16(v0[2], v0[3]); w.z = cvt_pk_bf16(v1[0], v1[1]); w.w = cvt_pk_bf16(v1[2], v1[3]);
                    bf16_t* dst = rowp + bj * HALF;
                    if (hm) { const int col = col0 + bj * HALF; dst = base + ((((size_t)(rowi >> 12) * hm_heads + (col >> 6)) << 18) + ((size_t)(rowi & 4095) << 6) + (col & 63)); }
                    *(u32x4*)dst = w; } }
    }
};
typedef unsigned u32x2 __attribute__((ext_vector_type(2)));
struct EpiQRope {
    static constexpr bool PERM = false, AFTER_DRAIN = false;
    bf16_t* O; int ldc; const float* cs;
    __device__ __forceinline__ void operator()(const f32x4 (&acc)[2][2][4][2], const Unit& u, int wr, int wc, int fr, int fq) const {
        const int row0 = u.pm * BM + wr * 64 + fr;
#pragma unroll
        for (int ai = 0; ai < 2; ++ai)
#pragma unroll
            for (int m = 0; m < 4; ++m) {
                const int row = row0 + ai * HALF + m * 16;
                const f32x4 cv = *(const f32x4*)(cs + (size_t)row * 32 + 4 * fq), sv = *(const f32x4*)(cs + (size_t)row * 32 + 16 + 4 * fq);
#pragma unroll
                for (int bj = 0; bj < 2; ++bj) {
                    const int colb = u.pn * BM + bj * HALF + wc * 32;
                    f32x4 v0 = acc[ai][bj][m][0], v1 = acc[ai][bj][m][1];
                    if (((colb >> 5) % 3) == 2) { const f32x4 a = v0 * cv - v1 * sv, b = v1 * cv + v0 * sv; v0 = a; v1 = b; }
                    bf16_t* rp = O + (size_t)row * ldc + colb + 4 * fq;
                    u32x2 w0, w1; w0.x = cvt_pk_bf16(v0[0], v0[1]); w0.y = cvt_pk_bf16(v0[2], v0[3]); w1.x = cvt_pk_bf16(v1[0], v1[1]); w1.y = cvt_pk_bf16(v1[2], v1[3]);
                    *(u32x2*)(rp) = w0; *(u32x2*)(rp + 16) = w1;
                }
                asm volatile("" ::: "memory");
            }
    }
};
struct EpiResF32 {
    static constexpr bool PERM = false, AFTER_DRAIN = false;
    const float* base; float* out; int ldc;
    __device__ __forceinline__ void operator()(const f32x4 (&acc)[2][2][4][2], const Unit& u, int wr, int wc, int fr, int fq) const {
        const int row0 = u.pm * BM + wr * 64 + fr, col0 = u.pn * BM + wc * 32 + 4 * fq;
#pragma unroll
        for (int ai = 0; ai < 2; ++ai)
#pragma unroll
            for (int m = 0; m < 4; ++m) {
                const size_t off = (size_t)(row0 + ai * HALF + m * 16) * ldc + col0;
#pragma unroll
                for (int bj = 0; bj < 2; ++bj)
#pragma unroll
                    for (int n = 0; n < 2; ++n) { const f32x4 b = *(const f32x4*)(base + off + bj * HALF + n * 16); *(f32x4*)(out + off + bj * HALF + n * 16) = b + acc[ai][bj][m][n]; }
                asm volatile("" ::: "memory");
            }
    }
};
struct PanelRms {
    float* xbuf;
    unsigned* cnt;
    float eps;
    __device__ __forceinline__ void run(const f32x4 (&v)[2][2][4][2], const Unit& u, int wr, int wc, int fr, int fq, PG8_LAS unsigned char* lds, int wid, int lane) const {
        PG8_LAS float* P = (PG8_LAS float*)lds;
        PG8_LAS float* S = (PG8_LAS float*)(lds + 4096);
#pragma unroll
        for (int ai = 0; ai < 2; ++ai)
#pragma unroll
            for (int m = 0; m < 4; ++m) {
                float s = 0.f;
#pragma unroll
                for (int bj = 0; bj < 2; ++bj)
#pragma unroll
                    for (int n = 0; n < 2; ++n) { const f32x4 x = v[ai][bj][m][n]; s += (x[0] * x[0] + x[1] * x[1]) + (x[2] * x[2] + x[3] * x[3]); }
                s += __shfl_xor(s, 16); s += __shfl_xor(s, 32);
                if (fq == 0) P[(ai * HALF + wr * 64 + m * 16 + fr) * 4 + wc] = s;
            }
        asm volatile("s_waitcnt lgkmcnt(0)" ::: "memory"); __builtin_amdgcn_s_barrier(); asm volatile("" ::: "memory");
        const int row = wid * 32 + (lane & 31);
        if (lane < 32) {
            const float t = (P[row * 4 + 0] + P[row * 4 + 1]) + (P[row * 4 + 2] + P[row * 4 + 3]);
            __hip_atomic_store(xbuf + ((size_t)(u.pm * BM + row) * 4 + u.pn), t, __ATOMIC_RELAXED, __HIP_MEMORY_SCOPE_AGENT);
        }
        asm volatile("s_waitcnt vmcnt(0)" ::: "memory");
        if (lane == 0) __hip_atomic_fetch_add(cnt + 64 * u.pm, 1u, __ATOMIC_RELAXED, __HIP_MEMORY_SCOPE_AGENT);
        if (wid == 0) {
            unsigned spins = 0;
            while ((unsigned)__builtin_amdgcn_readfirstlane(__hip_atomic_load(cnt + 64 * u.pm, __ATOMIC_RELAXED, __HIP_MEMORY_SCOPE_AGENT)) < 32u) { __builtin_amdgcn_s_sleep(2); if (++spins > (1u << 20)) break; }
            __builtin_amdgcn_fence(__ATOMIC_ACQUIRE, "agent");
        }
        asm volatile("s_waitcnt vmcnt(0) lgkmcnt(0)" ::: "memory"); __builtin_amdgcn_s_barrier(); asm volatile("" ::: "memory");
        if (lane < 32) {
            const float* slot = xbuf + (size_t)(u.pm * BM + row) * 4; float q = 0.f;
#pragma unroll
            for (int t = 0; t < 4; ++t) q += __hip_atomic_load(slot + t, __ATOMIC_RELAXED, __HIP_MEMORY_SCOPE_AGENT);
            S[row] = 1.0f / sqrtf(q * (1.0f / 1024.0f) + eps);
        }
        asm volatile("s_waitcnt lgkmcnt(0)" ::: "memory"); __builtin_amdgcn_s_barrier(); asm volatile("" ::: "memory");
    }
};
struct EpiRmsOut {
    static constexpr bool PERM = false, AFTER_DRAIN = true;
    const float* base; const bf16_t* dl; float* out; const float* g; int ldc; PanelRms st;
    __device__ __forceinline__ void fused(f32x4 (&acc)[2][2][4][2], const Unit& u, int wr, int wc, int fr, int fq, PG8_LAS unsigned char* lds, int wid, int lane) const {
        const PG8_LAS float* S = (const PG8_LAS float*)(lds + 4096);
        const int col0 = u.pn * BM + wc * 32 + 4 * fq;
#pragma unroll
        for (int ai = 0; ai < 2; ++ai)
#pragma unroll
            for (int m = 0; m < 4; ++m) { const size_t off = (size_t)(u.pm * BM + ai * HALF + wr * 64 + m * 16 + fr) * ldc + col0;
#pragma unroll
                for (int bj = 0; bj < 2; ++bj)
#pragma unroll
                    for (int n = 0; n < 2; ++n) { const u32x2 dd = *(const u32x2*)(dl + off + bj * HALF + n * 16); f32x4 bv = *(const f32x4*)(base + off + bj * HALF + n * 16);
                        bv[0] += __uint_as_float(dd.x << 16); bv[1] += __uint_as_float(dd.x & 0xffff0000u); bv[2] += __uint_as_float(dd.y << 16); bv[3] += __uint_as_float(dd.y & 0xffff0000u); acc[ai][bj][m][n] += bv; }
                asm volatile("" : "+v"(acc[ai][0][m][0]), "+v"(acc[ai][0][m][1]), "+v"(acc[ai][1][m][0]), "+v"(acc[ai][1][m][1]));
                if (m & 1) asm volatile("" ::: "memory"); }
        st.run(acc, u, wr, wc, fr, fq, lds, wid, lane);
#pragma unroll
        for (int bj = 0; bj < 2; ++bj)
#pragma unroll
            for (int n = 0; n < 2; ++n) { const f32x4 gv = *(const f32x4*)(g + col0 + bj * HALF + n * 16);
#pragma unroll
                for (int ai = 0; ai < 2; ++ai)
#pragma unroll
                    for (int m = 0; m < 4; ++m) { const int r = ai * HALF + wr * 64 + m * 16 + fr; const float rs = S[r];
                        *(f32x4*)(out + (size_t)(u.pm * BM + r) * ldc + col0 + bj * HALF + n * 16) = acc[ai][bj][m][n] * rs * gv; } }
    }
};
template <class Epi, class Sched, bool ALIGN_EPI = false, bool SP2 = false>
__device__ __forceinline__ void gemm_phase(PG8_LAS unsigned char* lds, const Gemm g, const Sched& S, const Epi& E) {
    const int tid = threadIdx.x, wid = __builtin_amdgcn_readfirstlane(tid >> 6), lane = tid & 63, wr = wid >> 2, wc = wid & 3, fr = lane & 15, fq = lane >> 4;
    const int K = g.K, nt = K / BK;
    unsigned voffA[2], voffB[2];
#pragma unroll
    for (int i = 0; i < 2; ++i) { int R, C; stage_rc(tid * 16 + i * 8192, R, C); const int Rb = Epi::PERM ? ((R & ~31) + perm32(R & 31)) : R;
        voffA[i] = (unsigned)(R * K + C) * 2u; voffB[i] = (unsigned)(Rb * K + C) * 2u; }
    const size_t kstep = (size_t)(BK * 2);
    const size_t hstep = (size_t)HALF * K * 2;
    const size_t tstep = 2 * hstep;
    const unsigned ldsw = (unsigned)wid * 1024u;
    const int aoff = lds_byte(wr * 64 + fr, fq * 8), boff = lds_byte(wc * 32 + fr, fq * 8);
#define PG8_SA(b, h) (((b) * 2 + (h)) * HTB)
#define PG8_SB(b, h) ((4 + (b) * 2 + (h)) * HTB)
#define PG8_STAGE(bufoff, gbase, voff) do { _Pragma("unroll") for (int _i = 0; _i < 2; ++_i) \
        __builtin_amdgcn_global_load_lds((const unsigned*)((const char*)(gbase) + (voff)[_i]), (PG8_LAS unsigned*)(lds + (bufoff) + ldsw + _i * 8192), 16, 0, 0); } while (0)
#define PG8_LDA(dst, b, h) do { _Pragma("unroll") for (int m = 0; m < 4; ++m) _Pragma("unroll") for (int k = 0; k < 2; ++k) dst[m][k] = *(const PG8_LAS bf16x8*)(lds + PG8_SA(b, h) + aoff + m * 2048 + k * 1024); } while (0)
#define PG8_LDB(dst, b, h) do { _Pragma("unroll") for (int n = 0; n < 2; ++n) _Pragma("unroll") for (int k = 0; k < 2; ++k) dst[n][k] = *(const PG8_LAS bf16x8*)(lds + PG8_SB(b, h) + boff + n * 2048 + k * 1024); } while (0)
#define PG8_MMA(ai, bj, At, Bt) do { __builtin_amdgcn_s_setprio(1); _Pragma("unroll") for (int m = 0; m < 4; ++m) _Pragma("unroll") for (int n = 0; n < 2; ++n) _Pragma("unroll") for (int k = 0; k < 2; ++k) \
        acc[ai][bj][m][n] = __builtin_amdgcn_mfma_f32_16x16x32_bf16(Bt[n][k], At[m][k], acc[ai][bj][m][n], 0, 0, 0); __builtin_amdgcn_s_setprio(0); } while (0)
#define PG8_WAIT_V(n) asm volatile("s_waitcnt vmcnt(" #n ")" ::: "memory")
#define PG8_WAIT_L(n) asm volatile("s_waitcnt lgkmcnt(" #n ")" ::: "memory")
#define PG8_BAR __builtin_amdgcn_s_barrier()
#define PG8_SCHED __builtin_amdgcn_sched_barrier(0)
    Unit cur, nxt; int ui = 0;
    if (!S.next(0, cur)) return;
    f32x4 acc[2][2][4][2];
#pragma unroll
    for (int a = 0; a < 2; ++a)
#pragma unroll
        for (int b = 0; b < 2; ++b)
#pragma unroll
            for (int m = 0; m < 4; ++m)
#pragma unroll
                for (int n = 0; n < 2; ++n) acc[a][b][m][n] = (f32x4){0.f, 0.f, 0.f, 0.f};
    bf16x8 At[4][2], B0[2][2], B1[2][2];
    const char* cA = (const char*)g.A + (size_t)cur.pm * tstep; const char* cB = (const char*)g.Bt + (size_t)cur.pn * tstep;
    S.a_ready(cur);
    if constexpr (SP2) {
        PG8_STAGE(PG8_SB(0, 0), cB, voffB); PG8_STAGE(PG8_SB(0, 1), cB + hstep, voffB); PG8_STAGE(PG8_SA(0, 0), cA, voffA); PG8_STAGE(PG8_SA(0, 1), cA + hstep, voffA);
        if (wr == 1) PG8_BAR;
        PG8_WAIT_V(2); PG8_BAR;
        PG8_STAGE(PG8_SB(1, 0), cB + kstep, voffB); PG8_STAGE(PG8_SA(1, 0), cA + kstep, voffA); PG8_STAGE(PG8_SB(1, 1), cB + hstep + kstep, voffB);
        PG8_WAIT_V(6); PG8_BAR;
    } else {
        PG8_STAGE(PG8_SB(0, 0), cB, voffB); PG8_STAGE(PG8_SA(0, 0), cA, voffA); PG8_STAGE(PG8_SB(0, 1), cB + hstep, voffB); PG8_STAGE(PG8_SA(0, 1), cA + hstep, voffA);
        if (wr == 1) PG8_BAR;
        PG8_WAIT_V(4); PG8_BAR;
        PG8_STAGE(PG8_SB(1, 0), cB + kstep, voffB); PG8_STAGE(PG8_SA(1, 0), cA + kstep, voffA); PG8_STAGE(PG8_SB(1, 1), cB + hstep + kstep, voffB);
        PG8_WAIT_V(6); PG8_BAR;
    }
    for (;;) {
        const bool has_next = S.next(ui + 1, nxt);
        const char* nA = has_next ? (const char*)g.A + (size_t)nxt.pm * tstep : cA; const char* nB = has_next ? (const char*)g.Bt + (size_t)nxt.pn * tstep : cB;
        for (int t = 0; t < nt; t += 2) {
            const bool last = (t == nt - 2);
            const char* a1 = cA + (size_t)(t + 1) * kstep;
            const char* a2 = last ? nA : cA + (size_t)(t + 2) * kstep; const char* b2 = last ? nB : cB + (size_t)(t + 2) * kstep;
            const char* a3 = a2 + kstep; const char* b3 = b2 + kstep;
            if (last && has_next) S.a_ready(nxt);
            if constexpr (SP2) {
            PG8_LDB(B0, 0, 0); PG8_LDB(B1, 0, 1); PG8_SCHED; PG8_LDA(At, 0, 0); PG8_STAGE(PG8_SA(1, 1), a1 + hstep, voffA);
            PG8_WAIT_V(8); PG8_WAIT_L(0); PG8_BAR; PG8_MMA(0, 0, At, B0); PG8_MMA(0, 1, At, B1); PG8_BAR; PG8_SCHED;
            PG8_LDA(At, 0, 1); PG8_STAGE(PG8_SB(0, 0), b2, voffB); PG8_STAGE(PG8_SB(0, 1), b2 + hstep, voffB); PG8_STAGE(PG8_SA(0, 0), a2, voffA);
            PG8_WAIT_V(8); PG8_WAIT_L(0); PG8_BAR; PG8_MMA(1, 0, At, B0); PG8_MMA(1, 1, At, B1); PG8_BAR; PG8_SCHED;
            PG8_LDB(B0, 1, 0); PG8_LDB(B1, 1, 1); PG8_SCHED; PG8_LDA(At, 1, 0); PG8_STAGE(PG8_SA(0, 1), a2 + hstep, voffA);
            PG8_WAIT_V(8); PG8_WAIT_L(0); PG8_BAR; PG8_MMA(0, 0, At, B0); PG8_MMA(0, 1, At, B1); PG8_BAR; PG8_SCHED;
            PG8_LDA(At, 1, 1); PG8_STAGE(PG8_SB(1, 0), b3, voffB); PG8_STAGE(PG8_SB(1, 1), b3 + hstep, voffB); PG8_STAGE(PG8_SA(1, 0), a3, voffA);
            PG8_WAIT_V(8); PG8_WAIT_L(0); PG8_BAR; PG8_MMA(1, 0, At, B0); PG8_MMA(1, 1, At, B1); PG8_BAR; PG8_SCHED;
            } else {
            PG8_LDB(B0, 0, 0); PG8_SCHED; PG8_LDA(At, 0, 0); PG8_STAGE(PG8_SA(1, 1), a1 + hstep, voffA);
            PG8_WAIT_L(8); PG8_BAR; PG8_WAIT_L(0); PG8_MMA(0, 0, At, B0); PG8_BAR; PG8_SCHED;
            PG8_LDB(B1, 0, 1); PG8_STAGE(PG8_SB(0, 0), b2, voffB);
            PG8_BAR; PG8_WAIT_L(0); PG8_MMA(0, 1, At, B1); PG8_BAR;
            PG8_LDA(At, 0, 1); PG8_STAGE(PG8_SA(0, 0), a2, voffA);
            PG8_BAR; PG8_WAIT_L(0); PG8_MMA(1, 0, At, B0); PG8_BAR; PG8_SCHED;
            PG8_STAGE(PG8_SB(0, 1), b2 + hstep, voffB);
            PG8_WAIT_V(6); PG8_BAR; PG8_MMA(1, 1, At, B1); PG8_BAR;
            PG8_LDB(B0, 1, 0); PG8_SCHED; PG8_LDA(At, 1, 0); PG8_STAGE(PG8_SA(0, 1), a2 + hstep, voffA);
            PG8_WAIT_L(8); PG8_BAR; PG8_WAIT_L(0); PG8_MMA(0, 0, At, B0); PG8_BAR; PG8_SCHED;
            PG8_LDB(B1, 1, 1); PG8_STAGE(PG8_SB(1, 0), b3, voffB);
            PG8_BAR; PG8_WAIT_L(0); PG8_MMA(0, 1, At, B1); PG8_BAR;
            PG8_LDA(At, 1, 1); PG8_STAGE(PG8_SA(1, 0), a3, voffA);
            PG8_BAR; PG8_WAIT_L(0); PG8_MMA(1, 0, At, B0); PG8_BAR; PG8_SCHED;
            PG8_STAGE(PG8_SB(1, 1), b3 + hstep, voffB);
            PG8_WAIT_V(6); PG8_BAR; PG8_MMA(1, 1, At, B1); PG8_BAR;
            }
        }
        if constexpr (ALIGN_EPI) { if (wr == 0) PG8_BAR; }
        if constexpr (!Epi::AFTER_DRAIN) { E(acc, cur, wr, wc, fr, fq); S.done(cur); }
        if (!has_next) break;
#pragma unroll
        for (int a = 0; a < 2; ++a)
#pragma unroll
            for (int b = 0; b < 2; ++b)
#pragma unroll
                for (int m = 0; m < 4; ++m)
#pragma unroll
                    for (int n = 0; n < 2; ++n) acc[a][b][m][n] = (f32x4){0.f, 0.f, 0.f, 0.f};
        cur = nxt; cA = nA; cB = nB; ++ui;
        if constexpr (ALIGN_EPI) { if (wr == 1) PG8_BAR; }
    }
    PG8_WAIT_V(0);
    if constexpr (!ALIGN_EPI) { if (wr == 0) PG8_BAR; }
    PG8_BAR;
    if constexpr (Epi::AFTER_DRAIN) { E.fused(acc, cur, wr, wc, fr, fq, lds, wid, lane); S.done(cur); }
#undef PG8_SA
#undef PG8_SB
#undef PG8_STAGE
#undef PG8_LDA
#undef PG8_LDB
#undef PG8_MMA
#undef PG8_WAIT_V
#undef PG8_WAIT_L
#undef PG8_BAR
#undef PG8_SCHED
}
}
#define LAS __attribute__((address_space(3)))
typedef unsigned short bf16;
typedef short bf16x8 __attribute__((ext_vector_type(8)));
typedef float f32x16 __attribute__((ext_vector_type(16)));
typedef float f32x4 __attribute__((ext_vector_type(4)));
typedef float f32x2 __attribute__((ext_vector_type(2)));
typedef unsigned u32x4 __attribute__((ext_vector_type(4)));
typedef unsigned u32x2 __attribute__((ext_vector_type(2)));
typedef __bf16 bf16x2_t __attribute__((ext_vector_type(2)));

constexpr int BATCH = 8, SEQ = 4096, DM = 1024, M = BATCH * SEQ;
constexpr int N0 = 2208, N0P = 2304;
constexpr int C_CQ = 0, C_CKV = 256, C_KPE = 384, C_QS = 416, C_KS = 928, C_VS = 1056, C_G0 = 1184;
constexpr int N1W = 4112, N1 = 4096;
constexpr int C1_Q = 0, C1_K = 1024, C1_V = 2048, C1_G = 3072, W1_F = 3072, W1_G = 3088;
constexpr float EPS = 1e-6f, LOG2E = 1.4426950408889634f;
constexpr int NTHREADS = 512, NWAVES = 8;

constexpr size_t MiB = 1u << 20;
constexpr size_t WS_WT0 = 1 * MiB;
constexpr size_t WS_WQUP = 6 * MiB;
constexpr size_t WS_WKVUP = 7 * MiB;
constexpr size_t WS_WOUT0 = 8 * MiB;
constexpr size_t WS_WT1 = 10 * MiB;
constexpr size_t WS_WOUT1 = 18 * MiB;
constexpr size_t WS_XN = 32 * MiB;
constexpr size_t WS_OG = 96 * MiB;
constexpr size_t WS_LF = 160 * MiB;
constexpr size_t WS_LC = 162 * MiB;
constexpr size_t WS_TMAX = 512 * 1024;
constexpr size_t WS_CS = 164 * MiB;
constexpr size_t WS_Z1 = 168 * MiB;
constexpr size_t WS_Z0 = 168 * MiB;
constexpr size_t WS_CQN = 312 * MiB;
constexpr size_t WS_CKVN = 328 * MiB;
constexpr size_t WS_KPE = 344 * MiB;
constexpr size_t WS_Q0 = 346 * MiB;
constexpr size_t WS_KN = 394 * MiB;
constexpr size_t WS_VM = 426 * MiB;
constexpr size_t WS_D0 = 426 * MiB;
constexpr size_t WS_END = 490 * MiB;
constexpr int LDS_BYTES = 135168, LDS_MISC = 131072 + 1024;

__device__ __forceinline__ unsigned cvtpk(float lo, float hi) { f32x2 v = {lo, hi}; bf16x2_t b = __builtin_convertvector(v, bf16x2_t); return __builtin_bit_cast(unsigned, b); }
__device__ __forceinline__ float bflo(unsigned u) { return __uint_as_float(u << 16); }
__device__ __forceinline__ float bfhi(unsigned u) { return __uint_as_float(u & 0xffff0000u); }
__device__ __forceinline__ float bf1(bf16 v) { return __uint_as_float(((unsigned)v) << 16); }
__device__ __forceinline__ float wave_sum(float v) {
#pragma unroll
    for (int o = 1; o < 64; o <<= 1) v += __shfl_xor(v, o);
    return v;
}

struct AttnP { const bf16 *Q, *K, *K2, *V, *G; bf16* O; const float* lc; const float* tmax; const float* sinkp; int h0; int ldq, ldk, ldk2, ldv, ldg, ldo; float c, sink2, slope2; };

typedef short v4i16_t __attribute__((ext_vector_type(4)));
__device__ __forceinline__ void glds16(const void* gsrc, unsigned lds_dst) { unsigned keep;
    asm volatile("s_mov_b32 %0, m0\n\ts_mov_b32 m0, %2\n\ts_nop 0\n\tglobal_load_lds_dwordx4 %1, off\n\ts_mov_b32 m0, %0" : "=&s"(keep) : "v"(gsrc), "s"(lds_dst) : "memory"); }
__device__ __forceinline__ void glds4(const void* gsrc, unsigned lds_dst) { unsigned keep;
    asm volatile("s_mov_b32 %0, m0\n\ts_mov_b32 m0, %2\n\ts_nop 0\n\tglobal_load_lds_dword %1, off\n\ts_mov_b32 m0, %0" : "=&s"(keep) : "v"(gsrc), "s"(lds_dst) : "memory"); }

#define PSB() __builtin_amdgcn_sched_barrier(0)
__device__ __forceinline__ constexpr int pch_lo(int k, int nch) { return k * (32 / nch) + (k < (32 % nch) ? k : (32 % nch)); }
template <int LO, int HI> __device__ __forceinline__ void p_exp_range(f32x16 (&SC)[2], float c, float m_new, float& l0, float& l1) {
#pragma unroll
    for (int e = LO; e < HI; ++e) { const float y = __builtin_amdgcn_exp2f(SC[e >> 4][e & 15] * c - m_new); SC[e >> 4][e & 15] = y; if (e & 1) l1 += y; else l0 += y; }
}
template <int DK, int K> struct PSeg1 {
    static __device__ __forceinline__ void run(f32x16 (&SC)[2], f32x16 (&SN)[2], const bf16x8 (&kf)[2][DK / 16], const bf16x8 (&qf)[DK / 16], float c, float m_new, float& l0, float& l1) {
        constexpr int NCH = 2 * (DK / 16);
        if constexpr (K < NCH) {
            SN[K & 1] = __builtin_amdgcn_mfma_f32_32x32x16_bf16(kf[K & 1][K >> 1], qf[K >> 1], SN[K & 1], 0, 0, 0);
            PSB();
            p_exp_range<pch_lo(K, NCH), pch_lo(K + 1, NCH)>(SC, c, m_new, l0, l1);
            PSB();
            PSeg1<DK, K + 1>::run(SC, SN, kf, qf, c, m_new, l0, l1);
        }
    }
};
template <int K> struct PSeg2 {
    static __device__ __forceinline__ void run(f32x16 (&SC)[2], f32x16 (&SN)[2], const bf16x8 (&vf)[2][4], bf16x8 (&pk)[4], f32x16 (&ot)[2], float& mx, bool has_next) {
        if constexpr (K < 8) {
            ot[K & 1] = __builtin_amdgcn_mfma_f32_32x32x16_bf16(vf[K & 1][K >> 1], pk[K >> 1], ot[K & 1], 0, 0, 0);
            PSB();
            if constexpr ((K & 1) == 0 && K < 6) { constexpr int cc = (K >> 1) + 1, ph = cc >> 1, o = 8 * (cc & 1); u32x4 w;
                w.x = cvtpk(SC[ph][o + 0], SC[ph][o + 1]); w.y = cvtpk(SC[ph][o + 2], SC[ph][o + 3]); w.z = cvtpk(SC[ph][o + 4], SC[ph][o + 5]); w.w = cvtpk(SC[ph][o + 6], SC[ph][o + 7]);
                pk[cc] = __builtin_bit_cast(bf16x8, w); }
            if (has_next) { constexpr int e = 4 * K, ph = e >> 4, r = e & 15;
                mx = __builtin_fmaxf(__builtin_fmaxf(mx, SN[ph][r]), SN[ph][r + 1]); mx = __builtin_fmaxf(__builtin_fmaxf(mx, SN[ph][r + 2]), SN[ph][r + 3]); }
            PSB();
            PSeg2<K + 1>::run(SC, SN, vf, pk, ot, mx, has_next);
        }
    }
};
#define AT_WAITV(n) asm volatile("s_waitcnt vmcnt(%0) lgkmcnt(0)" :: "n"(n) : "memory")
template <int DK, int MODE>
__device__ __forceinline__ void attn_unit(const AttnP& p, const int q0, LAS unsigned char* lds) {
    constexpr bool SKEW = (MODE == 2);
    constexpr int NS = SKEW ? 7 : 4, KN_B = 8192, KP_B = (DK == 96) ? 4096 : 0, VHALF = 4160, V_B = 2 * VHALF, LC_B = (MODE == 2) ? 256 : 0;
    constexpr int OFF_KP = KN_B, OFF_V = KN_B + KP_B, OFF_LC = OFF_V + V_B, SLOT = OFF_LC + LC_B, OFF_FLAG = NS * SLOT;
    constexpr int NPT = 2 + ((DK == 96 || MODE == 2) ? 1 : 0);
    const int tid = threadIdx.x, lane = tid & 63, wid = __builtin_amdgcn_readfirstlane(tid >> 6), r32 = lane & 31, hi = lane >> 5;
    const int hsel = (MODE == 1) ? (wid >> 1) : 0;
    const int qw0 = q0 + 32 * ((MODE == 1) ? (wid & 1) : wid), q = qw0 + r32;
    const bf16* Qp = p.Q + hsel * 64; const bf16* Gp = p.G + hsel * 64; bf16* Op = p.O + hsel * 64;
    float sink2 = 0.f, slope2 = 0.f;
    if (MODE == 1) { const int hh = p.h0 + hsel; sink2 = p.sinkp[hh] * LOG2E; slope2 = exp2f(-(float)(hh + 1)) * LOG2E; }
    const unsigned lds0 = (unsigned)(uintptr_t)lds;
    bf16x8 qf[DK / 16];
#pragma unroll
    for (int d0 = 0; d0 < DK / 16; ++d0) qf[d0] = *(const bf16x8*)(Qp + (size_t)q * p.ldq + 16 * d0 + 8 * hi);
#pragma unroll
    for (int d0 = 0; d0 < DK / 16; ++d0) asm volatile("" : "+v"(qf[d0]));
    const int t_hi = (MODE == 1) ? (q0 >> 6) : (((q0 + 256) >> 6) - 1);
    const int t_lo = (MODE == 1) ? (((q0 >> 6) >= 2) ? (q0 >> 6) - 2 : 0) : 0;
    const int ntile = t_hi - t_lo + 1;
    const int krow = 8 * wid + (lane >> 3), kch = (lane & 7) ^ ((krow >> 1) & 7);
    const bf16* ksrc = p.K + (size_t)krow * p.ldk + kch * 8;
    const int prow = 8 * wid + ((lane & 31) >> 2), pch = (lane & 3) ^ ((prow >> 2) & 3);
    const bf16* psrc = (DK == 96) ? (p.K2 + (size_t)prow * p.ldk2 + pch * 8) : p.K;
    const int vrow = 16 * (wid & 3) + (lane >> 2);
    const bf16* vsrc = p.V + (size_t)vrow * p.ldv + ((wid >> 2) * 4 + (lane & 3)) * 8;
    const float* lsrc = (MODE == 2) ? (p.lc + 8 * wid + (lane & 7)) : (const float*)p.K;
#define AT_DMA(t, slot) do { const size_t ro_ = (size_t)(t) * 64; const unsigned sb_ = lds0 + (unsigned)((slot) * SLOT); \
        glds16(ksrc + ro_ * p.ldk, (unsigned)__builtin_amdgcn_readfirstlane(sb_ + wid * 1024)); \
        glds16(vsrc + ro_ * p.ldv, (unsigned)__builtin_amdgcn_readfirstlane(sb_ + OFF_V + (wid >> 2) * VHALF + (wid & 3) * 1024)); \
        if (DK == 96) { if (lane < 32) glds16(psrc + ro_ * p.ldk2, (unsigned)__builtin_amdgcn_readfirstlane(sb_ + OFF_KP + wid * 512)); } \
        if (MODE == 2) { if (lane < 8) glds4(lsrc + ro_, (unsigned)__builtin_amdgcn_readfirstlane(sb_ + OFF_LC + wid * 32)); } } while (0)

    float m_run = (MODE == 1) ? sink2 : -INFINITY;
    float l_run = (MODE == 1 && hi == 0) ? 1.f : 0.f;
    f32x16 ot[2];
#pragma unroll
    for (int r = 0; r < 16; ++r) { ot[0][r] = 0.f; ot[1][r] = 0.f; }
    const int pim = 16 * (r32 >> 4) + 8 * ((r32 >> 2) & 1) + 4 * ((r32 >> 3) & 1) + (r32 & 3);
    const int vrd = (8 * hi + ((lane & 15) >> 2)) * 64 + ((lane >> 4) & 1) * 32 + (lane & 3) * 8;
    int koff[4], poff[2];
#pragma unroll
    for (int d0 = 0; d0 < 4; ++d0) koff[d0] = pim * 128 + (((2 * d0 + hi) ^ ((pim >> 1) & 7)) * 16);
#pragma unroll
    for (int j = 0; j < 2; ++j) poff[j] = OFF_KP + pim * 64 + (((2 * j + hi) ^ ((pim >> 2) & 3)) * 16);
    float pmv = 0.f, lcev = 0.f, qn = 0.f;
    if (MODE == 2) {
        pmv = (lane <= t_hi) ? p.tmax[lane] : 0.f;
#pragma unroll
        for (int o = 1; o < 64; o <<= 1) { const float n = __shfl_up(pmv, o); if (lane >= o) pmv = fmaxf(pmv, n); }
        lcev = (lane <= t_hi) ? p.lc[64 * lane + 63] : 0.f;
        float qs = 0.f;
#pragma unroll
        for (int d0 = 0; d0 < DK / 16; ++d0)
#pragma unroll
            for (int e = 0; e < 8; ++e) { const float f = bf1((bf16)qf[d0][e]); qs += f * f; }
        qs += __shfl_xor(qs, 32);
        qn = sqrtf(qs) * p.c * 1.002f;
    }
    const int sk = SKEW ? (3 - (wid >> 1)) : 0;
    int sw = sk, sd = 6;
    bool done_w = false;
    if (SKEW) {
#pragma unroll
        for (int d = 0; d < 6; ++d) if (d < ntile) AT_DMA(t_hi - d, d);
    } else {
        AT_DMA(t_hi, 0);
        if (ntile > 1) AT_DMA(t_hi - 1, 1);
        if (ntile > 2) AT_DMA(t_hi - 2, 2);
    }
    const int nfirst = (MODE == 0 && ntile > 4) ? 4 : ntile;
    for (int i = 0; i < nfirst; ++i) {
        const int t = t_hi - i - sk, kv0 = t * 64, rem = SKEW ? (ntile - 1 - (i + 3)) : (ntile - 1 - i);
        if (rem >= 2) AT_WAITV(2 * NPT); else if (rem == 1) AT_WAITV(NPT); else AT_WAITV(0);
        __builtin_amdgcn_s_barrier();
        asm volatile("" ::: "memory");
        if (MODE == 2) { if (i > 0) {
            const LAS unsigned char* fp = lds + OFF_FLAG + ((i - 1) & 1) * 32;
            const u32x4 f0 = *(const LAS u32x4*)(fp), f1 = *(const LAS u32x4*)(fp + 16);
            if ((f0.x & f0.y & f0.z & f0.w & f1.x & f1.y & f1.z & f1.w) != 0u) break; } }
        if (SKEW) { if (i + 6 < ntile) AT_DMA(t_hi - (i + 6), sd); sd = (sd == 6) ? 0 : sd + 1; }
        else { if (rem >= 3) AT_DMA(t - 3, (i + 3) & 3); }
        const LAS unsigned char* sb = lds + (SKEW ? sw : (i & 3)) * SLOT;
        if (SKEW) sw = (sw == 6) ? 0 : sw + 1;
        bool act = kv0 <= qw0 + 31;
        if (MODE == 1) act = act && (kv0 + 63 >= qw0 - 127);
        if (SKEW) act = act && (t >= 0) && !done_w;
        if (act) {
            f32x16 s[2];
            {
                bf16x8 kf[2][DK / 16];
#pragma unroll
                for (int ph = 0; ph < 2; ++ph) {
#pragma unroll
                    for (int d0 = 0; d0 < 4; ++d0) kf[ph][d0] = *(const LAS bf16x8*)(sb + koff[d0] + ph * 4096);
                    if (DK == 96) {
#pragma unroll
                        for (int j = 0; j < 2; ++j) kf[ph][(DK == 96) ? 4 + j : 0] = *(const LAS bf16x8*)(sb + poff[j] + ph * 2048);
                    }
                }
#pragma unroll
                for (int r = 0; r < 16; ++r) { s[0][r] = 0.f; s[1][r] = 0.f; }
                __builtin_amdgcn_sched_barrier(0);
#pragma unroll
                for (int d0 = 0; d0 < DK / 16; ++d0) {
                    s[0] = __builtin_amdgcn_mfma_f32_32x32x16_bf16(kf[0][d0], qf[d0], s[0], 0, 0, 0);
                    s[1] = __builtin_amdgcn_mfma_f32_32x32x16_bf16(kf[1][d0], qf[d0], s[1], 0, 0, 0);
                }
                __builtin_amdgcn_sched_barrier(0);
            }
            if (MODE == 2) {
                const LAS float* lcb = (const LAS float*)(sb + OFF_LC);
#pragma unroll
                for (int ph = 0; ph < 2; ++ph)
#pragma unroll
                    for (int j = 0; j < 4; ++j) { const f32x4 lk = *(const LAS f32x4*)(lcb + 32 * ph + 16 * (j >> 1) + 8 * hi + 4 * (j & 1));
#pragma unroll
                        for (int ii = 0; ii < 4; ++ii) s[ph][4 * j + ii] = s[ph][4 * j + ii] * p.c - lk[ii]; }
            } else if (MODE == 1) {
                const float dq = (float)(q - kv0 - 8 * hi);
#pragma unroll
                for (int ph = 0; ph < 2; ++ph)
#pragma unroll
                    for (int r = 0; r < 16; ++r) { const int kk = 32 * ph + 16 * (r >> 3) + 4 * ((r >> 2) & 1) + (r & 3); s[ph][r] = s[ph][r] * p.c - slope2 * (dq - (float)kk); }
            }
            bool needmask = (kv0 + 63 > qw0);
            if (MODE == 1) needmask = needmask || (kv0 < qw0 + 31 - 127);
            if (needmask) {
                const int dqi = q - kv0 - 8 * hi;
#pragma unroll
                for (int ph = 0; ph < 2; ++ph)
#pragma unroll
                    for (int r = 0; r < 16; ++r) { const int kk = 32 * ph + 16 * (r >> 3) + 4 * ((r >> 2) & 1) + (r & 3); const int dist = dqi - kk;
                        bool ok = dist >= 0; if (MODE == 1) ok = ok && (dist < 128); s[ph][r] = ok ? s[ph][r] : -INFINITY; }
            }
            float mx = fmaxf(fmaxf(s[0][0], s[0][1]), s[0][2]);
#pragma unroll
            for (int r = 3; r < 15; r += 2) mx = fmaxf(fmaxf(mx, s[0][r]), s[0][r + 1]);
            mx = fmaxf(mx, s[0][15]);
#pragma unroll
            for (int r = 0; r < 16; r += 2) mx = fmaxf(fmaxf(mx, s[1][r]), s[1][r + 1]);
            mx = fmaxf(mx, __shfl_xor(mx, 32));
            if (MODE == 0) mx *= p.c;
            const bool dead = (MODE == 2) && __all(mx < m_run - 40.f);
            if (!dead) {
                const float m_new = fmaxf(m_run, mx);
                const float alpha = __builtin_amdgcn_exp2f(m_run - m_new);
                m_run = m_new;
                float ls0 = 0.f, ls1 = 0.f;
#pragma unroll
                for (int ph = 0; ph < 2; ++ph)
#pragma unroll
                    for (int r = 0; r < 16; r += 2) {
                        const float e0 = __builtin_amdgcn_exp2f(MODE == 0 ? (s[ph][r] * p.c - m_new) : (s[ph][r] - m_new));
                        const float e1 = __builtin_amdgcn_exp2f(MODE == 0 ? (s[ph][r + 1] * p.c - m_new) : (s[ph][r + 1] - m_new));
                        s[ph][r] = e0; s[ph][r + 1] = e1; ls0 += e0; ls1 += e1; }
                if (__any(alpha != 1.f)) {
                    l_run *= alpha;
#pragma unroll
                    for (int r = 0; r < 16; ++r) { ot[0][r] *= alpha; ot[1][r] *= alpha; }
                }
                l_run += ls0 + ls1;
                bf16x8 pk[4];
#pragma unroll
                for (int cc = 0; cc < 4; ++cc) { const int ph = cc >> 1, o = 8 * (cc & 1); u32x4 w;
                    w.x = cvtpk(s[ph][o + 0], s[ph][o + 1]); w.y = cvtpk(s[ph][o + 2], s[ph][o + 3]); w.z = cvtpk(s[ph][o + 4], s[ph][o + 5]); w.w = cvtpk(s[ph][o + 6], s[ph][o + 7]);
                    pk[cc] = __builtin_bit_cast(bf16x8, w); }
                const LAS unsigned char* vb = sb + OFF_V + vrd;
                bf16x8 vf[2][4];
#pragma unroll
                for (int dh = 0; dh < 2; ++dh)
#pragma unroll
                    for (int cc = 0; cc < 4; ++cc) {
                        const v4i16_t v0 = __builtin_amdgcn_ds_read_tr16_b64_v4i16((LAS v4i16_t*)(vb + dh * VHALF + cc * 1024));
                        const v4i16_t v1 = __builtin_amdgcn_ds_read_tr16_b64_v4i16((LAS v4i16_t*)(vb + dh * VHALF + cc * 1024 + 256));
                        vf[dh][cc] = (bf16x8){v0[0], v0[1], v0[2], v0[3], v1[0], v1[1], v1[2], v1[3]}; }
                __builtin_amdgcn_sched_barrier(0);
#pragma unroll
                for (int cc = 0; cc < 4; ++cc) {
                    ot[0] = __builtin_amdgcn_mfma_f32_32x32x16_bf16(vf[0][cc], pk[cc], ot[0], 0, 0, 0);
                    ot[1] = __builtin_amdgcn_mfma_f32_32x32x16_bf16(vf[1][cc], pk[cc], ot[1], 0, 0, 0);
                }
                __builtin_amdgcn_sched_barrier(0);
            }
        }
        if (MODE == 2) {
            bool dn = true;
            if (t >= 1) { const float bnd = qn * __shfl(pmv, t - 1) - __shfl(lcev, t - 1); dn = __all(bnd < m_run - 40.f); }
            done_w = done_w || dn;
            if (lane == 0) *(LAS unsigned*)(lds + OFF_FLAG + (i & 1) * 32 + wid * 4) = done_w ? 1u : 0u;
        }
    }
    if (MODE == 0) { if (ntile > 4) {
        f32x16 SA[2], SB[2];
        float m_new, alpha;
        { const int y = ((ntile - 1 < 6) ? (ntile - 1) : 6) - 4;
          if (y >= 2) AT_WAITV(2 * NPT); else if (y == 1) AT_WAITV(NPT); else AT_WAITV(0); }
        __builtin_amdgcn_s_barrier(); asm volatile("" ::: "memory");
        { const LAS unsigned char* sb = lds + (4 & 3) * SLOT;
          bf16x8 kf[2][DK / 16];
#pragma unroll
          for (int ph = 0; ph < 2; ++ph) {
#pragma unroll
              for (int d0 = 0; d0 < 4; ++d0) kf[ph][d0] = *(const LAS bf16x8*)(sb + koff[d0] + ph * 4096);
              if (DK == 96) {
#pragma unroll
                  for (int j = 0; j < 2; ++j) kf[ph][(DK == 96) ? 4 + j : 0] = *(const LAS bf16x8*)(sb + poff[j] + ph * 2048);
              }
          }
#pragma unroll
          for (int r = 0; r < 16; ++r) { SA[0][r] = 0.f; SA[1][r] = 0.f; }
#pragma unroll
          for (int d0 = 0; d0 < DK / 16; ++d0) { SA[0] = __builtin_amdgcn_mfma_f32_32x32x16_bf16(kf[0][d0], qf[d0], SA[0], 0, 0, 0); SA[1] = __builtin_amdgcn_mfma_f32_32x32x16_bf16(kf[1][d0], qf[d0], SA[1], 0, 0, 0); }
          float mx = SA[0][0];
#pragma unroll
          for (int r = 1; r < 16; ++r) mx = fmaxf(mx, SA[0][r]);
#pragma unroll
          for (int r = 0; r < 16; ++r) mx = fmaxf(mx, SA[1][r]);
          mx = fmaxf(mx, __shfl_xor(mx, 32)) * p.c;
          m_new = fmaxf(m_run, mx); alpha = __builtin_amdgcn_exp2f(m_run - m_new); m_run = m_new; }
#define P_STEP(SC, SN, i_) do { const int i__ = (i_); const bool has_next = (i__ + 1 < ntile); \
        if (i__ + 2 < ntile) AT_WAITV(NPT); else AT_WAITV(0);                      \
        __builtin_amdgcn_s_barrier(); asm volatile("" ::: "memory"); \
        if (i__ + 3 < ntile) AT_DMA(t_hi - (i__ + 3), (i__ + 3) & 3); \
        const LAS unsigned char* sbc_ = lds + (i__ & 3) * SLOT; const LAS unsigned char* sbn_ = lds + ((i__ + 1) & 3) * SLOT; \
        float l0_ = 0.f, l1_ = 0.f; \
        if (has_next) { \
            bf16x8 kf_[2][DK / 16]; \
            _Pragma("unroll") for (int ph = 0; ph < 2; ++ph) { \
                _Pragma("unroll") for (int d0 = 0; d0 < 4; ++d0) kf_[ph][d0] = *(const LAS bf16x8*)(sbn_ + koff[d0] + ph * 4096); \
                if (DK == 96) { _Pragma("unroll") for (int j = 0; j < 2; ++j) kf_[ph][(DK == 96) ? 4 + j : 0] = *(const LAS bf16x8*)(sbn_ + poff[j] + ph * 2048); } } \
            _Pragma("unroll") for (int r = 0; r < 16; ++r) { SN[0][r] = 0.f; SN[1][r] = 0.f; } \
            PSB(); \
            PSeg1<DK, 0>::run(SC, SN, kf_, qf, p.c, m_new, l0_, l1_); \
        } else { p_exp_range<0, 32>(SC, p.c, m_new, l0_, l1_); } \
        if (__any(alpha != 1.f)) { l_run *= alpha; _Pragma("unroll") for (int r = 0; r < 16; ++r) { ot[0][r] *= alpha; ot[1][r] *= alpha; } } \
        l_run += l0_ + l1_; \
        { bf16x8 vf_[2][4], pk_[4]; const LAS unsigned char* vb_ = sbc_ + OFF_V + vrd; \
          _Pragma("unroll") for (int dh = 0; dh < 2; ++dh) _Pragma("unroll") for (int cc = 0; cc < 4; ++cc) { \
              const v4i16_t v0 = __builtin_amdgcn_ds_read_tr16_b64_v4i16((LAS v4i16_t*)(vb_ + dh * VHALF + cc * 1024)); \
              const v4i16_t v1 = __builtin_amdgcn_ds_read_tr16_b64_v4i16((LAS v4i16_t*)(vb_ + dh * VHALF + cc * 1024 + 256)); \
              vf_[dh][cc] = (bf16x8){v0[0], v0[1], v0[2], v0[3], v1[0], v1[1], v1[2], v1[3]}; } \
          { u32x4 w; w.x = cvtpk(SC[0][0], SC[0][1]); w.y = cvtpk(SC[0][2], SC[0][3]); w.z = cvtpk(SC[0][4], SC[0][5]); w.w = cvtpk(SC[0][6], SC[0][7]); pk_[0] = __builtin_bit_cast(bf16x8, w); } \
          float mx_ = -INFINITY; \
          PSB(); \
          PSeg2<0>::run(SC, SN, vf_, pk_, ot, mx_, has_next); \
          if (has_next) { mx_ = fmaxf(mx_, __shfl_xor(mx_, 32)) * p.c; m_new = fmaxf(m_run, mx_); alpha = __builtin_amdgcn_exp2f(m_run - m_new); m_run = m_new; } } \
    } while (0)
        for (int i = 4; i < ntile; i += 2) {
            P_STEP(SA, SB, i);
            if (i + 1 < ntile) P_STEP(SB, SA, i + 1);
        }
#undef P_STEP
    } }
    AT_WAITV(0);
    __builtin_amdgcn_s_barrier();
    asm volatile("" ::: "memory");
    const float lt = l_run + __shfl_xor(l_run, 32);
    const float inv = 1.f / lt;
#pragma unroll
    for (int dh = 0; dh < 2; ++dh)
#pragma unroll
        for (int j = 0; j < 4; ++j) {
            const int d = 32 * dh + 8 * j + 4 * hi;
            const u32x2 g = *(const u32x2*)(Gp + (size_t)q * p.ldg + d);
            const float g0 = bflo(g.x), g1 = bfhi(g.x), g2 = bflo(g.y), g3 = bfhi(g.y);
            const float o0 = ot[dh][4 * j + 0] * inv * (g0 / (1.f + __expf(-g0)));
            const float o1 = ot[dh][4 * j + 1] * inv * (g1 / (1.f + __expf(-g1)));
            const float o2 = ot[dh][4 * j + 2] * inv * (g2 / (1.f + __expf(-g2)));
            const float o3 = ot[dh][4 * j + 3] * inv * (g3 / (1.f + __expf(-g3)));
            u32x2 w; w.x = cvtpk(o0, o1); w.y = cvtpk(o2, o3);
            *(u32x2*)(Op + (size_t)q * p.ldo + d) = w;
        }
#undef AT_DMA
}

#define XB_TMO      128
#define XB_XCNT(j)  (256  + 64 * (j))
#define XB_XSUB(j)  (1280 + 64 * (j))
#define XB_XGEN(j)  (2304 + 64 * (j))
#define XB_TOP      3328
#define XB_TOPGEN   3392
#define XCD_BAR_WORDS 3456
#define XB_SPIN_CAP (1u << 18)

__device__ __forceinline__ unsigned xb_ld(unsigned* p)              { return __hip_atomic_load(p, __ATOMIC_RELAXED, __HIP_MEMORY_SCOPE_AGENT); }
__device__ __forceinline__ unsigned xb_add(unsigned* p, unsigned v) { return __hip_atomic_fetch_add(p, v, __ATOMIC_RELAXED, __HIP_MEMORY_SCOPE_AGENT); }
__device__ __forceinline__ unsigned xb_xcc_id() { return (unsigned)__builtin_amdgcn_s_getreg((3 << 11) | 20) & 0xFu; }
#define XB_SPIN(cond, bar) do { unsigned _sp = 0; while (cond) { __builtin_amdgcn_s_sleep(1); \
    if ((++_sp & 255u) == 0u) { if (xb_ld(&(bar)[XB_TMO])) break; if (_sp > XB_SPIN_CAP) { atomicAdd(&(bar)[XB_TMO], 1u); break; } } } } while (0)

struct XcdBarrier {
    unsigned* bar; unsigned x;
    volatile LAS unsigned* st;
};

__device__ __forceinline__ XcdBarrier xcd_barrier_post(unsigned* bar, volatile LAS unsigned* st) {
    XcdBarrier b; b.bar = bar; b.x = xb_xcc_id(); b.st = st;
    if (threadIdx.x == 0) (void)xb_add(&bar[XB_XCNT(b.x)], 1u);
    return b;
}
__device__ __forceinline__ void xcd_barrier_complete(unsigned* bar, unsigned x, unsigned& nloc, unsigned& nx) {
    const unsigned G = gridDim.x * gridDim.y * gridDim.z;
    unsigned sum, cnt, mine, sp = 0u;
    for (;;) {
        sum = 0u; cnt = 0u; mine = 0u;
#pragma unroll
        for (unsigned j = 0; j < 16; ++j) { const unsigned c = xb_ld(&bar[XB_XCNT(j)]); sum += c; cnt += (c > 0u) ? 1u : 0u; mine = (j == x) ? c : mine; }
        if (sum == G) break;
        __builtin_amdgcn_s_sleep(1);
        if ((++sp & 255u) == 0u) { if (xb_ld(&bar[XB_TMO])) break; if (sp > XB_SPIN_CAP) { atomicAdd(&bar[XB_TMO], 1u); break; } }
    }
    nloc = mine > 0u ? mine : 1u; nx = cnt > 0u ? cnt : 1u;
}

__device__ __forceinline__ void xcd_barrier(const XcdBarrier& b) {
    asm volatile("s_waitcnt vmcnt(0)" ::: "memory");
    __syncthreads();
    if (threadIdx.x == 0) {
        unsigned* bar = b.bar;
        __builtin_amdgcn_s_waitcnt(0);
        unsigned nloc = b.st[0], nx = b.st[1];
        if (nloc == 0u) { xcd_barrier_complete(bar, b.x, nloc, nx); b.st[0] = nloc; b.st[1] = nx; }
        const unsigned old = xb_add(&bar[XB_XSUB(b.x)], 1u);
        const unsigned gen = old / nloc;
        if (old + 1u == (gen + 1u) * nloc) {
            __builtin_amdgcn_fence(__ATOMIC_RELEASE, "agent");
            asm volatile("s_waitcnt vmcnt(0)" ::: "memory");
            const unsigned og = xb_add(&bar[XB_TOP], 1u);
            const unsigned tg = og / nx;
            if (og + 1u == (tg + 1u) * nx) xb_add(&bar[XB_TOPGEN], 1u);
            else XB_SPIN(xb_ld(&bar[XB_TOPGEN]) == tg, bar);
            __builtin_amdgcn_fence(__ATOMIC_ACQUIRE, "agent");
            xb_add(&bar[XB_XGEN(b.x)], 1u);
            asm volatile("s_waitcnt vmcnt(0)" ::: "memory");
        } else {
            XB_SPIN(xb_ld(&bar[XB_XGEN(b.x)]) == gen, bar);
            __builtin_amdgcn_fence(__ATOMIC_ACQUIRE, "agent");
            asm volatile("s_waitcnt vmcnt(0)" ::: "memory");
        }
    }
    __syncthreads();
}

struct Args { const float* in[15]; const int* pos; float* out; unsigned char* ws; int ph_lo, ph_hi; };

__device__ __forceinline__ void transpose_item(const float* W, int ldw, int col0, int k0, bf16* WT, int ldt, int row_off, LAS float* scr, int lane) {
#pragma unroll 8
    for (int i = 0; i < 32; ++i) { const int kk = 2 * i + (lane >> 5); scr[kk * 33 + (lane & 31)] = W[(size_t)(k0 + kk) * ldw + col0 + (lane & 31)]; }
    asm volatile("s_waitcnt lgkmcnt(0)" ::: "memory");
    const int c = lane & 7;
#pragma unroll
    for (int j = 0; j < 4; ++j) { const int n = (lane >> 3) + 8 * j; const LAS float* s = scr + (8 * c) * 33 + n;
        u32x4 o; o.x = cvtpk(s[0 * 33], s[1 * 33]); o.y = cvtpk(s[2 * 33], s[3 * 33]); o.z = cvtpk(s[4 * 33], s[5 * 33]); o.w = cvtpk(s[6 * 33], s[7 * 33]);
        *(u32x4*)(WT + (size_t)(row_off + n) * ldt + k0 + 8 * c) = o; }
    asm volatile("s_waitcnt lgkmcnt(0)" ::: "memory");
}

__device__ __forceinline__ void rms_row_to_bf16(const float* xrow, const float* g, bf16* orow, int lane) {
    const f32x4* xr = (const f32x4*)xrow + lane; const f32x4* gr = (const f32x4*)g + lane;
    f32x4 v[4]; float s = 0.f;
#pragma unroll
    for (int j = 0; j < 4; ++j) { v[j] = xr[64 * j]; s += (v[j].x * v[j].x + v[j].y * v[j].y) + (v[j].z * v[j].z + v[j].w * v[j].w); }
    const float rs = 1.f / sqrtf(wave_sum(s) * (1.f / DM) + EPS);
    u32x2* o8 = (u32x2*)orow + lane;
#pragma unroll
    for (int j = 0; j < 4; ++j) { const f32x4 gg = gr[64 * j]; u32x2 w; w.x = cvtpk(v[j].x * rs * gg.x, v[j].y * rs * gg.y); w.y = cvtpk(v[j].z * rs * gg.z, v[j].w * rs * gg.w); o8[64 * j] = w; }
}

template <bool COOP>
__global__ void __launch_bounds__(NTHREADS, 2) mk_fwd(Args args) {
    extern __shared__ __attribute__((aligned(16))) unsigned char lds_raw[];
    LAS unsigned char* lds = (LAS unsigned char*)lds_raw;
    const int tid = threadIdx.x, lane = tid & 63, wave = __builtin_amdgcn_readfirstlane(tid >> 6);
    const int G = gridDim.x, bx = blockIdx.x;
    const int vcu = (G % 8 == 0) ? (bx % 8) * (G / 8) + bx / 8 : bx;
    const int gw = vcu * NWAVES + wave, NGW = G * NWAVES;
    unsigned char* ws = args.ws;
    const float* x = args.in[0];
    bf16* Wt0 = (bf16*)(ws + WS_WT0); bf16* Wqup = (bf16*)(ws + WS_WQUP); bf16* Wkvup = (bf16*)(ws + WS_WKVUP); bf16* Wout0 = (bf16*)(ws + WS_WOUT0);
    bf16* Wt1 = (bf16*)(ws + WS_WT1); bf16* Wout1 = (bf16*)(ws + WS_WOUT1);
    bf16* XN = (bf16*)(ws + WS_XN); bf16* OG = (bf16*)(ws + WS_OG); float* LF = (float*)(ws + WS_LF); float* LC = (float*)(ws + WS_LC); float* CS = (float*)(ws + WS_CS); float* TMAXB = (float*)(ws + WS_TMAX);
    bf16* Z0 = (bf16*)(ws + WS_Z0); bf16* Z1 = (bf16*)(ws + WS_Z1); bf16* CQN = (bf16*)(ws + WS_CQN); bf16* CKVN = (bf16*)(ws + WS_CKVN); bf16* KPE = (bf16*)(ws + WS_KPE);
    bf16* D0 = (bf16*)(ws + WS_D0); bf16* Q0 = (bf16*)(ws + WS_Q0); bf16* KN = (bf16*)(ws + WS_KN); bf16* VM = (bf16*)(ws + WS_VM);
    float* out = args.out;
    const int lo = args.ph_lo, hi_ph = args.ph_hi;
#ifndef REPMASK
#define REPMASK 0
#endif
#define NREP(k) (1 + (((REPMASK) >> (k)) & 1))
#ifndef PHMASK
#define PHMASK 0xfff
#endif
#define IN(k) ((((PHMASK) >> (k)) & 1) && lo <= (k) && (k) < hi_ph)
#define SEAM(k) do { if constexpr (COOP) { if (IN(k) && IN((k) + 1)) { if ((k) == 0) { cg::this_grid().sync(); xbar = xcd_barrier_post(barw, (volatile LAS unsigned*)(lds + LDS_MISC)); } else { xcd_barrier(xbar); } } } } while (0)
    unsigned* qctr = (unsigned*)(ws + 256 * 1024);
    unsigned* barw = (unsigned*)ws;
    XcdBarrier xbar; xbar.bar = barw; xbar.x = 0; xbar.st = (volatile LAS unsigned*)(lds + LDS_MISC);
    if constexpr (COOP) {
        if (tid < 16) ((LAS unsigned*)(lds + LDS_MISC))[tid] = 0u;
        if (bx == 0) { for (int i = tid; i < XCD_BAR_WORDS; i += NTHREADS) barw[i] = 0u; for (int i = tid; i < 16 * 64; i += NTHREADS) qctr[i] = 0u; for (int i = tid; i < 2 * 64 * 64; i += NTHREADS) ((unsigned*)(ws + 64 * 1024))[i] = 0u; }
        __syncthreads();
    }

    if (IN(0)) {
        LAS float* scr = (LAS float*)(lds + wave * 16384);
        constexpr int I_A = 16 * 69, I_B = 4 * 24, I_C = 2 * 32, I_D = 16 * 32, I_E1 = 16 * 96, I_E2 = 16 * 32, I_F = 16 * 32;
        constexpr int NIT = I_A + I_B + I_C + I_D + I_E1 + I_E2 + I_F;
        for (int it = gw; it < NIT; it += NGW) {
            int r = it;
            if (r < I_A) { const int kb = r / 69, nb = r % 69; transpose_item(args.in[3], N0, 32 * nb, 64 * kb, Wt0, 1024, 32 * nb, scr, lane); continue; } r -= I_A;
            if (r < I_B) { const int kb = r / 24, nb = r % 24; transpose_item(args.in[5], 768, 32 * nb, 64 * kb, Wqup, 256, 32 * nb, scr, lane); continue; } r -= I_B;
            if (r < I_C) { const int kb = r / 32, nb = r % 32; const int n0 = 32 * nb, h = n0 >> 7, j0 = n0 & 127; const int dst = (j0 < 64) ? (h * 64 + j0) : (512 + h * 64 + (j0 - 64));
                           transpose_item(args.in[7], 1024, n0, 64 * kb, Wkvup, 256, dst, scr, lane); continue; } r -= I_C;
            if (r < I_D) { const int kb = r / 32, nb = r % 32; transpose_item(args.in[9], 1024, 32 * nb, 64 * kb, Wout0, 1024, 32 * nb, scr, lane); continue; } r -= I_D;
            if (r < I_E1) { const int kb = r / 96, nb = r % 96; transpose_item(args.in[11], N1W, 32 * nb, 64 * kb, Wt1, 1024, 32 * nb, scr, lane); continue; } r -= I_E1;
            if (r < I_E2) { const int kb = r / 32, nb = r % 32; transpose_item(args.in[11], N1W, W1_G + 32 * nb, 64 * kb, Wt1, 1024, C1_G + 32 * nb, scr, lane); continue; } r -= I_E2;
            { const int kb = r / 32, nb = r % 32; transpose_item(args.in[13], 1024, 32 * nb, 64 * kb, Wout1, 1024, 32 * nb, scr, lane); }
        }
        { const u32x4 z = {0u, 0u, 0u, 0u};
          u32x4* p0 = (u32x4*)(Wt0 + (size_t)N0 * 1024);
          for (int i = vcu * NTHREADS + tid; i < 96 * 1024 / 8; i += G * NTHREADS) p0[i] = z;
          for (int i = vcu * NTHREADS + tid; i < 1024 * 16; i += G * NTHREADS) { const int row = i >> 4, c = i & 15; *(u32x4*)(Wkvup + (size_t)row * 256 + 128 + c * 8) = z; } }
        for (int m = gw; m < M; m += NGW) rms_row_to_bf16(x + (size_t)m * DM, args.in[2], XN + (size_t)m * DM, lane);
    }
    SEAM(0);
    if (IN(1)) {
        __syncthreads();
        pg8::Gemm g{XN, Wt0, M, N0P, 1024}; pg8::StaticOrder S; S.init(M, N0P, G, bx);
        pg8::EpiBf16<0> E{Z0, N0P, nullptr, 0, 0, 1.f};
        for (int rep = 0; rep < NREP(1); ++rep) {
        pg8::gemm_phase<pg8::EpiBf16<0>, pg8::StaticOrder, true, true>(lds, g, S, E); __syncthreads(); }
    }
    SEAM(1);
    if (IN(2)) {
        const float* gq = args.in[4]; const float* gkv = args.in[6];
        for (int m = gw; m < M; m += NGW) {
            const bf16* z = Z0 + (size_t)m * N0P;
            const u32x2 a = *(const u32x2*)(z + C_CQ + 4 * lane);
            const unsigned bb = *(const unsigned*)(z + C_CKV + 2 * lane);
            const float a0 = bflo(a.x), a1 = bfhi(a.x), a2 = bflo(a.y), a3 = bfhi(a.y), b0 = bflo(bb), b1 = bfhi(bb);
            const float sa = wave_sum((a0 * a0 + a1 * a1) + (a2 * a2 + a3 * a3)), sb = wave_sum(b0 * b0 + b1 * b1);
            const float ra = 1.f / sqrtf(sa * (1.f / 256.f) + EPS), rb = 1.f / sqrtf(sb * (1.f / 128.f) + EPS);
            const f32x4 ga = *(const f32x4*)(gq + 4 * lane); const f32x2 gb = *(const f32x2*)(gkv + 2 * lane);
            u32x2 w; w.x = cvtpk(a0 * ra * ga.x, a1 * ra * ga.y); w.y = cvtpk(a2 * ra * ga.z, a3 * ra * ga.w);
            *(u32x2*)(CQN + (size_t)m * 256 + 4 * lane) = w;
            *(unsigned*)(CKVN + (size_t)m * 256 + 2 * lane) = cvtpk(b0 * rb * gb.x, b1 * rb * gb.y);
            *(unsigned*)(CKVN + (size_t)m * 256 + 128 + 2 * lane) = 0u;
            if (lane < 16) {
                const float invf = (float)exp2(-(double)lane * 0.8304820237218406);
                const double ang = (double)(float)args.pos[m] * (double)invf;
                const double rev = ang * 0.15915494309189535;
                const float rr = (float)(rev - rint(rev));
                const float cv = __builtin_amdgcn_cosf(rr), sv = __builtin_amdgcn_sinf(rr);
                CS[(size_t)m * 32 + lane] = cv; CS[(size_t)m * 32 + 16 + lane] = sv;
                const float x1 = bf1(z[C_KPE + lane]), x2 = bf1(z[C_KPE + 16 + lane]);
                const unsigned o1 = cvtpk(x1 * cv - x2 * sv, 0.f), o2 = cvtpk(x2 * cv + x1 * sv, 0.f);
                KPE[(size_t)m * 32 + lane] = (bf16)(o1 & 0xffffu); KPE[(size_t)m * 32 + 16 + lane] = (bf16)(o2 & 0xffffu);
            }
        }
    }
    SEAM(2);
    if (IN(3)) {
        __syncthreads();
#ifndef NO_QUP
        { int kq_ = 256; asm volatile("" : "+s"(kq_)); pg8::Gemm g{CQN, Wqup, M, 768, kq_}; pg8::StaticOrder S; S.init(M, 768, G, bx);
          pg8::EpiQRope E{Q0, 768, CS};
          pg8::gemm_phase<pg8::EpiQRope, pg8::StaticOrder, true, true>(lds, g, S, E); }
#endif
        __syncthreads();
#ifndef NO_KVUP
        { int kk_ = 256; asm volatile("" : "+s"(kk_)); pg8::Gemm g{CKVN, Wkvup, M, 1024, kk_}; pg8::StaticOrder S; S.init(M, 1024, G, bx);
          pg8::EpiBf16<0> E{KN, 512, nullptr, 512, (size_t)(WS_VM - WS_KN) / 2, 1.f, 3u, 8};
          pg8::gemm_phase<pg8::EpiBf16<0>, pg8::StaticOrder, true, true>(lds, g, S, E); }
#endif
    }
    SEAM(3);
    if (IN(4)) {
        __syncthreads();
        for (;;) {
            if (tid == 0) *(volatile LAS int*)(lds + LDS_MISC + 64) = (int)atomicAdd(qctr + 64 * (bx & 7), 1u);
            __syncthreads();
            const int tk = *(volatile LAS int*)(lds + LDS_MISC + 64);
            __syncthreads();
            if (tk >= 128) break;
            const bool swa = tk >= 64;
            AttnP p; p.sinkp = args.in[8]; p.h0 = 0;
            if (!swa) {
                const int bh = 8 * (bx & 7) + (tk >> 3), s = tk & 7, b = bh >> 3, h = bh & 7; const size_t rb = (size_t)b * SEQ;
                p.Q = Q0 + rb * 768 + h * 96; p.ldq = 768; p.K = KN + (size_t)bh * SEQ * 64; p.ldk = 64; p.K2 = KPE + rb * 32; p.ldk2 = 32; p.V = VM + (size_t)bh * SEQ * 64; p.ldv = 64;
                p.G = Z0 + rb * N0P + C_G0 + h * 64; p.ldg = N0P; p.O = OG + rb * 1024 + h * 64; p.ldo = 1024; p.lc = nullptr; p.tmax = nullptr; p.c = 0.10206207261596575f * LOG2E; p.sink2 = 0.f; p.slope2 = 0.f;
                attn_unit<96, 0>(p, (15 - s) * 256, lds); attn_unit<96, 0>(p, s * 256, lds);
            } else {
                const int j = tk - 64, pkv = 2 * (bx & 7) + (j >> 5), b = pkv >> 1, kvh = pkv & 1, qb = 2 * (j & 31); const size_t rb = (size_t)b * SEQ;
                p.Q = Z0 + rb * N0P + C_QS + kvh * 256; p.ldq = N0P; p.K = Z0 + rb * N0P + C_KS + kvh * 64; p.ldk = N0P; p.K2 = nullptr; p.ldk2 = 0; p.V = Z0 + rb * N0P + C_VS + kvh * 64; p.ldv = N0P;
                p.G = Z0 + rb * N0P + C_G0 + 512 + kvh * 256; p.ldg = N0P; p.O = OG + rb * 1024 + 512 + kvh * 256; p.ldo = 1024; p.lc = nullptr; p.tmax = nullptr; p.c = 0.125f * LOG2E;
                p.sink2 = 0.f; p.slope2 = 0.f; p.h0 = 4 * kvh;
                attn_unit<64, 1>(p, qb * 64, lds); attn_unit<64, 1>(p, (qb + 1) * 64, lds);
            }
        }
    }
    SEAM(4);
    if (IN(5)) {
        __syncthreads();
        pg8::Gemm g{OG, Wout0, M, 1024, 1024}; pg8::StaticOrder S; S.init(M, 1024, G, bx);
        pg8::EpiBf16<0> E{D0, 1024, nullptr, 0, 0, 1.f};
        pg8::gemm_phase<pg8::EpiBf16<0>, pg8::StaticOrder, true, true>(lds, g, S, E);
    }
    SEAM(5);
    if (IN(6)) {
        __syncthreads();
        const float* g1 = args.in[10]; const float* w1 = args.in[11]; const float* bfp = args.in[12];
        LAS float* WF = (LAS float*)lds;
        for (int k = tid; k < 1024; k += NTHREADS) {
            const int l = (k & 255) >> 2, j = k >> 8, e = k & 3; const int R = l + 64 * (4 * j + e); const float gk = g1[k];
#pragma unroll
            for (int c = 0; c < 4; ++c) { const f32x4 wv = *(const f32x4*)(w1 + (size_t)k * N1W + W1_F + 4 * c); *(LAS f32x4*)(WF + R * 20 + 4 * c) = wv * gk; }
        }
        __syncthreads();
        for (int m = gw; m < M; m += NGW) {
            const f32x4* xr = (const f32x4*)(x + (size_t)m * DM) + lane; const f32x4* gr = (const f32x4*)g1 + lane; const u32x2* dr = (const u32x2*)(D0 + (size_t)m * DM) + lane;
            f32x4 v[4]; float ss = 0.f;
#pragma unroll
            for (int j = 0; j < 4; ++j) { const u32x2 dd = dr[64 * j]; v[j] = xr[64 * j]; v[j].x += bflo(dd.x); v[j].y += bfhi(dd.x); v[j].z += bflo(dd.y); v[j].w += bfhi(dd.y); ss += (v[j].x * v[j].x + v[j].y * v[j].y) + (v[j].z * v[j].z + v[j].w * v[j].w); }
            const float rs = 1.f / sqrtf(wave_sum(ss) * (1.f / DM) + EPS);
            u32x2* o8 = (u32x2*)(XN + (size_t)m * DM) + lane;
            float fa[16];
#pragma unroll
            for (int n = 0; n < 16; ++n) fa[n] = 0.f;
#pragma unroll
            for (int j = 0; j < 4; ++j) { const f32x4 gg = gr[64 * j]; u32x2 w; w.x = cvtpk(v[j].x * rs * gg.x, v[j].y * rs * gg.y); w.y = cvtpk(v[j].z * rs * gg.z, v[j].w * rs * gg.w); o8[64 * j] = w;
#pragma unroll
                for (int e = 0; e < 4; ++e) { const float xv = v[j][e]; const LAS float* wr_ = WF + (lane + 64 * (4 * j + e)) * 20;
#pragma unroll
                    for (int c = 0; c < 4; ++c) { const f32x4 wv = *(const LAS f32x4*)(wr_ + 4 * c); fa[4 * c + 0] += xv * wv.x; fa[4 * c + 1] += xv * wv.y; fa[4 * c + 2] += xv * wv.z; fa[4 * c + 3] += xv * wv.w; }
                    asm volatile("" ::: "memory"); } }
            const bool b5 = (lane & 32) != 0, b4 = (lane & 16) != 0, b3 = (lane & 8) != 0, b2 = (lane & 4) != 0;
            float r8[8], r4[4], r2[2];
#pragma unroll
            for (int i = 0; i < 8; ++i) { const float snd = b5 ? fa[i] : fa[8 + i]; r8[i] = (b5 ? fa[8 + i] : fa[i]) + __shfl_xor(snd, 32); }
#pragma unroll
            for (int i = 0; i < 4; ++i) { const float snd = b4 ? r8[i] : r8[4 + i]; r4[i] = (b4 ? r8[4 + i] : r8[i]) + __shfl_xor(snd, 16); }
#pragma unroll
            for (int i = 0; i < 2; ++i) { const float snd = b3 ? r4[i] : r4[2 + i]; r2[i] = (b3 ? r4[2 + i] : r4[i]) + __shfl_xor(snd, 8); }
            float mine = (b2 ? r2[1] : r2[0]) + __shfl_xor(b2 ? r2[0] : r2[1], 4);
            mine += __shfl_xor(mine, 1); mine += __shfl_xor(mine, 2);
            if ((lane & 3) == 0) { const int n = (lane >> 2) & 15; const float f = mine * rs + bfp[n]; const float lsg = fminf(f, 0.f) - log1pf(expf(-fabsf(f))); LF[(size_t)m * 16 + n] = lsg; }
        }
    }
    SEAM(6);
    if (IN(7)) {
        __syncthreads();
        LAS float* sm = (LAS float*)lds;
        for (int bh = bx; bh < 128; bh += G) {
            const int b = bh >> 4, h = bh & 15; float v[8]; float run = 0.f;
#pragma unroll
            for (int e = 0; e < 8; ++e) { run += LF[((size_t)b * SEQ + 8 * tid + e) * 16 + h]; v[e] = run; }
            float sc = run;
#pragma unroll
            for (int o = 1; o < 64; o <<= 1) { const float n = __shfl_up(sc, o); if (lane >= o) sc += n; }
            if (lane == 63) sm[wave] = sc;
            __syncthreads();
            float off = sc - run;
            for (int w = 0; w < wave; ++w) off += sm[w];
            f32x4 o0 = {(v[0] + off) * LOG2E, (v[1] + off) * LOG2E, (v[2] + off) * LOG2E, (v[3] + off) * LOG2E}, o1 = {(v[4] + off) * LOG2E, (v[5] + off) * LOG2E, (v[6] + off) * LOG2E, (v[7] + off) * LOG2E};
            *(f32x4*)(LC + (size_t)bh * SEQ + 8 * tid) = o0; *(f32x4*)(LC + (size_t)bh * SEQ + 8 * tid + 4) = o1;
            __syncthreads();
        }
        pg8::Gemm g{XN, Wt1, M, N1, 1024}; pg8::StaticOrder S; S.init(M, N1, G, bx);
        pg8::EpiBf16<0> E{Z1, 1024, nullptr, 1024, (size_t)M * 1024, 1.f, 6u, 16};
        pg8::gemm_phase<pg8::EpiBf16<0>, pg8::StaticOrder, true, true>(lds, g, S, E);
        __syncthreads();
        { pg8::Unit u; LAS float* smx = (LAS float*)lds;
          for (int i = 0; S.next(i, u); ++i) {
            if (u.pn < 4 || u.pn >= 8) continue;
            const int b = u.pm >> 4, T0 = 4 * (u.pm & 15), h0 = 4 * (u.pn - 4);
            for (int st = 0; st < 4; ++st) {
                const bf16* kbase = Z1 + (size_t)M * 1024 + ((((size_t)(b * 16 + h0 + ((tid & 31) >> 3))) * SEQ + (size_t)(u.pm & 15) * 256 + 64 * st + (tid >> 5)) << 6) + (tid & 7) * 8;
                float mxn = 0.f;
#pragma unroll
                for (int j = 0; j < 4; ++j) {
                    const u32x4 v = *(const u32x4*)(kbase + (size_t)(16 * j) * 64);
                    float s = 0.f;
#pragma unroll
                    for (int e = 0; e < 4; ++e) { const float a = bflo(v[e]), c = bfhi(v[e]); s += a * a + c * c; }
                    s += __shfl_xor(s, 1); s += __shfl_xor(s, 2); s += __shfl_xor(s, 4);
                    mxn = fmaxf(mxn, s);
                }
                if ((tid & 7) == 0) smx[(tid >> 5) * 4 + ((tid & 31) >> 3)] = mxn;
                __syncthreads();
                if (tid < 4) { float m16 = 0.f;
#pragma unroll
                    for (int r = 0; r < 16; ++r) m16 = fmaxf(m16, smx[r * 4 + tid]);
                    TMAXB[((size_t)(b * 16 + h0 + tid)) * 64 + T0 + st] = sqrtf(m16); }
                __syncthreads();
            }
          } }
    }
    SEAM(7);
    if (IN(9)) {
        __syncthreads();
        for (;;) {
            if (tid == 0) *(volatile LAS int*)(lds + LDS_MISC + 64) = (int)atomicAdd(qctr + 64 * (8 + (bx & 7)), 1u);
            __syncthreads();
            const int tk = *(volatile LAS int*)(lds + LDS_MISC + 64);
            __syncthreads();
            if (tk >= 128) break;
            const int bh = 16 * (bx & 7) + (tk >> 3), s = tk & 7, b = bh >> 4, h = bh & 15; const size_t rb = (size_t)b * SEQ;
            AttnP p;
            p.Q = Z1 + rb * 1024 + h * 64; p.ldq = 1024; p.K = Z1 + (size_t)M * 1024 + (size_t)bh * SEQ * 64; p.ldk = 64; p.K2 = nullptr; p.ldk2 = 0; p.V = Z1 + (size_t)2 * M * 1024 + (size_t)bh * SEQ * 64; p.ldv = 64;
            p.G = Z1 + (size_t)3 * M * 1024 + rb * 1024 + h * 64; p.ldg = 1024; p.O = OG + rb * 1024 + h * 64; p.ldo = 1024; p.lc = LC + (size_t)bh * SEQ; p.tmax = TMAXB + (size_t)bh * 64; p.sinkp = args.in[8]; p.h0 = 0; p.c = 0.125f * LOG2E; p.sink2 = 0.f; p.slope2 = 0.f;
            attn_unit<64, 2>(p, (15 - s) * 256, lds); attn_unit<64, 2>(p, s * 256, lds);
        }
    }
    SEAM(9);
    if (IN(10)) {
        __syncthreads();
        for (int sub = 0; sub < 2; ++sub) {
            const size_t r0 = (size_t)sub * 16384;
            pg8::Gemm g{OG + r0 * 1024, Wout1, 16384, 1024, 1024}; pg8::StaticOrder S; S.init(16384, 1024, G, bx);
            pg8::PanelRms st{(float*)(ws + WS_LF) + (size_t)sub * 16384 * 4, (unsigned*)(ws + 64 * 1024) + sub * 64 * 64, EPS};
            pg8::EpiRmsOut E{x + r0 * 1024, D0 + r0 * 1024, out + r0 * 1024, args.in[14], 1024, st};
            pg8::gemm_phase<pg8::EpiRmsOut, pg8::StaticOrder, false, true>(lds, g, S, E);
            __syncthreads();
        }
    }
#undef IN
#undef SEAM
}

constexpr int NPHASES = 11;
extern "C" void kernel_launch(void* const* d_in, const int* in_sizes, int n_in, void* d_out, int out_size, void* d_ws, size_t ws_size, hipStream_t stream) {
    static int grid = 0;
    if (grid == 0) {
        if (n_in != 15 || out_size != M * DM || ws_size < WS_END) { fprintf(stderr, "kernel_launch: unexpected shapes (n_in %d, out %d, ws %zu)\n", n_in, out_size, ws_size); grid = -1; return; }
        int dev = 0, cus = 0, per_cu = 0;
        (void)hipGetDevice(&dev); (void)hipDeviceGetAttribute(&cus, hipDeviceAttributeMultiprocessorCount, dev);
#if MK_COOP
        (void)hipFuncSetAttribute((const void*)mk_fwd<true>, hipFuncAttributeMaxDynamicSharedMemorySize, LDS_BYTES);
        (void)hipOccupancyMaxActiveBlocksPerMultiprocessor(&per_cu, (const void*)mk_fwd<true>, NTHREADS, LDS_BYTES);
#else
        (void)hipFuncSetAttribute((const void*)mk_fwd<false>, hipFuncAttributeMaxDynamicSharedMemorySize, LDS_BYTES);
        (void)hipOccupancyMaxActiveBlocksPerMultiprocessor(&per_cu, (const void*)mk_fwd<false>, NTHREADS, LDS_BYTES);
#endif
        (void)hipGetLastError();
        if (per_cu < 1) per_cu = 1;
        if (cus <= 0) cus = 256;
        grid = cus * 1;
    }
    if (grid < 0) return;
    Args a{};
    for (int i = 0; i < 15; ++i) a.in[i] = (const float*)d_in[i];
    a.pos = (const int*)d_in[1]; a.out = (float*)d_out; a.ws = (unsigned char*)d_ws;
#if MK_COOP
    a.ph_lo = 0; a.ph_hi = NPHASES;
    void* kargs[] = {&a};
    hipError_t e = hipLaunchCooperativeKernel((const void*)mk_fwd<true>, dim3(grid), dim3(NTHREADS), kargs, LDS_BYTES, stream);
    if (e != hipSuccess) fprintf(stderr, "cooperative launch failed: %s (grid %d)\n", hipGetErrorString(e), grid);
#else
    for (int ph = 0; ph < NPHASES; ++ph) { a.ph_lo = ph; a.ph_hi = ph + 1; hipLaunchKernelGGL(mk_fwd<false>, dim3(grid), dim3(NTHREADS), LDS_BYTES, stream, a); }
#endif
}
```

```cpp
#include <hip/hip_runtime.h>
#include <hip/hip_cooperative_groups.h>
#include <cstdio>
#include <cstdint>
#include <cmath>
namespace cg = cooperative_groups;
#ifndef MK_COOP
#define MK_COOP 1
#endif
namespace pg8 {
#define PG8_LAS __attribute__((address_space(3)))
typedef unsigned short bf16_t;
typedef short bf16x8 __attribute__((ext_vector_type(8)));
typedef float f32x4 __attribute__((ext_vector_type(4)));
typedef unsigned u32x4 __attribute__((ext_vector_type(4)));
constexpr int BM = 256, BK = 64, HALF = 128, HTB = HALF * BK * 2  , STAGE_BYTES = 8 * HTB, NXCD = 8, WGM = 8;

__host__ __device__ __forceinline__ int lds_byte(int r, int c) { const int st = (r >> 4) * 2 + (c >> 5), rr = r & 15, cc = c & 31, ob = rr * 64 + cc * 2; return st * 1024 + (ob ^ (((ob >> 9) & 1) << 5)); }
__host__ __device__ __forceinline__ void stage_rc(int b, int& R, int& C) { const int st = b / 1024, sb = b % 1024, swz = sb ^ (((sb >> 9) & 1) << 5); R = (st >> 1) * 16 + swz / 64; C = (st & 1) * 32 + (swz % 64) / 2; }
__host__ __device__ __forceinline__ int perm32(int rho) { const int n = rho >> 4, i = rho & 15; return 8 * (i >> 2) + 4 * n + (i & 3); }

struct Unit { int pm, pn; };
struct Gemm { const bf16_t* A; const bf16_t* Bt; int M, N, K; };

struct StaticOrder {
    int nM, nN, nwg, G, c;
    __host__ __device__ __forceinline__ void init(int M, int N, int G_, int c_) { nM = M / BM; nN = N / BM; nwg = nM * nN; G = G_; c = c_; }
    __host__ __device__ __forceinline__ bool next(int i, Unit& u) const {
        const long L = (long)i * G + c; if (L >= nwg) return false;
        int wgid = (int)L; { const int q = nwg / NXCD, r = nwg % NXCD, xcd = wgid % NXCD, off = wgid / NXCD; wgid = (xcd < r ? xcd * (q + 1) : r * (q + 1) + (xcd - r) * q) + off; }
        const int nig = WGM * nN, gid = wgid / nig, fm = gid * WGM, gsz = (nM - fm) < WGM ? (nM - fm) : WGM;
        u.pm = fm + ((wgid % nig) % gsz); u.pn = (wgid % nig) / gsz; return true;
    }
    __device__ __forceinline__ void a_ready(const Unit&) const {}
    __device__ __forceinline__ void done(const Unit&) const {}
};

__device__ __forceinline__ unsigned cvt_pk_bf16(float lo, float hi) { unsigned r; asm volatile("v_cvt_pk_bf16_f32 %0, %1, %2" : "=v"(r) : "v"(lo), "v"(hi)); return r; }
typedef float f32x2 __attribute__((ext_vector_type(2)));
__device__ __forceinline__ f32x2 gelu_pk(f32x2 v) {
    const f32x2 av = __builtin_elementwise_abs(v), d = av * 0.2316418882f + 1.0f;
    f32x2 t; t.x = __builtin_amdgcn_rcpf(d.x); t.y = __builtin_amdgcn_rcpf(d.y);
    f32x2 q = t * 0.5307027145f + (-0.7265760135f); q = q * t + 0.7107068705f; q = q * t + (-0.142248368f); q = q * t + 0.127414796f; q = q * t;
    const f32x2 s = (v * v) * (-0.72134752044f);
    f32x2 e; e.x = __builtin_amdgcn_exp2f(s.x); e.y = __builtin_amdgcn_exp2f(s.y);
    const f32x2 m = v * (q * e), r = v - m;
    f32x2 o; o.x = v.x < 0.f ? m.x : r.x; o.y = v.y < 0.f ? m.y : r.y; return o;
}

template <int ACT  > struct EpiBf16 {
    static constexpr bool PERM = true, AFTER_DRAIN = false; static_assert(ACT == 0 || ACT == 1, "EpiBf16: ACT is 0 (none) or 1 (gelu_pk)");
    bf16_t* O; int ldc; const float* bias; int split_cols; size_t split_stride; float scale0; unsigned hm_mask; int hm_heads;
    __device__ __forceinline__ void operator()(const f32x4 (&acc)[2][2][4][2], const Unit& u, int wr, int wc, int fr, int fq) const {
        const int row0 = u.pm * BM + wr * 64 + fr; int colt = u.pn * BM; bf16_t* base = O;
        float sc = 1.f; bool hm = false; if (split_cols) { const int t = colt / split_cols; base += (size_t)t * split_stride; colt -= t * split_cols; if (t == 0) sc = scale0; hm = ((hm_mask >> t) & 1u) != 0u; }
        const int col0 = colt + wc * 32 + 8 * fq, bcol0 = u.pn * BM + wc * 32 + 8 * fq;
        f32x4 bv[2][2];
#pragma unroll
        for (int bj = 0; bj < 2; ++bj)
#pragma unroll
            for (int n = 0; n < 2; ++n) bv[bj][n] = bias ? *(const f32x4*)(bias + bcol0 + bj * HALF + 4 * n) : (f32x4){0.f, 0.f, 0.f, 0.f};
#pragma unroll
        for (int ai = 0; ai < 2; ++ai)
#pragma unroll
            for (int m = 0; m < 4; ++m) { const int rowi = row0 + ai * HALF + m * 16; bf16_t* rowp = base + (size_t)rowi * ldc + col0;
#pragma unroll
                for (int bj = 0; bj < 2; ++bj) { f32x4 v0 = acc[ai][bj][m][0] + bv[bj][0], v1 = acc[ai][bj][m][1] + bv[bj][1];
                    if (ACT == 1) { f32x2 a = gelu_pk((f32x2){v0[0], v0[1]}), b = gelu_pk((f32x2){v0[2], v0[3]}), c = gelu_pk((f32x2){v1[0], v1[1]}), d = gelu_pk((f32x2){v1[2], v1[3]});
                        v0 = (f32x4){a.x, a.y, b.x, b.y}; v1 = (f32x4){c.x, c.y, d.x, d.y}; }
                    v0 = v0 * sc; v1 = v1 * sc; u32x4 w; w.x = cvt_pk_bf16(v0[0], v0[1]); w.y = cvt_pk_bf16(v0[2], v0[3]); w.z = cvt_pk_bf16(v1[0], v1[1]); w.w = cvt_pk_bf16(v1[2], v1[3]);
                    bf16_t* dst = rowp + bj * HALF;
                    if (hm) { const int col = col0 + bj * HALF; dst = base + ((((size_t)(rowi >> 12) * hm_heads + (col >> 6)) << 18) + ((size_t)(rowi & 4095) << 6) + (col & 63)); }
                    *(u32x4*)dst = w; } }
    }
};
typedef unsigned u32x2 __attribute__((ext_vector_type(2)));
struct EpiQRope {
    static constexpr bool PERM = false, AFTER_DRAIN = false;
    bf16_t* O; int ldc; const float* cs;
    __device__ __forceinline__ void operator()(const f32x4 (&acc)[2][2][4][2], const Unit& u, int wr, int wc, int fr, int fq) const {
        const int row0 = u.pm * BM + wr * 64 + fr;
#pragma unroll
        for (int ai = 0; ai < 2; ++ai)
#pragma unroll
            for (int m = 0; m < 4; ++m) {
                const int row = row0 + ai * HALF + m * 16;
                const f32x4 cv = *(const f32x4*)(cs + (size_t)row * 32 + 4 * fq), sv = *(const f32x4*)(cs + (size_t)row * 32 + 16 + 4 * fq);
#pragma unroll
                for (int bj = 0; bj < 2; ++bj) {
                    const int colb = u.pn * BM + bj * HALF + wc * 32;
                    f32x4 v0 = acc[ai][bj][m][0], v1 = acc[ai][bj][m][1];
                    if (((colb >> 5) % 3) == 2) { const f32x4 a = v0 * cv - v1 * sv, b = v1 * cv + v0 * sv; v0 = a; v1 = b; }
                    bf16_t* rp = O + (size_t)row * ldc + colb + 4 * fq;
                    u32x2 w0, w1; w0.x = cvt_pk_bf16(v0[0], v0[1]); w0.y = cvt_pk_bf16(v0[2], v0[3]); w1.x = cvt_pk_bf16(v1[0], v1[1]); w1.y = cvt_pk_bf16(v1[2], v1[3]);
                    *(u32x2*)(rp) = w0; *(u32x2*)(rp + 16) = w1;
                }
                asm volatile("" ::: "memory");
            }
    }
};
struct EpiResF32 {
    static constexpr bool PERM = false, AFTER_DRAIN = false;
    const float* base; float* out; int ldc;
    __device__ __forceinline__ void operator()(const f32x4 (&acc)[2][2][4][2], const Unit& u, int wr, int wc, int fr, int fq) const {
        const int row0 = u.pm * BM + wr * 64 + fr, col0 = u.pn * BM + wc * 32 + 4 * fq;
#pragma unroll
        for (int ai = 0; ai < 2; ++ai)
#pragma unroll
            for (int m = 0; m < 4; ++m) {
                const size_t off = (size_t)(row0 + ai * HALF + m * 16) * ldc + col0;
#pragma unroll
                for (int bj = 0; bj < 2; ++bj)
#pragma unroll
                    for (int n = 0; n < 2; ++n) { const f32x4 b = *(const f32x4*)(base + off + bj * HALF + n * 16); *(f32x4*)(out + off + bj * HALF + n * 16) = b + acc[ai][bj][m][n]; }
                asm volatile("" ::: "memory");
            }
    }
};
struct PanelRms {
    float* xbuf;
    unsigned* cnt;
    float eps;
    __device__ __forceinline__ void run(const f32x4 (&v)[2][2][4][2], const Unit& u, int wr, int wc, int fr, int fq, PG8_LAS unsigned char* lds, int wid, int lane) const {
        PG8_LAS float* P = (PG8_LAS float*)lds;
        PG8_LAS float* S = (PG8_LAS float*)(lds + 4096);
#pragma unroll
        for (int ai = 0; ai < 2; ++ai)
#pragma unroll
            for (int m = 0; m < 4; ++m) {
                float s = 0.f;
#pragma unroll
                for (int bj = 0; bj < 2; ++bj)
#pragma unroll
                    for (int n = 0; n < 2; ++n) { const f32x4 x = v[ai][bj][m][n]; s += (x[0] * x[0] + x[1] * x[1]) + (x[2] * x[2] + x[3] * x[3]); }
                s += __shfl_xor(s, 16); s += __shfl_xor(s, 32);
                if (fq == 0) P[(ai * HALF + wr * 64 + m * 16 + fr) * 4 + wc] = s;
            }
        asm volatile("s_waitcnt lgkmcnt(0)" ::: "memory"); __builtin_amdgcn_s_barrier(); asm volatile("" ::: "memory");
        const int row = wid * 32 + (lane & 31);
        if (lane < 32) {
            const float t = (P[row * 4 + 0] + P[row * 4 + 1]) + (P[row * 4 + 2] + P[row * 4 + 3]);
            __hip_atomic_store(xbuf + ((size_t)(u.pm * BM + row) * 4 + u.pn), t, __ATOMIC_RELAXED, __HIP_MEMORY_SCOPE_AGENT);
        }
        asm volatile("s_waitcnt vmcnt(0)" ::: "memory");
        if (lane == 0) __hip_atomic_fetch_add(cnt + 64 * u.pm, 1u, __ATOMIC_RELAXED, __HIP_MEMORY_SCOPE_AGENT);
        if (wid == 0) {
            unsigned spins = 0;
            while ((unsigned)__builtin_amdgcn_readfirstlane(__hip_atomic_load(cnt + 64 * u.pm, __ATOMIC_RELAXED, __HIP_MEMORY_SCOPE_AGENT)) < 32u) { __builtin_amdgcn_s_sleep(2); if (++spins > (1u << 20)) break; }
            __builtin_amdgcn_fence(__ATOMIC_ACQUIRE, "agent");
        }
        asm volatile("s_waitcnt vmcnt(0) lgkmcnt(0)" ::: "memory"); __builtin_amdgcn_s_barrier(); asm volatile("" ::: "memory");
        if (lane < 32) {
            const float* slot = xbuf + (size_t)(u.pm * BM + row) * 4; float q = 0.f;
#pragma unroll
            for (int t = 0; t < 4; ++t) q += __hip_atomic_load(slot + t, __ATOMIC_RELAXED, __HIP_MEMORY_SCOPE_AGENT);
            S[row] = 1.0f / sqrtf(q * (1.0f / 1024.0f) + eps);
        }
        asm volatile("s_waitcnt lgkmcnt(0)" ::: "memory"); __builtin_amdgcn_s_barrier(); asm volatile("" ::: "memory");
    }
};
struct EpiRmsOut {
    static constexpr bool PERM = false, AFTER_DRAIN = true;
    const float* base; const bf16_t* dl; float* out; const float* g; int ldc; PanelRms st;
    __device__ __forceinline__ void fused(f32x4 (&acc)[2][2][4][2], const Unit& u, int wr, int wc, int fr, int fq, PG8_LAS unsigned char* lds, int wid, int lane) const {
        const PG8_LAS float* S = (const PG8_LAS float*)(lds + 4096);
        const int col0 = u.pn * BM + wc * 32 + 4 * fq;
#pragma unroll
        for (int ai = 0; ai < 2; ++ai)
#pragma unroll
            for (int m = 0; m < 4; ++m) { const size_t off = (size_t)(u.pm * BM + ai * HALF + wr * 64 + m * 16 + fr) * ldc + col0;
#pragma unroll
                for (int bj = 0; bj < 2; ++bj)
#pragma unroll
                    for (int n = 0; n < 2; ++n) { const u32x2 dd = *(const u32x2*)(dl + off + bj * HALF + n * 16); f32x4 bv = *(const f32x4*)(base + off + bj * HALF + n * 16);
                        bv[0] += __uint_as_float(dd.x << 16); bv[1] += __uint_as_float(dd.x & 0xffff0000u); bv[2] += __uint_as_float(dd.y << 16); bv[3] += __uint_as_float(dd.y & 0xffff0000u); acc[ai][bj][m][n] += bv; }
                asm volatile("" : "+v"(acc[ai][0][m][0]), "+v"(acc[ai][0][m][1]), "+v"(acc[ai][1][m][0]), "+v"(acc[ai][1][m][1]));
                if (m & 1) asm volatile("" ::: "memory"); }
        st.run(acc, u, wr, wc, fr, fq, lds, wid, lane);
#pragma unroll
        for (int bj = 0; bj < 2; ++bj)
#pragma unroll
            for (int n = 0; n < 2; ++n) { const f32x4 gv = *(const f32x4*)(g + col0 + bj * HALF + n * 16);
#pragma unroll
                for (int ai = 0; ai < 2; ++ai)
#pragma unroll
                    for (int m = 0; m < 4; ++m) { const int r = ai * HALF + wr * 64 + m * 16 + fr; const float rs = S[r];
                        *(f32x4*)(out + (size_t)(u.pm * BM + r) * ldc + col0 + bj * HALF + n * 16) = acc[ai][bj][m][n] * rs * gv; } }
    }
};
template <class Epi, class Sched, bool ALIGN_EPI = false, bool SP2 = false>
__device__ __forceinline__ void gemm_phase(PG8_LAS unsigned char* lds, const Gemm g, const Sched& S, const Epi& E) {
    const int tid = threadIdx.x, wid = __builtin_amdgcn_readfirstlane(tid >> 6), lane = tid & 63, wr = wid >> 2, wc = wid & 3, fr = lane & 15, fq = lane >> 4;
    const int K = g.K, nt = K / BK;
    unsigned voffA[2], voffB[2];
#pragma unroll
    for (int i = 0; i < 2; ++i) { int R, C; stage_rc(tid * 16 + i * 8192, R, C); const int Rb = Epi::PERM ? ((R & ~31) + perm32(R & 31)) : R;
        voffA[i] = (unsigned)(R * K + C) * 2u; voffB[i] = (unsigned)(Rb * K + C) * 2u; }
    const size_t kstep = (size_t)(BK * 2);
    const size_t hstep = (size_t)HALF * K * 2;
    const size_t tstep = 2 * hstep;
    const unsigned ldsw = (unsigned)wid * 1024u;
    const int aoff = lds_byte(wr * 64 + fr, fq * 8), boff = lds_byte(wc * 32 + fr, fq * 8);
#define PG8_SA(b, h) (((b) * 2 + (h)) * HTB)
#define PG8_SB(b, h) ((4 + (b) * 2 + (h)) * HTB)
#define PG8_STAGE(bufoff, gbase, voff) do { _Pragma("unroll") for (int _i = 0; _i < 2; ++_i) \
        __builtin_amdgcn_global_load_lds((const unsigned*)((const char*)(gbase) + (voff)[_i]), (PG8_LAS unsigned*)(lds + (bufoff) + ldsw + _i * 8192), 16, 0, 0); } while (0)
#define PG8_LDA(dst, b, h) do { _Pragma("unroll") for (int m = 0; m < 4; ++m) _Pragma("unroll") for (int k = 0; k < 2; ++k) dst[m][k] = *(const PG8_LAS bf16x8*)(lds + PG8_SA(b, h) + aoff + m * 2048 + k * 1024); } while (0)
#define PG8_LDB(dst, b, h) do { _Pragma("unroll") for (int n = 0; n < 2; ++n) _Pragma("unroll") for (int k = 0; k < 2; ++k) dst[n][k] = *(const PG8_LAS bf16x8*)(lds + PG8_SB(b, h) + boff + n * 2048 + k * 1024); } while (0)
#define PG8_MMA(ai, bj, At, Bt) do { __builtin_amdgcn_s_setprio(1); _Pragma("unroll") for (int m = 0; m < 4; ++m) _Pragma("unroll") for (int n = 0; n < 2; ++n) _Pragma("unroll") for (int k = 0; k < 2; ++k) \
        acc[ai][bj][m][n] = __builtin_amdgcn_mfma_f32_16x16x32_bf16(Bt[n][k], At[m][k], acc[ai][bj][m][n], 0, 0, 0); __builtin_amdgcn_s_setprio(0); } while (0)
#define PG8_WAIT_V(n) asm volatile("s_waitcnt vmcnt(" #n ")" ::: "memory")
#define PG8_WAIT_L(n) asm volatile("s_waitcnt lgkmcnt(" #n ")" ::: "memory")
#define PG8_BAR __builtin_amdgcn_s_barrier()
#define PG8_SCHED __builtin_amdgcn_sched_barrier(0)
    Unit cur, nxt; int ui = 0;
    if (!S.next(0, cur)) return;
    f32x4 acc[2][2][4][2];
#pragma unroll
    for (int a = 0; a < 2; ++a)
#pragma unroll
        for (int b = 0; b < 2; ++b)
#pragma unroll
            for (int m = 0; m < 4; ++m)
#pragma unroll
                for (int n = 0; n < 2; ++n) acc[a][b][m][n] = (f32x4){0.f, 0.f, 0.f, 0.f};
    bf16x8 At[4][2], B0[2][2], B1[2][2];
    const char* cA = (const char*)g.A + (size_t)cur.pm * tstep; const char* cB = (const char*)g.Bt + (size_t)cur.pn * tstep;
    S.a_ready(cur);
    if constexpr (SP2) {
        PG8_STAGE(PG8_SB(0, 0), cB, voffB); PG8_STAGE(PG8_SB(0, 1), cB + hstep, voffB); PG8_STAGE(PG8_SA(0, 0), cA, voffA); PG8_STAGE(PG8_SA(0, 1), cA + hstep, voffA);
        if (wr == 1) PG8_BAR;
        PG8_WAIT_V(2); PG8_BAR;
        PG8_STAGE(PG8_SB(1, 0), cB + kstep, voffB); PG8_STAGE(PG8_SA(1, 0), cA + kstep, voffA); PG8_STAGE(PG8_SB(1, 1), cB + hstep + kstep, voffB);
        PG8_WAIT_V(6); PG8_BAR;
    } else {
        PG8_STAGE(PG8_SB(0, 0), cB, voffB); PG8_STAGE(PG8_SA(0, 0), cA, voffA); PG8_STAGE(PG8_SB(0, 1), cB + hstep, voffB); PG8_STAGE(PG8_SA(0, 1), cA + hstep, voffA);
        if (wr == 1) PG8_BAR;
        PG8_WAIT_V(4); PG8_BAR;
        PG8_STAGE(PG8_SB(1, 0), cB + kstep, voffB); PG8_STAGE(PG8_SA(1, 0), cA + kstep, voffA); PG8_STAGE(PG8_SB(1, 1), cB + hstep + kstep, voffB);
        PG8_WAIT_V(6); PG8_BAR;
    }
    for (;;) {
        const bool has_next = S.next(ui + 1, nxt);
        const char* nA = has_next ? (const char*)g.A + (size_t)nxt.pm * tstep : cA; const char* nB = has_next ? (const char*)g.Bt + (size_t)nxt.pn * tstep : cB;
        for (int t = 0; t < nt; t += 2) {
            const bool last = (t == nt - 2);
            const char* a1 = cA + (size_t)(t + 1) * kstep;
            const char* a2 = last ? nA : cA + (size_t)(t + 2) * kstep; const char* b2 = last ? nB : cB + (size_t)(t + 2) * kstep;
            const char* a3 = a2 + kstep; const char* b3 = b2 + kstep;
            if (last && has_next) S.a_ready(nxt);
            if constexpr (SP2) {
            PG8_LDB(B0, 0, 0); PG8_LDB(B1, 0, 1); PG8_SCHED; PG8_LDA(At, 0, 0); PG8_STAGE(PG8_SA(1, 1), a1 + hstep, voffA);
            PG8_WAIT_V(8); PG8_WAIT_L(0); PG8_BAR; PG8_MMA(0, 0, At, B0); PG8_MMA(0, 1, At, B1); PG8_BAR; PG8_SCHED;
            PG8_LDA(At, 0, 1); PG8_STAGE(PG8_SB(0, 0), b2, voffB); PG8_STAGE(PG8_SB(0, 1), b2 + hstep, voffB); PG8_STAGE(PG8_SA(0, 0), a2, voffA);
            PG8_WAIT_V(8); PG8_WAIT_L(0); PG8_BAR; PG8_MMA(1, 0, At, B0); PG8_MMA(1, 1, At, B1); PG8_BAR; PG8_SCHED;
            PG8_LDB(B0, 1, 0); PG8_LDB(B1, 1, 1); PG8_SCHED; PG8_LDA(At, 1, 0); PG8_STAGE(PG8_SA(0, 1), a2 + hstep, voffA);
            PG8_WAIT_V(8); PG8_WAIT_L(0); PG8_BAR; PG8_MMA(0, 0, At, B0); PG8_MMA(0, 1, At, B1); PG8_BAR; PG8_SCHED;
            PG8_LDA(At, 1, 1); PG8_STAGE(PG8_SB(1, 0), b3, voffB); PG8_STAGE(PG8_SB(1, 1), b3 + hstep, voffB); PG8_STAGE(PG8_SA(1, 0), a3, voffA);
            PG8_WAIT_V(8); PG8_WAIT_L(0); PG8_BAR; PG8_MMA(1, 0, At, B0); PG8_MMA(1, 1, At, B1); PG8_BAR; PG8_SCHED;
            } else {
            PG8_LDB(B0, 0, 0); PG8_SCHED; PG8_LDA(At, 0, 0); PG8_STAGE(PG8_SA(1, 1), a1 + hstep, voffA);
            PG8_WAIT_L(8); PG8_BAR; PG8_WAIT_L(0); PG8_MMA(0, 0, At, B0); PG8_BAR; PG8_SCHED;
            PG8_LDB(B1, 0, 1); PG8_STAGE(PG8_SB(0, 0), b2, voffB);
            PG8_BAR; PG8_WAIT_L(0); PG8_MMA(0, 1, At, B1); PG8_BAR;
            PG8_LDA(At, 0, 1); PG8_STAGE(PG8_SA(0, 0), a2, voffA);
            PG8_BAR; PG8_WAIT_L(0); PG8_MMA(1, 0, At, B0); PG8_BAR; PG8_SCHED;
            PG8_STAGE(PG8_SB(0, 1), b2 + hstep, voffB);
            PG8_WAIT_V(6); PG8_BAR; PG8_MMA(1, 1, At, B1); PG8_BAR;
            PG8_LDB(B0, 1, 0); PG8_SCHED; PG8_LDA(At, 1, 0); PG8_STAGE(PG8_SA(0, 1), a2 + hstep, voffA);
            PG8_WAIT_L(8); PG8_BAR; PG8_WAIT_L(0); PG8_MMA(0, 0, At, B0); PG8_BAR; PG8_SCHED;
            PG8_LDB(B1, 1, 1); PG8_STAGE(PG8_SB(1, 0), b3, voffB);
            PG8_BAR; PG8_WAIT_L(0); PG8_MMA(0, 1, At, B1); PG8_BAR;
            PG8_LDA(At, 1, 1); PG8_STAGE(PG8_SA(1, 0), a3, voffA);
            PG8_BAR; PG8_WAIT_L(0); PG8_MMA(1, 0, At, B0); PG8_BAR; PG8_SCHED;
            PG8_STAGE(PG8_SB(1, 1), b3 + hstep, voffB);
            PG8_WAIT_V(6); PG8_BAR; PG8_MMA(1, 1, At, B1); PG8_BAR;
            }
        }
        if constexpr (ALIGN_EPI) { if (wr == 0) PG8_BAR; }
        if constexpr (!Epi::AFTER_DRAIN) { E(acc, cur, wr, wc, fr, fq); S.done(cur); }
        if (!has_next) break;
#pragma unroll
        for (int a = 0; a < 2; ++a)
#pragma unroll
            for (int b = 0; b < 2; ++b)
#pragma unroll
                for (int m = 0; m < 4; ++m)
#pragma unroll
                    for (int n = 0; n < 2; ++n) acc[a][b][m][n] = (f32x4){0.f, 0.f, 0.f, 0.f};
        cur = nxt; cA = nA; cB = nB; ++ui;
        if constexpr (ALIGN_EPI) { if (wr == 1) PG8_BAR; }
    }
    PG8_WAIT_V(0);
    if constexpr (!ALIGN_EPI) { if (wr == 0) PG8_BAR; }
    PG8_BAR;
    if constexpr (Epi::AFTER_DRAIN) { E.fused(acc, cur, wr, wc, fr, fq, lds, wid, lane); S.done(cur); }
#undef PG8_SA
#undef PG8_SB
#undef PG8_STAGE
#undef PG8_LDA
#undef PG8_LDB
#undef PG8_MMA
#undef PG8_WAIT_V
#undef PG8_WAIT_L
#undef PG8_BAR
#undef PG8_SCHED
}
}
#define LAS __attribute__((address_space(3)))
typedef unsigned short bf16;
typedef short bf16x8 __attribute__((ext_vector_type(8)));
typedef float f32x16 __attribute__((ext_vector_type(16)));
typedef float f32x4 __attribute__((ext_vector_type(4)));
typedef float f32x2 __attribute__((ext_vector_type(2)));
typedef unsigned u32x4 __attribute__((ext_vector_type(4)));
typedef unsigned u32x2 __attribute__((ext_vector_type(2)));
typedef __bf16 bf16x2_t __attribute__((ext_vector_type(2)));

constexpr int BATCH = 8, SEQ = 4096, DM = 1024, M = BATCH * SEQ;
constexpr int N0 = 2208, N0P = 2304;
constexpr int C_CQ = 0, C_CKV = 256, C_KPE = 384, C_QS = 416, C_KS = 928, C_VS = 1056, C_G0 = 1184;
constexpr int N1W = 4112, N1 = 4096;
constexpr int C1_Q = 0, C1_K = 1024, C1_V = 2048, C1_G = 3072, W1_F = 3072, W1_G = 3088;
constexpr float EPS = 1e-6f, LOG2E = 1.4426950408889634f;
constexpr int NTHREADS = 512, NWAVES = 8;

constexpr size_t MiB = 1u << 20;
constexpr size_t WS_WT0 = 1 * MiB;
constexpr size_t WS_WQUP = 6 * MiB;
constexpr size_t WS_WKVUP = 7 * MiB;
constexpr size_t WS_WOUT0 = 8 * MiB;
constexpr size_t WS_WT1 = 10 * MiB;
constexpr size_t WS_WOUT1 = 18 * MiB;
constexpr size_t WS_XN = 32 * MiB;
constexpr size_t WS_OG = 96 * MiB;
constexpr size_t WS_LF = 160 * MiB;
constexpr size_t WS_LC = 162 * MiB;
constexpr size_t WS_TMAX = 512 * 1024;
constexpr size_t WS_CS = 164 * MiB;
constexpr size_t WS_Z1 = 168 * MiB;
constexpr size_t WS_Z0 = 168 * MiB;
constexpr size_t WS_CQN = 312 * MiB;
constexpr size_t WS_CKVN = 328 * MiB;
constexpr size_t WS_KPE = 344 * MiB;
constexpr size_t WS_Q0 = 346 * MiB;
constexpr size_t WS_KN = 394 * MiB;
constexpr size_t WS_VM = 426 * MiB;
constexpr size_t WS_D0 = 426 * MiB;
constexpr size_t WS_END = 490 * MiB;
constexpr int LDS_BYTES = 135168, LDS_MISC = 131072 + 1024;

__device__ __forceinline__ unsigned cvtpk(float lo, float hi) { f32x2 v = {lo, hi}; bf16x2_t b = __builtin_convertvector(v, bf16x2_t); return __builtin_bit_cast(unsigned, b); }
__device__ __forceinline__ float bflo(unsigned u) { return __uint_as_float(u << 16); }
__device__ __forceinline__ float bfhi(unsigned u) { return __uint_as_float(u & 0xffff0000u); }
__device__ __forceinline__ float bf1(bf16 v) { return __uint_as_float(((unsigned)v) << 16); }
__device__ __forceinline__ float wave_sum(float v) {
#pragma unroll
    for (int o = 1; o < 64; o <<= 1) v += __shfl_xor(v, o);
    return v;
}

struct AttnP { const bf16 *Q, *K, *K2, *V, *G; bf16* O; const float* lc; const float* tmax; const float* sinkp; int h0; int ldq, ldk, ldk2, ldv, ldg, ldo; float c, sink2, slope2; };

typedef short v4i16_t __attribute__((ext_vector_type(4)));
__device__ __forceinline__ void glds16(const void* gsrc, unsigned lds_dst) { unsigned keep;
    asm volatile("s_mov_b32 %0, m0\n\ts_mov_b32 m0, %2\n\ts_nop 0\n\tglobal_load_lds_dwordx4 %1, off\n\ts_mov_b32 m0, %0" : "=&s"(keep) : "v"(gsrc), "s"(lds_dst) : "memory"); }
__device__ __forceinline__ void glds4(const void* gsrc, unsigned lds_dst) { unsigned keep;
    asm volatile("s_mov_b32 %0, m0\n\ts_mov_b32 m0, %2\n\ts_nop 0\n\tglobal_load_lds_dword %1, off\n\ts_mov_b32 m0, %0" : "=&s"(keep) : "v"(gsrc), "s"(lds_dst) : "memory"); }

#define PSB() __builtin_amdgcn_sched_barrier(0)
__device__ __forceinline__ constexpr int pch_lo(int k, int nch) { return k * (32 / nch) + (k < (32 % nch) ? k : (32 % nch)); }
template <int LO, int HI> __device__ __forceinline__ void p_exp_range(f32x16 (&SC)[2], float c, float m_new, float& l0, float& l1) {
#pragma unroll
    for (int e = LO; e < HI; ++e) { const float y = __builtin_amdgcn_exp2f(SC[e >> 4][e & 15] * c - m_new); SC[e >> 4][e & 15] = y; if (e & 1) l1 += y; else l0 += y; }
}
template <int DK, int K> struct PSeg1 {
    static __device__ __forceinline__ void run(f32x16 (&SC)[2], f32x16 (&SN)[2], const bf16x8 (&kf)[2][DK / 16], const bf16x8 (&qf)[DK / 16], float c, float m_new, float& l0, float& l1) {
        constexpr int NCH = 2 * (DK / 16);
        if constexpr (K < NCH) {
            SN[K & 1] = __builtin_amdgcn_mfma_f32_32x32x16_bf16(kf[K & 1][K >> 1], qf[K >> 1], SN[K & 1], 0, 0, 0);
            PSB();
            p_exp_range<pch_lo(K, NCH), pch_lo(K + 1, NCH)>(SC, c, m_new, l0, l1);
            PSB();
            PSeg1<DK, K + 1>::run(SC, SN, kf, qf, c, m_new, l0, l1);
        }
    }
};
template <int K> struct PSeg2 {
    static __device__ __forceinline__ void run(f32x16 (&SC)[2], f32x16 (&SN)[2], const bf16x8 (&vf)[2][4], bf16x8 (&pk)[4], f32x16 (&ot)[2], float& mx, bool has_next) {
        if constexpr (K < 8) {
            ot[K & 1] = __builtin_amdgcn_mfma_f32_32x32x16_bf16(vf[K & 1][K >> 1], pk[K >> 1], ot[K & 1], 0, 0, 0);
            PSB();
            if constexpr ((K & 1) == 0 && K < 6) { constexpr int cc = (K >> 1) + 1, ph = cc >> 1, o = 8 * (cc & 1); u32x4 w;
                w.x = cvtpk(SC[ph][o + 0], SC[ph][o + 1]); w.y = cvtpk(SC[ph][o + 2], SC[ph][o + 3]); w.z = cvtpk(SC[ph][o + 4], SC[ph][o + 5]); w.w = cvtpk(SC[ph][o + 6], SC[ph][o + 7]);
                pk[cc] = __builtin_bit_cast(bf16x8, w); }
            if (has_next) { constexpr int e = 4 * K, ph = e >> 4, r = e & 15;
                mx = __builtin_fmaxf(__builtin_fmaxf(mx, SN[ph][r]), SN[ph][r + 1]); mx = __builtin_fmaxf(__builtin_fmaxf(mx, SN[ph][r + 2]), SN[ph][r + 3]); }
            PSB();
            PSeg2<K + 1>::run(SC, SN, vf, pk, ot, mx, has_next);
        }
    }
};
#define AT_WAITV(n) asm volatile("s_waitcnt vmcnt(%0) lgkmcnt(0)" :: "n"(n) : "memory")
template <int DK, int MODE>
__device__ __forceinline__ void attn_unit(const AttnP& p, const int q0, LAS unsigned char* lds) {
    constexpr bool SKEW = (MODE == 2);
    constexpr int NS = SKEW ? 7 : 4, KN_B = 8192, KP_B = (DK == 96) ? 4096 : 0, VHALF = 4160, V_B = 2 * VHALF, LC_B = (MODE == 2) ? 256 : 0;
    constexpr int OFF_KP = KN_B, OFF_V = KN_B + KP_B, OFF_LC = OFF_V + V_B, SLOT = OFF_LC + LC_B, OFF_FLAG = NS * SLOT;
    constexpr int NPT = 2 + ((DK == 96 || MODE == 2) ? 1 : 0);
    const int tid = threadIdx.x, lane = tid & 63, wid = __builtin_amdgcn_readfirstlane(tid >> 6), r32 = lane & 31, hi = lane >> 5;
    const int hsel = (MODE == 1) ? (wid >> 1) : 0;
    const int qw0 = q0 + 32 * ((MODE == 1) ? (wid & 1) : wid), q = qw0 + r32;
    const bf16* Qp = p.Q + hsel * 64; const bf16* Gp = p.G + hsel * 64; bf16* Op = p.O + hsel * 64;
    float sink2 = 0.f, slope2 = 0.f;
    if (MODE == 1) { const int hh = p.h0 + hsel; sink2 = p.sinkp[hh] * LOG2E; slope2 = exp2f(-(float)(hh + 1)) * LOG2E; }
    const unsigned lds0 = (unsigned)(uintptr_t)lds;
    bf16x8 qf[DK / 16];
#pragma unroll
    for (int d0 = 0; d0 < DK / 16; ++d0) qf[d0] = *(const bf16x8*)(Qp + (size_t)q * p.ldq + 16 * d0 + 8 * hi);
#pragma unroll
    for (int d0 = 0; d0 < DK / 16; ++d0) asm volatile("" : "+v"(qf[d0]));
    const int t_hi = (MODE == 1) ? (q0 >> 6) : (((q0 + 256) >> 6) - 1);
    const int t_lo = (MODE == 1) ? (((q0 >> 6) >= 2) ? (q0 >> 6) - 2 : 0) : 0;
    const int ntile = t_hi - t_lo + 1;
    const int krow = 8 * wid + (lane >> 3), kch = (lane & 7) ^ ((krow >> 1) & 7);
    const bf16* ksrc = p.K + (size_t)krow * p.ldk + kch * 8;
    const int prow = 8 * wid + ((lane & 31) >> 2), pch = (lane & 3) ^ ((prow >> 2) & 3);
    const bf16* psrc = (DK == 96) ? (p.K2 + (size_t)prow * p.ldk2 + pch * 8) : p.K;
    const int vrow = 16 * (wid & 3) + (lane >> 2);
    const bf16* vsrc = p.V + (size_t)vrow * p.ldv + ((wid >> 2) * 4 + (lane & 3)) * 8;
    const float* lsrc = (MODE == 2) ? (p.lc + 8 * wid + (lane & 7)) : (const float*)p.K;
#define AT_DMA(t, slot) do { const size_t ro_ = (size_t)(t) * 64; const unsigned sb_ = lds0 + (unsigned)((slot) * SLOT); \
        glds16(ksrc + ro_ * p.ldk, (unsigned)__builtin_amdgcn_readfirstlane(sb_ + wid * 1024)); \
        glds16(vsrc + ro_ * p.ldv, (unsigned)__builtin_amdgcn_readfirstlane(sb_ + OFF_V + (wid >> 2) * VHALF + (wid & 3) * 1024)); \
        if (DK == 96) { if (lane < 32) glds16(psrc + ro_ * p.ldk2, (unsigned)__builtin_amdgcn_readfirstlane(sb_ + OFF_KP + wid * 512)); } \
        if (MODE == 2) { if (lane < 8) glds4(lsrc + ro_, (unsigned)__builtin_amdgcn_readfirstlane(sb_ + OFF_LC + wid * 32)); } } while (0)

    float m_run = (MODE == 1) ? sink2 : -INFINITY;
    float l_run = (MODE == 1 && hi == 0) ? 1.f : 0.f;
    f32x16 ot[2];
#pragma unroll
    for (int r = 0; r < 16; ++r) { ot[0][r] = 0.f; ot[1][r] = 0.f; }
    const int pim = 16 * (r32 >> 4) + 8 * ((r32 >> 2) & 1) + 4 * ((r32 >> 3) & 1) + (r32 & 3);
    const int vrd = (8 * hi + ((lane & 15) >> 2)) * 64 + ((lane >> 4) & 1) * 32 + (lane & 3) * 8;
    int koff[4], poff[2];
#pragma unroll
    for (int d0 = 0; d0 < 4; ++d0) koff[d0] = pim * 128 + (((2 * d0 + hi) ^ ((pim >> 1) & 7)) * 16);
#pragma unroll
    for (int j = 0; j < 2; ++j) poff[j] = OFF_KP + pim * 64 + (((2 * j + hi) ^ ((pim >> 2) & 3)) * 16);
    float pmv = 0.f, lcev = 0.f, qn = 0.f;
    if (MODE == 2) {
        pmv = (lane <= t_hi) ? p.tmax[lane] : 0.f;
#pragma unroll
        for (int o = 1; o < 64; o <<= 1) { const float n = __shfl_up(pmv, o); if (lane >= o) pmv = fmaxf(pmv, n); }
        lcev = (lane <= t_hi) ? p.lc[64 * lane + 63] : 0.f;
        float qs = 0.f;
#pragma unroll
        for (int d0 = 0; d0 < DK / 16; ++d0)
#pragma unroll
            for (int e = 0; e < 8; ++e) { const float f = bf1((bf16)qf[d0][e]); qs += f * f; }
        qs += __shfl_xor(qs, 32);
        qn = sqrtf(qs) * p.c * 1.002f;
    }
    const int sk = SKEW ? (3 - (wid >> 1)) : 0;
    int sw = sk, sd = 6;
    bool done_w = false;
    if (SKEW) {
#pragma unroll
        for (int d = 0; d < 6; ++d) if (d < ntile) AT_DMA(t_hi - d, d);
    } else {
        AT_DMA(t_hi, 0);
        if (ntile > 1) AT_DMA(t_hi - 1, 1);
        if (ntile > 2) AT_DMA(t_hi - 2, 2);
    }
    const int nfirst = (MODE == 0 && ntile > 4) ? 4 : ntile;
    for (int i = 0; i < nfirst; ++i) {
        const int t = t_hi - i - sk, kv0 = t * 64, rem = SKEW ? (ntile - 1 - (i + 3)) : (ntile - 1 - i);
        if (rem >= 2) AT_WAITV(2 * NPT); else if (rem == 1) AT_WAITV(NPT); else AT_WAITV(0);
        __builtin_amdgcn_s_barrier();
        asm volatile("" ::: "memory");
        if (MODE == 2) { if (i > 0) {
            const LAS unsigned char* fp = lds + OFF_FLAG + ((i - 1) & 1) * 32;
            const u32x4 f0 = *(const LAS u32x4*)(fp), f1 = *(const LAS u32x4*)(fp + 16);
            if ((f0.x & f0.y & f0.z & f0.w & f1.x & f1.y & f1.z & f1.w) != 0u) break; } }
        if (SKEW) { if (i + 6 < ntile) AT_DMA(t_hi - (i + 6), sd); sd = (sd == 6) ? 0 : sd + 1; }
        else { if (rem >= 3) AT_DMA(t - 3, (i + 3) & 3); }
        const LAS unsigned char* sb = lds + (SKEW ? sw : (i & 3)) * SLOT;
        if (SKEW) sw = (sw == 6) ? 0 : sw + 1;
        bool act = kv0 <= qw0 + 31;
        if (MODE == 1) act = act && (kv0 + 63 >= qw0 - 127);
        if (SKEW) act = act && (t >= 0) && !done_w;
        if (act) {
            f32x16 s[2];
            {
                bf16x8 kf[2][DK / 16];
#pragma unroll
                for (int ph = 0; ph < 2; ++ph) {
#pragma unroll
                    for (int d0 = 0; d0 < 4; ++d0) kf[ph][d0] = *(const LAS bf16x8*)(sb + koff[d0] + ph * 4096);
                    if (DK == 96) {
#pragma unroll
                        for (int j = 0; j < 2; ++j) kf[ph][(DK == 96) ? 4 + j : 0] = *(const LAS bf16x8*)(sb + poff[j] + ph * 2048);
                    }
                }
#pragma unroll
                for (int r = 0; r < 16; ++r) { s[0][r] = 0.f; s[1][r] = 0.f; }
                __builtin_amdgcn_sched_barrier(0);
#pragma unroll
                for (int d0 = 0; d0 < DK / 16; ++d0) {
                    s[0] = __builtin_amdgcn_mfma_f32_32x32x16_bf16(kf[0][d0], qf[d0], s[0], 0, 0, 0);
                    s[1] = __builtin_amdgcn_mfma_f32_32x32x16_bf16(kf[1][d0], qf[d0], s[1], 0, 0, 0);
                }
                __builtin_amdgcn_sched_barrier(0);
            }
            if (MODE == 2) {
                const LAS float* lcb = (const LAS float*)(sb + OFF_LC);
#pragma unroll
                for (int ph = 0; ph < 2; ++ph)
#pragma unroll
                    for (int j = 0; j < 4; ++j) { const f32x4 lk = *(const LAS f32x4*)(lcb + 32 * ph + 16 * (j >> 1) + 8 * hi + 4 * (j & 1));
#pragma unroll
                        for (int ii = 0; ii < 4; ++ii) s[ph][4 * j + ii] = s[ph][4 * j + ii] * p.c - lk[ii]; }
            } else if (MODE == 1) {
                const float dq = (float)(q - kv0 - 8 * hi);
#pragma unroll
                for (int ph = 0; ph < 2; ++ph)
#pragma unroll
                    for (int r = 0; r < 16; ++r) { const int kk = 32 * ph + 16 * (r >> 3) + 4 * ((r >> 2) & 1) + (r & 3); s[ph][r] = s[ph][r] * p.c - slope2 * (dq - (float)kk); }
            }
            bool needmask = (kv0 + 63 > qw0);
            if (MODE == 1) needmask = needmask || (kv0 < qw0 + 31 - 127);
            if (needmask) {
                const int dqi = q - kv0 - 8 * hi;
#pragma unroll
                for (int ph = 0; ph < 2; ++ph)
#pragma unroll
                    for (int r = 0; r < 16; ++r) { const int kk = 32 * ph + 16 * (r >> 3) + 4 * ((r >> 2) & 1) + (r & 3); const int dist = dqi - kk;
                        bool ok = dist >= 0; if (MODE == 1) ok = ok && (dist < 128); s[ph][r] = ok ? s[ph][r] : -INFINITY; }
            }
            float mx = fmaxf(fmaxf(s[0][0], s[0][1]), s[0][2]);
#pragma unroll
            for (int r = 3; r < 15; r += 2) mx = fmaxf(fmaxf(mx, s[0][r]), s[0][r + 1]);
            mx = fmaxf(mx, s[0][15]);
#pragma unroll
            for (int r = 0; r < 16; r += 2) mx = fmaxf(fmaxf(mx, s[1][r]), s[1][r + 1]);
            mx = fmaxf(mx, __shfl_xor(mx, 32));
            if (MODE == 0) mx *= p.c;
            const bool dead = (MODE == 2) && __all(mx < m_run - 40.f);
            if (!dead) {
                const float m_new = fmaxf(m_run, mx);
                const float alpha = __builtin_amdgcn_exp2f(m_run - m_new);
                m_run = m_new;
                float ls0 = 0.f, ls1 = 0.f;
#pragma unroll
                for (int ph = 0; ph < 2; ++ph)
#pragma unroll
                    for (int r = 0; r < 16; r += 2) {
                        const float e0 = __builtin_amdgcn_exp2f(MODE == 0 ? (s[ph][r] * p.c - m_new) : (s[ph][r] - m_new));
                        const float e1 = __builtin_amdgcn_exp2f(MODE == 0 ? (s[ph][r + 1] * p.c - m_new) : (s[ph][r + 1] - m_new));
                        s[ph][r] = e0; s[ph][r + 1] = e1; ls0 += e0; ls1 += e1; }
                if (__any(alpha != 1.f)) {
                    l_run *= alpha;
#pragma unroll
                    for (int r = 0; r < 16; ++r) { ot[0][r] *= alpha; ot[1][r] *= alpha; }
                }
                l_run += ls0 + ls1;
                bf16x8 pk[4];
#pragma unroll
                for (int cc = 0; cc < 4; ++cc) { const int ph = cc >> 1, o = 8 * (cc & 1); u32x4 w;
                    w.x = cvtpk(s[ph][o + 0], s[ph][o + 1]); w.y = cvtpk(s[ph][o + 2], s[ph][o + 3]); w.z = cvtpk(s[ph][o + 4], s[ph][o + 5]); w.w = cvtpk(s[ph][o + 6], s[ph][o + 7]);
                    pk[cc] = __builtin_bit_cast(bf16x8, w); }
                const LAS unsigned char* vb = sb + OFF_V + vrd;
                bf16x8 vf[2][4];
#pragma unroll
                for (int dh = 0; dh < 2; ++dh)
#pragma unroll
                    for (int cc = 0; cc < 4; ++cc) {
                        const v4i16_t v0 = __builtin_amdgcn_ds_read_tr16_b64_v4i16((LAS v4i16_t*)(vb + dh * VHALF + cc * 1024));
                        const v4i16_t v1 = __builtin_amdgcn_ds_read_tr16_b64_v4i16((LAS v4i16_t*)(vb + dh * VHALF + cc * 1024 + 256));
                        vf[dh][cc] = (bf16x8){v0[0], v0[1], v0[2], v0[3], v1[0], v1[1], v1[2], v1[3]}; }
                __builtin_amdgcn_sched_barrier(0);
#pragma unroll
                for (int cc = 0; cc < 4; ++cc) {
                    ot[0] = __builtin_amdgcn_mfma_f32_32x32x16_bf16(vf[0][cc], pk[cc], ot[0], 0, 0, 0);
                    ot[1] = __builtin_amdgcn_mfma_f32_32x32x16_bf16(vf[1][cc], pk[cc], ot[1], 0, 0, 0);
                }
                __builtin_amdgcn_sched_barrier(0);
            }
        }
        if (MODE == 2) {
            bool dn = true;
            if (t >= 1) { const float bnd = qn * __shfl(pmv, t - 1) - __shfl(lcev, t - 1); dn = __all(bnd < m_run - 40.f); }
            done_w = done_w || dn;
            if (lane == 0) *(LAS unsigned*)(lds + OFF_FLAG + (i & 1) * 32 + wid * 4) = done_w ? 1u : 0u;
        }
    }
    if (MODE == 0) { if (ntile > 4) {
        f32x16 SA[2], SB[2];
        float m_new, alpha;
        { const int y = ((ntile - 1 < 6) ? (ntile - 1) : 6) - 4;
          if (y >= 2) AT_WAITV(2 * NPT); else if (y == 1) AT_WAITV(NPT); else AT_WAITV(0); }
        __builtin_amdgcn_s_barrier(); asm volatile("" ::: "memory");
        { const LAS unsigned char* sb = lds + (4 & 3) * SLOT;
          bf16x8 kf[2][DK / 16];
#pragma unroll
          for (int ph = 0; ph < 2; ++ph) {
#pragma unroll
              for (int d0 = 0; d0 < 4; ++d0) kf[ph][d0] = *(const LAS bf16x8*)(sb + koff[d0] + ph * 4096);
              if (DK == 96) {
#pragma unroll
                  for (int j = 0; j < 2; ++j) kf[ph][(DK == 96) ? 4 + j : 0] = *(const LAS bf16x8*)(sb + poff[j] + ph * 2048);
              }
          }
#pragma unroll
          for (int r = 0; r < 16; ++r) { SA[0][r] = 0.f; SA[1][r] = 0.f; }
#pragma unroll
          for (int d0 = 0; d0 < DK / 16; ++d0) { SA[0] = __builtin_amdgcn_mfma_f32_32x32x16_bf16(kf[0][d0], qf[d0], SA[0], 0, 0, 0); SA[1] = __builtin_amdgcn_mfma_f32_32x32x16_bf16(kf[1][d0], qf[d0], SA[1], 0, 0, 0); }
          float mx = SA[0][0];
#pragma unroll
          for (int r = 1; r < 16; ++r) mx = fmaxf(mx, SA[0][r]);
#pragma unroll
          for (int r = 0; r < 16; ++r) mx = fmaxf(mx, SA[1][r]);
          mx = fmaxf(mx, __shfl_xor(mx, 32)) * p.c;
          m_new = fmaxf(m_run, mx); alpha = __builtin_amdgcn_exp2f(m_run - m_new); m_run = m_new; }
#define P_STEP(SC, SN, i_) do { const int i__ = (i_); const bool has_next = (i__ + 1 < ntile); \
        if (i__ + 2 < ntile) AT_WAITV(NPT); else AT_WAITV(0);                      \
        __builtin_amdgcn_s_barrier(); asm volatile("" ::: "memory"); \
        if (i__ + 3 < ntile) AT_DMA(t_hi - (i__ + 3), (i__ + 3) & 3); \
        const LAS unsigned char* sbc_ = lds + (i__ & 3) * SLOT; const LAS unsigned char* sbn_ = lds + ((i__ + 1) & 3) * SLOT; \
        float l0_ = 0.f, l1_ = 0.f; \
        if (has_next) { \
            bf16x8 kf_[2][DK / 16]; \
            _Pragma("unroll") for (int ph = 0; ph < 2; ++ph) { \
                _Pragma("unroll") for (int d0 = 0; d0 < 4; ++d0) kf_[ph][d0] = *(const LAS bf16x8*)(sbn_ + koff[d0] + ph * 4096); \
                if (DK == 96) { _Pragma("unroll") for (int j = 0; j < 2; ++j) kf_[ph][(DK == 96) ? 4 + j : 0] = *(const LAS bf16x8*)(sbn_ + poff[j] + ph * 2048); } } \
            _Pragma("unroll") for (int r = 0; r < 16; ++r) { SN[0][r] = 0.f; SN[1][r] = 0.f; } \
            PSB(); \
            PSeg1<DK, 0>::run(SC, SN, kf_, qf, p.c, m_new, l0_, l1_); \
        } else { p_exp_range<0, 32>(SC, p.c, m_new, l0_, l1_); } \
        if (__any(alpha != 1.f)) { l_run *= alpha; _Pragma("unroll") for (int r = 0; r < 16; ++r) { ot[0][r] *= alpha; ot[1][r] *= alpha; } } \
        l_run += l0_ + l1_; \
        { bf16x8 vf_[2][4], pk_[4]; const LAS unsigned char* vb_ = sbc_ + OFF_V + vrd; \
          _Pragma("unroll") for (int dh = 0; dh < 2; ++dh) _Pragma("unroll") for (int cc = 0; cc < 4; ++cc) { \
              const v4i16_t v0 = __builtin_amdgcn_ds_read_tr16_b64_v4i16((LAS v4i16_t*)(vb_ + dh * VHALF + cc * 1024)); \
              const v4i16_t v1 = __builtin_amdgcn_ds_read_tr16_b64_v4i16((LAS v4i16_t*)(vb_ + dh * VHALF + cc * 1024 + 256)); \
              vf_[dh][cc] = (bf16x8){v0[0], v0[1], v0[2], v0[3], v1[0], v1[1], v1[2], v1[3]}; } \
          { u32x4 w; w.x = cvtpk(SC[0][0], SC[0][1]); w.y = cvtpk(SC[0][2], SC[0][3]); w.z = cvtpk(SC[0][4], SC[0][5]); w.w = cvtpk(SC[0][6], SC[0][7]); pk_[0] = __builtin_bit_cast(bf16x8, w); } \
          float mx_ = -INFINITY; \
          PSB(); \
          PSeg2<0>::run(SC, SN, vf_, pk_, ot, mx_, has_next); \
          if (has_next) { mx_ = fmaxf(mx_, __shfl_xor(mx_, 32)) * p.c; m_new = fmaxf(m_run, mx_); alpha = __builtin_amdgcn_exp2f(m_run - m_new); m_run = m_new; } } \
    } while (0)
        for (int i = 4; i < ntile; i += 2) {
            P_STEP(SA, SB, i);
            if (i + 1 < ntile) P_STEP(SB, SA, i + 1);
        }
#undef P_STEP
    } }
    AT_WAITV(0);
    __builtin_amdgcn_s_barrier();
    asm volatile("" ::: "memory");
    const float lt = l_run + __shfl_xor(l_run, 32);
    const float inv = 1.f / lt;
#pragma unroll
    for (int dh = 0; dh < 2; ++dh)
#pragma unroll
        for (int j = 0; j < 4; ++j) {
            const int d = 32 * dh + 8 * j + 4 * hi;
            const u32x2 g = *(const u32x2*)(Gp + (size_t)q * p.ldg + d);
            const float g0 = bflo(g.x), g1 = bfhi(g.x), g2 = bflo(g.y), g3 = bfhi(g.y);
            const float o0 = ot[dh][4 * j + 0] * inv * (g0 / (1.f + __expf(-g0)));
            const float o1 = ot[dh][4 * j + 1] * inv * (g1 / (1.f + __expf(-g1)));
            const float o2 = ot[dh][4 * j + 2] * inv * (g2 / (1.f + __expf(-g2)));
            const float o3 = ot[dh][4 * j + 3] * inv * (g3 / (1.f + __expf(-g3)));
            u32x2 w; w.x = cvtpk(o0, o1); w.y = cvtpk(o2, o3);
            *(u32x2*)(Op + (size_t)q * p.ldo + d) = w;
        }
#undef AT_DMA
}

#define XB_TMO      128
#define XB_XCNT(j)  (256  + 64 * (j))
#define XB_XSUB(j)  (1280 + 64 * (j))
#define XB_XGEN(j)  (2304 + 64 * (j))
#define XB_TOP      3328
#define XB_TOPGEN   3392
#define XCD_BAR_WORDS 3456
#define XB_SPIN_CAP (1u << 18)

__device__ __forceinline__ unsigned xb_ld(unsigned* p)              { return __hip_atomic_load(p, __ATOMIC_RELAXED, __HIP_MEMORY_SCOPE_AGENT); }
__device__ __forceinline__ unsigned xb_add(unsigned* p, unsigned v) { return __hip_atomic_fetch_add(p, v, __ATOMIC_RELAXED, __HIP_MEMORY_SCOPE_AGENT); }
__device__ __forceinline__ unsigned xb_xcc_id() { return (unsigned)__builtin_amdgcn_s_getreg((3 << 11) | 20) & 0xFu; }
#define XB_SPIN(cond, bar) do { unsigned _sp = 0; while (cond) { __builtin_amdgcn_s_sleep(1); \
    if ((++_sp & 255u) == 0u) { if (xb_ld(&(bar)[XB_TMO])) break; if (_sp > XB_SPIN_CAP) { atomicAdd(&(bar)[XB_TMO], 1u); break; } } } } while (0)

struct XcdBarrier {
    unsigned* bar; unsigned x;
    volatile LAS unsigned* st;
};

__device__ __forceinline__ XcdBarrier xcd_barrier_post(unsigned* bar, volatile LAS unsigned* st) {
    XcdBarrier b; b.bar = bar; b.x = xb_xcc_id(); b.st = st;
    if (threadIdx.x == 0) (void)xb_add(&bar[XB_XCNT(b.x)], 1u);
    return b;
}
__device__ __forceinline__ void xcd_barrier_complete(unsigned* bar, unsigned x, unsigned& nloc, unsigned& nx) {
    const unsigned G = gridDim.x * gridDim.y * gridDim.z;
    unsigned sum, cnt, mine, sp = 0u;
    for (;;) {
        sum = 0u; cnt = 0u; mine = 0u;
#pragma unroll
        for (unsigned j = 0; j < 16; ++j) { const unsigned c = xb_ld(&bar[XB_XCNT(j)]); sum += c; cnt += (c > 0u) ? 1u : 0u; mine = (j == x) ? c : mine; }
        if (sum == G) break;
        __builtin_amdgcn_s_sleep(1);
        if ((++sp & 255u) == 0u) { if (xb_ld(&bar[XB_TMO])) break; if (sp > XB_SPIN_CAP) { atomicAdd(&bar[XB_TMO], 1u); break; } }
    }
    nloc = mine > 0u ? mine : 1u; nx = cnt > 0u ? cnt : 1u;
}

__device__ __forceinline__ void xcd_barrier(const XcdBarrier& b) {
    asm volatile("s_waitcnt vmcnt(0)" ::: "memory");
    __syncthreads();
    if (threadIdx.x == 0) {
        unsigned* bar = b.bar;
        __builtin_amdgcn_s_waitcnt(0);
        unsigned nloc = b.st[0], nx = b.st[1];
        if (nloc == 0u) { xcd_barrier_complete(bar, b.x, nloc, nx); b.st[0] = nloc; b.st[1] = nx; }
        const unsigned old = xb_add(&bar[XB_XSUB(b.x)], 1u);
        const unsigned gen = old / nloc;
        if (old + 1u == (gen + 1u) * nloc) {
            __builtin_amdgcn_fence(__ATOMIC_RELEASE, "agent");
            asm volatile("s_waitcnt vmcnt(0)" ::: "memory");
            const unsigned og = xb_add(&bar[XB_TOP], 1u);
            const unsigned tg = og / nx;
            if (og + 1u == (tg + 1u) * nx) xb_add(&bar[XB_TOPGEN], 1u);
            else XB_SPIN(xb_ld(&bar[XB_TOPGEN]) == tg, bar);
            __builtin_amdgcn_fence(__ATOMIC_ACQUIRE, "agent");
            xb_add(&bar[XB_XGEN(b.x)], 1u);
            asm volatile("s_waitcnt vmcnt(0)" ::: "memory");
        } else {
            XB_SPIN(xb_ld(&bar[XB_XGEN(b.x)]) == gen, bar);
            __builtin_amdgcn_fence(__ATOMIC_ACQUIRE, "agent");
            asm volatile("s_waitcnt vmcnt(0)" ::: "memory");
        }
    }
    __syncthreads();
}

struct Args { const float* in[15]; const int* pos; float* out; unsigned char* ws; int ph_lo, ph_hi; };

__device__ __forceinline__ void transpose_item(const float* W, int ldw, int col0, int k0, bf16* WT, int ldt, int row_off, LAS float* scr, int lane) {
#pragma unroll 8
    for (int i = 0; i < 32; ++i) { const int kk = 2 * i + (lane >> 5); scr[kk * 33 + (lane & 31)] = W[(size_t)(k0 + kk) * ldw + col0 + (lane & 31)]; }
    asm volatile("s_waitcnt lgkmcnt(0)" ::: "memory");
    const int c = lane & 7;
#pragma unroll
    for (int j = 0; j < 4; ++j) { const int n = (lane >> 3) + 8 * j; const LAS float* s = scr + (8 * c) * 33 + n;
        u32x4 o; o.x = cvtpk(s[0 * 33], s[1 * 33]); o.y = cvtpk(s[2 * 33], s[3 * 33]); o.z = cvtpk(s[4 * 33], s[5 * 33]); o.w = cvtpk(s[6 * 33], s[7 * 33]);
        *(u32x4*)(WT + (size_t)(row_off + n) * ldt + k0 + 8 * c) = o; }
    asm volatile("s_waitcnt lgkmcnt(0)" ::: "memory");
}

__device__ __forceinline__ void rms_row_to_bf16(const float* xrow, const float* g, bf16* orow, int lane) {
    const f32x4* xr = (const f32x4*)xrow + lane; const f32x4* gr = (const f32x4*)g + lane;
    f32x4 v[4]; float s = 0.f;
#pragma unroll
    for (int j = 0; j < 4; ++j) { v[j] = xr[64 * j]; s += (v[j].x * v[j].x + v[j].y * v[j].y) + (v[j].z * v[j].z + v[j].w * v[j].w); }
    const float rs = 1.f / sqrtf(wave_sum(s) * (1.f / DM) + EPS);
    u32x2* o8 = (u32x2*)orow + lane;
#pragma unroll
    for (int j = 0; j < 4; ++j) { const f32x4 gg = gr[64 * j]; u32x2 w; w.x = cvtpk(v[j].x * rs * gg.x, v[j].y * rs * gg.y); w.y = cvtpk(v[j].z * rs * gg.z, v[j].w * rs * gg.w); o8[64 * j] = w; }
}

template <bool COOP>
__global__ void __launch_bounds__(NTHREADS, 2) mk_fwd(Args args) {
    extern __shared__ __attribute__((aligned(16))) unsigned char lds_raw[];
    LAS unsigned char* lds = (LAS unsigned char*)lds_raw;
    const int tid = threadIdx.x, lane = tid & 63, wave = __builtin_amdgcn_readfirstlane(tid >> 6);
    const int G = gridDim.x, bx = blockIdx.x;
    const int vcu = (G % 8 == 0) ? (bx % 8) * (G / 8) + bx / 8 : bx;
    const int gw = vcu * NWAVES + wave, NGW = G * NWAVES;
    unsigned char* ws = args.ws;
    const float* x = args.in[0];
    bf16* Wt0 = (bf16*)(ws + WS_WT0); bf16* Wqup = (bf16*)(ws + WS_WQUP); bf16* Wkvup = (bf16*)(ws + WS_WKVUP); bf16* Wout0 = (bf16*)(ws + WS_WOUT0);
    bf16* Wt1 = (bf16*)(ws + WS_WT1); bf16* Wout1 = (bf16*)(ws + WS_WOUT1);
    bf16* XN = (bf16*)(ws + WS_XN); bf16* OG = (bf16*)(ws + WS_OG); float* LF = (float*)(ws + WS_LF); float* LC = (float*)(ws + WS_LC); float* CS = (float*)(ws + WS_CS); float* TMAXB = (float*)(ws + WS_TMAX);
    bf16* Z0 = (bf16*)(ws + WS_Z0); bf16* Z1 = (bf16*)(ws + WS_Z1); bf16* CQN = (bf16*)(ws + WS_CQN); bf16* CKVN = (bf16*)(ws + WS_CKVN); bf16* KPE = (bf16*)(ws + WS_KPE);
    bf16* D0 = (bf16*)(ws + WS_D0); bf16* Q0 = (bf16*)(ws + WS_Q0); bf16* KN = (bf16*)(ws + WS_KN); bf16* VM = (bf16*)(ws + WS_VM);
    float* out = args.out;
    const int lo = args.ph_lo, hi_ph = args.ph_hi;
#ifndef REPMASK
#define REPMASK 0
#endif
#define NREP(k) (1 + (((REPMASK) >> (k)) & 1))
#ifndef PHMASK
#define PHMASK 0xfff
#endif
#define IN(k) ((((PHMASK) >> (k)) & 1) && lo <= (k) && (k) < hi_ph)
#define SEAM(k) do { if constexpr (COOP) { if (IN(k) && IN((k) + 1)) { if ((k) == 0) { cg::this_grid().sync(); xbar = xcd_barrier_post(barw, (volatile LAS unsigned*)(lds + LDS_MISC)); } else { xcd_barrier(xbar); } } } } while (0)
    unsigned* qctr = (unsigned*)(ws + 256 * 1024);
    unsigned* barw = (unsigned*)ws;
    XcdBarrier xbar; xbar.bar = barw; xbar.x = 0; xbar.st = (volatile LAS unsigned*)(lds + LDS_MISC);
    if constexpr (COOP) {
        if (tid < 16) ((LAS unsigned*)(lds + LDS_MISC))[tid] = 0u;
        if (bx == 0) { for (int i = tid; i < XCD_BAR_WORDS; i += NTHREADS) barw[i] = 0u; for (int i = tid; i < 16 * 64; i += NTHREADS) qctr[i] = 0u; for (int i = tid; i < 2 * 64 * 64; i += NTHREADS) ((unsigned*)(ws + 64 * 1024))[i] = 0u; }
        __syncthreads();
    }

    if (IN(0)) {
        LAS float* scr = (LAS float*)(lds + wave * 16384);
        constexpr int I_A = 16 * 69, I_B = 4 * 24, I_C = 2 * 32, I_D = 16 * 32, I_E1 = 16 * 96, I_E2 = 16 * 32, I_F = 16 * 32;
        constexpr int NIT = I_A + I_B + I_C + I_D + I_E1 + I_E2 + I_F;
        for (int it = gw; it < NIT; it += NGW) {
            int r = it;
            if (r < I_A) { const int kb = r / 69, nb = r % 69; transpose_item(args.in[3], N0, 32 * nb, 64 * kb, Wt0, 1024, 32 * nb, scr, lane); continue; } r -= I_A;
            if (r < I_B) { const int kb = r / 24, nb = r % 24; transpose_item(args.in[5], 768, 32 * nb, 64 * kb, Wqup, 256, 32 * nb, scr, lane); continue; } r -= I_B;
            if (r < I_C) { const int kb = r / 32, nb = r % 32; const int n0 = 32 * nb, h = n0 >> 7, j0 = n0 & 127; const int dst = (j0 < 64) ? (h * 64 + j0) : (512 + h * 64 + (j0 - 64));
                           transpose_item(args.in[7], 1024, n0, 64 * kb, Wkvup, 256, dst, scr, lane); continue; } r -= I_C;
            if (r < I_D) { const int kb = r / 32, nb = r % 32; transpose_item(args.in[9], 1024, 32 * nb, 64 * kb, Wout0, 1024, 32 * nb, scr, lane); continue; } r -= I_D;
            if (r < I_E1) { const int kb = r / 96, nb = r % 96; transpose_item(args.in[11], N1W, 32 * nb, 64 * kb, Wt1, 1024, 32 * nb, scr, lane); continue; } r -= I_E1;
            if (r < I_E2) { const int kb = r / 32, nb = r % 32; transpose_item(args.in[11], N1W, W1_G + 32 * nb, 64 * kb, Wt1, 1024, C1_G + 32 * nb, scr, lane); continue; } r -= I_E2;
            { const int kb = r / 32, nb = r % 32; transpose_item(args.in[13], 1024, 32 * nb, 64 * kb, Wout1, 1024, 32 * nb, scr, lane); }
        }
        { const u32x4 z = {0u, 0u, 0u, 0u};
          u32x4* p0 = (u32x4*)(Wt0 + (size_t)N0 * 1024);
          for (int i = vcu * NTHREADS + tid; i < 96 * 1024 / 8; i += G * NTHREADS) p0[i] = z;
          for (int i = vcu * NTHREADS + tid; i < 1024 * 16; i += G * NTHREADS) { const int row = i >> 4, c = i & 15; *(u32x4*)(Wkvup + (size_t)row * 256 + 128 + c * 8) = z; } }
        for (int m0 = gw; m0 < M; m0 += 4 * NGW) {
            f32x4 v[4][4]; float ss[4];
#pragma unroll
            for (int r = 0; r < 4; ++r) { const int m = m0 + r * NGW, mc = (m < M) ? m : (M - 1); const f32x4* xr = (const f32x4*)(x + (size_t)mc * DM) + lane;
#pragma unroll
                for (int j = 0; j < 4; ++j) v[r][j] = xr[64 * j]; }
#pragma unroll
            for (int r = 0; r < 4; ++r) { ss[r] = 0.f;
#pragma unroll
                for (int j = 0; j < 4; ++j) ss[r] += (v[r][j].x * v[r][j].x + v[r][j].y * v[r][j].y) + (v[r][j].z * v[r][j].z + v[r][j].w * v[r][j].w); }
#pragma unroll
            for (int o = 1; o < 64; o <<= 1) {
#pragma unroll
                for (int r = 0; r < 4; ++r) ss[r] += __shfl_xor(ss[r], o); }
            const f32x4* gr = (const f32x4*)args.in[2] + lane;
#pragma unroll
            for (int r = 0; r < 4; ++r) { const int m = m0 + r * NGW;
                if (m < M) { const float rs = 1.f / sqrtf(ss[r] * (1.f / DM) + EPS); u32x2* o8 = (u32x2*)(XN + (size_t)m * DM) + lane;
#pragma unroll
                    for (int j = 0; j < 4; ++j) { const f32x4 gg = gr[64 * j]; u32x2 w; w.x = cvtpk(v[r][j].x * rs * gg.x, v[r][j].y * rs * gg.y); w.y = cvtpk(v[r][j].z * rs * gg.z, v[r][j].w * rs * gg.w); o8[64 * j] = w; } } }
        }
    }
    SEAM(0);
    if (IN(1)) {
        __syncthreads();
        pg8::Gemm g{XN, Wt0, M, N0P, 1024}; pg8::StaticOrder S; S.init(M, N0P, G, bx);
        pg8::EpiBf16<0> E{Z0, N0P, nullptr, 0, 0, 1.f};
        for (int rep = 0; rep < NREP(1); ++rep) {
        pg8::gemm_phase<pg8::EpiBf16<0>, pg8::StaticOrder, true, true>(lds, g, S, E); __syncthreads(); }
    }
    SEAM(1);
    if (IN(2)) {
        const float* gq = args.in[4]; const float* gkv = args.in[6];
        const f32x4 ga = *(const f32x4*)(gq + 4 * lane); const f32x2 gb = *(const f32x2*)(gkv + 2 * lane);
        const float invf = (float)exp2(-(double)(lane & 15) * 0.8304820237218406);
        for (int m0 = gw; m0 < M; m0 += 4 * NGW) {
            u32x2 a[4]; unsigned bb[4]; float px1[4], px2[4]; int ps[4]; float sa[4], sb[4];
#pragma unroll
            for (int r = 0; r < 4; ++r) { const int m = m0 + r * NGW, mc = (m < M) ? m : (M - 1); const bf16* z = Z0 + (size_t)mc * N0P;
                a[r] = *(const u32x2*)(z + C_CQ + 4 * lane); bb[r] = *(const unsigned*)(z + C_CKV + 2 * lane);
                px1[r] = bf1(z[C_KPE + (lane & 15)]); px2[r] = bf1(z[C_KPE + 16 + (lane & 15)]); ps[r] = args.pos[mc]; }
#pragma unroll
            for (int r = 0; r < 4; ++r) { const float a0 = bflo(a[r].x), a1 = bfhi(a[r].x), a2 = bflo(a[r].y), a3 = bfhi(a[r].y), b0 = bflo(bb[r]), b1 = bfhi(bb[r]);
                sa[r] = (a0 * a0 + a1 * a1) + (a2 * a2 + a3 * a3); sb[r] = b0 * b0 + b1 * b1; }
#pragma unroll
            for (int o = 1; o < 64; o <<= 1) {
#pragma unroll
                for (int r = 0; r < 4; ++r) { sa[r] += __shfl_xor(sa[r], o); sb[r] += __shfl_xor(sb[r], o); } }
#pragma unroll
            for (int r = 0; r < 4; ++r) { const int m = m0 + r * NGW;
                if (m < M) {
                    const float a0 = bflo(a[r].x), a1 = bfhi(a[r].x), a2 = bflo(a[r].y), a3 = bfhi(a[r].y), b0 = bflo(bb[r]), b1 = bfhi(bb[r]);
                    const float ra = 1.f / sqrtf(sa[r] * (1.f / 256.f) + EPS), rb = 1.f / sqrtf(sb[r] * (1.f / 128.f) + EPS);
                    u32x2 w; w.x = cvtpk(a0 * ra * ga.x, a1 * ra * ga.y); w.y = cvtpk(a2 * ra * ga.z, a3 * ra * ga.w);
                    *(u32x2*)(CQN + (size_t)m * 256 + 4 * lane) = w;
                    *(unsigned*)(CKVN + (size_t)m * 256 + 2 * lane) = cvtpk(b0 * rb * gb.x, b1 * rb * gb.y);
                    *(unsigned*)(CKVN + (size_t)m * 256 + 128 + 2 * lane) = 0u;
                    if (lane < 16) {
                        const double ang = (double)(float)ps[r] * (double)invf;
                        const double rev = ang * 0.15915494309189535;
                        const float rr = (float)(rev - rint(rev));
                        const float cv = __builtin_amdgcn_cosf(rr), sv = __builtin_amdgcn_sinf(rr);
                        CS[(size_t)m * 32 + lane] = cv; CS[(size_t)m * 32 + 16 + lane] = sv;
                        const unsigned o1 = cvtpk(px1[r] * cv - px2[r] * sv, 0.f), o2 = cvtpk(px2[r] * cv + px1[r] * sv, 0.f);
                        KPE[(size_t)m * 32 + lane] = (bf16)(o1 & 0xffffu); KPE[(size_t)m * 32 + 16 + lane] = (bf16)(o2 & 0xffffu);
                    } } }
        }
    }
    SEAM(2);
    if (IN(3)) {
        __syncthreads();
#ifndef NO_QUP
        { int kq_ = 256; asm volatile("" : "+s"(kq_)); pg8::Gemm g{CQN, Wqup, M, 768, kq_}; pg8::StaticOrder S; S.init(M, 768, G, bx);
          pg8::EpiQRope E{Q0, 768, CS};
          pg8::gemm_phase<pg8::EpiQRope, pg8::StaticOrder, true, true>(lds, g, S, E); }
#endif
        __syncthreads();
#ifndef NO_KVUP
        { int kk_ = 256; asm volatile("" : "+s"(kk_)); pg8::Gemm g{CKVN, Wkvup, M, 1024, kk_}; pg8::StaticOrder S; S.init(M, 1024, G, bx);
          pg8::EpiBf16<0> E{KN, 512, nullptr, 512, (size_t)(WS_VM - WS_KN) / 2, 1.f, 3u, 8};
          pg8::gemm_phase<pg8::EpiBf16<0>, pg8::StaticOrder, true, true>(lds, g, S, E); }
#endif
    }
    SEAM(3);
    if (IN(4)) {
        __syncthreads();
        for (;;) {
            if (tid == 0) *(volatile LAS int*)(lds + LDS_MISC + 64) = (int)atomicAdd(qctr + 64 * (bx & 7), 1u);
            __syncthreads();
            const int tk = *(volatile LAS int*)(lds + LDS_MISC + 64);
            __syncthreads();
            if (tk >= 128) break;
            const bool swa = tk >= 64;
            AttnP p; p.sinkp = args.in[8]; p.h0 = 0;
            if (!swa) {
                const int bh = 8 * (bx & 7) + (tk >> 3), s = tk & 7, b = bh >> 3, h = bh & 7; const size_t rb = (size_t)b * SEQ;
                p.Q = Q0 + rb * 768 + h * 96; p.ldq = 768; p.K = KN + (size_t)bh * SEQ * 64; p.ldk = 64; p.K2 = KPE + rb * 32; p.ldk2 = 32; p.V = VM + (size_t)bh * SEQ * 64; p.ldv = 64;
                p.G = Z0 + rb * N0P + C_G0 + h * 64; p.ldg = N0P; p.O = OG + rb * 1024 + h * 64; p.ldo = 1024; p.lc = nullptr; p.tmax = nullptr; p.c = 0.10206207261596575f * LOG2E; p.sink2 = 0.f; p.slope2 = 0.f;
                attn_unit<96, 0>(p, (15 - s) * 256, lds); attn_unit<96, 0>(p, s * 256, lds);
            } else {
                const int j = tk - 64, pkv = 2 * (bx & 7) + (j >> 5), b = pkv >> 1, kvh = pkv & 1, qb = 2 * (j & 31); const size_t rb = (size_t)b * SEQ;
                p.Q = Z0 + rb * N0P + C_QS + kvh * 256; p.ldq = N0P; p.K = Z0 + rb * N0P + C_KS + kvh * 64; p.ldk = N0P; p.K2 = nullptr; p.ldk2 = 0; p.V = Z0 + rb * N0P + C_VS + kvh * 64; p.ldv = N0P;
                p.G = Z0 + rb * N0P + C_G0 + 512 + kvh * 256; p.ldg = N0P; p.O = OG + rb * 1024 + 512 + kvh * 256; p.ldo = 1024; p.lc = nullptr; p.tmax = nullptr; p.c = 0.125f * LOG2E;
                p.sink2 = 0.f; p.slope2 = 0.f; p.h0 = 4 * kvh;
                attn_unit<64, 1>(p, qb * 64, lds); attn_unit<64, 1>(p, (qb + 1) * 64, lds);
            }
        }
    }
    SEAM(4);
    if (IN(5)) {
        __syncthreads();
        pg8::Gemm g{OG, Wout0, M, 1024, 1024}; pg8::StaticOrder S; S.init(M, 1024, G, bx);
        pg8::EpiBf16<0> E{D0, 1024, nullptr, 0, 0, 1.f};
        pg8::gemm_phase<pg8::EpiBf16<0>, pg8::StaticOrder, true, true>(lds, g, S, E);
    }
    SEAM(5);
    if (IN(6)) {
        __syncthreads();
        const float* g1 = args.in[10]; const float* w1 = args.in[11]; const float* bfp = args.in[12];
        LAS float* WF = (LAS float*)lds;
        for (int k = tid; k < 1024; k += NTHREADS) {
            const int l = (k & 255) >> 2, j = k >> 8, e = k & 3; const int R = l + 64 * (4 * j + e); const float gk = g1[k];
#pragma unroll
            for (int c = 0; c < 4; ++c) { const f32x4 wv = *(const f32x4*)(w1 + (size_t)k * N1W + W1_F + 4 * c); *(LAS f32x4*)(WF + R * 20 + 4 * c) = wv * gk; }
        }
        __syncthreads();
        for (int m = gw; m < M; m += NGW) {
            const f32x4* xr = (const f32x4*)(x + (size_t)m * DM) + lane; const f32x4* gr = (const f32x4*)g1 + lane; const u32x2* dr = (const u32x2*)(D0 + (size_t)m * DM) + lane;
            f32x4 v[4]; float ss = 0.f;
#pragma unroll
            for (int j = 0; j < 4; ++j) { const u32x2 dd = dr[64 * j]; v[j] = xr[64 * j]; v[j].x += bflo(dd.x); v[j].y += bfhi(dd.x); v[j].z += bflo(dd.y); v[j].w += bfhi(dd.y); ss += (v[j].x * v[j].x + v[j].y * v[j].y) + (v[j].z * v[j].z + v[j].w * v[j].w); }
            const float rs = 1.f / sqrtf(wave_sum(ss) * (1.f / DM) + EPS);
            u32x2* o8 = (u32x2*)(XN + (size_t)m * DM) + lane;
            float fa[16];
#pragma unroll
            for (int n = 0; n < 16; ++n) fa[n] = 0.f;
#pragma unroll
            for (int j = 0; j < 4; ++j) { const f32x4 gg = gr[64 * j]; u32x2 w; w.x = cvtpk(v[j].x * rs * gg.x, v[j].y * rs * gg.y); w.y = cvtpk(v[j].z * rs * gg.z, v[j].w * rs * gg.w); o8[64 * j] = w;
#pragma unroll
                for (int e = 0; e < 4; ++e) { const float xv = v[j][e]; const LAS float* wr_ = WF + (lane + 64 * (4 * j + e)) * 20;
#pragma unroll
                    for (int c = 0; c < 4; ++c) { const f32x4 wv = *(const LAS f32x4*)(wr_ + 4 * c); fa[4 * c + 0] += xv * wv.x; fa[4 * c + 1] += xv * wv.y; fa[4 * c + 2] += xv * wv.z; fa[4 * c + 3] += xv * wv.w; }
                    asm volatile("" ::: "memory"); } }
            const bool b5 = (lane & 32) != 0, b4 = (lane & 16) != 0, b3 = (lane & 8) != 0, b2 = (lane & 4) != 0;
            float r8[8], r4[4], r2[2];
#pragma unroll
            for (int i = 0; i < 8; ++i) { const float snd = b5 ? fa[i] : fa[8 + i]; r8[i] = (b5 ? fa[8 + i] : fa[i]) + __shfl_xor(snd, 32); }
#pragma unroll
            for (int i = 0; i < 4; ++i) { const float snd = b4 ? r8[i] : r8[4 + i]; r4[i] = (b4 ? r8[4 + i] : r8[i]) + __shfl_xor(snd, 16); }
#pragma unroll
            for (int i = 0; i < 2; ++i) { const float snd = b3 ? r4[i] : r4[2 + i]; r2[i] = (b3 ? r4[2 + i] : r4[i]) + __shfl_xor(snd, 8); }
            float mine = (b2 ? r2[1] : r2[0]) + __shfl_xor(b2 ? r2[0] : r2[1], 4);
            mine += __shfl_xor(mine, 1); mine += __shfl_xor(mine, 2);
            if ((lane & 3) == 0) { const int n = (lane >> 2) & 15; const float f = mine * rs + bfp[n]; const float lsg = fminf(f, 0.f) - log1pf(expf(-fabsf(f))); LF[(size_t)m * 16 + n] = lsg; }
        }
    }
    SEAM(6);
    if (IN(7)) {
        __syncthreads();
        LAS float* sm = (LAS float*)lds;
        for (int bh = bx; bh < 128; bh += G) {
            const int b = bh >> 4, h = bh & 15; float v[8]; float run = 0.f;
#pragma unroll
            for (int e = 0; e < 8; ++e) { run += LF[((size_t)b * SEQ + 8 * tid + e) * 16 + h]; v[e] = run; }
            float sc = run;
#pragma unroll
            for (int o = 1; o < 64; o <<= 1) { const float n = __shfl_up(sc, o); if (lane >= o) sc += n; }
            if (lane == 63) sm[wave] = sc;
            __syncthreads();
            float off = sc - run;
            for (int w = 0; w < wave; ++w) off += sm[w];
            f32x4 o0 = {(v[0] + off) * LOG2E, (v[1] + off) * LOG2E, (v[2] + off) * LOG2E, (v[3] + off) * LOG2E}, o1 = {(v[4] + off) * LOG2E, (v[5] + off) * LOG2E, (v[6] + off) * LOG2E, (v[7] + off) * LOG2E};
            *(f32x4*)(LC + (size_t)bh * SEQ + 8 * tid) = o0; *(f32x4*)(LC + (size_t)bh * SEQ + 8 * tid + 4) = o1;
            __syncthreads();
        }
        pg8::Gemm g{XN, Wt1, M, N1, 1024}; pg8::StaticOrder S; S.init(M, N1, G, bx);
        pg8::EpiBf16<0> E{Z1, 1024, nullptr, 1024, (size_t)M * 1024, 1.f, 6u, 16};
        pg8::gemm_phase<pg8::EpiBf16<0>, pg8::StaticOrder, true, true>(lds, g, S, E);
        __syncthreads();
        { pg8::Unit u; LAS float* smx = (LAS float*)lds; pg8::StaticOrder S2; S2.init(M, N1, G, bx);
          for (int i = 0; S2.next(i, u); ++i) {
            if (u.pn < 4 || u.pn >= 8) continue;
            const int b = u.pm >> 4, T0 = 4 * (u.pm & 15), h0 = 4 * (u.pn - 4);
            for (int st = 0; st < 4; ++st) {
                const bf16* kbase = Z1 + (size_t)M * 1024 + ((((size_t)(b * 16 + h0 + ((tid & 31) >> 3))) * SEQ + (size_t)(u.pm & 15) * 256 + 64 * st + (tid >> 5)) << 6) + (tid & 7) * 8;
                float mxn = 0.f;
#pragma unroll
                for (int j = 0; j < 4; ++j) {
                    const u32x4 v = *(const u32x4*)(kbase + (size_t)(16 * j) * 64);
                    float s = 0.f;
#pragma unroll
                    for (int e = 0; e < 4; ++e) { const float a = bflo(v[e]), c = bfhi(v[e]); s += a * a + c * c; }
                    s += __shfl_xor(s, 1); s += __shfl_xor(s, 2); s += __shfl_xor(s, 4);
                    mxn = fmaxf(mxn, s);
                }
                if ((tid & 7) == 0) smx[(tid >> 5) * 4 + ((tid & 31) >> 3)] = mxn;
                __syncthreads();
                if (tid < 4) { float m16 = 0.f;
#pragma unroll
                    for (int r = 0; r < 16; ++r) m16 = fmaxf(m16, smx[r * 4 + tid]);
                    TMAXB[((size_t)(b * 16 + h0 + tid)) * 64 + T0 + st] = sqrtf(m16); }
                __syncthreads();
            }
          } }
    }
    SEAM(7);
    if (IN(9)) {
        __syncthreads();
        for (;;) {
            if (tid == 0) *(volatile LAS int*)(lds + LDS_MISC + 64) = (int)atomicAdd(qctr + 64 * (8 + (bx & 7)), 1u);
            __syncthreads();
            const int tk = *(volatile LAS int*)(lds + LDS_MISC + 64);
            __syncthreads();
            if (tk >= 128) break;
            const int bh = 16 * (bx & 7) + (tk >> 3), s = tk & 7, b = bh >> 4, h = bh & 15; const size_t rb = (size_t)b * SEQ;
            AttnP p;
            p.Q = Z1 + rb * 1024 + h * 64; p.ldq = 1024; p.K = Z1 + (size_t)M * 1024 + (size_t)bh * SEQ * 64; p.ldk = 64; p.K2 = nullptr; p.ldk2 = 0; p.V = Z1 + (size_t)2 * M * 1024 + (size_t)bh * SEQ * 64; p.ldv = 64;
            p.G = Z1 + (size_t)3 * M * 1024 + rb * 1024 + h * 64; p.ldg = 1024; p.O = OG + rb * 1024 + h * 64; p.ldo = 1024; p.lc = LC + (size_t)bh * SEQ; p.tmax = TMAXB + (size_t)bh * 64; p.sinkp = args.in[8]; p.h0 = 0; p.c = 0.125f * LOG2E; p.sink2 = 0.f; p.slope2 = 0.f;
            attn_unit<64, 2>(p, (15 - s) * 256, lds); attn_unit<64, 2>(p, s * 256, lds);
        }
    }
    SEAM(9);
    if (IN(10)) {
        __syncthreads();
        for (int sub = 0; sub < 2; ++sub) {
            const size_t r0 = (size_t)sub * 16384;
            pg8::Gemm g{OG + r0 * 1024, Wout1, 16384, 1024, 1024}; pg8::StaticOrder S; S.init(16384, 1024, G, bx);
            pg8::PanelRms st{(float*)(ws + WS_LF) + (size_t)sub * 16384 * 4, (unsigned*)(ws + 64 * 1024) + sub * 64 * 64, EPS};
            pg8::EpiRmsOut E{x + r0 * 1024, D0 + r0 * 1024, out + r0 * 1024, args.in[14], 1024, st};
            pg8::gemm_phase<pg8::EpiRmsOut, pg8::StaticOrder, false, true>(lds, g, S, E);
            __syncthreads();
        }
    }
#undef IN
#undef SEAM
}

constexpr int NPHASES = 11;
extern "C" void kernel_launch(void* const* d_in, const int* in_sizes, int n_in, void* d_out, int out_size, void* d_ws, size_t ws_size, hipStream_t stream) {
    static int grid = 0;
    if (grid == 0) {
        if (n_in != 15 || out_size != M * DM || ws_size < WS_END) { fprintf(stderr, "kernel_launch: unexpected shapes (n_in %d, out %d, ws %zu)\n", n_in, out_size, ws_size); grid = -1; return; }
        int dev = 0, cus = 0, per_cu = 0;
        (void)hipGetDevice(&dev); (void)hipDeviceGetAttribute(&cus, hipDeviceAttributeMultiprocessorCount, dev);
#if MK_COOP
        (void)hipFuncSetAttribute((const void*)mk_fwd<true>, hipFuncAttributeMaxDynamicSharedMemorySize, LDS_BYTES);
        (void)hipOccupancyMaxActiveBlocksPerMultiprocessor(&per_cu, (const void*)mk_fwd<true>, NTHREADS, LDS_BYTES);
#else
        (void)hipFuncSetAttribute((const void*)mk_fwd<false>, hipFuncAttributeMaxDynamicSharedMemorySize, LDS_BYTES);
        (void)hipOccupancyMaxActiveBlocksPerMultiprocessor(&per_cu, (const void*)mk_fwd<false>, NTHREADS, LDS_BYTES);
#endif
        (void)hipGetLastError();
        if (per_cu < 1) per_cu = 1;
        if (cus <= 0) cus = 256;
        grid = cus * 1;
    }
    if (grid < 0) return;
    Args a{};
    for (int i = 0; i < 15; ++i) a.in[i] = (const float*)d_in[i];
    a.pos = (const int*)d_in[1]; a.out = (float*)d_out; a.ws = (unsigned char*)d_ws;
#if MK_COOP
    a.ph_lo = 0; a.ph_hi = NPHASES;
    void* kargs[] = {&a};
    hipError_t e = hipLaunchCooperativeKernel((const void*)mk_fwd<true>, dim3(grid), dim3(NTHREADS), kargs, LDS_BYTES, stream);
    if (e != hipSuccess) fprintf(stderr, "cooperative launch failed: %s (grid %d)\n", hipGetErrorString(e), grid);
#else
    for (int ph = 0; ph < NPHASES; ++ph) { a.ph_lo = ph; a.ph_hi = ph + 1; hipLaunchKernelGGL(mk_fwd<false>, dim3(grid), dim3(NTHREADS), LDS_BYTES, stream, a); }
#endif
}
```

```cpp
#include <hip/hip_runtime.h>
#include <hip/hip_cooperative_groups.h>
#include <cstdio>
#include <cstdint>
#include <cmath>
namespace cg = cooperative_groups;
#ifndef MK_COOP
#define MK_COOP 1
#endif
namespace pg8 {
#define PG8_LAS __attribute__((address_space(3)))
typedef unsigned short bf16_t;
typedef short bf16x8 __attribute__((ext_vector_type(8)));
typedef float f32x4 __attribute__((ext_vector_type(4)));
typedef unsigned u32x4 __attribute__((ext_vector_type(4)));
constexpr int BM = 256, BK = 64, HALF = 128, HTB = HALF * BK * 2  , STAGE_BYTES = 8 * HTB, NXCD = 8, WGM = 8;

__host__ __device__ __forceinline__ int lds_byte(int r, int c) { const int st = (r >> 4) * 2 + (c >> 5), rr = r & 15, cc = c & 31, ob = rr * 64 + cc * 2; return st * 1024 + (ob ^ (((ob >> 9) & 1) << 5)); }
__host__ __device__ __forceinline__ void stage_rc(int b, int& R, int& C) { const int st = b / 1024, sb = b % 1024, swz = sb ^ (((sb >> 9) & 1) << 5); R = (st >> 1) * 16 + swz / 64; C = (st & 1) * 32 + (swz % 64) / 2; }
__host__ __device__ __forceinline__ int perm32(int rho) { const int n = rho >> 4, i = rho & 15; return 8 * (i >> 2) + 4 * n + (i & 3); }

struct Unit { int pm, pn; };
struct Gemm { const bf16_t* A; const bf16_t* Bt; int M, N, K; };

struct StaticOrder {
    int nM, nN, nwg, G, c;
    __host__ __device__ __forceinline__ void init(int M, int N, int G_, int c_) { nM = M / BM; nN = N / BM; nwg = nM * nN; G = G_; c = c_; }
    __host__ __device__ __forceinline__ bool next(int i, Unit& u) const {
        const long L = (long)i * G + c; if (L >= nwg) return false;
        int wgid = (int)L; { const int q = nwg / NXCD, r = nwg % NXCD, xcd = wgid % NXCD, off = wgid / NXCD; wgid = (xcd < r ? xcd * (q + 1) : r * (q + 1) + (xcd - r) * q) + off; }
        const int nig = WGM * nN, gid = wgid / nig, fm = gid * WGM, gsz = (nM - fm) < WGM ? (nM - fm) : WGM;
        u.pm = fm + ((wgid % nig) % gsz); u.pn = (wgid % nig) / gsz; return true;
    }
    __device__ __forceinline__ void a_ready(const Unit&) const {}
    __device__ __forceinline__ void done(const Unit&) const {}
};

__device__ __forceinline__ unsigned cvt_pk_bf16(float lo, float hi) { unsigned r; asm volatile("v_cvt_pk_bf16_f32 %0, %1, %2" : "=v"(r) : "v"(lo), "v"(hi)); return r; }
typedef float f32x2 __attribute__((ext_vector_type(2)));
__device__ __forceinline__ f32x2 gelu_pk(f32x2 v) {
    const f32x2 av = __builtin_elementwise_abs(v), d = av * 0.2316418882f + 1.0f;
    f32x2 t; t.x = __builtin_amdgcn_rcpf(d.x); t.y = __builtin_amdgcn_rcpf(d.y);
    f32x2 q = t * 0.5307027145f + (-0.7265760135f); q = q * t + 0.7107068705f; q = q * t + (-0.142248368f); q = q * t + 0.127414796f; q = q * t;
    const f32x2 s = (v * v) * (-0.72134752044f);
    f32x2 e; e.x = __builtin_amdgcn_exp2f(s.x); e.y = __builtin_amdgcn_exp2f(s.y);
    const f32x2 m = v * (q * e), r = v - m;
    f32x2 o; o.x = v.x < 0.f ? m.x : r.x; o.y = v.y < 0.f ? m.y : r.y; return o;
}

template <int ACT  > struct EpiBf16 {
    static constexpr bool PERM = true, AFTER_DRAIN = false; static_assert(ACT == 0 || ACT == 1, "EpiBf16: ACT is 0 (none) or 1 (gelu_pk)");
    bf16_t* O; int ldc; const float* bias; int split_cols; size_t split_stride; float scale0; unsigned hm_mask; int hm_heads;
    __device__ __forceinline__ void operator()(const f32x4 (&acc)[2][2][4][2], const Unit& u, int wr, int wc, int fr, int fq) const {
        const int row0 = u.pm * BM + wr * 64 + fr; int colt = u.pn * BM; bf16_t* base = O;
        float sc = 1.f; bool hm = false; if (split_cols) { const int t = colt / split_cols; base += (size_t)t * split_stride; colt -= t * split_cols; if (t == 0) sc = scale0; hm = ((hm_mask >> t) & 1u) != 0u; }
        const int col0 = colt + wc * 32 + 8 * fq, bcol0 = u.pn * BM + wc * 32 + 8 * fq;
        f32x4 bv[2][2];
#pragma unroll
        for (int bj = 0; bj < 2; ++bj)
#pragma unroll
            for (int n = 0; n < 2; ++n) bv[bj][n] = bias ? *(const f32x4*)(bias + bcol0 + bj * HALF + 4 * n) : (f32x4){0.f, 0.f, 0.f, 0.f};
#pragma unroll
        for (int ai = 0; ai < 2; ++ai)
#pragma unroll
            for (int m = 0; m < 4; ++m) { const int rowi = row0 + ai * HALF + m * 16; bf16_t* rowp = base + (size_t)rowi * ldc + col0;
#pragma unroll
                for (int bj = 0; bj < 2; ++bj) { f32x4 v0 = acc[ai][bj][m][0] + bv[bj][0], v1 = acc[ai][bj][m][1] + bv[bj][1];
                    if (ACT == 1) { f32x2 a = gelu_pk((f32x2){v0[0], v0[1]}), b = gelu_pk((f32x2){v0[2], v0[3]}), c = gelu_pk((f32x2){v1[0], v1[1]}), d = gelu_pk((f32x2){v1[2], v1[3]});
                        v0 = (f32x4){a.x, a.y, b.x, b.y}; v1 = (f32x4){c.x, c.y, d.x, d.y}; }
                    v0 = v0 * sc; v1 = v1 * sc; u32x4 w; w.x = cvt_pk_bf16(v0[0], v0[1]); w.y = cvt_pk_bf16(v0[2], v0[3]); w.z = cvt_pk_bf16(v1[0], v1[1]); w.w = cvt_pk_bf16(v1[2], v1[3]);
                    bf16_t* dst = rowp + bj * HALF;
                    if (hm) { const int col = col0 + bj * HALF; dst = base + ((((size_t)(rowi >> 12) * hm_heads + (col >> 6)) << 18) + ((size_t)(rowi & 4095) << 6) + (col & 63)); }
                    *(u32x4*)dst = w; } }
    }
};
typedef unsigned u32x2 __attribute__((ext_vector_type(2)));
struct EpiQRope {
    static constexpr bool PERM = false, AFTER_DRAIN = false;
    bf16_t* O; int ldc; const float* cs;
    __device__ __forceinline__ void operator()(const f32x4 (&acc)[2][2][4][2], const Unit& u, int wr, int wc, int fr, int fq) const {
        const int row0 = u.pm * BM + wr * 64 + fr;
#pragma unroll
        for (int ai = 0; ai < 2; ++ai)
#pragma unroll
            for (int m = 0; m < 4; ++m) {
                const int row = row0 + ai * HALF + m * 16;
                const f32x4 cv = *(const f32x4*)(cs + (size_t)row * 32 + 4 * fq), sv = *(const f32x4*)(cs + (size_t)row * 32 + 16 + 4 * fq);
#pragma unroll
                for (int bj = 0; bj < 2; ++bj) {
                    const int colb = u.pn * BM + bj * HALF + wc * 32;
                    f32x4 v0 = acc[ai][bj][m][0], v1 = acc[ai][bj][m][1];
                    if (((colb >> 5) % 3) == 2) { const f32x4 a = v0 * cv - v1 * sv, b = v1 * cv + v0 * sv; v0 = a; v1 = b; }
                    bf16_t* rp = O + (size_t)row * ldc + colb + 4 * fq;
                    u32x2 w0, w1; w0.x = cvt_pk_bf16(v0[0], v0[1]); w0.y = cvt_pk_bf16(v0[2], v0[3]); w1.x = cvt_pk_bf16(v1[0], v1[1]); w1.y = cvt_pk_bf16(v1[2], v1[3]);
                    *(u32x2*)(rp) = w0; *(u32x2*)(rp + 16) = w1;
                }
                asm volatile("" ::: "memory");
            }
    }
};
struct EpiResF32 {
    static constexpr bool PERM = false, AFTER_DRAIN = false;
    const float* base; float* out; int ldc;
    __device__ __forceinline__ void operator()(const f32x4 (&acc)[2][2][4][2], const Unit& u, int wr, int wc, int fr, int fq) const {
        const int row0 = u.pm * BM + wr * 64 + fr, col0 = u.pn * BM + wc * 32 + 4 * fq;
#pragma unroll
        for (int ai = 0; ai < 2; ++ai)
#pragma unroll
            for (int m = 0; m < 4; ++m) {
                const size_t off = (size_t)(row0 + ai * HALF + m * 16) * ldc + col0;
#pragma unroll
                for (int bj = 0; bj < 2; ++bj)
#pragma unroll
                    for (int n = 0; n < 2; ++n) { const f32x4 b = *(const f32x4*)(base + off + bj * HALF + n * 16); *(f32x4*)(out + off + bj * HALF + n * 16) = b + acc[ai][bj][m][n]; }
                asm volatile("" ::: "memory");
            }
    }
};
struct PanelRms {
    float* xbuf;
    unsigned* cnt;
    float eps;
    __device__ __forceinline__ void run(const f32x4 (&v)[2][2][4][2], const Unit& u, int wr, int wc, int fr, int fq, PG8_LAS unsigned char* lds, int wid, int lane) const {
        PG8_LAS float* P = (PG8_LAS float*)lds;
        PG8_LAS float* S = (PG8_LAS float*)(lds + 4096);
#pragma unroll
        for (int ai = 0; ai < 2; ++ai)
#pragma unroll
            for (int m = 0; m < 4; ++m) {
                float s = 0.f;
#pragma unroll
                for (int bj = 0; bj < 2; ++bj)
#pragma unroll
                    for (int n = 0; n < 2; ++n) { const f32x4 x = v[ai][bj][m][n]; s += (x[0] * x[0] + x[1] * x[1]) + (x[2] * x[2] + x[3] * x[3]); }
                s += __shfl_xor(s, 16); s += __shfl_xor(s, 32);
                if (fq == 0) P[(ai * HALF + wr * 64 + m * 16 + fr) * 4 + wc] = s;
            }
        asm volatile("s_waitcnt lgkmcnt(0)" ::: "memory"); __builtin_amdgcn_s_barrier(); asm volatile("" ::: "memory");
        const int row = wid * 32 + (lane & 31);
        if (lane < 32) {
            const float t = (P[row * 4 + 0] + P[row * 4 + 1]) + (P[row * 4 + 2] + P[row * 4 + 3]);
            __hip_atomic_store(xbuf + ((size_t)(u.pm * BM + row) * 4 + u.pn), t, __ATOMIC_RELAXED, __HIP_MEMORY_SCOPE_AGENT);
        }
        asm volatile("s_waitcnt vmcnt(0)" ::: "memory");
        if (lane == 0) __hip_atomic_fetch_add(cnt + 64 * u.pm, 1u, __ATOMIC_RELAXED, __HIP_MEMORY_SCOPE_AGENT);
        if (wid == 0) {
            unsigned spins = 0;
            while ((unsigned)__builtin_amdgcn_readfirstlane(__hip_atomic_load(cnt + 64 * u.pm, __ATOMIC_RELAXED, __HIP_MEMORY_SCOPE_AGENT)) < 32u) { __builtin_amdgcn_s_sleep(2); if (++spins > (1u << 20)) break; }
            __builtin_amdgcn_fence(__ATOMIC_ACQUIRE, "agent");
        }
        asm volatile("s_waitcnt vmcnt(0) lgkmcnt(0)" ::: "memory"); __builtin_amdgcn_s_barrier(); asm volatile("" ::: "memory");
        if (lane < 32) {
            const float* slot = xbuf + (size_t)(u.pm * BM + row) * 4; float q = 0.f;
#pragma unroll
            for (int t = 0; t < 4; ++t) q += __hip_atomic_load(slot + t, __ATOMIC_RELAXED, __HIP_MEMORY_SCOPE_AGENT);
            S[row] = 1.0f / sqrtf(q * (1.0f / 1024.0f) + eps);
        }
        asm volatile("s_waitcnt lgkmcnt(0)" ::: "memory"); __builtin_amdgcn_s_barrier(); asm volatile("" ::: "memory");
    }
};
struct EpiRmsOut {
    static constexpr bool PERM = false, AFTER_DRAIN = true;
    const float* base; const bf16_t* dl; float* out; const float* g; int ldc; PanelRms st;
    __device__ __forceinline__ void fused(f32x4 (&acc)[2][2][4][2], const Unit& u, int wr, int wc, int fr, int fq, PG8_LAS unsigned char* lds, int wid, int lane) const {
        const PG8_LAS float* S = (const PG8_LAS float*)(lds + 4096);
        const int col0 = u.pn * BM + wc * 32 + 4 * fq;
#pragma unroll
        for (int ai = 0; ai < 2; ++ai)
#pragma unroll
            for (int m = 0; m < 4; ++m) { const size_t off = (size_t)(u.pm * BM + ai * HALF + wr * 64 + m * 16 + fr) * ldc + col0;
#pragma unroll
                for (int bj = 0; bj < 2; ++bj)
#pragma unroll
                    for (int n = 0; n < 2; ++n) { const u32x2 dd = *(const u32x2*)(dl + off + bj * HALF + n * 16); f32x4 bv = *(const f32x4*)(base + off + bj * HALF + n * 16);
                        bv[0] += __uint_as_float(dd.x << 16); bv[1] += __uint_as_float(dd.x & 0xffff0000u); bv[2] += __uint_as_float(dd.y << 16); bv[3] += __uint_as_float(dd.y & 0xffff0000u); acc[ai][bj][m][n] += bv; }
                asm volatile("" : "+v"(acc[ai][0][m][0]), "+v"(acc[ai][0][m][1]), "+v"(acc[ai][1][m][0]), "+v"(acc[ai][1][m][1]));
                if (m & 1) asm volatile("" ::: "memory"); }
        st.run(acc, u, wr, wc, fr, fq, lds, wid, lane);
#pragma unroll
        for (int bj = 0; bj < 2; ++bj)
#pragma unroll
            for (int n = 0; n < 2; ++n) { const f32x4 gv = *(const f32x4*)(g + col0 + bj * HALF + n * 16);
#pragma unroll
                for (int ai = 0; ai < 2; ++ai)
#pragma unroll
                    for (int m = 0; m < 4; ++m) { const int r = ai * HALF + wr * 64 + m * 16 + fr; const float rs = S[r];
                        *(f32x4*)(out + (size_t)(u.pm * BM + r) * ldc + col0 + bj * HALF + n * 16) = acc[ai][bj][m][n] * rs * gv; } }
    }
};
template <class Epi, class Sched, bool ALIGN_EPI = false, bool SP2 = false>
__device__ __forceinline__ void gemm_phase(PG8_LAS unsigned char* lds, const Gemm g, const Sched& S, const Epi& E) {
    const int tid = threadIdx.x, wid = __builtin_amdgcn_readfirstlane(tid >> 6), lane = tid & 63, wr = wid >> 2, wc = wid & 3, fr = lane & 15, fq = lane >> 4;
    const int K = g.K, nt = K / BK;
    unsigned voffA[2], voffB[2];
#pragma unroll
    for (int i = 0; i < 2; ++i) { int R, C; stage_rc(tid * 16 + i * 8192, R, C); const int Rb = Epi::PERM ? ((R & ~31) + perm32(R & 31)) : R;
        voffA[i] = (unsigned)(R * K + C) * 2u; voffB[i] = (unsigned)(Rb * K + C) * 2u; }
    const size_t kstep = (size_t)(BK * 2);
    const size_t hstep = (size_t)HALF * K * 2;
    const size_t tstep = 2 * hstep;
    const unsigned ldsw = (unsigned)wid * 1024u;
    const int aoff = lds_byte(wr * 64 + fr, fq * 8), boff = lds_byte(wc * 32 + fr, fq * 8);
#define PG8_SA(b, h) (((b) * 2 + (h)) * HTB)
#define PG8_SB(b, h) ((4 + (b) * 2 + (h)) * HTB)
#define PG8_STAGE(bufoff, gbase, voff) do { _Pragma("unroll") for (int _i = 0; _i < 2; ++_i) \
        __builtin_amdgcn_global_load_lds((const unsigned*)((const char*)(gbase) + (voff)[_i]), (PG8_LAS unsigned*)(lds + (bufoff) + ldsw + _i * 8192), 16, 0, 0); } while (0)
#define PG8_LDA(dst, b, h) do { _Pragma("unroll") for (int m = 0; m < 4; ++m) _Pragma("unroll") for (int k = 0; k < 2; ++k) dst[m][k] = *(const PG8_LAS bf16x8*)(lds + PG8_SA(b, h) + aoff + m * 2048 + k * 1024); } while (0)
#define PG8_LDB(dst, b, h) do { _Pragma("unroll") for (int n = 0; n < 2; ++n) _Pragma("unroll") for (int k = 0; k < 2; ++k) dst[n][k] = *(const PG8_LAS bf16x8*)(lds + PG8_SB(b, h) + boff + n * 2048 + k * 1024); } while (0)
#define PG8_MMA(ai, bj, At, Bt) do { __builtin_amdgcn_s_setprio(1); _Pragma("unroll") for (int m = 0; m < 4; ++m) _Pragma("unroll") for (int n = 0; n < 2; ++n) _Pragma("unroll") for (int k = 0; k < 2; ++k) \
        acc[ai][bj][m][n] = __builtin_amdgcn_mfma_f32_16x16x32_bf16(Bt[n][k], At[m][k], acc[ai][bj][m][n], 0, 0, 0); __builtin_amdgcn_s_setprio(0); } while (0)
#define PG8_WAIT_V(n) asm volatile("s_waitcnt vmcnt(" #n ")" ::: "memory")
#define PG8_WAIT_L(n) asm volatile("s_waitcnt lgkmcnt(" #n ")" ::: "memory")
#define PG8_BAR __builtin_amdgcn_s_barrier()
#define PG8_SCHED __builtin_amdgcn_sched_barrier(0)
    Unit cur, nxt; int ui = 0;
    if (!S.next(0, cur)) return;
    f32x4 acc[2][2][4][2];
#pragma unroll
    for (int a = 0; a < 2; ++a)
#pragma unroll
        for (int b = 0; b < 2; ++b)
#pragma unroll
            for (int m = 0; m < 4; ++m)
#pragma unroll
                for (int n = 0; n < 2; ++n) acc[a][b][m][n] = (f32x4){0.f, 0.f, 0.f, 0.f};
    bf16x8 At[4][2], B0[2][2], B1[2][2];
    const char* cA = (const char*)g.A + (size_t)cur.pm * tstep; const char* cB = (const char*)g.Bt + (size_t)cur.pn * tstep;
    S.a_ready(cur);
    if constexpr (SP2) {
        PG8_STAGE(PG8_SB(0, 0), cB, voffB); PG8_STAGE(PG8_SB(0, 1), cB + hstep, voffB); PG8_STAGE(PG8_SA(0, 0), cA, voffA); PG8_STAGE(PG8_SA(0, 1), cA + hstep, voffA);
        if (wr == 1) PG8_BAR;
        PG8_WAIT_V(2); PG8_BAR;
        PG8_STAGE(PG8_SB(1, 0), cB + kstep, voffB); PG8_STAGE(PG8_SA(1, 0), cA + kstep, voffA); PG8_STAGE(PG8_SB(1, 1), cB + hstep + kstep, voffB);
        PG8_WAIT_V(6); PG8_BAR;
    } else {
        PG8_STAGE(PG8_SB(0, 0), cB, voffB); PG8_STAGE(PG8_SA(0, 0), cA, voffA); PG8_STAGE(PG8_SB(0, 1), cB + hstep, voffB); PG8_STAGE(PG8_SA(0, 1), cA + hstep, voffA);
        if (wr == 1) PG8_BAR;
        PG8_WAIT_V(4); PG8_BAR;
        PG8_STAGE(PG8_SB(1, 0), cB + kstep, voffB); PG8_STAGE(PG8_SA(1, 0), cA + kstep, voffA); PG8_STAGE(PG8_SB(1, 1), cB + hstep + kstep, voffB);
        PG8_WAIT_V(6); PG8_BAR;
    }
    for (;;) {
        const bool has_next = S.next(ui + 1, nxt);
        const char* nA = has_next ? (const char*)g.A + (size_t)nxt.pm * tstep : cA; const char* nB = has_next ? (const char*)g.Bt + (size_t)nxt.pn * tstep : cB;
        for (int t = 0; t < nt; t += 2) {
            const bool last = (t == nt - 2);
            const char* a1 = cA + (size_t)(t + 1) * kstep;
            const char* a2 = last ? nA : cA + (size_t)(t + 2) * kstep; const char* b2 = last ? nB : cB + (size_t)(t + 2) * kstep;
            const char* a3 = a2 + kstep; const char* b3 = b2 + kstep;
            if (last && has_next) S.a_ready(nxt);
            if constexpr (SP2) {
            PG8_LDB(B0, 0, 0); PG8_LDB(B1, 0, 1); PG8_SCHED; PG8_LDA(At, 0, 0); PG8_STAGE(PG8_SA(1, 1), a1 + hstep, voffA);
            PG8_WAIT_V(8); PG8_WAIT_L(0); PG8_BAR; PG8_MMA(0, 0, At, B0); PG8_MMA(0, 1, At, B1); PG8_BAR; PG8_SCHED;
            PG8_LDA(At, 0, 1); PG8_STAGE(PG8_SB(0, 0), b2, voffB); PG8_STAGE(PG8_SB(0, 1), b2 + hstep, voffB); PG8_STAGE(PG8_SA(0, 0), a2, voffA);
            PG8_WAIT_V(8); PG8_WAIT_L(0); PG8_BAR; PG8_MMA(1, 0, At, B0); PG8_MMA(1, 1, At, B1); PG8_BAR; PG8_SCHED;
            PG8_LDB(B0, 1, 0); PG8_LDB(B1, 1, 1); PG8_SCHED; PG8_LDA(At, 1, 0); PG8_STAGE(PG8_SA(0, 1), a2 + hstep, voffA);
            PG8_WAIT_V(8); PG8_WAIT_L(0); PG8_BAR; PG8_MMA(0, 0, At, B0); PG8_MMA(0, 1, At, B1); PG8_BAR; PG8_SCHED;
            PG8_LDA(At, 1, 1); PG8_STAGE(PG8_SB(1, 0), b3, voffB); PG8_STAGE(PG8_SB(1, 1), b3 + hstep, voffB); PG8_STAGE(PG8_SA(1, 0), a3, voffA);
            PG8_WAIT_V(8); PG8_WAIT_L(0); PG8_BAR; PG8_MMA(1, 0, At, B0); PG8_MMA(1, 1, At, B1); PG8_BAR; PG8_SCHED;
            } else {
            PG8_LDB(B0, 0, 0); PG8_SCHED; PG8_LDA(At, 0, 0); PG8_STAGE(PG8_SA(1, 1), a1 + hstep, voffA);
            PG8_WAIT_L(8); PG8_BAR; PG8_WAIT_L(0); PG8_MMA(0, 0, At, B0); PG8_BAR; PG8_SCHED;
            PG8_LDB(B1, 0, 1); PG8_STAGE(PG8_SB(0, 0), b2, voffB);
            PG8_BAR; PG8_WAIT_L(0); PG8_MMA(0, 1, At, B1); PG8_BAR;
            PG8_LDA(At, 0, 1); PG8_STAGE(PG8_SA(0, 0), a2, voffA);
            PG8_BAR; PG8_WAIT_L(0); PG8_MMA(1, 0, At, B0); PG8_BAR; PG8_SCHED;
            PG8_STAGE(PG8_SB(0, 1), b2 + hstep, voffB);
            PG8_WAIT_V(6); PG8_BAR; PG8_MMA(1, 1, At, B1); PG8_BAR;
            PG8_LDB(B0, 1, 0); PG8_SCHED; PG8_LDA(At, 1, 0); PG8_STAGE(PG8_SA(0, 1), a2 + hstep, voffA);
            PG8_WAIT_L(8); PG8_BAR; PG8_WAIT_L(0); PG8_MMA(0, 0, At, B0); PG8_BAR; PG8_SCHED;
            PG8_LDB(B1, 1, 1); PG8_STAGE(PG8_SB(1, 0), b3, voffB);
            PG8_BAR; PG8_WAIT_L(0); PG8_MMA(0, 1, At, B1); PG8_BAR;
            PG8_LDA(At, 1, 1); PG8_STAGE(PG8_SA(1, 0), a3, voffA);
            PG8_BAR; PG8_WAIT_L(0); PG8_MMA(1, 0, At, B0); PG8_BAR; PG8_SCHED;
            PG8_STAGE(PG8_SB(1, 1), b3 + hstep, voffB);
            PG8_WAIT_V(6); PG8_BAR; PG8_MMA(1, 1, At, B1); PG8_BAR;
            }
        }
        if constexpr (ALIGN_EPI) { if (wr == 0) PG8_BAR; }
        if constexpr (!Epi::AFTER_DRAIN) { E(acc, cur, wr, wc, fr, fq); S.done(cur); }
        if (!has_next) break;
#pragma unroll
        for (int a = 0; a < 2; ++a)
#pragma unroll
            for (int b = 0; b < 2; ++b)
#pragma unroll
                for (int m = 0; m < 4; ++m)
#pragma unroll
                    for (int n = 0; n < 2; ++n) acc[a][b][m][n] = (f32x4){0.f, 0.f, 0.f, 0.f};
        cur = nxt; cA = nA; cB = nB; ++ui;
        if constexpr (ALIGN_EPI) { if (wr == 1) PG8_BAR; }
    }
    PG8_WAIT_V(0);
    if constexpr (!ALIGN_EPI) { if (wr == 0) PG8_BAR; }
    PG8_BAR;
    if constexpr (Epi::AFTER_DRAIN) { E.fused(acc, cur, wr, wc, fr, fq, lds, wid, lane); S.done(cur); }
#undef PG8_SA
#undef PG8_SB
#undef PG8_STAGE
#undef PG8_LDA
#undef PG8_LDB
#undef PG8_MMA
#undef PG8_WAIT_V
#undef PG8_WAIT_L
#undef PG8_BAR
#undef PG8_SCHED
}
}
#define LAS __attribute__((address_space(3)))
typedef unsigned short bf16;
typedef short bf16x8 __attribute__((ext_vector_type(8)));
typedef float f32x16 __attribute__((ext_vector_type(16)));
typedef float f32x4 __attribute__((ext_vector_type(4)));
typedef float f32x2 __attribute__((ext_vector_type(2)));
typedef unsigned u32x4 __attribute__((ext_vector_type(4)));
typedef unsigned u32x2 __attribute__((ext_vector_type(2)));
typedef __bf16 bf16x2_t __attribute__((ext_vector_type(2)));

constexpr int BATCH = 8, SEQ = 4096, DM = 1024, M = BATCH * SEQ;
constexpr int N0 = 2208, N0P = 2304;
constexpr int C_CQ = 0, C_CKV = 256, C_KPE = 384, C_QS = 416, C_KS = 928, C_VS = 1056, C_G0 = 1184;
constexpr int N1W = 4112, N1 = 4096;
constexpr int C1_Q = 0, C1_K = 1024, C1_V = 2048, C1_G = 3072, W1_F = 3072, W1_G = 3088;
constexpr float EPS = 1e-6f, LOG2E = 1.4426950408889634f;
constexpr int NTHREADS = 512, NWAVES = 8;

constexpr size_t MiB = 1u << 20;
constexpr size_t WS_WT0 = 1 * MiB;
constexpr size_t WS_WQUP = 6 * MiB;
constexpr size_t WS_WKVUP = 7 * MiB;
constexpr size_t WS_WOUT0 = 8 * MiB;
constexpr size_t WS_WT1 = 10 * MiB;
constexpr size_t WS_WOUT1 = 18 * MiB;
constexpr size_t WS_XN = 32 * MiB;
constexpr size_t WS_OG = 96 * MiB;
constexpr size_t WS_LF = 160 * MiB;
constexpr size_t WS_LC = 162 * MiB;
constexpr size_t WS_TMAX = 512 * 1024;
constexpr size_t WS_CS = 164 * MiB;
constexpr size_t WS_Z1 = 168 * MiB;
constexpr size_t WS_Z0 = 168 * MiB;
constexpr size_t WS_CQN = 312 * MiB;
constexpr size_t WS_CKVN = 328 * MiB;
constexpr size_t WS_KPE = 344 * MiB;
constexpr size_t WS_Q0 = 346 * MiB;
constexpr size_t WS_KN = 394 * MiB;
constexpr size_t WS_VM = 426 * MiB;
constexpr size_t WS_D0 = 426 * MiB;
constexpr size_t WS_END = 490 * MiB;
constexpr int LDS_BYTES = 135168, LDS_MISC = 131072 + 1024;

__device__ __forceinline__ unsigned cvtpk(float lo, float hi) { f32x2 v = {lo, hi}; bf16x2_t b = __builtin_convertvector(v, bf16x2_t); return __builtin_bit_cast(unsigned, b); }
__device__ __forceinline__ float bflo(unsigned u) { return __uint_as_float(u << 16); }
__device__ __forceinline__ float bfhi(unsigned u) { return __uint_as_float(u & 0xffff0000u); }
__device__ __forceinline__ float bf1(bf16 v) { return __uint_as_float(((unsigned)v) << 16); }
__device__ __forceinline__ float wave_sum(float v) {
#pragma unroll
    for (int o = 1; o < 64; o <<= 1) v += __shfl_xor(v, o);
    return v;
}

struct AttnP { const bf16 *Q, *K, *K2, *V, *G; bf16* O; const float* lc; const float* tmax; const float* sinkp; int h0; int ldq, ldk, ldk2, ldv, ldg, ldo; float c, sink2, slope2; };

typedef short v4i16_t __attribute__((ext_vector_type(4)));
__device__ __forceinline__ void glds16(const void* gsrc, unsigned lds_dst) { unsigned keep;
    asm volatile("s_mov_b32 %0, m0\n\ts_mov_b32 m0, %2\n\ts_nop 0\n\tglobal_load_lds_dwordx4 %1, off\n\ts_mov_b32 m0, %0" : "=&s"(keep) : "v"(gsrc), "s"(lds_dst) : "memory"); }
__device__ __forceinline__ void glds4(const void* gsrc, unsigned lds_dst) { unsigned keep;
    asm volatile("s_mov_b32 %0, m0\n\ts_mov_b32 m0, %2\n\ts_nop 0\n\tglobal_load_lds_dword %1, off\n\ts_mov_b32 m0, %0" : "=&s"(keep) : "v"(gsrc), "s"(lds_dst) : "memory"); }

#define PSB() __builtin_amdgcn_sched_barrier(0)
__device__ __forceinline__ constexpr int pch_lo(int k, int nch) { return k * (32 / nch) + (k < (32 % nch) ? k : (32 % nch)); }
template <int LO, int HI> __device__ __forceinline__ void p_exp_range(f32x16 (&SC)[2], float c, float m_new, float& l0, float& l1) {
#pragma unroll
    for (int e = LO; e < HI; ++e) { const float y = __builtin_amdgcn_exp2f(SC[e >> 4][e & 15] * c - m_new); SC[e >> 4][e & 15] = y; if (e & 1) l1 += y; else l0 += y; }
}
template <int DK, int K> struct PSeg1 {
    static __device__ __forceinline__ void run(f32x16 (&SC)[2], f32x16 (&SN)[2], const bf16x8 (&kf)[2][DK / 16], const bf16x8 (&qf)[DK / 16], float c, float m_new, float& l0, float& l1) {
        constexpr int NCH = 2 * (DK / 16);
        if constexpr (K < NCH) {
            SN[K & 1] = __builtin_amdgcn_mfma_f32_32x32x16_bf16(kf[K & 1][K >> 1], qf[K >> 1], SN[K & 1], 0, 0, 0);
            PSB();
            p_exp_range<pch_lo(K, NCH), pch_lo(K + 1, NCH)>(SC, c, m_new, l0, l1);
            PSB();
            PSeg1<DK, K + 1>::run(SC, SN, kf, qf, c, m_new, l0, l1);
        }
    }
};
template <int K> struct PSeg2 {
    static __device__ __forceinline__ void run(f32x16 (&SC)[2], f32x16 (&SN)[2], const bf16x8 (&vf)[2][4], bf16x8 (&pk)[4], f32x16 (&ot)[2], float& mx, bool has_next) {
        if constexpr (K < 8) {
            ot[K & 1] = __builtin_amdgcn_mfma_f32_32x32x16_bf16(vf[K & 1][K >> 1], pk[K >> 1], ot[K & 1], 0, 0, 0);
            PSB();
            if constexpr ((K & 1) == 0 && K < 6) { constexpr int cc = (K >> 1) + 1, ph = cc >> 1, o = 8 * (cc & 1); u32x4 w;
                w.x = cvtpk(SC[ph][o + 0], SC[ph][o + 1]); w.y = cvtpk(SC[ph][o + 2], SC[ph][o + 3]); w.z = cvtpk(SC[ph][o + 4], SC[ph][o + 5]); w.w = cvtpk(SC[ph][o + 6], SC[ph][o + 7]);
                pk[cc] = __builtin_bit_cast(bf16x8, w); }
            if (has_next) { constexpr int e = 4 * K, ph = e >> 4, r = e & 15;
                mx = __builtin_fmaxf(__builtin_fmaxf(mx, SN[ph][r]), SN[ph][r + 1]); mx = __builtin_fmaxf(__builtin_fmaxf(mx, SN[ph][r + 2]), SN[ph][r + 3]); }
            PSB();
            PSeg2<K + 1>::run(SC, SN, vf, pk, ot, mx, has_next);
        }
    }
};
#define AT_WAITV(n) asm volatile("s_waitcnt vmcnt(%0) lgkmcnt(0)" :: "n"(n) : "memory")
template <int DK, int MODE>
__device__ __forceinline__ void attn_unit(const AttnP& p, const int q0, LAS unsigned char* lds) {
    constexpr bool SKEW = (MODE == 2);
    constexpr int NS = SKEW ? 7 : 4, KN_B = 8192, KP_B = (DK == 96) ? 4096 : 0, VHALF = 4160, V_B = 2 * VHALF, LC_B = (MODE == 2) ? 256 : 0;
    constexpr int OFF_KP = KN_B, OFF_V = KN_B + KP_B, OFF_LC = OFF_V + V_B, SLOT = OFF_LC + LC_B, OFF_FLAG = NS * SLOT;
    constexpr int NPT = 2 + ((DK == 96 || MODE == 2) ? 1 : 0);
    const int tid = threadIdx.x, lane = tid & 63, wid = __builtin_amdgcn_readfirstlane(tid >> 6), r32 = lane & 31, hi = lane >> 5;
    const int hsel = (MODE == 1) ? (wid >> 1) : 0;
    const int qw0 = q0 + 32 * ((MODE == 1) ? (wid & 1) : wid), q = qw0 + r32;
    const bf16* Qp = p.Q + hsel * 64; const bf16* Gp = p.G + hsel * 64; bf16* Op = p.O + hsel * 64;
    float sink2 = 0.f, slope2 = 0.f;
    if (MODE == 1) { const int hh = p.h0 + hsel; sink2 = p.sinkp[hh] * LOG2E; slope2 = exp2f(-(float)(hh + 1)) * LOG2E; }
    const unsigned lds0 = (unsigned)(uintptr_t)lds;
    bf16x8 qf[DK / 16];
#pragma unroll
    for (int d0 = 0; d0 < DK / 16; ++d0) qf[d0] = *(const bf16x8*)(Qp + (size_t)q * p.ldq + 16 * d0 + 8 * hi);
#pragma unroll
    for (int d0 = 0; d0 < DK / 16; ++d0) asm volatile("" : "+v"(qf[d0]));
    const int t_hi = (MODE == 1) ? (q0 >> 6) : (((q0 + 256) >> 6) - 1);
    const int t_lo = (MODE == 1) ? (((q0 >> 6) >= 2) ? (q0 >> 6) - 2 : 0) : 0;
    const int ntile = t_hi - t_lo + 1;
    const int krow = 8 * wid + (lane >> 3), kch = (lane & 7) ^ ((krow >> 1) & 7);
    const bf16* ksrc = p.K + (size_t)krow * p.ldk + kch * 8;
    const int prow = 8 * wid + ((lane & 31) >> 2), pch = (lane & 3) ^ ((prow >> 2) & 3);
    const bf16* psrc = (DK == 96) ? (p.K2 + (size_t)prow * p.ldk2 + pch * 8) : p.K;
    const int vrow = 16 * (wid & 3) + (lane >> 2);
    const bf16* vsrc = p.V + (size_t)vrow * p.ldv + ((wid >> 2) * 4 + (lane & 3)) * 8;
    const float* lsrc = (MODE == 2) ? (p.lc + 8 * wid + (lane & 7)) : (const float*)p.K;
#define AT_DMA(t, slot) do { const size_t ro_ = (size_t)(t) * 64; const unsigned sb_ = lds0 + (unsigned)((slot) * SLOT); \
        glds16(ksrc + ro_ * p.ldk, (unsigned)__builtin_amdgcn_readfirstlane(sb_ + wid * 1024)); \
        glds16(vsrc + ro_ * p.ldv, (unsigned)__builtin_amdgcn_readfirstlane(sb_ + OFF_V + (wid >> 2) * VHALF + (wid & 3) * 1024)); \
        if (DK == 96) { if (lane < 32) glds16(psrc + ro_ * p.ldk2, (unsigned)__builtin_amdgcn_readfirstlane(sb_ + OFF_KP + wid * 512)); } \
        if (MODE == 2) { if (lane < 8) glds4(lsrc + ro_, (unsigned)__builtin_amdgcn_readfirstlane(sb_ + OFF_LC + wid * 32)); } } while (0)

    float m_run = (MODE == 1) ? sink2 : -INFINITY;
    float l_run = (MODE == 1 && hi == 0) ? 1.f : 0.f;
    f32x16 ot[2];
#pragma unroll
    for (int r = 0; r < 16; ++r) { ot[0][r] = 0.f; ot[1][r] = 0.f; }
    const int pim = 16 * (r32 >> 4) + 8 * ((r32 >> 2) & 1) + 4 * ((r32 >> 3) & 1) + (r32 & 3);
    const int vrd = (8 * hi + ((lane & 15) >> 2)) * 64 + ((lane >> 4) & 1) * 32 + (lane & 3) * 8;
    int koff[4], poff[2];
#pragma unroll
    for (int d0 = 0; d0 < 4; ++d0) koff[d0] = pim * 128 + (((2 * d0 + hi) ^ ((pim >> 1) & 7)) * 16);
#pragma unroll
    for (int j = 0; j < 2; ++j) poff[j] = OFF_KP + pim * 64 + (((2 * j + hi) ^ ((pim >> 2) & 3)) * 16);
    float pmv = 0.f, lcev = 0.f, qn = 0.f;
    if (MODE == 2) {
        pmv = (lane <= t_hi) ? p.tmax[lane] : 0.f;
#pragma unroll
        for (int o = 1; o < 64; o <<= 1) { const float n = __shfl_up(pmv, o); if (lane >= o) pmv = fmaxf(pmv, n); }
        lcev = (lane <= t_hi) ? p.lc[64 * lane + 63] : 0.f;
        float qs = 0.f;
#pragma unroll
        for (int d0 = 0; d0 < DK / 16; ++d0)
#pragma unroll
            for (int e = 0; e < 8; ++e) { const float f = bf1((bf16)qf[d0][e]); qs += f * f; }
        qs += __shfl_xor(qs, 32);
        qn = sqrtf(qs) * p.c * 1.002f;
    }
    const int sk = SKEW ? (3 - (wid >> 1)) : 0;
    int sw = sk, sd = 6;
    bool done_w = false;
    if (SKEW) {
#pragma unroll
        for (int d = 0; d < 6; ++d) if (d < ntile) AT_DMA(t_hi - d, d);
    } else {
        AT_DMA(t_hi, 0);
        if (ntile > 1) AT_DMA(t_hi - 1, 1);
        if (ntile > 2) AT_DMA(t_hi - 2, 2);
    }
    const int nfirst = (MODE == 0 && ntile > 4) ? 4 : ntile;
    for (int i = 0; i < nfirst; ++i) {
        const int t = t_hi - i - sk, kv0 = t * 64, rem = SKEW ? (ntile - 1 - (i + 3)) : (ntile - 1 - i);
        if (rem >= 2) AT_WAITV(2 * NPT); else if (rem == 1) AT_WAITV(NPT); else AT_WAITV(0);
        __builtin_amdgcn_s_barrier();
        asm volatile("" ::: "memory");
        if (MODE == 2) { if (i > 0) {
            const LAS unsigned char* fp = lds + OFF_FLAG + ((i - 1) & 1) * 32;
            const u32x4 f0 = *(const LAS u32x4*)(fp), f1 = *(const LAS u32x4*)(fp + 16);
            if ((f0.x & f0.y & f0.z & f0.w & f1.x & f1.y & f1.z & f1.w) != 0u) break; } }
        if (SKEW) { if (i + 6 < ntile) AT_DMA(t_hi - (i + 6), sd); sd = (sd == 6) ? 0 : sd + 1; }
        else { if (rem >= 3) AT_DMA(t - 3, (i + 3) & 3); }
        const LAS unsigned char* sb = lds + (SKEW ? sw : (i & 3)) * SLOT;
        if (SKEW) sw = (sw == 6) ? 0 : sw + 1;
        bool act = kv0 <= qw0 + 31;
        if (MODE == 1) act = act && (kv0 + 63 >= qw0 - 127);
        if (SKEW) act = act && (t >= 0) && !done_w;
        if (act) {
            f32x16 s[2];
            {
                bf16x8 kf[2][DK / 16];
#pragma unroll
                for (int ph = 0; ph < 2; ++ph) {
#pragma unroll
                    for (int d0 = 0; d0 < 4; ++d0) kf[ph][d0] = *(const LAS bf16x8*)(sb + koff[d0] + ph * 4096);
                    if (DK == 96) {
#pragma unroll
                        for (int j = 0; j < 2; ++j) kf[ph][(DK == 96) ? 4 + j : 0] = *(const LAS bf16x8*)(sb + poff[j] + ph * 2048);
                    }
                }
#pragma unroll
                for (int r = 0; r < 16; ++r) { s[0][r] = 0.f; s[1][r] = 0.f; }
                __builtin_amdgcn_sched_barrier(0);
#pragma unroll
                for (int d0 = 0; d0 < DK / 16; ++d0) {
                    s[0] = __builtin_amdgcn_mfma_f32_32x32x16_bf16(kf[0][d0], qf[d0], s[0], 0, 0, 0);
                    s[1] = __builtin_amdgcn_mfma_f32_32x32x16_bf16(kf[1][d0], qf[d0], s[1], 0, 0, 0);
                }
                __builtin_amdgcn_sched_barrier(0);
            }
            if (MODE == 2) {
                const LAS float* lcb = (const LAS float*)(sb + OFF_LC);
#pragma unroll
                for (int ph = 0; ph < 2; ++ph)
#pragma unroll
                    for (int j = 0; j < 4; ++j) { const f32x4 lk = *(const LAS f32x4*)(lcb + 32 * ph + 16 * (j >> 1) + 8 * hi + 4 * (j & 1));
#pragma unroll
                        for (int ii = 0; ii < 4; ++ii) s[ph][4 * j + ii] = s[ph][4 * j + ii] * p.c - lk[ii]; }
            } else if (MODE == 1) {
                const float dq = (float)(q - kv0 - 8 * hi);
#pragma unroll
                for (int ph = 0; ph < 2; ++ph)
#pragma unroll
                    for (int r = 0; r < 16; ++r) { const int kk = 32 * ph + 16 * (r >> 3) + 4 * ((r >> 2) & 1) + (r & 3); s[ph][r] = s[ph][r] * p.c - slope2 * (dq - (float)kk); }
            }
            bool needmask = (kv0 + 63 > qw0);
            if (MODE == 1) needmask = needmask || (kv0 < qw0 + 31 - 127);
            if (needmask) {
                const int dqi = q - kv0 - 8 * hi;
#pragma unroll
                for (int ph = 0; ph < 2; ++ph)
#pragma unroll
                    for (int r = 0; r < 16; ++r) { const int kk = 32 * ph + 16 * (r >> 3) + 4 * ((r >> 2) & 1) + (r & 3); const int dist = dqi - kk;
                        bool ok = dist >= 0; if (MODE == 1) ok = ok && (dist < 128); s[ph][r] = ok ? s[ph][r] : -INFINITY; }
            }
            float mx = fmaxf(fmaxf(s[0][0], s[0][1]), s[0][2]);
#pragma unroll
            for (int r = 3; r < 15; r += 2) mx = fmaxf(fmaxf(mx, s[0][r]), s[0][r + 1]);
            mx = fmaxf(mx, s[0][15]);
#pragma unroll
            for (int r = 0; r < 16; r += 2) mx = fmaxf(fmaxf(mx, s[1][r]), s[1][r + 1]);
            mx = fmaxf(mx, __shfl_xor(mx, 32));
            if (MODE == 0) mx *= p.c;
            const bool dead = (MODE == 2) && __all(mx < m_run - 40.f);
            if (!dead) {
                const float m_new = fmaxf(m_run, mx);
                const float alpha = __builtin_amdgcn_exp2f(m_run - m_new);
                m_run = m_new;
                float ls0 = 0.f, ls1 = 0.f;
#pragma unroll
                for (int ph = 0; ph < 2; ++ph)
#pragma unroll
                    for (int r = 0; r < 16; r += 2) {
                        const float e0 = __builtin_amdgcn_exp2f(MODE == 0 ? (s[ph][r] * p.c - m_new) : (s[ph][r] - m_new));
                        const float e1 = __builtin_amdgcn_exp2f(MODE == 0 ? (s[ph][r + 1] * p.c - m_new) : (s[ph][r + 1] - m_new));
                        s[ph][r] = e0; s[ph][r + 1] = e1; ls0 += e0; ls1 += e1; }
                if (__any(alpha != 1.f)) {
                    l_run *= alpha;
#pragma unroll
                    for (int r = 0; r < 16; ++r) { ot[0][r] *= alpha; ot[1][r] *= alpha; }
                }
                l_run += ls0 + ls1;
                bf16x8 pk[4];
#pragma unroll
                for (int cc = 0; cc < 4; ++cc) { const int ph = cc >> 1, o = 8 * (cc & 1); u32x4 w;
                    w.x = cvtpk(s[ph][o + 0], s[ph][o + 1]); w.y = cvtpk(s[ph][o + 2], s[ph][o + 3]); w.z = cvtpk(s[ph][o + 4], s[ph][o + 5]); w.w = cvtpk(s[ph][o + 6], s[ph][o + 7]);
                    pk[cc] = __builtin_bit_cast(bf16x8, w); }
                const LAS unsigned char* vb = sb + OFF_V + vrd;
                bf16x8 vf[2][4];
#pragma unroll
                for (int dh = 0; dh < 2; ++dh)
#pragma unroll
                    for (int cc = 0; cc < 4; ++cc) {
                        const v4i16_t v0 = __builtin_amdgcn_ds_read_tr16_b64_v4i16((LAS v4i16_t*)(vb + dh * VHALF + cc * 1024));
                        const v4i16_t v1 = __builtin_amdgcn_ds_read_tr16_b64_v4i16((LAS v4i16_t*)(vb + dh * VHALF + cc * 1024 + 256));
                        vf[dh][cc] = (bf16x8){v0[0], v0[1], v0[2], v0[3], v1[0], v1[1], v1[2], v1[3]}; }
                __builtin_amdgcn_sched_barrier(0);
#pragma unroll
                for (int cc = 0; cc < 4; ++cc) {
                    ot[0] = __builtin_amdgcn_mfma_f32_32x32x16_bf16(vf[0][cc], pk[cc], ot[0], 0, 0, 0);
                    ot[1] = __builtin_amdgcn_mfma_f32_32x32x16_bf16(vf[1][cc], pk[cc], ot[1], 0, 0, 0);
                }
                __builtin_amdgcn_sched_barrier(0);
            }
        }
        if (MODE == 2) {
            bool dn = true;
            if (t >= 1) { const float bnd = qn * __shfl(pmv, t - 1) - __shfl(lcev, t - 1); dn = __all(bnd < m_run - 40.f); }
            done_w = done_w || dn;
            if (lane == 0) *(LAS unsigned*)(lds + OFF_FLAG + (i & 1) * 32 + wid * 4) = done_w ? 1u : 0u;
        }
    }
    if (MODE == 0) { if (ntile > 4) {
        f32x16 SA[2], SB[2];
        float m_new, alpha;
        { const int y = ((ntile - 1 < 6) ? (ntile - 1) : 6) - 4;
          if (y >= 2) AT_WAITV(2 * NPT); else if (y == 1) AT_WAITV(NPT); else AT_WAITV(0); }
        __builtin_amdgcn_s_barrier(); asm volatile("" ::: "memory");
        { const LAS unsigned char* sb = lds + (4 & 3) * SLOT;
          bf16x8 kf[2][DK / 16];
#pragma unroll
          for (int ph = 0; ph < 2; ++ph) {
#pragma unroll
              for (int d0 = 0; d0 < 4; ++d0) kf[ph][d0] = *(const LAS bf16x8*)(sb + koff[d0] + ph * 4096);
              if (DK == 96) {
#pragma unroll
                  for (int j = 0; j < 2; ++j) kf[ph][(DK == 96) ? 4 + j : 0] = *(const LAS bf16x8*)(sb + poff[j] + ph * 2048);
              }
          }
#pragma unroll
          for (int r = 0; r < 16; ++r) { SA[0][r] = 0.f; SA[1][r] = 0.f; }
#pragma unroll
          for (int d0 = 0; d0 < DK / 16; ++d0) { SA[0] = __builtin_amdgcn_mfma_f32_32x32x16_bf16(kf[0][d0], qf[d0], SA[0], 0, 0, 0); SA[1] = __builtin_amdgcn_mfma_f32_32x32x16_bf16(kf[1][d0], qf[d0], SA[1], 0, 0, 0); }
          float mx = SA[0][0];
#pragma unroll
          for (int r = 1; r < 16; ++r) mx = fmaxf(mx, SA[0][r]);
#pragma unroll
          for (int r = 0; r < 16; ++r) mx = fmaxf(mx, SA[1][r]);
          mx = fmaxf(mx, __shfl_xor(mx, 32)) * p.c;
          m_new = (mx > m_run + 8.f) ? mx : m_run; alpha = __builtin_amdgcn_exp2f(m_run - m_new); m_run = m_new; }
#define P_STEP(SC, SN, i_) do { const int i__ = (i_); const bool has_next = (i__ + 1 < ntile); \
        if (i__ + 2 < ntile) AT_WAITV(NPT); else AT_WAITV(0);                      \
        __builtin_amdgcn_s_barrier(); asm volatile("" ::: "memory"); \
        if (i__ + 3 < ntile) AT_DMA(t_hi - (i__ + 3), (i__ + 3) & 3); \
        const LAS unsigned char* sbc_ = lds + (i__ & 3) * SLOT; const LAS unsigned char* sbn_ = lds + ((i__ + 1) & 3) * SLOT; \
        float l0_ = 0.f, l1_ = 0.f; \
        if (has_next) { \
            bf16x8 kf_[2][DK / 16]; \
            _Pragma("unroll") for (int ph = 0; ph < 2; ++ph) { \
                _Pragma("unroll") for (int d0 = 0; d0 < 4; ++d0) kf_[ph][d0] = *(const LAS bf16x8*)(sbn_ + koff[d0] + ph * 4096); \
                if (DK == 96) { _Pragma("unroll") for (int j = 0; j < 2; ++j) kf_[ph][(DK == 96) ? 4 + j : 0] = *(const LAS bf16x8*)(sbn_ + poff[j] + ph * 2048); } } \
            _Pragma("unroll") for (int r = 0; r < 16; ++r) { SN[0][r] = 0.f; SN[1][r] = 0.f; } \
            PSB(); \
            PSeg1<DK, 0>::run(SC, SN, kf_, qf, p.c, m_new, l0_, l1_); \
        } else { p_exp_range<0, 32>(SC, p.c, m_new, l0_, l1_); } \
        if (__any(alpha != 1.f)) { l_run *= alpha; _Pragma("unroll") for (int r = 0; r < 16; ++r) { ot[0][r] *= alpha; ot[1][r] *= alpha; } } \
        l_run += l0_ + l1_; \
        { bf16x8 vf_[2][4], pk_[4]; const LAS unsigned char* vb_ = sbc_ + OFF_V + vrd; \
          _Pragma("unroll") for (int dh = 0; dh < 2; ++dh) _Pragma("unroll") for (int cc = 0; cc < 4; ++cc) { \
              const v4i16_t v0 = __builtin_amdgcn_ds_read_tr16_b64_v4i16((LAS v4i16_t*)(vb_ + dh * VHALF + cc * 1024)); \
              const v4i16_t v1 = __builtin_amdgcn_ds_read_tr16_b64_v4i16((LAS v4i16_t*)(vb_ + dh * VHALF + cc * 1024 + 256)); \
              vf_[dh][cc] = (bf16x8){v0[0], v0[1], v0[2], v0[3], v1[0], v1[1], v1[2], v1[3]}; } \
          { u32x4 w; w.x = cvtpk(SC[0][0], SC[0][1]); w.y = cvtpk(SC[0][2], SC[0][3]); w.z = cvtpk(SC[0][4], SC[0][5]); w.w = cvtpk(SC[0][6], SC[0][7]); pk_[0] = __builtin_bit_cast(bf16x8, w); } \
          float mx_ = -INFINITY; \
          PSB(); \
          PSeg2<0>::run(SC, SN, vf_, pk_, ot, mx_, has_next); \
          if (has_next) { mx_ = fmaxf(mx_, __shfl_xor(mx_, 32)) * p.c; m_new = (mx_ > m_run + 8.f) ? mx_ : m_run; alpha = __builtin_amdgcn_exp2f(m_run - m_new); m_run = m_new; } } \
    } while (0)
        for (int i = 4; i < ntile; i += 2) {
            P_STEP(SA, SB, i);
            if (i + 1 < ntile) P_STEP(SB, SA, i + 1);
        }
#undef P_STEP
    } }
    AT_WAITV(0);
    __builtin_amdgcn_s_barrier();
    asm volatile("" ::: "memory");
    const float lt = l_run + __shfl_xor(l_run, 32);
    const float inv = 1.f / lt;
#pragma unroll
    for (int dh = 0; dh < 2; ++dh)
#pragma unroll
        for (int j = 0; j < 4; ++j) {
            const int d = 32 * dh + 8 * j + 4 * hi;
            const u32x2 g = *(const u32x2*)(Gp + (size_t)q * p.ldg + d);
            const float g0 = bflo(g.x), g1 = bfhi(g.x), g2 = bflo(g.y), g3 = bfhi(g.y);
            const float o0 = ot[dh][4 * j + 0] * inv * (g0 / (1.f + __expf(-g0)));
            const float o1 = ot[dh][4 * j + 1] * inv * (g1 / (1.f + __expf(-g1)));
            const float o2 = ot[dh][4 * j + 2] * inv * (g2 / (1.f + __expf(-g2)));
            const float o3 = ot[dh][4 * j + 3] * inv * (g3 / (1.f + __expf(-g3)));
            u32x2 w; w.x = cvtpk(o0, o1); w.y = cvtpk(o2, o3);
            *(u32x2*)(Op + (size_t)q * p.ldo + d) = w;
        }
#undef AT_DMA
}

#define XB_TMO      128
#define XB_XCNT(j)  (256  + 64 * (j))
#define XB_XSUB(j)  (1280 + 64 * (j))
#define XB_XGEN(j)  (2304 + 64 * (j))
#define XB_TOP      3328
#define XB_TOPGEN   3392
#define XCD_BAR_WORDS 3456
#define XB_SPIN_CAP (1u << 18)

__device__ __forceinline__ unsigned xb_ld(unsigned* p)              { return __hip_atomic_load(p, __ATOMIC_RELAXED, __HIP_MEMORY_SCOPE_AGENT); }
__device__ __forceinline__ unsigned xb_add(unsigned* p, unsigned v) { return __hip_atomic_fetch_add(p, v, __ATOMIC_RELAXED, __HIP_MEMORY_SCOPE_AGENT); }
__device__ __forceinline__ unsigned xb_xcc_id() { return (unsigned)__builtin_amdgcn_s_getreg((3 << 11) | 20) & 0xFu; }
#define XB_SPIN(cond, bar) do { unsigned _sp = 0; while (cond) { __builtin_amdgcn_s_sleep(1); \
    if ((++_sp & 255u) == 0u) { if (xb_ld(&(bar)[XB_TMO])) break; if (_sp > XB_SPIN_CAP) { atomicAdd(&(bar)[XB_TMO], 1u); break; } } } } while (0)

struct XcdBarrier {
    unsigned* bar; unsigned x;
    volatile LAS unsigned* st;
};

__device__ __forceinline__ XcdBarrier xcd_barrier_post(unsigned* bar, volatile LAS unsigned* st) {
    XcdBarrier b; b.bar = bar; b.x = xb_xcc_id(); b.st = st;
    if (threadIdx.x == 0) (void)xb_add(&bar[XB_XCNT(b.x)], 1u);
    return b;
}
__device__ __forceinline__ void xcd_barrier_complete(unsigned* bar, unsigned x, unsigned& nloc, unsigned& nx) {
    const unsigned G = gridDim.x * gridDim.y * gridDim.z;
    unsigned sum, cnt, mine, sp = 0u;
    for (;;) {
        sum = 0u; cnt = 0u; mine = 0u;
#pragma unroll
        for (unsigned j = 0; j < 16; ++j) { const unsigned c = xb_ld(&bar[XB_XCNT(j)]); sum += c; cnt += (c > 0u) ? 1u : 0u; mine = (j == x) ? c : mine; }
        if (sum == G) break;
        __builtin_amdgcn_s_sleep(1);
        if ((++sp & 255u) == 0u) { if (xb_ld(&bar[XB_TMO])) break; if (sp > XB_SPIN_CAP) { atomicAdd(&bar[XB_TMO], 1u); break; } }
    }
    nloc = mine > 0u ? mine : 1u; nx = cnt > 0u ? cnt : 1u;
}

__device__ __forceinline__ void xcd_barrier(const XcdBarrier& b) {
    asm volatile("s_waitcnt vmcnt(0)" ::: "memory");
    __syncthreads();
    if (threadIdx.x == 0) {
        unsigned* bar = b.bar;
        __builtin_amdgcn_s_waitcnt(0);
        unsigned nloc = b.st[0], nx = b.st[1];
        if (nloc == 0u) { xcd_barrier_complete(bar, b.x, nloc, nx); b.st[0] = nloc; b.st[1] = nx; }
        const unsigned old = xb_add(&bar[XB_XSUB(b.x)], 1u);
        const unsigned gen = old / nloc;
        if (old + 1u == (gen + 1u) * nloc) {
            __builtin_amdgcn_fence(__ATOMIC_RELEASE, "agent");
            asm volatile("s_waitcnt vmcnt(0)" ::: "memory");
            const unsigned og = xb_add(&bar[XB_TOP], 1u);
            const unsigned tg = og / nx;
            if (og + 1u == (tg + 1u) * nx) xb_add(&bar[XB_TOPGEN], 1u);
            else XB_SPIN(xb_ld(&bar[XB_TOPGEN]) == tg, bar);
            __builtin_amdgcn_fence(__ATOMIC_ACQUIRE, "agent");
            xb_add(&bar[XB_XGEN(b.x)], 1u);
            asm volatile("s_waitcnt vmcnt(0)" ::: "memory");
        } else {
            XB_SPIN(xb_ld(&bar[XB_XGEN(b.x)]) == gen, bar);
            __builtin_amdgcn_fence(__ATOMIC_ACQUIRE, "agent");
            asm volatile("s_waitcnt vmcnt(0)" ::: "memory");
        }
    }
    __syncthreads();
}

struct Args { const float* in[15]; const int* pos; float* out; unsigned char* ws; int ph_lo, ph_hi; };

__device__ __forceinline__ void transpose_item(const float* W, int ldw, int col0, int k0, bf16* WT, int ldt, int row_off, LAS float* scr, int lane) {
#pragma unroll 8
    for (int i = 0; i < 32; ++i) { const int kk = 2 * i + (lane >> 5); scr[kk * 33 + (lane & 31)] = W[(size_t)(k0 + kk) * ldw + col0 + (lane & 31)]; }
    asm volatile("s_waitcnt lgkmcnt(0)" ::: "memory");
    const int c = lane & 7;
#pragma unroll
    for (int j = 0; j < 4; ++j) { const int n = (lane >> 3) + 8 * j; const LAS float* s = scr + (8 * c) * 33 + n;
        u32x4 o; o.x = cvtpk(s[0 * 33], s[1 * 33]); o.y = cvtpk(s[2 * 33], s[3 * 33]); o.z = cvtpk(s[4 * 33], s[5 * 33]); o.w = cvtpk(s[6 * 33], s[7 * 33]);
        *(u32x4*)(WT + (size_t)(row_off + n) * ldt + k0 + 8 * c) = o; }
    asm volatile("s_waitcnt lgkmcnt(0)" ::: "memory");
}

__device__ __forceinline__ void rms_row_to_bf16(const float* xrow, const float* g, bf16* orow, int lane) {
    const f32x4* xr = (const f32x4*)xrow + lane; const f32x4* gr = (const f32x4*)g + lane;
    f32x4 v[4]; float s = 0.f;
#pragma unroll
    for (int j = 0; j < 4; ++j) { v[j] = xr[64 * j]; s += (v[j].x * v[j].x + v[j].y * v[j].y) + (v[j].z * v[j].z + v[j].w * v[j].w); }
    const float rs = 1.f / sqrtf(wave_sum(s) * (1.f / DM) + EPS);
    u32x2* o8 = (u32x2*)orow + lane;
#pragma unroll
    for (int j = 0; j < 4; ++j) { const f32x4 gg = gr[64 * j]; u32x2 w; w.x = cvtpk(v[j].x * rs * gg.x, v[j].y * rs * gg.y); w.y = cvtpk(v[j].z * rs * gg.z, v[j].w * rs * gg.w); o8[64 * j] = w; }
}

template <bool COOP>
__global__ void __launch_bounds__(NTHREADS, 2) mk_fwd(Args args) {
    extern __shared__ __attribute__((aligned(16))) unsigned char lds_raw[];
    LAS unsigned char* lds = (LAS unsigned char*)lds_raw;
    const int tid = threadIdx.x, lane = tid & 63, wave = __builtin_amdgcn_readfirstlane(tid >> 6);
    const int G = gridDim.x, bx = blockIdx.x;
    const int vcu = (G % 8 == 0) ? (bx % 8) * (G / 8) + bx / 8 : bx;
    const int gw = vcu * NWAVES + wave, NGW = G * NWAVES;
    unsigned char* ws = args.ws;
    const float* x = args.in[0];
    bf16* Wt0 = (bf16*)(ws + WS_WT0); bf16* Wqup = (bf16*)(ws + WS_WQUP); bf16* Wkvup = (bf16*)(ws + WS_WKVUP); bf16* Wout0 = (bf16*)(ws + WS_WOUT0);
    bf16* Wt1 = (bf16*)(ws + WS_WT1); bf16* Wout1 = (bf16*)(ws + WS_WOUT1);
    bf16* XN = (bf16*)(ws + WS_XN); bf16* OG = (bf16*)(ws + WS_OG); float* LF = (float*)(ws + WS_LF); float* LC = (float*)(ws + WS_LC); float* CS = (float*)(ws + WS_CS); float* TMAXB = (float*)(ws + WS_TMAX);
    bf16* Z0 = (bf16*)(ws + WS_Z0); bf16* Z1 = (bf16*)(ws + WS_Z1); bf16* CQN = (bf16*)(ws + WS_CQN); bf16* CKVN = (bf16*)(ws + WS_CKVN); bf16* KPE = (bf16*)(ws + WS_KPE);
    bf16* D0 = (bf16*)(ws + WS_D0); bf16* Q0 = (bf16*)(ws + WS_Q0); bf16* KN = (bf16*)(ws + WS_KN); bf16* VM = (bf16*)(ws + WS_VM);
    float* out = args.out;
    const int lo = args.ph_lo, hi_ph = args.ph_hi;
#ifndef REPMASK
#define REPMASK 0
#endif
#define NREP(k) (1 + (((REPMASK) >> (k)) & 1))
#ifndef PHMASK
#define PHMASK 0xfff
#endif
#define IN(k) ((((PHMASK) >> (k)) & 1) && lo <= (k) && (k) < hi_ph)
#define SEAM(k) do { if constexpr (COOP) { if (IN(k) && IN((k) + 1)) { if ((k) == 0) { cg::this_grid().sync(); xbar = xcd_barrier_post(barw, (volatile LAS unsigned*)(lds + LDS_MISC)); } else { xcd_barrier(xbar); } } } } while (0)
    unsigned* qctr = (unsigned*)(ws + 256 * 1024);
    unsigned* barw = (unsigned*)ws;
    XcdBarrier xbar; xbar.bar = barw; xbar.x = 0; xbar.st = (volatile LAS unsigned*)(lds + LDS_MISC);
    if constexpr (COOP) {
        if (tid < 16) ((LAS unsigned*)(lds + LDS_MISC))[tid] = 0u;
        if (bx == 0) { for (int i = tid; i < XCD_BAR_WORDS; i += NTHREADS) barw[i] = 0u; for (int i = tid; i < 16 * 64; i += NTHREADS) qctr[i] = 0u; for (int i = tid; i < 2 * 64 * 64; i += NTHREADS) ((unsigned*)(ws + 64 * 1024))[i] = 0u; }
        __syncthreads();
    }

    if (IN(0)) {
        LAS float* scr = (LAS float*)(lds + wave * 16384);
        constexpr int I_A = 16 * 69, I_B = 4 * 24, I_C = 2 * 32, I_D = 16 * 32, I_E1 = 16 * 96, I_E2 = 16 * 32, I_F = 16 * 32;
        constexpr int NIT = I_A + I_B + I_C + I_D + I_E1 + I_E2 + I_F;
        for (int it = gw; it < NIT; it += NGW) {
            int r = it;
            if (r < I_A) { const int kb = r / 69, nb = r % 69; transpose_item(args.in[3], N0, 32 * nb, 64 * kb, Wt0, 1024, 32 * nb, scr, lane); continue; } r -= I_A;
            if (r < I_B) { const int kb = r / 24, nb = r % 24; transpose_item(args.in[5], 768, 32 * nb, 64 * kb, Wqup, 256, 32 * nb, scr, lane); continue; } r -= I_B;
            if (r < I_C) { const int kb = r / 32, nb = r % 32; const int n0 = 32 * nb, h = n0 >> 7, j0 = n0 & 127; const int dst = (j0 < 64) ? (h * 64 + j0) : (512 + h * 64 + (j0 - 64));
                           transpose_item(args.in[7], 1024, n0, 64 * kb, Wkvup, 256, dst, scr, lane); continue; } r -= I_C;
            if (r < I_D) { const int kb = r / 32, nb = r % 32; transpose_item(args.in[9], 1024, 32 * nb, 64 * kb, Wout0, 1024, 32 * nb, scr, lane); continue; } r -= I_D;
            if (r < I_E1) { const int kb = r / 96, nb = r % 96; transpose_item(args.in[11], N1W, 32 * nb, 64 * kb, Wt1, 1024, 32 * nb, scr, lane); continue; } r -= I_E1;
            if (r < I_E2) { const int kb = r / 32, nb = r % 32; transpose_item(args.in[11], N1W, W1_G + 32 * nb, 64 * kb, Wt1, 1024, C1_G + 32 * nb, scr, lane); continue; } r -= I_E2;
            { const int kb = r / 32, nb = r % 32; transpose_item(args.in[13], 1024, 32 * nb, 64 * kb, Wout1, 1024, 32 * nb, scr, lane); }
        }
        { const u32x4 z = {0u, 0u, 0u, 0u};
          u32x4* p0 = (u32x4*)(Wt0 + (size_t)N0 * 1024);
          for (int i = vcu * NTHREADS + tid; i < 96 * 1024 / 8; i += G * NTHREADS) p0[i] = z;
          for (int i = vcu * NTHREADS + tid; i < 1024 * 16; i += G * NTHREADS) { const int row = i >> 4, c = i & 15; *(u32x4*)(Wkvup + (size_t)row * 256 + 128 + c * 8) = z; } }
        for (int m0 = gw; m0 < M; m0 += 4 * NGW) {
            f32x4 v[4][4]; float ss[4];
#pragma unroll
            for (int r = 0; r < 4; ++r) { const int m = m0 + r * NGW, mc = (m < M) ? m : (M - 1); const f32x4* xr = (const f32x4*)(x + (size_t)mc * DM) + lane;
#pragma unroll
                for (int j = 0; j < 4; ++j) v[r][j] = xr[64 * j]; }
#pragma unroll
            for (int r = 0; r < 4; ++r) { ss[r] = 0.f;
#pragma unroll
                for (int j = 0; j < 4; ++j) ss[r] += (v[r][j].x * v[r][j].x + v[r][j].y * v[r][j].y) + (v[r][j].z * v[r][j].z + v[r][j].w * v[r][j].w); }
#pragma unroll
            for (int o = 1; o < 64; o <<= 1) {
#pragma unroll
                for (int r = 0; r < 4; ++r) ss[r] += __shfl_xor(ss[r], o); }
            const f32x4* gr = (const f32x4*)args.in[2] + lane;
#pragma unroll
            for (int r = 0; r < 4; ++r) { const int m = m0 + r * NGW;
                if (m < M) { const float rs = 1.f / sqrtf(ss[r] * (1.f / DM) + EPS); u32x2* o8 = (u32x2*)(XN + (size_t)m * DM) + lane;
#pragma unroll
                    for (int j = 0; j < 4; ++j) { const f32x4 gg = gr[64 * j]; u32x2 w; w.x = cvtpk(v[r][j].x * rs * gg.x, v[r][j].y * rs * gg.y); w.y = cvtpk(v[r][j].z * rs * gg.z, v[r][j].w * rs * gg.w); o8[64 * j] = w; } } }
        }
    }
    SEAM(0);
    if (IN(1)) {
        __syncthreads();
        pg8::Gemm g{XN, Wt0, M, N0P, 1024}; pg8::StaticOrder S; S.init(M, N0P, G, bx);
        pg8::EpiBf16<0> E{Z0, N0P, nullptr, 0, 0, 1.f};
        for (int rep = 0; rep < NREP(1); ++rep) {
        pg8::gemm_phase<pg8::EpiBf16<0>, pg8::StaticOrder, true, true>(lds, g, S, E); __syncthreads(); }
    }
    SEAM(1);
    if (IN(2)) {
        const float* gq = args.in[4]; const float* gkv = args.in[6];
        const f32x4 ga = *(const f32x4*)(gq + 4 * lane); const f32x2 gb = *(const f32x2*)(gkv + 2 * lane);
        const float invf = (float)exp2(-(double)(lane & 15) * 0.8304820237218406);
        for (int m0 = gw; m0 < M; m0 += 4 * NGW) {
            u32x2 a[4]; unsigned bb[4]; float px1[4], px2[4]; int ps[4]; float sa[4], sb[4];
#pragma unroll
            for (int r = 0; r < 4; ++r) { const int m = m0 + r * NGW, mc = (m < M) ? m : (M - 1); const bf16* z = Z0 + (size_t)mc * N0P;
                a[r] = *(const u32x2*)(z + C_CQ + 4 * lane); bb[r] = *(const unsigned*)(z + C_CKV + 2 * lane);
                px1[r] = bf1(z[C_KPE + (lane & 15)]); px2[r] = bf1(z[C_KPE + 16 + (lane & 15)]); ps[r] = args.pos[mc]; }
#pragma unroll
            for (int r = 0; r < 4; ++r) { const float a0 = bflo(a[r].x), a1 = bfhi(a[r].x), a2 = bflo(a[r].y), a3 = bfhi(a[r].y), b0 = bflo(bb[r]), b1 = bfhi(bb[r]);
                sa[r] = (a0 * a0 + a1 * a1) + (a2 * a2 + a3 * a3); sb[r] = b0 * b0 + b1 * b1; }
#pragma unroll
            for (int o = 1; o < 64; o <<= 1) {
#pragma unroll
                for (int r = 0; r < 4; ++r) { sa[r] += __shfl_xor(sa[r], o); sb[r] += __shfl_xor(sb[r], o); } }
#pragma unroll
            for (int r = 0; r < 4; ++r) { const int m = m0 + r * NGW;
                if (m < M) {
                    const float a0 = bflo(a[r].x), a1 = bfhi(a[r].x), a2 = bflo(a[r].y), a3 = bfhi(a[r].y), b0 = bflo(bb[r]), b1 = bfhi(bb[r]);
                    const float ra = 1.f / sqrtf(sa[r] * (1.f / 256.f) + EPS), rb = 1.f / sqrtf(sb[r] * (1.f / 128.f) + EPS);
                    u32x2 w; w.x = cvtpk(a0 * ra * ga.x, a1 * ra * ga.y); w.y = cvtpk(a2 * ra * ga.z, a3 * ra * ga.w);
                    *(u32x2*)(CQN + (size_t)m * 256 + 4 * lane) = w;
                    *(unsigned*)(CKVN + (size_t)m * 256 + 2 * lane) = cvtpk(b0 * rb * gb.x, b1 * rb * gb.y);
                    *(unsigned*)(CKVN + (size_t)m * 256 + 128 + 2 * lane) = 0u;
                    if (lane < 16) {
                        const double ang = (double)(float)ps[r] * (double)invf;
                        const double rev = ang * 0.15915494309189535;
                        const float rr = (float)(rev - rint(rev));
                        const float cv = __builtin_amdgcn_cosf(rr), sv = __builtin_amdgcn_sinf(rr);
                        CS[(size_t)m * 32 + lane] = cv; CS[(size_t)m * 32 + 16 + lane] = sv;
                        const unsigned o1 = cvtpk(px1[r] * cv - px2[r] * sv, 0.f), o2 = cvtpk(px2[r] * cv + px1[r] * sv, 0.f);
                        KPE[(size_t)m * 32 + lane] = (bf16)(o1 & 0xffffu); KPE[(size_t)m * 32 + 16 + lane] = (bf16)(o2 & 0xffffu);
                    } } }
        }
    }
    SEAM(2);
    if (IN(3)) {
        __syncthreads();
#ifndef NO_QUP
        { int kq_ = 256; asm volatile("" : "+s"(kq_)); pg8::Gemm g{CQN, Wqup, M, 768, kq_}; pg8::StaticOrder S; S.init(M, 768, G, bx);
          pg8::EpiQRope E{Q0, 768, CS};
          pg8::gemm_phase<pg8::EpiQRope, pg8::StaticOrder, true, true>(lds, g, S, E); }
#endif
        __syncthreads();
#ifndef NO_KVUP
        { int kk_ = 256; asm volatile("" : "+s"(kk_)); pg8::Gemm g{CKVN, Wkvup, M, 1024, kk_}; pg8::StaticOrder S; S.init(M, 1024, G, bx);
          pg8::EpiBf16<0> E{KN, 512, nullptr, 512, (size_t)(WS_VM - WS_KN) / 2, 1.f, 3u, 8};
          pg8::gemm_phase<pg8::EpiBf16<0>, pg8::StaticOrder, true, true>(lds, g, S, E); }
#endif
    }
    SEAM(3);
    if (IN(4)) {
        __syncthreads();
        for (;;) {
            if (tid == 0) *(volatile LAS int*)(lds + LDS_MISC + 64) = (int)atomicAdd(qctr + 64 * (bx & 7), 1u);
            __syncthreads();
            const int tk = *(volatile LAS int*)(lds + LDS_MISC + 64);
            __syncthreads();
            if (tk >= 128) break;
            const bool swa = tk >= 64;
            AttnP p; p.sinkp = args.in[8]; p.h0 = 0;
            if (!swa) {
                const int bh = 8 * (bx & 7) + (tk >> 3), s = tk & 7, b = bh >> 3, h = bh & 7; const size_t rb = (size_t)b * SEQ;
                p.Q = Q0 + rb * 768 + h * 96; p.ldq = 768; p.K = KN + (size_t)bh * SEQ * 64; p.ldk = 64; p.K2 = KPE + rb * 32; p.ldk2 = 32; p.V = VM + (size_t)bh * SEQ * 64; p.ldv = 64;
                p.G = Z0 + rb * N0P + C_G0 + h * 64; p.ldg = N0P; p.O = OG + rb * 1024 + h * 64; p.ldo = 1024; p.lc = nullptr; p.tmax = nullptr; p.c = 0.10206207261596575f * LOG2E; p.sink2 = 0.f; p.slope2 = 0.f;
                attn_unit<96, 0>(p, (15 - s) * 256, lds); attn_unit<96, 0>(p, s * 256, lds);
            } else {
                const int j = tk - 64, pkv = 2 * (bx & 7) + (j >> 5), b = pkv >> 1, kvh = pkv & 1, qb = 2 * (j & 31); const size_t rb = (size_t)b * SEQ;
                p.Q = Z0 + rb * N0P + C_QS + kvh * 256; p.ldq = N0P; p.K = Z0 + rb * N0P + C_KS + kvh * 64; p.ldk = N0P; p.K2 = nullptr; p.ldk2 = 0; p.V = Z0 + rb * N0P + C_VS + kvh * 64; p.ldv = N0P;
                p.G = Z0 + rb * N0P + C_G0 + 512 + kvh * 256; p.ldg = N0P; p.O = OG + rb * 1024 + 512 + kvh * 256; p.ldo = 1024; p.lc = nullptr; p.tmax = nullptr; p.c = 0.125f * LOG2E;
                p.sink2 = 0.f; p.slope2 = 0.f; p.h0 = 4 * kvh;
                attn_unit<64, 1>(p, qb * 64, lds); attn_unit<64, 1>(p, (qb + 1) * 64, lds);
            }
        }
    }
    SEAM(4);
    if (IN(5)) {
        __syncthreads();
        pg8::Gemm g{OG, Wout0, M, 1024, 1024}; pg8::StaticOrder S; S.init(M, 1024, G, bx);
        pg8::EpiBf16<0> E{D0, 1024, nullptr, 0, 0, 1.f};
        pg8::gemm_phase<pg8::EpiBf16<0>, pg8::StaticOrder, true, true>(lds, g, S, E);
    }
    SEAM(5);
    if (IN(6)) {
        __syncthreads();
        const float* g1 = args.in[10]; const float* w1 = args.in[11]; const float* bfp = args.in[12];
        LAS float* WF = (LAS float*)lds;
        for (int k = tid; k < 1024; k += NTHREADS) {
            const int l = (k & 255) >> 2, j = k >> 8, e = k & 3; const int R = l + 64 * (4 * j + e); const float gk = g1[k];
#pragma unroll
            for (int c = 0; c < 4; ++c) { const f32x4 wv = *(const f32x4*)(w1 + (size_t)k * N1W + W1_F + 4 * c); *(LAS f32x4*)(WF + R * 20 + 4 * c) = wv * gk; }
        }
        __syncthreads();
        for (int m = gw; m < M; m += NGW) {
            const f32x4* xr = (const f32x4*)(x + (size_t)m * DM) + lane; const f32x4* gr = (const f32x4*)g1 + lane; const u32x2* dr = (const u32x2*)(D0 + (size_t)m * DM) + lane;
            f32x4 v[4]; float ss = 0.f;
#pragma unroll
            for (int j = 0; j < 4; ++j) { const u32x2 dd = dr[64 * j]; v[j] = xr[64 * j]; v[j].x += bflo(dd.x); v[j].y += bfhi(dd.x); v[j].z += bflo(dd.y); v[j].w += bfhi(dd.y); ss += (v[j].x * v[j].x + v[j].y * v[j].y) + (v[j].z * v[j].z + v[j].w * v[j].w); }
            const float rs = 1.f / sqrtf(wave_sum(ss) * (1.f / DM) + EPS);
            u32x2* o8 = (u32x2*)(XN + (size_t)m * DM) + lane;
            float fa[16];
#pragma unroll
            for (int n = 0; n < 16; ++n) fa[n] = 0.f;
#pragma unroll
            for (int j = 0; j < 4; ++j) { const f32x4 gg = gr[64 * j]; u32x2 w; w.x = cvtpk(v[j].x * rs * gg.x, v[j].y * rs * gg.y); w.y = cvtpk(v[j].z * rs * gg.z, v[j].w * rs * gg.w); o8[64 * j] = w;
#pragma unroll
                for (int e = 0; e < 4; ++e) { const float xv = v[j][e]; const LAS float* wr_ = WF + (lane + 64 * (4 * j + e)) * 20;
#pragma unroll
                    for (int c = 0; c < 4; ++c) { const f32x4 wv = *(const LAS f32x4*)(wr_ + 4 * c); fa[4 * c + 0] += xv * wv.x; fa[4 * c + 1] += xv * wv.y; fa[4 * c + 2] += xv * wv.z; fa[4 * c + 3] += xv * wv.w; }
                    asm volatile("" ::: "memory"); } }
            const bool b5 = (lane & 32) != 0, b4 = (lane & 16) != 0, b3 = (lane & 8) != 0, b2 = (lane & 4) != 0;
            float r8[8], r4[4], r2[2];
#pragma unroll
            for (int i = 0; i < 8; ++i) { const float snd = b5 ? fa[i] : fa[8 + i]; r8[i] = (b5 ? fa[8 + i] : fa[i]) + __shfl_xor(snd, 32); }
#pragma unroll
            for (int i = 0; i < 4; ++i) { const float snd = b4 ? r8[i] : r8[4 + i]; r4[i] = (b4 ? r8[4 + i] : r8[i]) + __shfl_xor(snd, 16); }
#pragma unroll
            for (int i = 0; i < 2; ++i) { const float snd = b3 ? r4[i] : r4[2 + i]; r2[i] = (b3 ? r4[2 + i] : r4[i]) + __shfl_xor(snd, 8); }
            float mine = (b2 ? r2[1] : r2[0]) + __shfl_xor(b2 ? r2[0] : r2[1], 4);
            mine += __shfl_xor(mine, 1); mine += __shfl_xor(mine, 2);
            if ((lane & 3) == 0) { const int n = (lane >> 2) & 15; const float f = mine * rs + bfp[n]; const float lsg = fminf(f, 0.f) - log1pf(expf(-fabsf(f))); LF[(size_t)m * 16 + n] = lsg; }
        }
    }
    SEAM(6);
    if (IN(7)) {
        __syncthreads();
        LAS float* sm = (LAS float*)lds;
        for (int bh = bx; bh < 128; bh += G) {
            const int b = bh >> 4, h = bh & 15; float v[8]; float run = 0.f;
#pragma unroll
            for (int e = 0; e < 8; ++e) { run += LF[((size_t)b * SEQ + 8 * tid + e) * 16 + h]; v[e] = run; }
            float sc = run;
#pragma unroll
            for (int o = 1; o < 64; o <<= 1) { const float n = __shfl_up(sc, o); if (lane >= o) sc += n; }
            if (lane == 63) sm[wave] = sc;
            __syncthreads();
            float off = sc - run;
            for (int w = 0; w < wave; ++w) off += sm[w];
            f32x4 o0 = {(v[0] + off) * LOG2E, (v[1] + off) * LOG2E, (v[2] + off) * LOG2E, (v[3] + off) * LOG2E}, o1 = {(v[4] + off) * LOG2E, (v[5] + off) * LOG2E, (v[6] + off) * LOG2E, (v[7] + off) * LOG2E};
            *(f32x4*)(LC + (size_t)bh * SEQ + 8 * tid) = o0; *(f32x4*)(LC + (size_t)bh * SEQ + 8 * tid + 4) = o1;
            __syncthreads();
        }
        pg8::Gemm g{XN, Wt1, M, N1, 1024}; pg8::StaticOrder S; S.init(M, N1, G, bx);
        pg8::EpiBf16<0> E{Z1, 1024, nullptr, 1024, (size_t)M * 1024, 1.f, 6u, 16};
        pg8::gemm_phase<pg8::EpiBf16<0>, pg8::StaticOrder, true, true>(lds, g, S, E);
        __syncthreads();
        { pg8::Unit u; LAS float* smx = (LAS float*)lds; pg8::StaticOrder S2; S2.init(M, N1, G, bx);
          for (int i = 0; S2.next(i, u); ++i) {
            if (u.pn < 4 || u.pn >= 8) continue;
            const int b = u.pm >> 4, T0 = 4 * (u.pm & 15), h0 = 4 * (u.pn - 4);
            for (int st = 0; st < 4; ++st) {
                const bf16* kbase = Z1 + (size_t)M * 1024 + ((((size_t)(b * 16 + h0 + ((tid & 31) >> 3))) * SEQ + (size_t)(u.pm & 15) * 256 + 64 * st + (tid >> 5)) << 6) + (tid & 7) * 8;
                float mxn = 0.f;
#pragma unroll
                for (int j = 0; j < 4; ++j) {
                    const u32x4 v = *(const u32x4*)(kbase + (size_t)(16 * j) * 64);
                    float s = 0.f;
#pragma unroll
                    for (int e = 0; e < 4; ++e) { const float a = bflo(v[e]), c = bfhi(v[e]); s += a * a + c * c; }
                    s += __shfl_xor(s, 1); s += __shfl_xor(s, 2); s += __shfl_xor(s, 4);
                    mxn = fmaxf(mxn, s);
                }
                if ((tid & 7) == 0) smx[(tid >> 5) * 4 + ((tid & 31) >> 3)] = mxn;
                __syncthreads();
                if (tid < 4) { float m16 = 0.f;
#pragma unroll
                    for (int r = 0; r < 16; ++r) m16 = fmaxf(m16, smx[r * 4 + tid]);
                    TMAXB[((size_t)(b * 16 + h0 + tid)) * 64 + T0 + st] = sqrtf(m16); }
                __syncthreads();
            }
          } }
    }
    SEAM(7);
    if (IN(9)) {
        __syncthreads();
        for (;;) {
            if (tid == 0) *(volatile LAS int*)(lds + LDS_MISC + 64) = (int)atomicAdd(qctr + 64 * (8 + (bx & 7)), 1u);
            __syncthreads();
            const int tk = *(volatile LAS int*)(lds + LDS_MISC + 64);
            __syncthreads();
            if (tk >= 128) break;
            const int bh = 16 * (bx & 7) + (tk >> 3), s = tk & 7, b = bh >> 4, h = bh & 15; const size_t rb = (size_t)b * SEQ;
            AttnP p;
            p.Q = Z1 + rb * 1024 + h * 64; p.ldq = 1024; p.K = Z1 + (size_t)M * 1024 + (size_t)bh * SEQ * 64; p.ldk = 64; p.K2 = nullptr; p.ldk2 = 0; p.V = Z1 + (size_t)2 * M * 1024 + (size_t)bh * SEQ * 64; p.ldv = 64;
            p.G = Z1 + (size_t)3 * M * 1024 + rb * 1024 + h * 64; p.ldg = 1024; p.O = OG + rb * 1024 + h * 64; p.ldo = 1024; p.lc = LC + (size_t)bh * SEQ; p.tmax = TMAXB + (size_t)bh * 64; p.sinkp = args.in[8]; p.h0 = 0; p.c = 0.125f * LOG2E; p.sink2 = 0.f; p.slope2 = 0.f;
            attn_unit<64, 2>(p, (15 - s) * 256, lds); attn_unit<64, 2>(p, s * 256, lds);
        }
    }
    SEAM(9);
    if (IN(10)) {
        __syncthreads();
        for (int sub = 0; sub < 2; ++sub) {
            const size_t r0 = (size_t)sub * 16384;
            pg8::Gemm g{OG + r0 * 1024, Wout1, 16384, 1024, 1024}; pg8::StaticOrder S; S.init(16384, 1024, G, bx);
            pg8::PanelRms st{(float*)(ws + WS_LF) + (size_t)sub * 16384 * 4, (unsigned*)(ws + 64 * 1024) + sub * 64 * 64, EPS};
            pg8::EpiRmsOut E{x + r0 * 1024, D0 + r0 * 1024, out + r0 * 1024, args.in[14], 1024, st};
            pg8::gemm_phase<pg8::EpiRmsOut, pg8::StaticOrder, false, true>(lds, g, S, E);
            __syncthreads();
        }
    }
#undef IN
#undef SEAM
}

constexpr int NPHASES = 11;
extern "C" void kernel_launch(void* const* d_in, const int* in_sizes, int n_in, void* d_out, int out_size, void* d_ws, size_t ws_size, hipStream_t stream) {
    static int grid = 0;
    if (grid == 0) {
        if (n_in != 15 || out_size != M * DM || ws_size < WS_END) { fprintf(stderr, "kernel_launch: unexpected shapes (n_in %d, out %d, ws %zu)\n", n_in, out_size, ws_size); grid = -1; return; }
        int dev = 0, cus = 0, per_cu = 0;
        (void)hipGetDevice(&dev); (void)hipDeviceGetAttribute(&cus, hipDeviceAttributeMultiprocessorCount, dev);
#if MK_COOP
        (void)hipFuncSetAttribute((const void*)mk_fwd<true>, hipFuncAttributeMaxDynamicSharedMemorySize, LDS_BYTES);
        (void)hipOccupancyMaxActiveBlocksPerMultiprocessor(&per_cu, (const void*)mk_fwd<true>, NTHREADS, LDS_BYTES);
#else
        (void)hipFuncSetAttribute((const void*)mk_fwd<false>, hipFuncAttributeMaxDynamicSharedMemorySize, LDS_BYTES);
        (void)hipOccupancyMaxActiveBlocksPerMultiprocessor(&per_cu, (const void*)mk_fwd<false>, NTHREADS, LDS_BYTES);
#endif
        (void)hipGetLastError();
        if (per_cu < 1) per_cu = 1;
        if (cus <= 0) cus = 256;
        grid = cus * 1;
    }
    if (grid < 0) return;
    Args a{};
    for (int i = 0; i < 15; ++i) a.in[i] = (const float*)d_in[i];
    a.pos = (const int*)d_in[1]; a.out = (float*)d_out; a.ws = (unsigned char*)d_ws;
#if MK_COOP
    a.ph_lo = 0; a.ph_hi = NPHASES;
    void* kargs[] = {&a};
    hipError_t e = hipLaunchCooperativeKernel((const void*)mk_fwd<true>, dim3(grid), dim3(NTHREADS), kargs, LDS_BYTES, stream);
    if (e != hipSuccess) fprintf(stderr, "cooperative launch failed: %s (grid %d)\n", hipGetErrorString(e), grid);
#else
    for (int ph = 0; ph < NPHASES; ++ph) { a.ph_lo = ph; a.ph_hi = ph + 1; hipLaunchKernelGGL(mk_fwd<false>, dim3(grid), dim3(NTHREADS), LDS_BYTES, stream, a); }
#endif
}
```

```cpp
#include <hip/hip_runtime.h>
#include <hip/hip_cooperative_groups.h>
#include <cstdio>
#include <cstdint>
#include <cmath>
namespace cg = cooperative_groups;
#ifndef MK_COOP
#define MK_COOP 1
#endif
namespace pg8 {
#define PG8_LAS __attribute__((address_space(3)))
typedef unsigned short bf16_t;
typedef short bf16x8 __attribute__((ext_vector_type(8)));
typedef float f32x4 __attribute__((ext_vector_type(4)));
typedef unsigned u32x4 __attribute__((ext_vector_type(4)));
constexpr int BM = 256, BK = 64, HALF = 128, HTB = HALF * BK * 2  , STAGE_BYTES = 8 * HTB, NXCD = 8, WGM = 8;

__host__ __device__ __forceinline__ int lds_byte(int r, int c) { const int st = (r >> 4) * 2 + (c >> 5), rr = r & 15, cc = c & 31, ob = rr * 64 + cc * 2; return st * 1024 + (ob ^ (((ob >> 9) & 1) << 5)); }
__host__ __device__ __forceinline__ void stage_rc(int b, int& R, int& C) { const int st = b / 1024, sb = b % 1024, swz = sb ^ (((sb >> 9) & 1) << 5); R = (st >> 1) * 16 + swz / 64; C = (st & 1) * 32 + (swz % 64) / 2; }
__host__ __device__ __forceinline__ int perm32(int rho) { const int n = rho >> 4, i = rho & 15; return 8 * (i >> 2) + 4 * n + (i & 3); }

struct Unit { int pm, pn; };
struct Gemm { const bf16_t* A; const bf16_t* Bt; int M, N, K; };

struct StaticOrder {
    int nM, nN, nwg, G, c;
    __host__ __device__ __forceinline__ void init(int M, int N, int G_, int c_) { nM = M / BM; nN = N / BM; nwg = nM * nN; G = G_; c = c_; }
    __host__ __device__ __forceinline__ bool next(int i, Unit& u) const {
        const long L = (long)i * G + c; if (L >= nwg) return false;
        int wgid = (int)L; { const int q = nwg / NXCD, r = nwg % NXCD, xcd = wgid % NXCD, off = wgid / NXCD; wgid = (xcd < r ? xcd * (q + 1) : r * (q + 1) + (xcd - r) * q) + off; }
        const int nig = WGM * nN, gid = wgid / nig, fm = gid * WGM, gsz = (nM - fm) < WGM ? (nM - fm) : WGM;
        u.pm = fm + ((wgid % nig) % gsz); u.pn = (wgid % nig) / gsz; return true;
    }
    __device__ __forceinline__ void a_ready(const Unit&) const {}
    __device__ __forceinline__ void done(const Unit&) const {}
};

__device__ __forceinline__ unsigned cvt_pk_bf16(float lo, float hi) { unsigned r; asm volatile("v_cvt_pk_bf16_f32 %0, %1, %2" : "=v"(r) : "v"(lo), "v"(hi)); return r; }
typedef float f32x2 __attribute__((ext_vector_type(2)));
__device__ __forceinline__ f32x2 gelu_pk(f32x2 v) {
    const f32x2 av = __builtin_elementwise_abs(v), d = av * 0.2316418882f + 1.0f;
    f32x2 t; t.x = __builtin_amdgcn_rcpf(d.x); t.y = __builtin_amdgcn_rcpf(d.y);
    f32x2 q = t * 0.5307027145f + (-0.7265760135f); q = q * t + 0.7107068705f; q = q * t + (-0.142248368f); q = q * t + 0.127414796f; q = q * t;
    const f32x2 s = (v * v) * (-0.72134752044f);
    f32x2 e; e.x = __builtin_amdgcn_exp2f(s.x); e.y = __builtin_amdgcn_exp2f(s.y);
    const f32x2 m = v * (q * e), r = v - m;
    f32x2 o; o.x = v.x < 0.f ? m.x : r.x; o.y = v.y < 0.f ? m.y : r.y; return o;
}

template <int ACT  > struct EpiBf16 {
    static constexpr bool PERM = true, AFTER_DRAIN = false; static_assert(ACT == 0 || ACT == 1, "EpiBf16: ACT is 0 (none) or 1 (gelu_pk)");
    bf16_t* O; int ldc; const float* bias; int split_cols; size_t split_stride; float scale0; unsigned hm_mask; int hm_heads;
    __device__ __forceinline__ void operator()(const f32x4 (&acc)[2][2][4][2], const Unit& u, int wr, int wc, int fr, int fq) const {
        const int row0 = u.pm * BM + wr * 64 + fr; int colt = u.pn * BM; bf16_t* base = O;
        float sc = 1.f; bool hm = false; if (split_cols) { const int t = colt / split_cols; base += (size_t)t * split_stride; colt -= t * split_cols; if (t == 0) sc = scale0; hm = ((hm_mask >> t) & 1u) != 0u; }
        const int col0 = colt + wc * 32 + 8 * fq, bcol0 = u.pn * BM + wc * 32 + 8 * fq;
        f32x4 bv[2][2];
#pragma unroll
        for (int bj = 0; bj < 2; ++bj)
#pragma unroll
            for (int n = 0; n < 2; ++n) bv[bj][n] = bias ? *(const f32x4*)(bias + bcol0 + bj * HALF + 4 * n) : (f32x4){0.f, 0.f, 0.f, 0.f};
#pragma unroll
        for (int ai = 0; ai < 2; ++ai)
#pragma unroll
            for (int m = 0; m < 4; ++m) { const int rowi = row0 + ai * HALF + m * 16; bf16_t* rowp = base + (size_t)rowi * ldc + col0;
#pragma unroll
                for (int bj = 0; bj < 2; ++bj) { f32x4 v0 = acc[ai][bj][m][0] + bv[bj][0], v1 = acc[ai][bj][m][1] + bv[bj][1];
                    if (ACT == 1) { f32x2 a = gelu_pk((f32x2){v0[0], v0[1]}), b = gelu_pk((f32x2){v0[2], v0[3]}), c = gelu_pk((f32x2){v1[0], v1[1]}), d = gelu_pk((f32x2){v1[2], v1[3]});
                        v0 = (f32x4){a.x, a.y, b.x, b.y}; v1 = (f32x4){c.x, c.y, d.x, d.y}; }
                    v0 = v0 * sc; v1 = v1 * sc; u32x4 w; w.x = cvt_pk_bf16(v0[0], v0[1]); w.y = cvt_pk_bf16(v0[2], v0[3]); w.z = cvt_pk_bf16(v1[0], v1[1]); w.w = cvt_pk_bf16(v1[2], v1[3]);
                    bf16_t* dst = rowp + bj * HALF;
                    if (hm) { const int col = col0 + bj * HALF; dst = base + ((((size_t)(rowi >> 12) * hm_heads + (col >> 6)) << 18) + ((size_t)(rowi & 4095) << 6) + (col & 63)); }
                    *(u32x4*)dst = w; } }
    }
};
typedef unsigned u32x2 __attribute__((ext_vector_type(2)));
struct EpiQRope {
    static constexpr bool PERM = false, AFTER_DRAIN = false;
    bf16_t* O; int ldc; const float* cs; float qs;
    __device__ __forceinline__ void operator()(const f32x4 (&acc)[2][2][4][2], const Unit& u, int wr, int wc, int fr, int fq) const {
        const int row0 = u.pm * BM + wr * 64 + fr;
#pragma unroll
        for (int ai = 0; ai < 2; ++ai)
#pragma unroll
            for (int m = 0; m < 4; ++m) {
                const int row = row0 + ai * HALF + m * 16;
                const f32x4 cv = *(const f32x4*)(cs + (size_t)row * 32 + 4 * fq), sv = *(const f32x4*)(cs + (size_t)row * 32 + 16 + 4 * fq);
#pragma unroll
                for (int bj = 0; bj < 2; ++bj) {
                    const int colb = u.pn * BM + bj * HALF + wc * 32;
                    f32x4 v0 = acc[ai][bj][m][0], v1 = acc[ai][bj][m][1];
                    if (((colb >> 5) % 3) == 2) { const f32x4 a = v0 * cv - v1 * sv, b = v1 * cv + v0 * sv; v0 = a; v1 = b; }
                    v0 = v0 * qs; v1 = v1 * qs;
                    bf16_t* rp = O + (size_t)row * ldc + colb + 4 * fq;
                    u32x2 w0, w1; w0.x = cvt_pk_bf16(v0[0], v0[1]); w0.y = cvt_pk_bf16(v0[2], v0[3]); w1.x = cvt_pk_bf16(v1[0], v1[1]); w1.y = cvt_pk_bf16(v1[2], v1[3]);
                    *(u32x2*)(rp) = w0; *(u32x2*)(rp + 16) = w1;
                }
                asm volatile("" ::: "memory");
            }
    }
};
struct EpiResF32 {
    static constexpr bool PERM = false, AFTER_DRAIN = false;
    const float* base; float* out; int ldc;
    __device__ __forceinline__ void operator()(const f32x4 (&acc)[2][2][4][2], const Unit& u, int wr, int wc, int fr, int fq) const {
        const int row0 = u.pm * BM + wr * 64 + fr, col0 = u.pn * BM + wc * 32 + 4 * fq;
#pragma unroll
        for (int ai = 0; ai < 2; ++ai)
#pragma unroll
            for (int m = 0; m < 4; ++m) {
                const size_t off = (size_t)(row0 + ai * HALF + m * 16) * ldc + col0;
#pragma unroll
                for (int bj = 0; bj < 2; ++bj)
#pragma unroll
                    for (int n = 0; n < 2; ++n) { const f32x4 b = *(const f32x4*)(base + off + bj * HALF + n * 16); *(f32x4*)(out + off + bj * HALF + n * 16) = b + acc[ai][bj][m][n]; }
                asm volatile("" ::: "memory");
            }
    }
};
struct PanelRms {
    float* xbuf;
    unsigned* cnt;
    float eps;
    __device__ __forceinline__ void run(const f32x4 (&v)[2][2][4][2], const Unit& u, int wr, int wc, int fr, int fq, PG8_LAS unsigned char* lds, int wid, int lane) const {
        PG8_LAS float* P = (PG8_LAS float*)lds;
        PG8_LAS float* S = (PG8_LAS float*)(lds + 4096);
#pragma unroll
        for (int ai = 0; ai < 2; ++ai)
#pragma unroll
            for (int m = 0; m < 4; ++m) {
                float s = 0.f;
#pragma unroll
                for (int bj = 0; bj < 2; ++bj)
#pragma unroll
                    for (int n = 0; n < 2; ++n) { const f32x4 x = v[ai][bj][m][n]; s += (x[0] * x[0] + x[1] * x[1]) + (x[2] * x[2] + x[3] * x[3]); }
                s += __shfl_xor(s, 16); s += __shfl_xor(s, 32);
                if (fq == 0) P[(ai * HALF + wr * 64 + m * 16 + fr) * 4 + wc] = s;
            }
        asm volatile("s_waitcnt lgkmcnt(0)" ::: "memory"); __builtin_amdgcn_s_barrier(); asm volatile("" ::: "memory");
        const int row = wid * 32 + (lane & 31);
        if (lane < 32) {
            const float t = (P[row * 4 + 0] + P[row * 4 + 1]) + (P[row * 4 + 2] + P[row * 4 + 3]);
            __hip_atomic_store(xbuf + ((size_t)(u.pm * BM + row) * 4 + u.pn), t, __ATOMIC_RELAXED, __HIP_MEMORY_SCOPE_AGENT);
        }
        asm volatile("s_waitcnt vmcnt(0)" ::: "memory");
        if (lane == 0) __hip_atomic_fetch_add(cnt + 64 * u.pm, 1u, __ATOMIC_RELAXED, __HIP_MEMORY_SCOPE_AGENT);
        if (wid == 0) {
            unsigned spins = 0;
            while ((unsigned)__builtin_amdgcn_readfirstlane(__hip_atomic_load(cnt + 64 * u.pm, __ATOMIC_RELAXED, __HIP_MEMORY_SCOPE_AGENT)) < 32u) { __builtin_amdgcn_s_sleep(2); if (++spins > (1u << 20)) break; }
            __builtin_amdgcn_fence(__ATOMIC_ACQUIRE, "agent");
        }
        asm volatile("s_waitcnt vmcnt(0) lgkmcnt(0)" ::: "memory"); __builtin_amdgcn_s_barrier(); asm volatile("" ::: "memory");
        if (lane < 32) {
            const float* slot = xbuf + (size_t)(u.pm * BM + row) * 4; float q = 0.f;
#pragma unroll
            for (int t = 0; t < 4; ++t) q += __hip_atomic_load(slot + t, __ATOMIC_RELAXED, __HIP_MEMORY_SCOPE_AGENT);
            S[row] = 1.0f / sqrtf(q * (1.0f / 1024.0f) + eps);
        }
        asm volatile("s_waitcnt lgkmcnt(0)" ::: "memory"); __builtin_amdgcn_s_barrier(); asm volatile("" ::: "memory");
    }
};
struct EpiRmsOut {
    static constexpr bool PERM = false, AFTER_DRAIN = true;
    const float* base; const bf16_t* dl; float* out; const float* g; int ldc; PanelRms st;
    __device__ __forceinline__ void fused(f32x4 (&acc)[2][2][4][2], const Unit& u, int wr, int wc, int fr, int fq, PG8_LAS unsigned char* lds, int wid, int lane) const {
        const PG8_LAS float* S = (const PG8_LAS float*)(lds + 4096);
        const int col0 = u.pn * BM + wc * 32 + 4 * fq;
#pragma unroll
        for (int ai = 0; ai < 2; ++ai)
#pragma unroll
            for (int m = 0; m < 4; ++m) { const size_t off = (size_t)(u.pm * BM + ai * HALF + wr * 64 + m * 16 + fr) * ldc + col0;
#pragma unroll
                for (int bj = 0; bj < 2; ++bj)
#pragma unroll
                    for (int n = 0; n < 2; ++n) { const u32x2 dd = *(const u32x2*)(dl + off + bj * HALF + n * 16); f32x4 bv = *(const f32x4*)(base + off + bj * HALF + n * 16);
                        bv[0] += __uint_as_float(dd.x << 16); bv[1] += __uint_as_float(dd.x & 0xffff0000u); bv[2] += __uint_as_float(dd.y << 16); bv[3] += __uint_as_float(dd.y & 0xffff0000u); acc[ai][bj][m][n] += bv; }
                asm volatile("" : "+v"(acc[ai][0][m][0]), "+v"(acc[ai][0][m][1]), "+v"(acc[ai][1][m][0]), "+v"(acc[ai][1][m][1]));
                if (m & 1) asm volatile("" ::: "memory"); }
        st.run(acc, u, wr, wc, fr, fq, lds, wid, lane);
#pragma unroll
        for (int bj = 0; bj < 2; ++bj)
#pragma unroll
            for (int n = 0; n < 2; ++n) { const f32x4 gv = *(const f32x4*)(g + col0 + bj * HALF + n * 16);
#pragma unroll
                for (int ai = 0; ai < 2; ++ai)
#pragma unroll
                    for (int m = 0; m < 4; ++m) { const int r = ai * HALF + wr * 64 + m * 16 + fr; const float rs = S[r];
                        *(f32x4*)(out + (size_t)(u.pm * BM + r) * ldc + col0 + bj * HALF + n * 16) = acc[ai][bj][m][n] * rs * gv; } }
    }
};
template <class Epi, class Sched, bool ALIGN_EPI = false, bool SP2 = false>
__device__ __forceinline__ void gemm_phase(PG8_LAS unsigned char* lds, const Gemm g, const Sched& S, const Epi& E) {
    const int tid = threadIdx.x, wid = __builtin_amdgcn_readfirstlane(tid >> 6), lane = tid & 63, wr = wid >> 2, wc = wid & 3, fr = lane & 15, fq = lane >> 4;
    const int K = g.K, nt = K / BK;
    unsigned voffA[2], voffB[2];
#pragma unroll
    for (int i = 0; i < 2; ++i) { int R, C; stage_rc(tid * 16 + i * 8192, R, C); const int Rb = Epi::PERM ? ((R & ~31) + perm32(R & 31)) : R;
        voffA[i] = (unsigned)(R * K + C) * 2u; voffB[i] = (unsigned)(Rb * K + C) * 2u; }
    const size_t kstep = (size_t)(BK * 2);
    const size_t hstep = (size_t)HALF * K * 2;
    const size_t tstep = 2 * hstep;
    const unsigned ldsw = (unsigned)wid * 1024u;
    const int aoff = lds_byte(wr * 64 + fr, fq * 8), boff = lds_byte(wc * 32 + fr, fq * 8);
#define PG8_SA(b, h) (((b) * 2 + (h)) * HTB)
#define PG8_SB(b, h) ((4 + (b) * 2 + (h)) * HTB)
#define PG8_STAGE(bufoff, gbase, voff) do { _Pragma("unroll") for (int _i = 0; _i < 2; ++_i) \
        __builtin_amdgcn_global_load_lds((const unsigned*)((const char*)(gbase) + (voff)[_i]), (PG8_LAS unsigned*)(lds + (bufoff) + ldsw + _i * 8192), 16, 0, 0); } while (0)
#define PG8_LDA(dst, b, h) do { _Pragma("unroll") for (int m = 0; m < 4; ++m) _Pragma("unroll") for (int k = 0; k < 2; ++k) dst[m][k] = *(const PG8_LAS bf16x8*)(lds + PG8_SA(b, h) + aoff + m * 2048 + k * 1024); } while (0)
#define PG8_LDB(dst, b, h) do { _Pragma("unroll") for (int n = 0; n < 2; ++n) _Pragma("unroll") for (int k = 0; k < 2; ++k) dst[n][k] = *(const PG8_LAS bf16x8*)(lds + PG8_SB(b, h) + boff + n * 2048 + k * 1024); } while (0)
#define PG8_MMA(ai, bj, At, Bt) do { __builtin_amdgcn_s_setprio(1); _Pragma("unroll") for (int m = 0; m < 4; ++m) _Pragma("unroll") for (int n = 0; n < 2; ++n) _Pragma("unroll") for (int k = 0; k < 2; ++k) \
        acc[ai][bj][m][n] = __builtin_amdgcn_mfma_f32_16x16x32_bf16(Bt[n][k], At[m][k], acc[ai][bj][m][n], 0, 0, 0); __builtin_amdgcn_s_setprio(0); } while (0)
#define PG8_WAIT_V(n) asm volatile("s_waitcnt vmcnt(" #n ")" ::: "memory")
#define PG8_WAIT_L(n) asm volatile("s_waitcnt lgkmcnt(" #n ")" ::: "memory")
#define PG8_BAR __builtin_amdgcn_s_barrier()
#define PG8_SCHED __builtin_amdgcn_sched_barrier(0)
    Unit cur, nxt; int ui = 0;
    if (!S.next(0, cur)) return;
    f32x4 acc[2][2][4][2];
#pragma unroll
    for (int a = 0; a < 2; ++a)
#pragma unroll
        for (int b = 0; b < 2; ++b)
#pragma unroll
            for (int m = 0; m < 4; ++m)
#pragma unroll
                for (int n = 0; n < 2; ++n) acc[a][b][m][n] = (f32x4){0.f, 0.f, 0.f, 0.f};
    bf16x8 At[4][2], B0[2][2], B1[2][2];
    const char* cA = (const char*)g.A + (size_t)cur.pm * tstep; const char* cB = (const char*)g.Bt + (size_t)cur.pn * tstep;
    S.a_ready(cur);
    if constexpr (SP2) {
        PG8_STAGE(PG8_SB(0, 0), cB, voffB); PG8_STAGE(PG8_SB(0, 1), cB + hstep, voffB); PG8_STAGE(PG8_SA(0, 0), cA, voffA); PG8_STAGE(PG8_SA(0, 1), cA + hstep, voffA);
        if (wr == 1) PG8_BAR;
        PG8_WAIT_V(2); PG8_BAR;
        PG8_STAGE(PG8_SB(1, 0), cB + kstep, voffB); PG8_STAGE(PG8_SA(1, 0), cA + kstep, voffA); PG8_STAGE(PG8_SB(1, 1), cB + hstep + kstep, voffB);
        PG8_WAIT_V(6); PG8_BAR;
    } else {
        PG8_STAGE(PG8_SB(0, 0), cB, voffB); PG8_STAGE(PG8_SA(0, 0), cA, voffA); PG8_STAGE(PG8_SB(0, 1), cB + hstep, voffB); PG8_STAGE(PG8_SA(0, 1), cA + hstep, voffA);
        if (wr == 1) PG8_BAR;
        PG8_WAIT_V(4); PG8_BAR;
        PG8_STAGE(PG8_SB(1, 0), cB + kstep, voffB); PG8_STAGE(PG8_SA(1, 0), cA + kstep, voffA); PG8_STAGE(PG8_SB(1, 1), cB + hstep + kstep, voffB);
        PG8_WAIT_V(6); PG8_BAR;
    }
    for (;;) {
        const bool has_next = S.next(ui + 1, nxt);
        const char* nA = has_next ? (const char*)g.A + (size_t)nxt.pm * tstep : cA; const char* nB = has_next ? (const char*)g.Bt + (size_t)nxt.pn * tstep : cB;
        for (int t = 0; t < nt; t += 2) {
            const bool last = (t == nt - 2);
            const char* a1 = cA + (size_t)(t + 1) * kstep;
            const char* a2 = last ? nA : cA + (size_t)(t + 2) * kstep; const char* b2 = last ? nB : cB + (size_t)(t + 2) * kstep;
            const char* a3 = a2 + kstep; const char* b3 = b2 + kstep;
            if (last && has_next) S.a_ready(nxt);
            if constexpr (SP2) {
            PG8_LDB(B0, 0, 0); PG8_LDB(B1, 0, 1); PG8_SCHED; PG8_LDA(At, 0, 0); PG8_STAGE(PG8_SA(1, 1), a1 + hstep, voffA);
            PG8_WAIT_V(8); PG8_WAIT_L(0); PG8_BAR; PG8_MMA(0, 0, At, B0); PG8_MMA(0, 1, At, B1); PG8_BAR; PG8_SCHED;
            PG8_LDA(At, 0, 1); PG8_STAGE(PG8_SB(0, 0), b2, voffB); PG8_STAGE(PG8_SB(0, 1), b2 + hstep, voffB); PG8_STAGE(PG8_SA(0, 0), a2, voffA);
            PG8_WAIT_V(8); PG8_WAIT_L(0); PG8_BAR; PG8_MMA(1, 0, At, B0); PG8_MMA(1, 1, At, B1); PG8_BAR; PG8_SCHED;
            PG8_LDB(B0, 1, 0); PG8_LDB(B1, 1, 1); PG8_SCHED; PG8_LDA(At, 1, 0); PG8_STAGE(PG8_SA(0, 1), a2 + hstep, voffA);
            PG8_WAIT_V(8); PG8_WAIT_L(0); PG8_BAR; PG8_MMA(0, 0, At, B0); PG8_MMA(0, 1, At, B1); PG8_BAR; PG8_SCHED;
            PG8_LDA(At, 1, 1); PG8_STAGE(PG8_SB(1, 0), b3, voffB); PG8_STAGE(PG8_SB(1, 1), b3 + hstep, voffB); PG8_STAGE(PG8_SA(1, 0), a3, voffA);
            PG8_WAIT_V(8); PG8_WAIT_L(0); PG8_BAR; PG8_MMA(1, 0, At, B0); PG8_MMA(1, 1, At, B1); PG8_BAR; PG8_SCHED;
            } else {
            PG8_LDB(B0, 0, 0); PG8_SCHED; PG8_LDA(At, 0, 0); PG8_STAGE(PG8_SA(1, 1), a1 + hstep, voffA);
            PG8_WAIT_L(8); PG8_BAR; PG8_WAIT_L(0); PG8_MMA(0, 0, At, B0); PG8_BAR; PG8_SCHED;
            PG8_LDB(B1, 0, 1); PG8_STAGE(PG8_SB(0, 0), b2, voffB);
            PG8_BAR; PG8_WAIT_L(0); PG8_MMA(0, 1, At, B1); PG8_BAR;
            PG8_LDA(At, 0, 1); PG8_STAGE(PG8_SA(0, 0), a2, voffA);
            PG8_BAR; PG8_WAIT_L(0); PG8_MMA(1, 0, At, B0); PG8_BAR; PG8_SCHED;
            PG8_STAGE(PG8_SB(0, 1), b2 + hstep, voffB);
            PG8_WAIT_V(6); PG8_BAR; PG8_MMA(1, 1, At, B1); PG8_BAR;
            PG8_LDB(B0, 1, 0); PG8_SCHED; PG8_LDA(At, 1, 0); PG8_STAGE(PG8_SA(0, 1), a2 + hstep, voffA);
            PG8_WAIT_L(8); PG8_BAR; PG8_WAIT_L(0); PG8_MMA(0, 0, At, B0); PG8_BAR; PG8_SCHED;
            PG8_LDB(B1, 1, 1); PG8_STAGE(PG8_SB(1, 0), b3, voffB);
            PG8_BAR; PG8_WAIT_L(0); PG8_MMA(0, 1, At, B1); PG8_BAR;
            PG8_LDA(At, 1, 1); PG8_STAGE(PG8_SA(1, 0), a3, voffA);
            PG8_BAR; PG8_WAIT_L(0); PG8_MMA(1, 0, At, B0); PG8_BAR; PG8_SCHED;
            PG8_STAGE(PG8_SB(1, 1), b3 + hstep, voffB);
            PG8_WAIT_V(6); PG8_BAR; PG8_MMA(1, 1, At, B1); PG8_BAR;
            }
        }
        if constexpr (ALIGN_EPI) { if (wr == 0) PG8_BAR; }
        if constexpr (!Epi::AFTER_DRAIN) { E(acc, cur, wr, wc, fr, fq); S.done(cur); }
        if (!has_next) break;
#pragma unroll
        for (int a = 0; a < 2; ++a)
#pragma unroll
            for (int b = 0; b < 2; ++b)
#pragma unroll
                for (int m = 0; m < 4; ++m)
#pragma unroll
                    for (int n = 0; n < 2; ++n) acc[a][b][m][n] = (f32x4){0.f, 0.f, 0.f, 0.f};
        cur = nxt; cA = nA; cB = nB; ++ui;
        if constexpr (ALIGN_EPI) { if (wr == 1) PG8_BAR; }
    }
    PG8_WAIT_V(0);
    if constexpr (!ALIGN_EPI) { if (wr == 0) PG8_BAR; }
    PG8_BAR;
    if constexpr (Epi::AFTER_DRAIN) { E.fused(acc, cur, wr, wc, fr, fq, lds, wid, lane); S.done(cur); }
#undef PG8_SA
#undef PG8_SB
#undef PG8_STAGE
#undef PG8_LDA
#undef PG8_LDB
#undef PG8_MMA
#undef PG8_WAIT_V
#undef PG8_WAIT_L
#undef PG8_BAR
#undef PG8_SCHED
}
}
#define LAS __attribute__((address_space(3)))
typedef unsigned short bf16;
typedef short bf16x8 __attribute__((ext_vector_type(8)));
typedef float f32x16 __attribute__((ext_vector_type(16)));
typedef float f32x4 __attribute__((ext_vector_type(4)));
typedef float f32x2 __attribute__((ext_vector_type(2)));
typedef unsigned u32x4 __attribute__((ext_vector_type(4)));
typedef unsigned u32x2 __attribute__((ext_vector_type(2)));
typedef __bf16 bf16x2_t __attribute__((ext_vector_type(2)));

constexpr int BATCH = 8, SEQ = 4096, DM = 1024, M = BATCH * SEQ;
constexpr int N0 = 2208, N0P = 2304;
constexpr int C_CQ = 0, C_CKV = 256, C_KPE = 384, C_QS = 416, C_KS = 928, C_VS = 1056, C_G0 = 1184;
constexpr int N1W = 4112, N1 = 4096;
constexpr int C1_Q = 0, C1_K = 1024, C1_V = 2048, C1_G = 3072, W1_F = 3072, W1_G = 3088;
constexpr float EPS = 1e-6f, LOG2E = 1.4426950408889634f;
constexpr int NTHREADS = 512, NWAVES = 8;

constexpr size_t MiB = 1u << 20;
constexpr size_t WS_WT0 = 1 * MiB;
constexpr size_t WS_WQUP = 6 * MiB;
constexpr size_t WS_WKVUP = 7 * MiB;
constexpr size_t WS_WOUT0 = 8 * MiB;
constexpr size_t WS_WT1 = 10 * MiB;
constexpr size_t WS_WOUT1 = 18 * MiB;
constexpr size_t WS_XN = 32 * MiB;
constexpr size_t WS_OG = 96 * MiB;
constexpr size_t WS_LF = 160 * MiB;
constexpr size_t WS_LC = 162 * MiB;
constexpr size_t WS_TMAX = 512 * 1024;
constexpr size_t WS_CS = 164 * MiB;
constexpr size_t WS_Z1 = 168 * MiB;
constexpr size_t WS_Z0 = 168 * MiB;
constexpr size_t WS_CQN = 312 * MiB;
constexpr size_t WS_CKVN = 328 * MiB;
constexpr size_t WS_KPE = 344 * MiB;
constexpr size_t WS_Q0 = 346 * MiB;
constexpr size_t WS_KN = 394 * MiB;
constexpr size_t WS_VM = 426 * MiB;
constexpr size_t WS_D0 = 426 * MiB;
constexpr size_t WS_END = 490 * MiB;
constexpr int LDS_BYTES = 135168, LDS_MISC = 131072 + 1024;

__device__ __forceinline__ unsigned cvtpk(float lo, float hi) { f32x2 v = {lo, hi}; bf16x2_t b = __builtin_convertvector(v, bf16x2_t); return __builtin_bit_cast(unsigned, b); }
__device__ __forceinline__ float bflo(unsigned u) { return __uint_as_float(u << 16); }
__device__ __forceinline__ float bfhi(unsigned u) { return __uint_as_float(u & 0xffff0000u); }
__device__ __forceinline__ float bf1(bf16 v) { return __uint_as_float(((unsigned)v) << 16); }
__device__ __forceinline__ float wave_sum(float v) {
#pragma unroll
    for (int o = 1; o < 64; o <<= 1) v += __shfl_xor(v, o);
    return v;
}

struct AttnP { const bf16 *Q, *K, *K2, *V, *G; bf16* O; const float* lc; const float* tmax; const float* sinkp; int h0; int ldq, ldk, ldk2, ldv, ldg, ldo; float c, sink2, slope2; };

typedef short v4i16_t __attribute__((ext_vector_type(4)));
__device__ __forceinline__ void glds16(const void* gsrc, unsigned lds_dst) { unsigned keep;
    asm volatile("s_mov_b32 %0, m0\n\ts_mov_b32 m0, %2\n\ts_nop 0\n\tglobal_load_lds_dwordx4 %1, off\n\ts_mov_b32 m0, %0" : "=&s"(keep) : "v"(gsrc), "s"(lds_dst) : "memory"); }
__device__ __forceinline__ void glds4(const void* gsrc, unsigned lds_dst) { unsigned keep;
    asm volatile("s_mov_b32 %0, m0\n\ts_mov_b32 m0, %2\n\ts_nop 0\n\tglobal_load_lds_dword %1, off\n\ts_mov_b32 m0, %0" : "=&s"(keep) : "v"(gsrc), "s"(lds_dst) : "memory"); }

#define PSB() __builtin_amdgcn_sched_barrier(0)
__device__ __forceinline__ constexpr int pch_lo(int k, int nch) { return k * (32 / nch) + (k < (32 % nch) ? k : (32 % nch)); }
template <int LO, int HI> __device__ __forceinline__ void p_exp_range(f32x16 (&SC)[2], float& l0, float& l1) {
#pragma unroll
    for (int e = LO; e < HI; ++e) { const float y = __builtin_amdgcn_exp2f(SC[e >> 4][e & 15]); SC[e >> 4][e & 15] = y; if (e & 1) l1 += y; else l0 += y; }
}
template <int DK, int K> struct PSeg1 {
    static __device__ __forceinline__ void run(f32x16 (&SC)[2], f32x16 (&SN)[2], const bf16x8 (&kf)[2][DK / 16], const bf16x8 (&qf)[DK / 16], const f32x16& negm, float& l0, float& l1) {
        constexpr int NCH = 2 * (DK / 16);
        if constexpr (K < NCH) {
            if constexpr (K < 2) SN[K & 1] = __builtin_amdgcn_mfma_f32_32x32x16_bf16(kf[K & 1][K >> 1], qf[K >> 1], negm, 0, 0, 0);
            else SN[K & 1] = __builtin_amdgcn_mfma_f32_32x32x16_bf16(kf[K & 1][K >> 1], qf[K >> 1], SN[K & 1], 0, 0, 0);
            PSB();
            p_exp_range<pch_lo(K, NCH), pch_lo(K + 1, NCH)>(SC, l0, l1);
            PSB();
            PSeg1<DK, K + 1>::run(SC, SN, kf, qf, negm, l0, l1);
        }
    }
};
template <int K> struct PSeg2 {
    static __device__ __forceinline__ void run(f32x16 (&SC)[2], f32x16 (&SN)[2], const bf16x8 (&vf)[2][4], bf16x8 (&pk)[4], f32x16 (&ot)[2], float& mx, bool has_next) {
        if constexpr (K < 8) {
            ot[K & 1] = __builtin_amdgcn_mfma_f32_32x32x16_bf16(vf[K & 1][K >> 1], pk[K >> 1], ot[K & 1], 0, 0, 0);
            PSB();
            if constexpr ((K & 1) == 0 && K < 6) { constexpr int cc = (K >> 1) + 1, ph = cc >> 1, o = 8 * (cc & 1); u32x4 w;
                w.x = cvtpk(SC[ph][o + 0], SC[ph][o + 1]); w.y = cvtpk(SC[ph][o + 2], SC[ph][o + 3]); w.z = cvtpk(SC[ph][o + 4], SC[ph][o + 5]); w.w = cvtpk(SC[ph][o + 6], SC[ph][o + 7]);
                pk[cc] = __builtin_bit_cast(bf16x8, w); }
            if (has_next) { constexpr int e = 4 * K, ph = e >> 4, r = e & 15;
                mx = __builtin_fmaxf(__builtin_fmaxf(mx, SN[ph][r]), SN[ph][r + 1]); mx = __builtin_fmaxf(__builtin_fmaxf(mx, SN[ph][r + 2]), SN[ph][r + 3]); }
            PSB();
            PSeg2<K + 1>::run(SC, SN, vf, pk, ot, mx, has_next);
        }
    }
};
#define AT_WAITV(n) asm volatile("s_waitcnt vmcnt(%0) lgkmcnt(0)" :: "n"(n) : "memory")
template <int DK, int MODE>
__device__ __forceinline__ void attn_unit(const AttnP& p, const int q0, LAS unsigned char* lds) {
    constexpr bool SKEW = (MODE == 2);
    constexpr int NS = SKEW ? 7 : 4, KN_B = 8192, KP_B = (DK == 96) ? 4096 : 0, VHALF = 4160, V_B = 2 * VHALF, LC_B = (MODE == 2) ? 256 : 0;
    constexpr int OFF_KP = KN_B, OFF_V = KN_B + KP_B, OFF_LC = OFF_V + V_B, SLOT = OFF_LC + LC_B, OFF_FLAG = NS * SLOT;
    constexpr int NPT = 2 + ((DK == 96 || MODE == 2) ? 1 : 0);
    const int tid = threadIdx.x, lane = tid & 63, wid = __builtin_amdgcn_readfirstlane(tid >> 6), r32 = lane & 31, hi = lane >> 5;
    const int hsel = (MODE == 1) ? (wid >> 1) : 0;
    const int qw0 = q0 + 32 * ((MODE == 1) ? (wid & 1) : wid), q = qw0 + r32;
    const bf16* Qp = p.Q + hsel * 64; const bf16* Gp = p.G + hsel * 64; bf16* Op = p.O + hsel * 64;
    float sink2 = 0.f, slope2 = 0.f;
    if (MODE == 1) { const int hh = p.h0 + hsel; sink2 = p.sinkp[hh] * LOG2E; slope2 = exp2f(-(float)(hh + 1)) * LOG2E; }
    const unsigned lds0 = (unsigned)(uintptr_t)lds;
    bf16x8 qf[DK / 16];
#pragma unroll
    for (int d0 = 0; d0 < DK / 16; ++d0) qf[d0] = *(const bf16x8*)(Qp + (size_t)q * p.ldq + 16 * d0 + 8 * hi);
#pragma unroll
    for (int d0 = 0; d0 < DK / 16; ++d0) asm volatile("" : "+v"(qf[d0]));
    const int t_hi = (MODE == 1) ? (q0 >> 6) : (((q0 + 256) >> 6) - 1);
    const int t_lo = (MODE == 1) ? (((q0 >> 6) >= 2) ? (q0 >> 6) - 2 : 0) : 0;
    const int ntile = t_hi - t_lo + 1;
    const int krow = 8 * wid + (lane >> 3), kch = (lane & 7) ^ ((krow >> 1) & 7);
    const bf16* ksrc = p.K + (size_t)krow * p.ldk + kch * 8;
    const int prow = 8 * wid + ((lane & 31) >> 2), pch = (lane & 3) ^ ((prow >> 2) & 3);
    const bf16* psrc = (DK == 96) ? (p.K2 + (size_t)prow * p.ldk2 + pch * 8) : p.K;
    const int vrow = 16 * (wid & 3) + (lane >> 2);
    const bf16* vsrc = p.V + (size_t)vrow * p.ldv + ((wid >> 2) * 4 + (lane & 3)) * 8;
    const float* lsrc = (MODE == 2) ? (p.lc + 8 * wid + (lane & 7)) : (const float*)p.K;
#define AT_DMA(t, slot) do { const size_t ro_ = (size_t)(t) * 64; const unsigned sb_ = lds0 + (unsigned)((slot) * SLOT); \
        glds16(ksrc + ro_ * p.ldk, (unsigned)__builtin_amdgcn_readfirstlane(sb_ + wid * 1024)); \
        glds16(vsrc + ro_ * p.ldv, (unsigned)__builtin_amdgcn_readfirstlane(sb_ + OFF_V + (wid >> 2) * VHALF + (wid & 3) * 1024)); \
        if (DK == 96) { if (lane < 32) glds16(psrc + ro_ * p.ldk2, (unsigned)__builtin_amdgcn_readfirstlane(sb_ + OFF_KP + wid * 512)); } \
        if (MODE == 2) { if (lane < 8) glds4(lsrc + ro_, (unsigned)__builtin_amdgcn_readfirstlane(sb_ + OFF_LC + wid * 32)); } } while (0)

    float m_run = (MODE == 1) ? sink2 : -INFINITY;
    float l_run = (MODE == 1 && hi == 0) ? 1.f : 0.f;
    f32x16 ot[2];
#pragma unroll
    for (int r = 0; r < 16; ++r) { ot[0][r] = 0.f; ot[1][r] = 0.f; }
    const int pim = 16 * (r32 >> 4) + 8 * ((r32 >> 2) & 1) + 4 * ((r32 >> 3) & 1) + (r32 & 3);
    const int vrd = (8 * hi + ((lane & 15) >> 2)) * 64 + ((lane >> 4) & 1) * 32 + (lane & 3) * 8;
    int koff[4], poff[2];
#pragma unroll
    for (int d0 = 0; d0 < 4; ++d0) koff[d0] = pim * 128 + (((2 * d0 + hi) ^ ((pim >> 1) & 7)) * 16);
#pragma unroll
    for (int j = 0; j < 2; ++j) poff[j] = OFF_KP + pim * 64 + (((2 * j + hi) ^ ((pim >> 2) & 3)) * 16);
    float pmv = 0.f, lcev = 0.f, qn = 0.f;
    if (MODE == 2) {
        pmv = (lane <= t_hi) ? p.tmax[lane] : 0.f;
#pragma unroll
        for (int o = 1; o < 64; o <<= 1) { const float n = __shfl_up(pmv, o); if (lane >= o) pmv = fmaxf(pmv, n); }
        lcev = (lane <= t_hi) ? p.lc[64 * lane + 63] : 0.f;
        float qs = 0.f;
#pragma unroll
        for (int d0 = 0; d0 < DK / 16; ++d0)
#pragma unroll
            for (int e = 0; e < 8; ++e) { const float f = bf1((bf16)qf[d0][e]); qs += f * f; }
        qs += __shfl_xor(qs, 32);
        qn = sqrtf(qs) * p.c * 1.002f;
    }
    const int sk = SKEW ? (3 - (wid >> 1)) : 0;
    int sw = sk, sd = 6;
    bool done_w = false;
    if (SKEW) {
#pragma unroll
        for (int d = 0; d < 6; ++d) if (d < ntile) AT_DMA(t_hi - d, d);
    } else {
        AT_DMA(t_hi, 0);
        if (ntile > 1) AT_DMA(t_hi - 1, 1);
        if (ntile > 2) AT_DMA(t_hi - 2, 2);
    }
    const int nfirst = (MODE == 0 && ntile > 4) ? 4 : ntile;
    for (int i = 0; i < nfirst; ++i) {
        const int t = t_hi - i - sk, kv0 = t * 64, rem = SKEW ? (ntile - 1 - (i + 3)) : (ntile - 1 - i);
        if (rem >= 2) AT_WAITV(2 * NPT); else if (rem == 1) AT_WAITV(NPT); else AT_WAITV(0);
        __builtin_amdgcn_s_barrier();
        asm volatile("" ::: "memory");
        if (MODE == 2) { if (i > 0) {
            const LAS unsigned char* fp = lds + OFF_FLAG + ((i - 1) & 1) * 32;
            const u32x4 f0 = *(const LAS u32x4*)(fp), f1 = *(const LAS u32x4*)(fp + 16);
            if ((f0.x & f0.y & f0.z & f0.w & f1.x & f1.y & f1.z & f1.w) != 0u) break; } }
        if (SKEW) { if (i + 6 < ntile) AT_DMA(t_hi - (i + 6), sd); sd = (sd == 6) ? 0 : sd + 1; }
        else { if (rem >= 3) AT_DMA(t - 3, (i + 3) & 3); }
        const LAS unsigned char* sb = lds + (SKEW ? sw : (i & 3)) * SLOT;
        if (SKEW) sw = (sw == 6) ? 0 : sw + 1;
        bool act = kv0 <= qw0 + 31;
        if (MODE == 1) act = act && (kv0 + 63 >= qw0 - 127);
        if (SKEW) act = act && (t >= 0) && !done_w;
        if (act) {
            f32x16 s[2];
            {
                bf16x8 kf[2][DK / 16];
#pragma unroll
                for (int ph = 0; ph < 2; ++ph) {
#pragma unroll
                    for (int d0 = 0; d0 < 4; ++d0) kf[ph][d0] = *(const LAS bf16x8*)(sb + koff[d0] + ph * 4096);
                    if (DK == 96) {
#pragma unroll
                        for (int j = 0; j < 2; ++j) kf[ph][(DK == 96) ? 4 + j : 0] = *(const LAS bf16x8*)(sb + poff[j] + ph * 2048);
                    }
                }
#pragma unroll
                for (int r = 0; r < 16; ++r) { s[0][r] = 0.f; s[1][r] = 0.f; }
                __builtin_amdgcn_sched_barrier(0);
#pragma unroll
                for (int d0 = 0; d0 < DK / 16; ++d0) {
                    s[0] = __builtin_amdgcn_mfma_f32_32x32x16_bf16(kf[0][d0], qf[d0], s[0], 0, 0, 0);
                    s[1] = __builtin_amdgcn_mfma_f32_32x32x16_bf16(kf[1][d0], qf[d0], s[1], 0, 0, 0);
                }
                __builtin_amdgcn_sched_barrier(0);
            }
            if (MODE == 2) {
                const LAS float* lcb = (const LAS float*)(sb + OFF_LC);
#pragma unroll
                for (int ph = 0; ph < 2; ++ph)
#pragma unroll
                    for (int j = 0; j < 4; ++j) { const f32x4 lk = *(const LAS f32x4*)(lcb + 32 * ph + 16 * (j >> 1) + 8 * hi + 4 * (j & 1));
#pragma unroll
                        for (int ii = 0; ii < 4; ++ii) s[ph][4 * j + ii] = s[ph][4 * j + ii] * p.c - lk[ii]; }
            } else if (MODE == 1) {
                const float dq = (float)(q - kv0 - 8 * hi);
#pragma unroll
                for (int ph = 0; ph < 2; ++ph)
#pragma unroll
                    for (int r = 0; r < 16; ++r) { const int kk = 32 * ph + 16 * (r >> 3) + 4 * ((r >> 2) & 1) + (r & 3); s[ph][r] = s[ph][r] * p.c - slope2 * (dq - (float)kk); }
            }
            bool needmask = (kv0 + 63 > qw0);
            if (MODE == 1) needmask = needmask || (kv0 < qw0 + 31 - 127);
            if (needmask) {
                const int dqi = q - kv0 - 8 * hi;
#pragma unroll
                for (int ph = 0; ph < 2; ++ph)
#pragma unroll
                    for (int r = 0; r < 16; ++r) { const int kk = 32 * ph + 16 * (r >> 3) + 4 * ((r >> 2) & 1) + (r & 3); const int dist = dqi - kk;
                        bool ok = dist >= 0; if (MODE == 1) ok = ok && (dist < 128); s[ph][r] = ok ? s[ph][r] : -INFINITY; }
            }
            float mx = fmaxf(fmaxf(s[0][0], s[0][1]), s[0][2]);
#pragma unroll
            for (int r = 3; r < 15; r += 2) mx = fmaxf(fmaxf(mx, s[0][r]), s[0][r + 1]);
            mx = fmaxf(mx, s[0][15]);
#pragma unroll
            for (int r = 0; r < 16; r += 2) mx = fmaxf(fmaxf(mx, s[1][r]), s[1][r + 1]);
            mx = fmaxf(mx, __shfl_xor(mx, 32));
            if (MODE == 0) mx *= p.c;
            const bool dead = (MODE == 2) && __all(mx < m_run - 40.f);
            if (!dead) {
                const float m_new = fmaxf(m_run, mx);
                const float alpha = __builtin_amdgcn_exp2f(m_run - m_new);
                m_run = m_new;
                float ls0 = 0.f, ls1 = 0.f;
#pragma unroll
                for (int ph = 0; ph < 2; ++ph)
#pragma unroll
                    for (int r = 0; r < 16; r += 2) {
                        const float e0 = __builtin_amdgcn_exp2f(MODE == 0 ? (s[ph][r] * p.c - m_new) : (s[ph][r] - m_new));
                        const float e1 = __builtin_amdgcn_exp2f(MODE == 0 ? (s[ph][r + 1] * p.c - m_new) : (s[ph][r + 1] - m_new));
                        s[ph][r] = e0; s[ph][r + 1] = e1; ls0 += e0; ls1 += e1; }
                if (__any(alpha != 1.f)) {
                    l_run *= alpha;
#pragma unroll
                    for (int r = 0; r < 16; ++r) { ot[0][r] *= alpha; ot[1][r] *= alpha; }
                }
                l_run += ls0 + ls1;
                bf16x8 pk[4];
#pragma unroll
                for (int cc = 0; cc < 4; ++cc) { const int ph = cc >> 1, o = 8 * (cc & 1); u32x4 w;
                    w.x = cvtpk(s[ph][o + 0], s[ph][o + 1]); w.y = cvtpk(s[ph][o + 2], s[ph][o + 3]); w.z = cvtpk(s[ph][o + 4], s[ph][o + 5]); w.w = cvtpk(s[ph][o + 6], s[ph][o + 7]);
                    pk[cc] = __builtin_bit_cast(bf16x8, w); }
                const LAS unsigned char* vb = sb + OFF_V + vrd;
                bf16x8 vf[2][4];
#pragma unroll
                for (int dh = 0; dh < 2; ++dh)
#pragma unroll
                    for (int cc = 0; cc < 4; ++cc) {
                        const v4i16_t v0 = __builtin_amdgcn_ds_read_tr16_b64_v4i16((LAS v4i16_t*)(vb + dh * VHALF + cc * 1024));
                        const v4i16_t v1 = __builtin_amdgcn_ds_read_tr16_b64_v4i16((LAS v4i16_t*)(vb + dh * VHALF + cc * 1024 + 256));
                        vf[dh][cc] = (bf16x8){v0[0], v0[1], v0[2], v0[3], v1[0], v1[1], v1[2], v1[3]}; }
                __builtin_amdgcn_sched_barrier(0);
#pragma unroll
                for (int cc = 0; cc < 4; ++cc) {
                    ot[0] = __builtin_amdgcn_mfma_f32_32x32x16_bf16(vf[0][cc], pk[cc], ot[0], 0, 0, 0);
                    ot[1] = __builtin_amdgcn_mfma_f32_32x32x16_bf16(vf[1][cc], pk[cc], ot[1], 0, 0, 0);
                }
                __builtin_amdgcn_sched_barrier(0);
            }
        }
        if (MODE == 2) {
            bool dn = true;
            if (t >= 1) { const float bnd = qn * __shfl(pmv, t - 1) - __shfl(lcev, t - 1); dn = __all(bnd < m_run - 40.f); }
            done_w = done_w || dn;
            if (lane == 0) *(LAS unsigned*)(lds + OFF_FLAG + (i & 1) * 32 + wid * 4) = done_w ? 1u : 0u;
        }
    }
    if (MODE == 0) { if (ntile > 4) {
        f32x16 SA[2], SB[2];
        float alpha = 1.f; f32x16 negm;
#pragma unroll
        for (int r = 0; r < 16; ++r) negm[r] = -m_run;
        asm volatile("" : "+v"(negm));
#define P_UPDATE(SX, mxv) do { const float rm_ = fmaxf((mxv), __shfl_xor((mxv), 32)); alpha = 1.f; \
        if (__any(rm_ > 8.f)) { const float dl_ = (rm_ > 8.f) ? rm_ : 0.f; m_run += dl_; alpha = __builtin_amdgcn_exp2f(-dl_); \
            _Pragma("unroll") for (int r = 0; r < 16; ++r) { SX[0][r] -= dl_; SX[1][r] -= dl_; negm[r] = -m_run; } asm volatile("" : "+v"(negm)); } } while (0)
        { const int y = ((ntile - 1 < 6) ? (ntile - 1) : 6) - 4;
          if (y >= 2) AT_WAITV(2 * NPT); else if (y == 1) AT_WAITV(NPT); else AT_WAITV(0); }
        __builtin_amdgcn_s_barrier(); asm volatile("" ::: "memory");
        { const LAS unsigned char* sb = lds + (4 & 3) * SLOT;
          bf16x8 kf[2][DK / 16];
#pragma unroll
          for (int ph = 0; ph < 2; ++ph) {
#pragma unroll
              for (int d0 = 0; d0 < 4; ++d0) kf[ph][d0] = *(const LAS bf16x8*)(sb + koff[d0] + ph * 4096);
              if (DK == 96) {
#pragma unroll
                  for (int j = 0; j < 2; ++j) kf[ph][(DK == 96) ? 4 + j : 0] = *(const LAS bf16x8*)(sb + poff[j] + ph * 2048);
              }
          }
          SA[0] = __builtin_amdgcn_mfma_f32_32x32x16_bf16(kf[0][0], qf[0], negm, 0, 0, 0); SA[1] = __builtin_amdgcn_mfma_f32_32x32x16_bf16(kf[1][0], qf[0], negm, 0, 0, 0);
#pragma unroll
          for (int d0 = 1; d0 < DK / 16; ++d0) { SA[0] = __builtin_amdgcn_mfma_f32_32x32x16_bf16(kf[0][d0], qf[d0], SA[0], 0, 0, 0); SA[1] = __builtin_amdgcn_mfma_f32_32x32x16_bf16(kf[1][d0], qf[d0], SA[1], 0, 0, 0); }
          float mx = SA[0][0];
#pragma unroll
          for (int r = 1; r < 16; ++r) mx = fmaxf(mx, SA[0][r]);
#pragma unroll
          for (int r = 0; r < 16; ++r) mx = fmaxf(mx, SA[1][r]);
          P_UPDATE(SA, mx); }
#define P_STEP(SC, SN, i_) do { const int i__ = (i_); const bool has_next = (i__ + 1 < ntile); \
        if (i__ + 2 < ntile) AT_WAITV(NPT); else AT_WAITV(0);                      \
        __builtin_amdgcn_s_barrier(); asm volatile("" ::: "memory"); \
        if (i__ + 3 < ntile) AT_DMA(t_hi - (i__ + 3), (i__ + 3) & 3); \
        const LAS unsigned char* sbc_ = lds + (i__ & 3) * SLOT; const LAS unsigned char* sbn_ = lds + ((i__ + 1) & 3) * SLOT; \
        float l0_ = 0.f, l1_ = 0.f; \
        if (has_next) { \
            bf16x8 kf_[2][DK / 16]; \
            _Pragma("unroll") for (int ph = 0; ph < 2; ++ph) { \
                _Pragma("unroll") for (int d0 = 0; d0 < 4; ++d0) kf_[ph][d0] = *(const LAS bf16x8*)(sbn_ + koff[d0] + ph * 4096); \
                if (DK == 96) { _Pragma("unroll") for (int j = 0; j < 2; ++j) kf_[ph][(DK == 96) ? 4 + j : 0] = *(const LAS bf16x8*)(sbn_ + poff[j] + ph * 2048); } } \
            PSB(); \
            PSeg1<DK, 0>::run(SC, SN, kf_, qf, negm, l0_, l1_); \
        } else { p_exp_range<0, 32>(SC, l0_, l1_); } \
        if (__any(alpha != 1.f)) { l_run *= alpha; _Pragma("unroll") for (int r = 0; r < 16; ++r) { ot[0][r] *= alpha; ot[1][r] *= alpha; } } \
        l_run += l0_ + l1_; \
        { bf16x8 vf_[2][4], pk_[4]; const LAS unsigned char* vb_ = sbc_ + OFF_V + vrd; \
          _Pragma("unroll") for (int dh = 0; dh < 2; ++dh) _Pragma("unroll") for (int cc = 0; cc < 4; ++cc) { \
              const v4i16_t v0 = __builtin_amdgcn_ds_read_tr16_b64_v4i16((LAS v4i16_t*)(vb_ + dh * VHALF + cc * 1024)); \
              const v4i16_t v1 = __builtin_amdgcn_ds_read_tr16_b64_v4i16((LAS v4i16_t*)(vb_ + dh * VHALF + cc * 1024 + 256)); \
              vf_[dh][cc] = (bf16x8){v0[0], v0[1], v0[2], v0[3], v1[0], v1[1], v1[2], v1[3]}; } \
          { u32x4 w; w.x = cvtpk(SC[0][0], SC[0][1]); w.y = cvtpk(SC[0][2], SC[0][3]); w.z = cvtpk(SC[0][4], SC[0][5]); w.w = cvtpk(SC[0][6], SC[0][7]); pk_[0] = __builtin_bit_cast(bf16x8, w); } \
          float mx_ = -INFINITY; \
          PSB(); \
          PSeg2<0>::run(SC, SN, vf_, pk_, ot, mx_, has_next); \
          alpha = 1.f; if (has_next) P_UPDATE(SN, mx_); } \
    } while (0)
        for (int i = 4; i < ntile; i += 2) {
            P_STEP(SA, SB, i);
            if (i + 1 < ntile) P_STEP(SB, SA, i + 1);
        }
#undef P_STEP
#undef P_UPDATE
    } }
    AT_WAITV(0);
    __builtin_amdgcn_s_barrier();
    asm volatile("" ::: "memory");
    const float lt = l_run + __shfl_xor(l_run, 32);
    const float inv = 1.f / lt;
#pragma unroll
    for (int dh = 0; dh < 2; ++dh)
#pragma unroll
        for (int j = 0; j < 4; ++j) {
            const int d = 32 * dh + 8 * j + 4 * hi;
            const u32x2 g = *(const u32x2*)(Gp + (size_t)q * p.ldg + d);
            const float g0 = bflo(g.x), g1 = bfhi(g.x), g2 = bflo(g.y), g3 = bfhi(g.y);
            const float o0 = ot[dh][4 * j + 0] * inv * (g0 / (1.f + __expf(-g0)));
            const float o1 = ot[dh][4 * j + 1] * inv * (g1 / (1.f + __expf(-g1)));
            const float o2 = ot[dh][4 * j + 2] * inv * (g2 / (1.f + __expf(-g2)));
            const float o3 = ot[dh][4 * j + 3] * inv * (g3 / (1.f + __expf(-g3)));
            u32x2 w; w.x = cvtpk(o0, o1); w.y = cvtpk(o2, o3);
            *(u32x2*)(Op + (size_t)q * p.ldo + d) = w;
        }
#undef AT_DMA
}

#define XB_TMO      128
#define XB_XCNT(j)  (256  + 64 * (j))
#define XB_XSUB(j)  (1280 + 64 * (j))
#define XB_XGEN(j)  (2304 + 64 * (j))
#define XB_TOP      3328
#define XB_TOPGEN   3392
#define XCD_BAR_WORDS 3456
#define XB_SPIN_CAP (1u << 18)

__device__ __forceinline__ unsigned xb_ld(unsigned* p)              { return __hip_atomic_load(p, __ATOMIC_RELAXED, __HIP_MEMORY_SCOPE_AGENT); }
__device__ __forceinline__ unsigned xb_add(unsigned* p, unsigned v) { return __hip_atomic_fetch_add(p, v, __ATOMIC_RELAXED, __HIP_MEMORY_SCOPE_AGENT); }
__device__ __forceinline__ unsigned xb_xcc_id() { return (unsigned)__builtin_amdgcn_s_getreg((3 << 11) | 20) & 0xFu; }
#define XB_SPIN(cond, bar) do { unsigned _sp = 0; while (cond) { __builtin_amdgcn_s_sleep(1); \
    if ((++_sp & 255u) == 0u) { if (xb_ld(&(bar)[XB_TMO])) break; if (_sp > XB_SPIN_CAP) { atomicAdd(&(bar)[XB_TMO], 1u); break; } } } } while (0)

struct XcdBarrier {
    unsigned* bar; unsigned x;
    volatile LAS unsigned* st;
};

__device__ __forceinline__ XcdBarrier xcd_barrier_post(unsigned* bar, volatile LAS unsigned* st) {
    XcdBarrier b; b.bar = bar; b.x = xb_xcc_id(); b.st = st;
    if (threadIdx.x == 0) (void)xb_add(&bar[XB_XCNT(b.x)], 1u);
    return b;
}
__device__ __forceinline__ void xcd_barrier_complete(unsigned* bar, unsigned x, unsigned& nloc, unsigned& nx) {
    const unsigned G = gridDim.x * gridDim.y * gridDim.z;
    unsigned sum, cnt, mine, sp = 0u;
    for (;;) {
        sum = 0u; cnt = 0u; mine = 0u;
#pragma unroll
        for (unsigned j = 0; j < 16; ++j) { const unsigned c = xb_ld(&bar[XB_XCNT(j)]); sum += c; cnt += (c > 0u) ? 1u : 0u; mine = (j == x) ? c : mine; }
        if (sum == G) break;
        __builtin_amdgcn_s_sleep(1);
        if ((++sp & 255u) == 0u) { if (xb_ld(&bar[XB_TMO])) break; if (sp > XB_SPIN_CAP) { atomicAdd(&bar[XB_TMO], 1u); break; } }
    }
    nloc = mine > 0u ? mine : 1u; nx = cnt > 0u ? cnt : 1u;
}

__device__ __forceinline__ void xcd_barrier(const XcdBarrier& b) {
    asm volatile("s_waitcnt vmcnt(0)" ::: "memory");
    __syncthreads();
    if (threadIdx.x == 0) {
        unsigned* bar = b.bar;
        __builtin_amdgcn_s_waitcnt(0);
        unsigned nloc = b.st[0], nx = b.st[1];
        if (nloc == 0u) { xcd_barrier_complete(bar, b.x, nloc, nx); b.st[0] = nloc; b.st[1] = nx; }
        const unsigned old = xb_add(&bar[XB_XSUB(b.x)], 1u);
        const unsigned gen = old / nloc;
        if (old + 1u == (gen + 1u) * nloc) {
            __builtin_amdgcn_fence(__ATOMIC_RELEASE, "agent");
            asm volatile("s_waitcnt vmcnt(0)" ::: "memory");
            const unsigned og = xb_add(&bar[XB_TOP], 1u);
            const unsigned tg = og / nx;
            if (og + 1u == (tg + 1u) * nx) xb_add(&bar[XB_TOPGEN], 1u);
            else XB_SPIN(xb_ld(&bar[XB_TOPGEN]) == tg, bar);
            __builtin_amdgcn_fence(__ATOMIC_ACQUIRE, "agent");
            xb_add(&bar[XB_XGEN(b.x)], 1u);
            asm volatile("s_waitcnt vmcnt(0)" ::: "memory");
        } else {
            XB_SPIN(xb_ld(&bar[XB_XGEN(b.x)]) == gen, bar);
            __builtin_amdgcn_fence(__ATOMIC_ACQUIRE, "agent");
            asm volatile("s_waitcnt vmcnt(0)" ::: "memory");
        }
    }
    __syncthreads();
}

struct Args { const float* in[15]; const int* pos; float* out; unsigned char* ws; int ph_lo, ph_hi; };

__device__ __forceinline__ void transpose_item(const float* W, int ldw, int col0, int k0, bf16* WT, int ldt, int row_off, LAS float* scr, int lane) {
#pragma unroll 8
    for (int i = 0; i < 32; ++i) { const int kk = 2 * i + (lane >> 5); scr[kk * 33 + (lane & 31)] = W[(size_t)(k0 + kk) * ldw + col0 + (lane & 31)]; }
    asm volatile("s_waitcnt lgkmcnt(0)" ::: "memory");
    const int c = lane & 7;
#pragma unroll
    for (int j = 0; j < 4; ++j) { const int n = (lane >> 3) + 8 * j; const LAS float* s = scr + (8 * c) * 33 + n;
        u32x4 o; o.x = cvtpk(s[0 * 33], s[1 * 33]); o.y = cvtpk(s[2 * 33], s[3 * 33]); o.z = cvtpk(s[4 * 33], s[5 * 33]); o.w = cvtpk(s[6 * 33], s[7 * 33]);
        *(u32x4*)(WT + (size_t)(row_off + n) * ldt + k0 + 8 * c) = o; }
    asm volatile("s_waitcnt lgkmcnt(0)" ::: "memory");
}

__device__ __forceinline__ void rms_row_to_bf16(const float* xrow, const float* g, bf16* orow, int lane) {
    const f32x4* xr = (const f32x4*)xrow + lane; const f32x4* gr = (const f32x4*)g + lane;
    f32x4 v[4]; float s = 0.f;
#pragma unroll
    for (int j = 0; j < 4; ++j) { v[j] = xr[64 * j]; s += (v[j].x * v[j].x + v[j].y * v[j].y) + (v[j].z * v[j].z + v[j].w * v[j].w); }
    const float rs = 1.f / sqrtf(wave_sum(s) * (1.f / DM) + EPS);
    u32x2* o8 = (u32x2*)orow + lane;
#pragma unroll
    for (int j = 0; j < 4; ++j) { const f32x4 gg = gr[64 * j]; u32x2 w; w.x = cvtpk(v[j].x * rs * gg.x, v[j].y * rs * gg.y); w.y = cvtpk(v[j].z * rs * gg.z, v[j].w * rs * gg.w); o8[64 * j] = w; }
}

template <bool COOP>
__global__ void __launch_bounds__(NTHREADS, 2) mk_fwd(Args args) {
    extern __shared__ __attribute__((aligned(16))) unsigned char lds_raw[];
    LAS unsigned char* lds = (LAS unsigned char*)lds_raw;
    const int tid = threadIdx.x, lane = tid & 63, wave = __builtin_amdgcn_readfirstlane(tid >> 6);
    const int G = gridDim.x, bx = blockIdx.x;
    const int vcu = (G % 8 == 0) ? (bx % 8) * (G / 8) + bx / 8 : bx;
    const int gw = vcu * NWAVES + wave, NGW = G * NWAVES;
    unsigned char* ws = args.ws;
    const float* x = args.in[0];
    bf16* Wt0 = (bf16*)(ws + WS_WT0); bf16* Wqup = (bf16*)(ws + WS_WQUP); bf16* Wkvup = (bf16*)(ws + WS_WKVUP); bf16* Wout0 = (bf16*)(ws + WS_WOUT0);
    bf16* Wt1 = (bf16*)(ws + WS_WT1); bf16* Wout1 = (bf16*)(ws + WS_WOUT1);
    bf16* XN = (bf16*)(ws + WS_XN); bf16* OG = (bf16*)(ws + WS_OG); float* LF = (float*)(ws + WS_LF); float* LC = (float*)(ws + WS_LC); float* CS = (float*)(ws + WS_CS); float* TMAXB = (float*)(ws + WS_TMAX);
    bf16* Z0 = (bf16*)(ws + WS_Z0); bf16* Z1 = (bf16*)(ws + WS_Z1); bf16* CQN = (bf16*)(ws + WS_CQN); bf16* CKVN = (bf16*)(ws + WS_CKVN); bf16* KPE = (bf16*)(ws + WS_KPE);
    bf16* D0 = (bf16*)(ws + WS_D0); bf16* Q0 = (bf16*)(ws + WS_Q0); bf16* KN = (bf16*)(ws + WS_KN); bf16* VM = (bf16*)(ws + WS_VM);
    float* out = args.out;
    const int lo = args.ph_lo, hi_ph = args.ph_hi;
#ifndef REPMASK
#define REPMASK 0
#endif
#define NREP(k) (1 + (((REPMASK) >> (k)) & 1))
#ifndef PHMASK
#define PHMASK 0xfff
#endif
#define IN(k) ((((PHMASK) >> (k)) & 1) && lo <= (k) && (k) < hi_ph)
#define SEAM(k) do { if constexpr (COOP) { if (IN(k) && IN((k) + 1)) { if ((k) == 0) { cg::this_grid().sync(); xbar = xcd_barrier_post(barw, (volatile LAS unsigned*)(lds + LDS_MISC)); } else { xcd_barrier(xbar); } } } } while (0)
    unsigned* qctr = (unsigned*)(ws + 256 * 1024);
    unsigned* barw = (unsigned*)ws;
    XcdBarrier xbar; xbar.bar = barw; xbar.x = 0; xbar.st = (volatile LAS unsigned*)(lds + LDS_MISC);
    if constexpr (COOP) {
        if (tid < 16) ((LAS unsigned*)(lds + LDS_MISC))[tid] = 0u;
        if (bx == 0) { for (int i = tid; i < XCD_BAR_WORDS; i += NTHREADS) barw[i] = 0u; for (int i = tid; i < 16 * 64; i += NTHREADS) qctr[i] = 0u; for (int i = tid; i < 2 * 64 * 64; i += NTHREADS) ((unsigned*)(ws + 64 * 1024))[i] = 0u; }
        __syncthreads();
    }

    if (IN(0)) {
        LAS float* scr = (LAS float*)(lds + wave * 16384);
        constexpr int I_A = 16 * 69, I_B = 4 * 24, I_C = 2 * 32, I_D = 16 * 32, I_E1 = 16 * 96, I_E2 = 16 * 32, I_F = 16 * 32;
        constexpr int NIT = I_A + I_B + I_C + I_D + I_E1 + I_E2 + I_F;
        for (int it = gw; it < NIT; it += NGW) {
            int r = it;
            if (r < I_A) { const int kb = r / 69, nb = r % 69; transpose_item(args.in[3], N0, 32 * nb, 64 * kb, Wt0, 1024, 32 * nb, scr, lane); continue; } r -= I_A;
            if (r < I_B) { const int kb = r / 24, nb = r % 24; transpose_item(args.in[5], 768, 32 * nb, 64 * kb, Wqup, 256, 32 * nb, scr, lane); continue; } r -= I_B;
            if (r < I_C) { const int kb = r / 32, nb = r % 32; const int n0 = 32 * nb, h = n0 >> 7, j0 = n0 & 127; const int dst = (j0 < 64) ? (h * 64 + j0) : (512 + h * 64 + (j0 - 64));
                           transpose_item(args.in[7], 1024, n0, 64 * kb, Wkvup, 256, dst, scr, lane); continue; } r -= I_C;
            if (r < I_D) { const int kb = r / 32, nb = r % 32; transpose_item(args.in[9], 1024, 32 * nb, 64 * kb, Wout0, 1024, 32 * nb, scr, lane); continue; } r -= I_D;
            if (r < I_E1) { const int kb = r / 96, nb = r % 96; transpose_item(args.in[11], N1W, 32 * nb, 64 * kb, Wt1, 1024, 32 * nb, scr, lane); continue; } r -= I_E1;
            if (r < I_E2) { const int kb = r / 32, nb = r % 32; transpose_item(args.in[11], N1W, W1_G + 32 * nb, 64 * kb, Wt1, 1024, C1_G + 32 * nb, scr, lane); continue; } r -= I_E2;
            { const int kb = r / 32, nb = r % 32; transpose_item(args.in[13], 1024, 32 * nb, 64 * kb, Wout1, 1024, 32 * nb, scr, lane); }
        }
        { const u32x4 z = {0u, 0u, 0u, 0u};
          u32x4* p0 = (u32x4*)(Wt0 + (size_t)N0 * 1024);
          for (int i = vcu * NTHREADS + tid; i < 96 * 1024 / 8; i += G * NTHREADS) p0[i] = z;
          for (int i = vcu * NTHREADS + tid; i < 1024 * 16; i += G * NTHREADS) { const int row = i >> 4, c = i & 15; *(u32x4*)(Wkvup + (size_t)row * 256 + 128 + c * 8) = z; } }
        for (int m0 = gw; m0 < M; m0 += 4 * NGW) {
            f32x4 v[4][4]; float ss[4];
#pragma unroll
            for (int r = 0; r < 4; ++r) { const int m = m0 + r * NGW, mc = (m < M) ? m : (M - 1); const f32x4* xr = (const f32x4*)(x + (size_t)mc * DM) + lane;
#pragma unroll
                for (int j = 0; j < 4; ++j) v[r][j] = xr[64 * j]; }
#pragma unroll
            for (int r = 0; r < 4; ++r) { ss[r] = 0.f;
#pragma unroll
                for (int j = 0; j < 4; ++j) ss[r] += (v[r][j].x * v[r][j].x + v[r][j].y * v[r][j].y) + (v[r][j].z * v[r][j].z + v[r][j].w * v[r][j].w); }
#pragma unroll
            for (int o = 1; o < 64; o <<= 1) {
#pragma unroll
                for (int r = 0; r < 4; ++r) ss[r] += __shfl_xor(ss[r], o); }
            const f32x4* gr = (const f32x4*)args.in[2] + lane;
#pragma unroll
            for (int r = 0; r < 4; ++r) { const int m = m0 + r * NGW;
                if (m < M) { const float rs = 1.f / sqrtf(ss[r] * (1.f / DM) + EPS); u32x2* o8 = (u32x2*)(XN + (size_t)m * DM) + lane;
#pragma unroll
                    for (int j = 0; j < 4; ++j) { const f32x4 gg = gr[64 * j]; u32x2 w; w.x = cvtpk(v[r][j].x * rs * gg.x, v[r][j].y * rs * gg.y); w.y = cvtpk(v[r][j].z * rs * gg.z, v[r][j].w * rs * gg.w); o8[64 * j] = w; } } }
        }
    }
    SEAM(0);
    if (IN(1)) {
        __syncthreads();
        pg8::Gemm g{XN, Wt0, M, N0P, 1024}; pg8::StaticOrder S; S.init(M, N0P, G, bx);
        pg8::EpiBf16<0> E{Z0, N0P, nullptr, 0, 0, 1.f};
        for (int rep = 0; rep < NREP(1); ++rep) {
        pg8::gemm_phase<pg8::EpiBf16<0>, pg8::StaticOrder, true, true>(lds, g, S, E); __syncthreads(); }
    }
    SEAM(1);
    if (IN(2)) {
        const float* gq = args.in[4]; const float* gkv = args.in[6];
        const f32x4 ga = *(const f32x4*)(gq + 4 * lane); const f32x2 gb = *(const f32x2*)(gkv + 2 * lane);
        const float invf = (float)exp2(-(double)(lane & 15) * 0.8304820237218406);
        for (int m0 = gw; m0 < M; m0 += 4 * NGW) {
            u32x2 a[4]; unsigned bb[4]; float px1[4], px2[4]; int ps[4]; float sa[4], sb[4];
#pragma unroll
            for (int r = 0; r < 4; ++r) { const int m = m0 + r * NGW, mc = (m < M) ? m : (M - 1); const bf16* z = Z0 + (size_t)mc * N0P;
                a[r] = *(const u32x2*)(z + C_CQ + 4 * lane); bb[r] = *(const unsigned*)(z + C_CKV + 2 * lane);
                px1[r] = bf1(z[C_KPE + (lane & 15)]); px2[r] = bf1(z[C_KPE + 16 + (lane & 15)]); ps[r] = args.pos[mc]; }
#pragma unroll
            for (int r = 0; r < 4; ++r) { const float a0 = bflo(a[r].x), a1 = bfhi(a[r].x), a2 = bflo(a[r].y), a3 = bfhi(a[r].y), b0 = bflo(bb[r]), b1 = bfhi(bb[r]);
                sa[r] = (a0 * a0 + a1 * a1) + (a2 * a2 + a3 * a3); sb[r] = b0 * b0 + b1 * b1; }
#pragma unroll
            for (int o = 1; o < 64; o <<= 1) {
#pragma unroll
                for (int r = 0; r < 4; ++r) { sa[r] += __shfl_xor(sa[r], o); sb[r] += __shfl_xor(sb[r], o); } }
#pragma unroll
            for (int r = 0; r < 4; ++r) { const int m = m0 + r * NGW;
                if (m < M) {
                    const float a0 = bflo(a[r].x), a1 = bfhi(a[r].x), a2 = bflo(a[r].y), a3 = bfhi(a[r].y), b0 = bflo(bb[r]), b1 = bfhi(bb[r]);
                    const float ra = 1.f / sqrtf(sa[r] * (1.f / 256.f) + EPS), rb = 1.f / sqrtf(sb[r] * (1.f / 128.f) + EPS);
                    u32x2 w; w.x = cvtpk(a0 * ra * ga.x, a1 * ra * ga.y); w.y = cvtpk(a2 * ra * ga.z, a3 * ra * ga.w);
                    *(u32x2*)(CQN + (size_t)m * 256 + 4 * lane) = w;
                    *(unsigned*)(CKVN + (size_t)m * 256 + 2 * lane) = cvtpk(b0 * rb * gb.x, b1 * rb * gb.y);
                    *(unsigned*)(CKVN + (size_t)m * 256 + 128 + 2 * lane) = 0u;
                    if (lane < 16) {
                        const double ang = (double)(float)ps[r] * (double)invf;
                        const double rev = ang * 0.15915494309189535;
                        const float rr = (float)(rev - rint(rev));
                        const float cv = __builtin_amdgcn_cosf(rr), sv = __builtin_amdgcn_sinf(rr);
                        CS[(size_t)m * 32 + lane] = cv; CS[(size_t)m * 32 + 16 + lane] = sv;
                        const unsigned o1 = cvtpk(px1[r] * cv - px2[r] * sv, 0.f), o2 = cvtpk(px2[r] * cv + px1[r] * sv, 0.f);
                        KPE[(size_t)m * 32 + lane] = (bf16)(o1 & 0xffffu); KPE[(size_t)m * 32 + 16 + lane] = (bf16)(o2 & 0xffffu);
                    } } }
        }
    }
    SEAM(2);
    if (IN(3)) {
        __syncthreads();
#ifndef NO_QUP
        { int kq_ = 256; asm volatile("" : "+s"(kq_)); pg8::Gemm g{CQN, Wqup, M, 768, kq_}; pg8::StaticOrder S; S.init(M, 768, G, bx);
          pg8::EpiQRope E{Q0, 768, CS, 0.10206207261596575f * LOG2E};
          pg8::gemm_phase<pg8::EpiQRope, pg8::StaticOrder, true, true>(lds, g, S, E); }
#endif
        __syncthreads();
#ifndef NO_KVUP
        { int kk_ = 256; asm volatile("" : "+s"(kk_)); pg8::Gemm g{CKVN, Wkvup, M, 1024, kk_}; pg8::StaticOrder S; S.init(M, 1024, G, bx);
          pg8::EpiBf16<0> E{KN, 512, nullptr, 512, (size_t)(WS_VM - WS_KN) / 2, 1.f, 3u, 8};
          pg8::gemm_phase<pg8::EpiBf16<0>, pg8::StaticOrder, true, true>(lds, g, S, E); }
#endif
    }
    SEAM(3);
    if (IN(4)) {
        __syncthreads();
        for (;;) {
            if (tid == 0) *(volatile LAS int*)(lds + LDS_MISC + 64) = (int)atomicAdd(qctr + 64 * (bx & 7), 1u);
            __syncthreads();
            const int tk = *(volatile LAS int*)(lds + LDS_MISC + 64);
            __syncthreads();
            if (tk >= 128) break;
            const bool swa = tk >= 64;
            AttnP p; p.sinkp = args.in[8]; p.h0 = 0;
            if (!swa) {
                const int bh = 8 * (bx & 7) + (tk >> 3), s = tk & 7, b = bh >> 3, h = bh & 7; const size_t rb = (size_t)b * SEQ;
                p.Q = Q0 + rb * 768 + h * 96; p.ldq = 768; p.K = KN + (size_t)bh * SEQ * 64; p.ldk = 64; p.K2 = KPE + rb * 32; p.ldk2 = 32; p.V = VM + (size_t)bh * SEQ * 64; p.ldv = 64;
                p.G = Z0 + rb * N0P + C_G0 + h * 64; p.ldg = N0P; p.O = OG + rb * 1024 + h * 64; p.ldo = 1024; p.lc = nullptr; p.tmax = nullptr; p.c = 1.0f; p.sink2 = 0.f; p.slope2 = 0.f;
                attn_unit<96, 0>(p, (15 - s) * 256, lds); attn_unit<96, 0>(p, s * 256, lds);
            } else {
                const int j = tk - 64, pkv = 2 * (bx & 7) + (j >> 5), b = pkv >> 1, kvh = pkv & 1, qb = 2 * (j & 31); const size_t rb = (size_t)b * SEQ;
                p.Q = Z0 + rb * N0P + C_QS + kvh * 256; p.ldq = N0P; p.K = Z0 + rb * N0P + C_KS + kvh * 64; p.ldk = N0P; p.K2 = nullptr; p.ldk2 = 0; p.V = Z0 + rb * N0P + C_VS + kvh * 64; p.ldv = N0P;
                p.G = Z0 + rb * N0P + C_G0 + 512 + kvh * 256; p.ldg = N0P; p.O = OG + rb * 1024 + 512 + kvh * 256; p.ldo = 1024; p.lc = nullptr; p.tmax = nullptr; p.c = 0.125f * LOG2E;
                p.sink2 = 0.f; p.slope2 = 0.f; p.h0 = 4 * kvh;
                attn_unit<64, 1>(p, qb * 64, lds); attn_unit<64, 1>(p, (qb + 1) * 64, lds);
            }
        }
    }
    SEAM(4);
    if (IN(5)) {
        __syncthreads();
        pg8::Gemm g{OG, Wout0, M, 1024, 1024}; pg8::StaticOrder S; S.init(M, 1024, G, bx);
        pg8::EpiBf16<0> E{D0, 1024, nullptr, 0, 0, 1.f};
        pg8::gemm_phase<pg8::EpiBf16<0>, pg8::StaticOrder, true, true>(lds, g, S, E);
    }
    SEAM(5);
    if (IN(6)) {
        __syncthreads();
        const float* g1 = args.in[10]; const float* w1 = args.in[11]; const float* bfp = args.in[12];
        LAS float* WF = (LAS float*)lds;
        for (int k = tid; k < 1024; k += NTHREADS) {
            const int l = (k & 255) >> 2, j = k >> 8, e = k & 3; const int R = l + 64 * (4 * j + e); const float gk = g1[k];
#pragma unroll
            for (int c = 0; c < 4; ++c) { const f32x4 wv = *(const f32x4*)(w1 + (size_t)k * N1W + W1_F + 4 * c); *(LAS f32x4*)(WF + R * 20 + 4 * c) = wv * gk; }
        }
        __syncthreads();
        for (int m = gw; m < M; m += NGW) {
            const f32x4* xr = (const f32x4*)(x + (size_t)m * DM) + lane; const f32x4* gr = (const f32x4*)g1 + lane; const u32x2* dr = (const u32x2*)(D0 + (size_t)m * DM) + lane;
            f32x4 v[4]; float ss = 0.f;
#pragma unroll
            for (int j = 0; j < 4; ++j) { const u32x2 dd = dr[64 * j]; v[j] = xr[64 * j]; v[j].x += bflo(dd.x); v[j].y += bfhi(dd.x); v[j].z += bflo(dd.y); v[j].w += bfhi(dd.y); ss += (v[j].x * v[j].x + v[j].y * v[j].y) + (v[j].z * v[j].z + v[j].w * v[j].w); }
            const float rs = 1.f / sqrtf(wave_sum(ss) * (1.f / DM) + EPS);
            u32x2* o8 = (u32x2*)(XN + (size_t)m * DM) + lane;
            float fa[16];
#pragma unroll
            for (int n = 0; n < 16; ++n) fa[n] = 0.f;
#pragma unroll
            for (int j = 0; j < 4; ++j) { const f32x4 gg = gr[64 * j]; u32x2 w; w.x = cvtpk(v[j].x * rs * gg.x, v[j].y * rs * gg.y); w.y = cvtpk(v[j].z * rs * gg.z, v[j].w * rs * gg.w); o8[64 * j] = w;
#pragma unroll
                for (int e = 0; e < 4; ++e) { const float xv = v[j][e]; const LAS float* wr_ = WF + (lane + 64 * (4 * j + e)) * 20;
#pragma unroll
                    for (int c = 0; c < 4; ++c) { const f32x4 wv = *(const LAS f32x4*)(wr_ + 4 * c); fa[4 * c + 0] += xv * wv.x; fa[4 * c + 1] += xv * wv.y; fa[4 * c + 2] += xv * wv.z; fa[4 * c + 3] += xv * wv.w; }
                    asm volatile("" ::: "memory"); } }
            const bool b5 = (lane & 32) != 0, b4 = (lane & 16) != 0, b3 = (lane & 8) != 0, b2 = (lane & 4) != 0;
            float r8[8], r4[4], r2[2];
#pragma unroll
            for (int i = 0; i < 8; ++i) { const float snd = b5 ? fa[i] : fa[8 + i]; r8[i] = (b5 ? fa[8 + i] : fa[i]) + __shfl_xor(snd, 32); }
#pragma unroll
            for (int i = 0; i < 4; ++i) { const float snd = b4 ? r8[i] : r8[4 + i]; r4[i] = (b4 ? r8[4 + i] : r8[i]) + __shfl_xor(snd, 16); }
#pragma unroll
            for (int i = 0; i < 2; ++i) { const float snd = b3 ? r4[i] : r4[2 + i]; r2[i] = (b3 ? r4[2 + i] : r4[i]) + __shfl_xor(snd, 8); }
            float mine = (b2 ? r2[1] : r2[0]) + __shfl_xor(b2 ? r2[0] : r2[1], 4);
            mine += __shfl_xor(mine, 1); mine += __shfl_xor(mine, 2);
            if ((lane & 3) == 0) { const int n = (lane >> 2) & 15; const float f = mine * rs + bfp[n]; const float lsg = fminf(f, 0.f) - log1pf(expf(-fabsf(f))); LF[(size_t)m * 16 + n] = lsg; }
        }
    }
    SEAM(6);
    if (IN(7)) {
        __syncthreads();
        LAS float* sm = (LAS float*)lds;
        for (int bh = bx; bh < 128; bh += G) {
            const int b = bh >> 4, h = bh & 15; float v[8]; float run = 0.f;
#pragma unroll
            for (int e = 0; e < 8; ++e) { run += LF[((size_t)b * SEQ + 8 * tid + e) * 16 + h]; v[e] = run; }
            float sc = run;
#pragma unroll
            for (int o = 1; o < 64; o <<= 1) { const float n = __shfl_up(sc, o); if (lane >= o) sc += n; }
            if (lane == 63) sm[wave] = sc;
            __syncthreads();
            float off = sc - run;
            for (int w = 0; w < wave; ++w) off += sm[w];
            f32x4 o0 = {(v[0] + off) * LOG2E, (v[1] + off) * LOG2E, (v[2] + off) * LOG2E, (v[3] + off) * LOG2E}, o1 = {(v[4] + off) * LOG2E, (v[5] + off) * LOG2E, (v[6] + off) * LOG2E, (v[7] + off) * LOG2E};
            *(f32x4*)(LC + (size_t)bh * SEQ + 8 * tid) = o0; *(f32x4*)(LC + (size_t)bh * SEQ + 8 * tid + 4) = o1;
            __syncthreads();
        }
        pg8::Gemm g{XN, Wt1, M, N1, 1024}; pg8::StaticOrder S; S.init(M, N1, G, bx);
        pg8::EpiBf16<0> E{Z1, 1024, nullptr, 1024, (size_t)M * 1024, 1.f, 6u, 16};
        pg8::gemm_phase<pg8::EpiBf16<0>, pg8::StaticOrder, true, true>(lds, g, S, E);
        __syncthreads();
        { pg8::Unit u; LAS float* smx = (LAS float*)lds; pg8::StaticOrder S2; S2.init(M, N1, G, bx);
          for (int i = 0; S2.next(i, u); ++i) {
            if (u.pn < 4 || u.pn >= 8) continue;
            const int b = u.pm >> 4, T0 = 4 * (u.pm & 15), h0 = 4 * (u.pn - 4);
            for (int st = 0; st < 4; ++st) {
                const bf16* kbase = Z1 + (size_t)M * 1024 + ((((size_t)(b * 16 + h0 + ((tid & 31) >> 3))) * SEQ + (size_t)(u.pm & 15) * 256 + 64 * st + (tid >> 5)) << 6) + (tid & 7) * 8;
                float mxn = 0.f;
#pragma unroll
                for (int j = 0; j < 4; ++j) {
                    const u32x4 v = *(const u32x4*)(kbase + (size_t)(16 * j) * 64);
                    float s = 0.f;
#pragma unroll
                    for (int e = 0; e < 4; ++e) { const float a = bflo(v[e]), c = bfhi(v[e]); s += a * a + c * c; }
                    s += __shfl_xor(s, 1); s += __shfl_xor(s, 2); s += __shfl_xor(s, 4);
                    mxn = fmaxf(mxn, s);
                }
                if ((tid & 7) == 0) smx[(tid >> 5) * 4 + ((tid & 31) >> 3)] = mxn;
                __syncthreads();
                if (tid < 4) { float m16 = 0.f;
#pragma unroll
                    for (int r = 0; r < 16; ++r) m16 = fmaxf(m16, smx[r * 4 + tid]);
                    TMAXB[((size_t)(b * 16 + h0 + tid)) * 64 + T0 + st] = sqrtf(m16); }
                __syncthreads();
            }
          } }
    }
    SEAM(7);
    if (IN(9)) {
        __syncthreads();
        for (;;) {
            if (tid == 0) *(volatile LAS int*)(lds + LDS_MISC + 64) = (int)atomicAdd(qctr + 64 * (8 + (bx & 7)), 1u);
            __syncthreads();
            const int tk = *(volatile LAS int*)(lds + LDS_MISC + 64);
            __syncthreads();
            if (tk >= 128) break;
            const int bh = 16 * (bx & 7) + (tk >> 3), s = tk & 7, b = bh >> 4, h = bh & 15; const size_t rb = (size_t)b * SEQ;
            AttnP p;
            p.Q = Z1 + rb * 1024 + h * 64; p.ldq = 1024; p.K = Z1 + (size_t)M * 1024 + (size_t)bh * SEQ * 64; p.ldk = 64; p.K2 = nullptr; p.ldk2 = 0; p.V = Z1 + (size_t)2 * M * 1024 + (size_t)bh * SEQ * 64; p.ldv = 64;
            p.G = Z1 + (size_t)3 * M * 1024 + rb * 1024 + h * 64; p.ldg = 1024; p.O = OG + rb * 1024 + h * 64; p.ldo = 1024; p.lc = LC + (size_t)bh * SEQ; p.tmax = TMAXB + (size_t)bh * 64; p.sinkp = args.in[8]; p.h0 = 0; p.c = 0.125f * LOG2E; p.sink2 = 0.f; p.slope2 = 0.f;
            attn_unit<64, 2>(p, (15 - s) * 256, lds); attn_unit<64, 2>(p, s * 256, lds);
        }
    }
    SEAM(9);
    if (IN(10)) {
        __syncthreads();
        for (int sub = 0; sub < 2; ++sub) {
            const size_t r0 = (size_t)sub * 16384;
            pg8::Gemm g{OG + r0 * 1024, Wout1, 16384, 1024, 1024}; pg8::StaticOrder S; S.init(16384, 1024, G, bx);
            pg8::PanelRms st{(float*)(ws + WS_LF) + (size_t)sub * 16384 * 4, (unsigned*)(ws + 64 * 1024) + sub * 64 * 64, EPS};
            pg8::EpiRmsOut E{x + r0 * 1024, D0 + r0 * 1024, out + r0 * 1024, args.in[14], 1024, st};
            pg8::gemm_phase<pg8::EpiRmsOut, pg8::StaticOrder, false, true>(lds, g, S, E);
            __syncthreads();
        }
    }
#undef IN
#undef SEAM
}

constexpr int NPHASES = 11;
extern "C" void kernel_launch(void* const* d_in, const int* in_sizes, int n_in, void* d_out, int out_size, void* d_ws, size_t ws_size, hipStream_t stream) {
    static int grid = 0;
    if (grid == 0) {
        if (n_in != 15 || out_size != M * DM || ws_size < WS_END) { fprintf(stderr, "kernel_launch: unexpected shapes (n_in %d, out %d, ws %zu)\n", n_in, out_size, ws_size); grid = -1; return; }
        int dev = 0, cus = 0, per_cu = 0;
        (void)hipGetDevice(&dev); (void)hipDeviceGetAttribute(&cus, hipDeviceAttributeMultiprocessorCount, dev);
#if MK_COOP
        (void)hipFuncSetAttribute((const void*)mk_fwd<true>, hipFuncAttributeMaxDynamicSharedMemorySize, LDS_BYTES);
        (void)hipOccupancyMaxActiveBlocksPerMultiprocessor(&per_cu, (const void*)mk_fwd<true>, NTHREADS, LDS_BYTES);
#else
        (void)hipFuncSetAttribute((const void*)mk_fwd<false>, hipFuncAttributeMaxDynamicSharedMemorySize, LDS_BYTES);
        (void)hipOccupancyMaxActiveBlocksPerMultiprocessor(&per_cu, (const void*)mk_fwd<false>, NTHREADS, LDS_BYTES);
#endif
        (void)hipGetLastError();
        if (per_cu < 1) per_cu = 1;
        if (cus <= 0) cus = 256;
        grid = cus * 1;
    }
    if (grid < 0) return;
    Args a{};
    for (int i = 0; i < 15; ++i) a.in[i] = (const float*)d_in[i];
    a.pos = (const int*)d_in[1]; a.out = (float*)d_out; a.ws = (unsigned char*)d_ws;
#if MK_COOP
    a.ph_lo = 0; a.ph_hi = NPHASES;
    void* kargs[] = {&a};
    hipError_t e = hipLaunchCooperativeKernel((const void*)mk_fwd<true>, dim3(grid), dim3(NTHREADS), kargs, LDS_BYTES, stream);
    if (e != hipSuccess) fprintf(stderr, "cooperative launch failed: %s (grid %d)\n", hipGetErrorString(e), grid);
#else
    for (int ph = 0; ph < NPHASES; ++ph) { a.ph_lo = ph; a.ph_hi = ph + 1; hipLaunchKernelGGL(mk_fwd<false>, dim3(grid), dim3(NTHREADS), LDS_BYTES, stream, a); }
#endif
}
```
